# Optimizing an MI355X kernel written in HIP

```python
import math
import jax
import jax.numpy as jnp
from jax import lax
import numpy as np


D_MODEL = 2048
BATCH = 4
SEQ = 2048
DEPTH = 2

N_BRANCH = 4
BR_W = D_MODEL // 4
RMS_EPS = 1e-6

HY_W = BR_W
HY_SHORT = 3
HY_EMB = 33
HY_BANDS = (HY_EMB - 1) // 2
HY_ORDER = 64
HY_TARGET = 1e-2
HY_FAST = 0.3
HY_SLOW = 1.5

LRU_W = BR_W
LRU_HEADS = 8
LRU_HD = LRU_W // LRU_HEADS
LRU_CONV = 4
LRU_C = 8.0

DA_HEADS = 4
DA_HD = BR_W // (2 * DA_HEADS)
DA_QBLOCK = 128
REL_BUCKETS = 32
REL_MAX_DIST = 128

SSD_W = BR_W
SSD_HD = 64
SSD_HEADS = SSD_W // SSD_HD
SSD_GROUPS = 2
SSD_STATE = 128
SSD_CONV = 4
SSD_CHUNK = 128

N_EXPERTS = 16
EC_CAPACITY = 2
D_EXPERT = D_MODEL

HY_COLS = 3 * HY_W
LRU_COLS = 2 * LRU_W
DA_COLS = 3 * DA_HEADS * 2 * DA_HD
SSD_XBC = SSD_W + 2 * SSD_GROUPS * SSD_STATE
SSD_COLS = SSD_W + SSD_XBC + 2 * SSD_HEADS
GATE_COLS = N_BRANCH * D_MODEL
IN_COLS = HY_COLS + LRU_COLS + DA_COLS + SSD_COLS + GATE_COLS

kernel_name = 'hybrid_gated_hyena_rglru_diffattn_ssd_ecmoe'


def _rmsnorm(x, g, eps=RMS_EPS):
    xf = x.astype(jnp.float32)
    y = xf * lax.rsqrt(jnp.mean(xf * xf, axis=-1, keepdims=True) + eps)
    return (y * g.astype(jnp.float32)).astype(x.dtype)


def _dwconv_centred(x, w, b):
    k = w.shape[0]
    left = k // 2
    right = k - 1 - left
    y = lax.conv_general_dilated(x, w[:, None, :].astype(x.dtype), window_strides=(1,),
                                 padding=[(left, right)], dimension_numbers=('NWC', 'WIO', 'NWC'),
                                 feature_group_count=x.shape[-1])
    return y + b.astype(x.dtype)


def _hyena_filter(seq_len, fw1, fb1, fw2, fb2, fw3, fb3, fw4, freq):
    f32 = jnp.float32
    t = jnp.linspace(0.0, 1.0, seq_len, dtype=f32)[:, None]
    w = (2.0 * math.pi / seq_len) * jnp.arange(seq_len, dtype=f32)[:, None]
    bands = jnp.linspace(1e-4, HY_BANDS - 1, HY_BANDS, dtype=f32)[None, :]
    z = jnp.concatenate([t, jnp.cos(bands * w), -jnp.sin(bands * w)], axis=-1).astype(fw1.dtype)
    hid = jnp.sin(freq * (z @ fw1 + fb1))
    hid = jnp.sin(freq * (hid @ fw2 + fb2))
    hid = jnp.sin(freq * (hid @ fw3 + fb3))
    filt = (hid @ fw4).astype(f32)
    deltas = jnp.abs(jnp.linspace(math.log(HY_TARGET) / HY_SLOW, math.log(HY_TARGET) / HY_FAST,
                                  HY_W, dtype=f32))
    filt = filt * jnp.exp(-2.0 * jnp.abs(t - 0.5) * deltas[None, :])
    return filt / jnp.sum(jnp.abs(filt), axis=0, keepdims=True)


def _hyena_mixer(u, conv_w, conv_b, fw1, fb1, fw2, fb2, fw3, fb3, fw4, freq, fft_bias):
    _, seq_len, _ = u.shape
    x0, x1, v = jnp.split(_dwconv_centred(u, conv_w, conv_b), 3, axis=-1)
    v = (v * x1).astype(jnp.float32)
    filt = _hyena_filter(seq_len, fw1, fb1, fw2, fb2, fw3, fb3, fw4, freq)
    n_fft = 2 * seq_len
    y = jnp.fft.irfft(jnp.fft.rfft(v, n=n_fft, axis=1) * jnp.fft.rfft(filt, n=n_fft, axis=0)[None],
                      n=n_fft, axis=1)
    start = seq_len // 2
    y = y[:, start:start + seq_len] + v * fft_bias.astype(jnp.float32)
    return y.astype(u.dtype) * x0


def _linear_combine(e1, e2):
    a1, b1 = e1
    a2, b2 = e2
    return a1 * a2, a2 * b1 + b2


def _rglru_direction(xc, w_a, b_a, w_x, b_x, lam, reverse):
    bsz, seq_len, width = xc.shape
    xh = xc.reshape(bsz, seq_len, LRU_HEADS, LRU_HD)
    gate_a = jnp.einsum('blhi,hij->blhj', xh, w_a).reshape(bsz, seq_len, width) + b_a
    gate_x = jnp.einsum('blhi,hij->blhj', xh, w_x).reshape(bsz, seq_len, width) + b_x
    r = jax.nn.sigmoid(gate_a.astype(jnp.float32))
    i = jax.nn.sigmoid(gate_x.astype(jnp.float32))
    log_a = -LRU_C * r * jax.nn.softplus(-lam.astype(jnp.float32))
    a = jnp.exp(log_a)
    mult = jnp.sqrt(-jnp.expm1(2.0 * log_a))
    first = seq_len - 1 if reverse else 0
    mult = jnp.where((jnp.arange(seq_len) == first)[None, :, None], 1.0, mult)
    b = mult * i * xc.astype(jnp.float32)
    _, h = lax.associative_scan(_linear_combine, (a, b), reverse=reverse, axis=1)
    return h


def _rglru_mixer(u_x, u_gate, conv_w, conv_b, w_a, b_a, w_x, b_x, lam):
    xc = _dwconv_centred(u_x, conv_w, conv_b)
    h_f = _rglru_direction(xc, w_a[0], b_a[0], w_x[0], b_x[0], lam[0], False)
    h_b = _rglru_direction(xc, w_a[1], b_a[1], w_x[1], b_x[1], lam[1], True)
    return (h_f + h_b).astype(u_x.dtype) * jax.nn.gelu(u_gate)


def _t5_bucket(rel):
    nb = REL_BUCKETS // 2
    ret = (rel > 0).astype(jnp.int32) * nb
    n = jnp.abs(rel)
    max_exact = nb // 2
    large = max_exact + (jnp.log(jnp.maximum(n, 1).astype(jnp.float32) / max_exact)
                         / math.log(REL_MAX_DIST / max_exact) * (nb - max_exact)).astype(jnp.int32)
    large = jnp.minimum(large, nb - 1)
    return ret + jnp.where(n < max_exact, n, large)


def _diff_attention(q, k, v, lam_qk, subln_g, rel_bias, lam_init):
    bsz, seq_len, _ = q.shape
    q = q.reshape(bsz, seq_len, DA_HEADS, 2, DA_HD).transpose(0, 2, 3, 1, 4)
    k = k.reshape(bsz, seq_len, DA_HEADS, 2, DA_HD).transpose(0, 2, 3, 1, 4)
    v = v.reshape(bsz, seq_len, DA_HEADS, 2 * DA_HD).transpose(0, 2, 1, 3)
    lq = lam_qk.astype(jnp.float32)
    lam = jnp.exp(jnp.sum(lq[0] * lq[1])) - jnp.exp(jnp.sum(lq[2] * lq[3])) + lam_init
    n_blk = seq_len // DA_QBLOCK
    q_blocks = jnp.moveaxis(q.reshape(bsz, DA_HEADS, 2, n_blk, DA_QBLOCK, DA_HD), 3, 0)
    kpos = jnp.arange(seq_len)
    scale = DA_HD ** -0.5

    def block(args):
        q_blk, start = args
        qpos = start + jnp.arange(DA_QBLOCK)
        bias = rel_bias[_t5_bucket(kpos[None, :] - qpos[:, None])]
        bias = jnp.transpose(bias, (2, 0, 1)).astype(jnp.float32)
        s = jnp.einsum('bhiqd,bhikd->bhiqk', q_blk, k).astype(jnp.float32) * scale + bias[None, :, None]
        p = jax.nn.softmax(s, axis=-1)
        a = p[:, :, 0] - lam * p[:, :, 1]
        return jnp.einsum('bhqk,bhkd->bhqd', a.astype(v.dtype), v)

    o = lax.map(block, (q_blocks, jnp.arange(n_blk) * DA_QBLOCK))
    o = jnp.moveaxis(o, 0, 2).reshape(bsz, DA_HEADS, seq_len, 2 * DA_HD)
    o = _rmsnorm(o, subln_g, 1e-5) * (1.0 - lam_init)
    return o.transpose(0, 2, 1, 3).reshape(bsz, seq_len, DA_HEADS * 2 * DA_HD)


def _ssd_chunked(x, dt, a, bm, cm):
    bsz, seq_len, n_heads, hd = x.shape
    g = bm.shape[2]
    j = n_heads // g
    n = bm.shape[-1]
    q = SSD_CHUNK
    c = seq_len // q
    xd = (x.astype(jnp.float32) * dt[..., None]).reshape(bsz, c, q, g, j, hd)
    a_cum = jnp.cumsum((dt * a).reshape(bsz, c, q, g, j), axis=2)
    bc = bm.astype(jnp.float32).reshape(bsz, c, q, g, n)
    cc = cm.astype(jnp.float32).reshape(bsz, c, q, g, n)
    seg = a_cum[:, :, :, None] - a_cum[:, :, None, :]
    lower = jnp.tril(jnp.ones((q, q), dtype=bool))[:, :, None, None]
    l_mat = jnp.exp(jnp.where(lower, seg, -jnp.inf))
    cb = jnp.einsum('bclgn,bcsgn->bclsg', cc, bc)
    y_diag = jnp.einsum('bclsgj,bcsgjp->bclgjp', cb[..., None] * l_mat, xd)
    decay_s = jnp.exp(a_cum[:, :, -1:] - a_cum)
    states = jnp.einsum('bclgn,bclgjp->bcgjpn', bc, xd * decay_s[..., None])
    chunk_decay = jnp.exp(a_cum[:, :, -1])

    def step(s, inp):
        dec, st = inp
        return dec[..., None, None] * s + st, s

    s0 = jnp.zeros((bsz, g, j, hd, n), jnp.float32)
    _, prev = lax.scan(step, s0, (jnp.moveaxis(chunk_decay, 1, 0), jnp.moveaxis(states, 1, 0)))
    prev = jnp.moveaxis(prev, 0, 1)
    y_off = jnp.einsum('bclgn,bcgjpn->bclgjp', cc, prev) * jnp.exp(a_cum)[..., None]
    return (y_diag + y_off).reshape(bsz, seq_len, n_heads, hd)


def _ssd_mixer(z, xbc, dt_raw, conv_w, conv_b, dt_bias, a_log, d_skip, norm_g):
    bsz, seq_len, _ = z.shape
    xbc = jax.nn.silu(_dwconv_centred(xbc, conv_w, conv_b))
    xs, bm, cm = jnp.split(xbc, [SSD_W, SSD_W + SSD_GROUPS * SSD_STATE], axis=-1)
    xh = xs.reshape(bsz, seq_len, SSD_HEADS, SSD_HD)
    bm = bm.reshape(bsz, seq_len, SSD_GROUPS, SSD_STATE)
    cm = cm.reshape(bsz, seq_len, SSD_GROUPS, SSD_STATE)
    dts = jax.nn.softplus(dt_raw.astype(jnp.float32).reshape(bsz, seq_len, 2, SSD_HEADS)
                          + dt_bias.astype(jnp.float32))
    a = -jnp.exp(a_log.astype(jnp.float32))
    y_f = _ssd_chunked(xh, dts[:, :, 0], a[0], bm, cm)
    fl = lambda t: jnp.flip(t, axis=1)
    y_b = fl(_ssd_chunked(fl(xh), fl(dts[:, :, 1]), a[1], fl(bm), fl(cm)))
    y = y_f + y_b + d_skip.astype(jnp.float32)[:, None] * xh.astype(jnp.float32)
    y = y.reshape(bsz, seq_len, SSD_W) * jax.nn.silu(z.astype(jnp.float32))
    yg = y.reshape(bsz, seq_len, SSD_GROUPS, SSD_W // SSD_GROUPS)
    yg = yg * lax.rsqrt(jnp.mean(yg * yg, axis=-1, keepdims=True) + RMS_EPS)
    return (yg.reshape(bsz, seq_len, SSD_W) * norm_g.astype(jnp.float32)).astype(z.dtype)


def _expert_choice_ffn(h, w_router, w1, w3, w2):
    bsz, n_tok, _ = h.shape
    cap = EC_CAPACITY * n_tok // N_EXPERTS
    aff = jax.nn.softmax((h @ w_router).astype(jnp.float32), axis=-1)
    gate, idx = lax.top_k(jnp.swapaxes(aff, 1, 2), cap)
    bidx = jnp.arange(bsz)[:, None, None]
    xg = h[bidx, idx]
    hid = jax.nn.silu(jnp.einsum('becd,edf->becf', xg, w1)) * jnp.einsum('becd,edf->becf', xg, w3)
    y = jnp.einsum('becf,efd->becd', hid, w2) * gate[..., None].astype(h.dtype)
    return jnp.zeros_like(h).at[bidx, idx].add(y)


def _normal(k, shape, scale):
    return scale * jax.random.normal(k, shape, jnp.float32)


def setup_inputs(seed: int = 0) -> dict:
    key = jax.random.key(seed)
    ks = iter(jax.random.split(key, 48))
    L = DEPTH
    dt0 = jnp.exp(jax.random.uniform(next(ks), (L, 2, SSD_HEADS), jnp.float32,
                                     math.log(1e-3), math.log(1e-1)))
    u_lam = jax.random.uniform(next(ks), (L, 2, LRU_W), jnp.float32, 0.9, 0.999)
    s_lam = u_lam ** (1.0 / LRU_C)
    return {
        'x': _normal(next(ks), (BATCH, SEQ, D_MODEL), 1.0),
        'norm1_g': 1.0 + _normal(next(ks), (L, D_MODEL), 0.05),
        'w_in': _normal(next(ks), (L, D_MODEL, IN_COLS), D_MODEL ** -0.5),
        'hy_conv_w': _normal(next(ks), (L, HY_SHORT, HY_COLS), HY_SHORT ** -0.5),
        'hy_conv_b': _normal(next(ks), (L, HY_COLS), 0.02),
        'hy_fw1': _normal(next(ks), (L, HY_EMB, HY_ORDER), HY_EMB ** -0.5),
        'hy_fb1': _normal(next(ks), (L, HY_ORDER), 0.1),
        'hy_fw2': _normal(next(ks), (L, HY_ORDER, HY_ORDER), HY_ORDER ** -0.5),
        'hy_fb2': _normal(next(ks), (L, HY_ORDER), 0.1),
        'hy_fw3': _normal(next(ks), (L, HY_ORDER, HY_ORDER), HY_ORDER ** -0.5),
        'hy_fb3': _normal(next(ks), (L, HY_ORDER), 0.1),
        'hy_fw4': _normal(next(ks), (L, HY_ORDER, HY_W), HY_ORDER ** -0.5),
        'hy_freq': 1.0 + _normal(next(ks), (L, HY_ORDER), 0.1),
        'hy_bias': _normal(next(ks), (L, HY_W), 1.0),
        'lru_conv_w': _normal(next(ks), (L, LRU_CONV, LRU_W), LRU_CONV ** -0.5),
        'lru_conv_b': _normal(next(ks), (L, LRU_W), 0.02),
        'lru_wa': _normal(next(ks), (L, 2, LRU_HEADS, LRU_HD, LRU_HD), LRU_HD ** -0.5),
        'lru_ba': _normal(next(ks), (L, 2, LRU_W), 0.02),
        'lru_wx': _normal(next(ks), (L, 2, LRU_HEADS, LRU_HD, LRU_HD), LRU_HD ** -0.5),
        'lru_bx': _normal(next(ks), (L, 2, LRU_W), 0.02),
        'lru_lam': jnp.log(s_lam) - jnp.log1p(-s_lam),
        'da_lam': _normal(next(ks), (L, 4, DA_HD), 0.1),
        'da_subln_g': 1.0 + _normal(next(ks), (L, 2 * DA_HD), 0.05),
        'ssd_conv_w': _normal(next(ks), (L, SSD_CONV, SSD_XBC), SSD_CONV ** -0.5),
        'ssd_conv_b': _normal(next(ks), (L, SSD_XBC), 0.02),
        'ssd_dt_bias': dt0 + jnp.log(-jnp.expm1(-dt0)),
        'ssd_a_log': jnp.log(jax.random.uniform(next(ks), (L, 2, SSD_HEADS), jnp.float32, 1.0, 16.0)),
        'ssd_d': 1.0 + _normal(next(ks), (L, SSD_HEADS), 0.1),
        'ssd_norm_g': 1.0 + _normal(next(ks), (L, SSD_W), 0.05),
        'w_branch': _normal(next(ks), (L, N_BRANCH, BR_W, D_MODEL), BR_W ** -0.5),
        'b_gate': _normal(next(ks), (L, N_BRANCH, D_MODEL), 0.02),
        'w_out': _normal(next(ks), (L, D_MODEL, D_MODEL), D_MODEL ** -0.5),
        'norm2_g': 1.0 + _normal(next(ks), (L, D_MODEL), 0.05),
        'w_router': _normal(next(ks), (L, D_MODEL, N_EXPERTS), D_MODEL ** -0.5),
        'moe_w1': _normal(next(ks), (L, N_EXPERTS, D_MODEL, D_EXPERT), D_MODEL ** -0.5),
        'moe_w3': _normal(next(ks), (L, N_EXPERTS, D_MODEL, D_EXPERT), D_MODEL ** -0.5),
        'moe_w2': _normal(next(ks), (L, N_EXPERTS, D_EXPERT, D_MODEL), D_EXPERT ** -0.5),
        'rel_bias': _normal(next(ks), (REL_BUCKETS, DA_HEADS), 0.5),
        'final_g': 1.0 + _normal(next(ks), (D_MODEL,), 0.05),
    }


def reference(x, norm1_g, w_in, hy_conv_w, hy_conv_b, hy_fw1, hy_fb1, hy_fw2, hy_fb2, hy_fw3, hy_fb3,
              hy_fw4, hy_freq, hy_bias, lru_conv_w, lru_conv_b, lru_wa, lru_ba, lru_wx, lru_bx, lru_lam,
              da_lam, da_subln_g, ssd_conv_w, ssd_conv_b, ssd_dt_bias, ssd_a_log, ssd_d, ssd_norm_g,
              w_branch, b_gate, w_out, norm2_g, w_router, moe_w1, moe_w3, moe_w2, rel_bias, final_g):
    bsz, seq_len, d_model = x.shape
    o1 = HY_COLS
    o2 = o1 + LRU_COLS
    o3 = o2 + DA_COLS
    o4 = o3 + SSD_COLS
    for l in range(DEPTH):
        h = _rmsnorm(x, norm1_g[l])
        proj = h @ w_in[l]
        p_hy, p_lru, p_da, p_ssd, p_gate = jnp.split(proj, [o1, o2, o3, o4], axis=-1)
        o_hy = _hyena_mixer(p_hy, hy_conv_w[l], hy_conv_b[l], hy_fw1[l], hy_fb1[l], hy_fw2[l], hy_fb2[l],
                            hy_fw3[l], hy_fb3[l], hy_fw4[l], hy_freq[l], hy_bias[l])
        lru_x, lru_gate = jnp.split(p_lru, 2, axis=-1)
        o_lru = _rglru_mixer(lru_x, lru_gate, lru_conv_w[l], lru_conv_b[l], lru_wa[l], lru_ba[l],
                             lru_wx[l], lru_bx[l], lru_lam[l])
        q, k, v = jnp.split(p_da, 3, axis=-1)
        lam_init = 0.8 - 0.6 * math.exp(-0.3 * l)
        o_da = _diff_attention(q, k, v, da_lam[l], da_subln_g[l], rel_bias, lam_init)
        z, xbc, dt_raw = jnp.split(p_ssd, [SSD_W, SSD_W + SSD_XBC], axis=-1)
        o_ssd = _ssd_mixer(z, xbc, dt_raw, ssd_conv_w[l], ssd_conv_b[l], ssd_dt_bias[l], ssd_a_log[l],
                           ssd_d[l], ssd_norm_g[l])
        branches = jnp.stack([o_hy, o_lru, o_da, o_ssd], axis=2)
        gates = jax.nn.sigmoid(p_gate.reshape(bsz, seq_len, N_BRANCH, d_model) + b_gate[l])
        merged = jnp.sum(gates * jnp.einsum('blkc,kcd->blkd', branches, w_branch[l]), axis=2)
        x = x + merged @ w_out[l]
        x = x + _expert_choice_ffn(_rmsnorm(x, norm2_g[l]), w_router[l], moe_w1[l], moe_w3[l], moe_w2[l])
    return _rmsnorm(x, final_g)
```

```cpp
#include <hip/hip_runtime.h>
#include <math.h>
#include <stdint.h>
#include <stdio.h>

#define NB_ 4
#define SEQ_ 2048
#define DM_ 2048
#define TT_ 8192
#define INC_ 13840
#define O_HY 0
#define O_LRU 1536
#define O_DA 2560
#define O_SSD 4096
#define O_GATE 5648
typedef short bf16x8 __attribute__((ext_vector_type(8)));
typedef float f32x4 __attribute__((ext_vector_type(4)));
typedef float f32x2 __attribute__((ext_vector_type(2)));
typedef int i32x4 __attribute__((ext_vector_type(4)));
typedef unsigned short bf16_t;
__device__ __forceinline__ int bid_opaque();
__device__ __forceinline__ int grid_n();

typedef __bf16 bf16x2_t __attribute__((ext_vector_type(2)));
__device__ __forceinline__ unsigned cvt_pk_bf16(float lo, float hi) { const f32x2 v = {lo, hi}; return __builtin_bit_cast(unsigned, __builtin_convertvector(v, bf16x2_t)); }
__device__ __forceinline__ int tid_opaque() { int t = (int)__builtin_amdgcn_workitem_id_x(); asm volatile("" : "+v"(t)); return t; }
__device__ __forceinline__ float bf2f(bf16_t v) { return __uint_as_float((unsigned)v << 16); }
__device__ __forceinline__ bf16_t f2bf(float f) { return (bf16_t)(cvt_pk_bf16(f, 0.f) & 0xffffu); }

__device__ __forceinline__ int lds_rc(int r, int chunk) { return r * 128 + ((chunk ^ ((r >> 1) & 7)) << 4); }
#define GEMM_LDS_BYTES(BM) (2 * ((BM) * 128 + 256 * 128))
#ifndef GEMM_L2PF
#define GEMM_L2PF 0
#endif
#ifndef GEMM_BT_AH
#define GEMM_BT_AH 8
#endif

#define GEMM_KTILE(buf, HOOK) do { const char* sS = shm + (buf) * STAGE; bf16x8 Bc[4], Bn[4], Ar[4]; \
        _Pragma("unroll") for (int n = 0; n < 4; ++n) Bc[n] = *(const bf16x8*)(sS + broff0 + n * 2048); \
        _Pragma("unroll") for (int q = 0; q < 3; ++q) Ar[q] = *(const bf16x8*)(sS + aroff0 + q * 2048); \
        __builtin_amdgcn_sched_barrier(0); \
        _Pragma("unroll") for (int g = 0; g < 2 * FM; ++g) { \
            if (g + 3 < 2 * FM) Ar[(g + 3) & 3] = *(const bf16x8*)(sS + ((g + 3) / FM ? aroff1 : aroff0) + ((g + 3) % FM) * 2048); \
            if (g == FM - 4) { _Pragma("unroll") for (int n = 0; n < 4; ++n) Bn[n] = *(const bf16x8*)(sS + broff1 + n * 2048); } \
            __builtin_amdgcn_sched_barrier(0); \
            _Pragma("unroll") for (int n = 0; n < 4; ++n) acc[g % FM][n] = __builtin_amdgcn_mfma_f32_16x16x32_bf16(Ar[g & 3], (g < FM ? Bc[n] : Bn[n]), acc[g % FM][n], 0, 0, 0); \
            HOOK(g); \
            __builtin_amdgcn_sched_barrier(0); } } while (0)
template <int BM, bool DUAL>
struct GemmCore {
    static constexpr int FM = BM / 32;
    static constexpr int GLA = BM * 128 / 8192;
    static constexpr int TILE_A = BM * 128, TILE_B = 256 * 128, STAGE = TILE_A + TILE_B;

    template <class AccT>
    static __device__ __forceinline__ void run(char* shm, const char* abase, const unsigned (&aoff)[GLA], const char* bl, unsigned ldb, int nt, AccT& acc) {
        const int tid = tid_opaque(), wid = tid >> 6, lane = tid & 63, wr = wid >> 2, wc = wid & 3, fr = lane & 15, fq = lane >> 4;
        const int kq = lane & 3, ngl = lane >> 2, ksub = wid & 1, grp = wid >> 1;
        i32x4 sa[GLA];
        f32x4 sb[8];
        const int awoff = lds_rc(tid >> 3, tid & 7);
        const int bwoff = TILE_A + lds_rc(grp * 64 + ngl, ksub * 4 + kq);
        const int aroff0 = lds_rc(wr * (BM / 2) + fr, fq), aroff1 = lds_rc(wr * (BM / 2) + fr, 4 + fq);
        const int broff0 = TILE_A + lds_rc(wc * 64 + fr, fq), broff1 = TILE_A + lds_rc(wc * 64 + fr, 4 + fq);
#define G_ISSUE(kt) do { const char* ab_ = abase + (size_t)(kt) * 128; _Pragma("unroll") for (int i = 0; i < GLA; ++i) sa[i] = *(const i32x4*)(ab_ + aoff[i]); \
        _Pragma("unroll") for (int r = 0; r < 8; ++r) sb[r] = *(const f32x4*)(bl + (size_t)((kt) * 64 + r) * ldb); \
        __builtin_amdgcn_sched_barrier(0); } while (0)
#define G_WRITE(buf) do { char* sbase = shm + (buf) * STAGE; _Pragma("unroll") for (int i = 0; i < GLA; ++i) *(i32x4*)(sbase + awoff + i * 8192) = sa[i]; \
        _Pragma("unroll") for (int i = 0; i < 4; ++i) { i32x4 w; w[0] = (int)cvt_pk_bf16(sb[0][i], sb[1][i]); w[1] = (int)cvt_pk_bf16(sb[2][i], sb[3][i]); \
              w[2] = (int)cvt_pk_bf16(sb[4][i], sb[5][i]); w[3] = (int)cvt_pk_bf16(sb[6][i], sb[7][i]); *(i32x4*)(sbase + bwoff + i * 2048) = w; } } while (0)
        G_ISSUE(0); G_WRITE(0); if (nt > 1) G_ISSUE(1); __syncthreads();
        for (int t = 0; t < nt; ++t) {
            const int cur = t & 1; const bool w_ok = t + 1 < nt, i_ok = t + 2 < nt;
            char* wb_ = shm + (cur ^ 1) * STAGE; const char* ab2_ = abase + (size_t)(t + 2) * 128; const char* bl2_ = bl + (size_t)(t + 2) * 64 * ldb;
#define G_HOOK(g) do { if ((g) < GLA) { if (w_ok) *(i32x4*)(wb_ + awoff + (g) * 8192) = sa[(g)]; if (i_ok) sa[(g)] = *(const i32x4*)(ab2_ + aoff[(g)]); } \
            else if ((g) >= 8 && (g) < 12) { if (w_ok) { const int i = (g) - 8; i32x4 w; w[0] = (int)cvt_pk_bf16(sb[0][i], sb[1][i]); w[1] = (int)cvt_pk_bf16(sb[2][i], sb[3][i]); \
                  w[2] = (int)cvt_pk_bf16(sb[4][i], sb[5][i]); w[3] = (int)cvt_pk_bf16(sb[6][i], sb[7][i]); *(i32x4*)(wb_ + bwoff + i * 2048) = w; } } \
            else if ((g) >= 12) { if (i_ok) { const int r = ((g) - 12) * 2; sb[r] = *(const f32x4*)(bl2_ + (size_t)r * ldb); sb[r + 1] = *(const f32x4*)(bl2_ + (size_t)(r + 1) * ldb); } } } while (0)
            GEMM_KTILE(cur, G_HOOK);
#undef G_HOOK
            __syncthreads();
        }
#undef G_ISSUE
#undef G_WRITE
    }
    struct NoEpi { __device__ __forceinline__ void operator()(int) const {} };
    template <class AccT>
    static __device__ __forceinline__ void run_bt(char* shm, const char* abase, const unsigned (&aoff)[GLA], const char* bbase, const unsigned (&boff)[4], unsigned ldbt, const char* pf_in, int nt, AccT& acc) {
        run_bt_seg<1 << 20>(shm, abase, aoff, bbase, boff, ldbt, 0, pf_in, nt, acc, NoEpi());
    }
    template <int SEG, class AccT, class Epi>
    static __device__ __forceinline__ void run_bt_seg(char* shm, const char* abase, const unsigned (&aoff)[GLA], const char* bbase, const unsigned (&boff)[4], unsigned ldbt, size_t segstride, const char* pf_in, int nt, AccT& acc, Epi seg_epi) {
        const int tid = tid_opaque(), wid = tid >> 6, lane = tid & 63, wr = wid >> 2, wc = wid & 3, fr = lane & 15, fq = lane >> 4;
        i32x4 sa[GLA], sbt[4];
        const unsigned astr = 64u * DM_ * 2u, bstr = 64u * ldbt;
        const int awoff = lds_rc(tid >> 3, tid & 7);
        const int aroff0 = lds_rc(wr * (BM / 2) + fr, fq), aroff1 = lds_rc(wr * (BM / 2) + fr, 4 + fq);
        const int broff0 = TILE_A + lds_rc(wc * 64 + fr, fq), broff1 = TILE_A + lds_rc(wc * 64 + fr, 4 + fq);
#define T_ISSUE(kt) do { const char* ab_ = abase + (size_t)(kt) * 128 + aoff[0]; const char* bb_ = bbase + (size_t)((kt) / SEG) * segstride + (size_t)((kt) % SEG) * 128 + boff[0]; \
        _Pragma("unroll") for (int i = 0; i < GLA; ++i) sa[i] = *(const i32x4*)(ab_ + (size_t)i * astr); \
        _Pragma("unroll") for (int i = 0; i < 4; ++i) sbt[i] = *(const i32x4*)(bb_ + (size_t)i * bstr); \
        __builtin_amdgcn_sched_barrier(0); } while (0)
#define T_WRITE(buf) do { char* sbase = shm + (buf) * STAGE; _Pragma("unroll") for (int i = 0; i < GLA; ++i) *(i32x4*)(sbase + awoff + i * 8192) = sa[i]; \
        _Pragma("unroll") for (int i = 0; i < 4; ++i) *(i32x4*)(sbase + TILE_A + awoff + i * 8192) = sbt[i]; } while (0)
        const unsigned long long pf0 = (unsigned long long)pf_in;
        const unsigned long long pfu = ((unsigned long long)(unsigned)__builtin_amdgcn_readfirstlane((int)(pf0 >> 32)) << 32) | (unsigned)__builtin_amdgcn_readfirstlane((int)(unsigned)pf0);
        const char* pf = (const char*)pfu; const unsigned pfo = (unsigned)(pf0 - pfu);
        unsigned pfa = 0u, pfb = 0u;
        T_ISSUE(0); T_WRITE(0); if (nt > 1) T_ISSUE(1);
#if GEMM_L2PF
        if (nt > 2) pfa = *(const unsigned*)(pf + 2 * 128 + pfo);
#endif
        __syncthreads();
        for (int t = 0; t < nt; ++t) {
            const int cur = t & 1;
            const bool w_ok = t + 1 < nt, i_ok = t + 2 < nt;
            char* wb_ = shm + (cur ^ 1) * STAGE; const char* ab2_ = abase + (size_t)(t + 2) * 128 + aoff[0];
            const char* bb2_ = bbase + (size_t)((t + 2) / SEG) * segstride + (size_t)((t + 2) % SEG) * 128 + boff[0];
#define T_HOOK(g) do { if ((g) < GLA) { if (w_ok) *(i32x4*)(wb_ + awoff + (g) * 8192) = sa[(g)]; if (i_ok) sa[(g)] = *(const i32x4*)(ab2_ + (size_t)(g) * astr); } \
            else if ((g) < GLA + 4) { const int i = (g) - GLA; if (w_ok) *(i32x4*)(wb_ + TILE_A + awoff + i * 8192) = sbt[i]; if (i_ok) sbt[i] = *(const i32x4*)(bb2_ + (size_t)i * bstr); } } while (0)
#if GEMM_L2PF
            if (t + 3 < nt) pfb = *(const unsigned*)(pf + (size_t)(t + 3) * 128 + pfo);
            asm volatile("" :: "v"(pfa));
            pfa = pfb;
#endif
            GEMM_KTILE(cur, T_HOOK);
#undef T_HOOK
            __syncthreads();
            if ((t % SEG) == SEG - 1) seg_epi(t / SEG);
        }
#undef T_ISSUE
#undef T_WRITE
    }
    static __device__ __forceinline__ void bt_coord(int tid, int i, int& col, int& C) { const int R = (tid >> 3) + 64 * i; C = (tid & 7) * 8;
        col = (R & ~63) + 4 * (R & 15) + ((R >> 4) & 3); }
    static __device__ __forceinline__ void a_coord(int tid, int i, int& R, int& C) { R = (tid >> 3) + 64 * i; C = (tid & 7) * 8; }
    static __device__ __forceinline__ void b_coord(int tid, int& k, int& col, int& which) { const int wid = tid >> 6, lane = tid & 63; const int kq = lane & 3, ngl = lane >> 2, ksub = wid & 1, grp = wid >> 1;
        k = ksub * 32 + kq * 8; if (DUAL) { which = ngl >> 3; col = grp * 32 + 4 * (ngl & 7); } else { which = 0; col = grp * 64 + 4 * ngl; } }
};
#define PROJW 5632
typedef unsigned u32x2_t __attribute__((ext_vector_type(2)));
__device__ __forceinline__ float rows_sum(float x) {
    u32x2_t r = __builtin_amdgcn_permlane16_swap(__float_as_uint(x), __float_as_uint(x), false, false); x = __uint_as_float(r[0]) + __uint_as_float(r[1]);
    r = __builtin_amdgcn_permlane32_swap(__float_as_uint(x), __float_as_uint(x), false, false); return __uint_as_float(r[0]) + __uint_as_float(r[1]);
}
__device__ __forceinline__ float rows_max(float x) {
    u32x2_t r = __builtin_amdgcn_permlane16_swap(__float_as_uint(x), __float_as_uint(x), false, false); x = fmaxf(__uint_as_float(r[0]), __uint_as_float(r[1]));
    r = __builtin_amdgcn_permlane32_swap(__float_as_uint(x), __float_as_uint(x), false, false); return fmaxf(__uint_as_float(r[0]), __uint_as_float(r[1]));
}
__device__ __forceinline__ float sigmoidf_(float x) { return 1.0f / (1.0f + expf(-x)); }
__device__ __forceinline__ float siluf_(float x) { return x / (1.0f + expf(-x)); }
__device__ __forceinline__ float softplusf_(float x) { return x > 20.f ? x : log1pf(expf(x)); }
__device__ __forceinline__ float sigmoid_fast_(float x) { return __builtin_amdgcn_rcpf(1.0f + __expf(-x)); }
__device__ __forceinline__ float silu_fast_(float x) { return x * __builtin_amdgcn_rcpf(1.0f + __expf(-x)); }
__device__ __forceinline__ float softplus_fast_(float x) { const float e = __expf(x); const float sm = e * (1.0f - e * (0.5f - e * (1.0f / 3.0f))); return x > 15.f ? x : (e < 0.01f ? sm : __logf(1.0f + e)); }
__device__ __forceinline__ float gelu_tanh_(float x) { return 0.5f * x * (1.0f + tanhf(0.7978845608028654f * (x + 0.044715f * x * x * x))); }

__device__ __forceinline__ float block_sum_256(float v, float* red) {
    for (int o = 32; o > 0; o >>= 1) v += __shfl_down(v, o, 64);
    __syncthreads();
    if ((tid_opaque() & 63) == 0) red[tid_opaque() >> 6] = v;
    __syncthreads();
    float r = red[0] + red[1] + red[2] + red[3];
    __syncthreads();
    return r;
}
__device__ __forceinline__ float block_max_256(float v, float* red) {
    for (int o = 32; o > 0; o >>= 1) v = fmaxf(v, __shfl_down(v, o, 64));
    __syncthreads();
    if ((tid_opaque() & 63) == 0) red[tid_opaque() >> 6] = v;
    __syncthreads();
    float r = fmaxf(fmaxf(red[0], red[1]), fmaxf(red[2], red[3]));
    __syncthreads();
    return r;
}

__device__ __forceinline__ int t5_bucket(int rel) {
    const int ret = rel > 0 ? 16 : 0; const int n = rel < 0 ? -rel : rel;
    if (n < 8) return ret + n;
    const float v = logf((float)n / 8.0f) / 2.772588722239781f * 8.0f;
    int large = 8 + (int)v; if (large > 15) large = 15;
    return ret + large;
}
struct AP { const bf16_t* proj; const bf16_t* vt; const float* rel_bias; const float* dlam; const float* subg; bf16_t* br; float lam_init; };
#define ATT_LDS (2 * 32768 + 2048)
__device__ __forceinline__ void phase_attn(char* shm, const AP& p) {
    float* btab = (float*)(shm + 65536);
    const float LOG2E = 1.4426950408889634f;
    for (int unit = bid_opaque(); unit < NB_ * 4 * 16; unit += grid_n()) {
        const int xq = unit & 7, sq = unit >> 3, bh = (xq * 2 + (sq >> 4)) & 15, qt = sq & 15, h = bh & 3, b = bh >> 2;
        const int tid = tid_opaque(), wid = tid >> 6, lane = tid & 63, fr = lane & 15, fq = lane >> 4;
        __syncthreads();
        if (tid < 257) btab[tid] = p.rel_bias[t5_bucket(tid - 128) * 4 + h] * LOG2E;
        float l0 = 0.f, l1 = 0.f;
        for (int d = 0; d < 64; ++d) { l0 += p.dlam[d] * p.dlam[64 + d]; l1 += p.dlam[128 + d] * p.dlam[192 + d]; }
        const float lam = expf(l0) - expf(l1) + p.lam_init;
        const int q0 = qt * 128, qrow = q0 + wid * 16 + fr;
        bf16x8 qf[2][2];
        { const bf16_t* qp = p.proj + (size_t)(b * SEQ_ + qrow) * PROJW + O_DA + h * 128 + fq * 8;
#pragma unroll
          for (int i = 0; i < 2; ++i)
#pragma unroll
            for (int s = 0; s < 2; ++s) qf[i][s] = *(const bf16x8*)(qp + i * 64 + s * 32); }
        const bf16_t* kg[2]; const bf16_t* vg[2]; int kl[2], vl[2]; bool vswap[2];
#pragma unroll
        for (int u = 0; u < 2; ++u) {
            const int c = tid + u * 512;
            const int krow = c >> 4, kch = c & 15;
            kg[u] = p.proj + (size_t)(b * SEQ_ + krow) * PROJW + O_DA + 512 + h * 128 + kch * 8;
            kl[u] = krow * 256 + ((kch ^ (krow & 15)) * 16);
            const int dv = c >> 3, ch16 = c & 7;
            vg[u] = p.vt + (size_t)(b * 512 + h * 128 + dv) * SEQ_ + ch16 * 8;
            vl[u] = 16384 + dv * 128 + ((ch16 ^ ((dv & 15) >> 1)) * 16); vswap[u] = dv & 1;
        }
        i32x4 sk[2], sv[2];
#define A_ISSUE(kt) do { _Pragma("unroll") for (int u = 0; u < 2; ++u) { sk[u] = *(const i32x4*)(kg[u] + (size_t)(kt) * 64 * PROJW); sv[u] = *(const i32x4*)(vg[u] + (kt) * 64); } } while (0)
#define A_WRITE(buf) do { char* sb_ = shm + (buf) * 32768; _Pragma("unroll") for (int u = 0; u < 2; ++u) { *(i32x4*)(sb_ + kl[u]) = sk[u]; \
            i32x4 w_ = sv[u]; if (vswap[u]) w_ = (i32x4){sv[u][2], sv[u][3], sv[u][0], sv[u][1]}; *(i32x4*)(sb_ + vl[u]) = w_; } } while (0)
        f32x4 O[2][8];
#pragma unroll
        for (int i = 0; i < 2; ++i)
#pragma unroll
            for (int f = 0; f < 8; ++f) O[i][f] = (f32x4){0.f, 0.f, 0.f, 0.f};
        float mrun[2] = {-1e30f, -1e30f}, lrun[2] = {0.f, 0.f};
        A_ISSUE(0); A_WRITE(0); A_ISSUE(1); __syncthreads();
        const int NT = SEQ_ / 64;
        for (int kt = 0; kt < NT; ++kt) {
            const int cur = kt & 1;
            if (kt + 1 < NT) A_WRITE(cur ^ 1);
            if (kt + 2 < NT) A_ISSUE(kt + 2);
            const char* sK = shm + cur * 32768; const char* sV = sK + 16384;
            f32x4 S[2][4];
#pragma unroll
            for (int i = 0; i < 2; ++i)
#pragma unroll
                for (int kf = 0; kf < 4; ++kf) {
                    f32x4 a = (f32x4){0.f, 0.f, 0.f, 0.f};
#pragma unroll
                    for (int s = 0; s < 2; ++s) {
                        const int row = kf * 16 + fr, ch = i * 8 + s * 4 + fq;
                        const bf16x8 kfA = *(const bf16x8*)(sK + row * 256 + ((ch ^ (row & 15)) * 16));
                        a = __builtin_amdgcn_mfma_f32_16x16x32_bf16(kfA, qf[i][s], a, 0, 0, 0);
                    }
                    S[i][kf] = a;
                }
            const int k0 = kt * 64;
            const bool far_hi = (k0 >= q0 + 127 + 128), far_lo = (k0 + 63 <= q0 - 128);
            const float c1 = 0.125f * LOG2E;
            if (far_hi || far_lo) {
                const float bc_ = far_hi ? btab[256] : btab[0];
#pragma unroll
                for (int i = 0; i < 2; ++i)
#pragma unroll
                    for (int kf = 0; kf < 4; ++kf)
#pragma unroll
                        for (int j = 0; j < 4; ++j) S[i][kf][j] = S[i][kf][j] * c1 + bc_;
            } else {
#pragma unroll
                for (int kf = 0; kf < 4; ++kf)
#pragma unroll
                    for (int j = 0; j < 4; ++j) {
                        int rel = (k0 + kf * 16 + fq * 4 + j) - qrow; rel = rel < -128 ? -128 : (rel > 128 ? 128 : rel);
                        const float bv_ = btab[rel + 128];
                        S[0][kf][j] = S[0][kf][j] * c1 + bv_; S[1][kf][j] = S[1][kf][j] * c1 + bv_;
                    }
            }
            bf16x8 Pf[2][2];
#pragma unroll
            for (int i = 0; i < 2; ++i) {
                float mx = S[i][0][0];
#pragma unroll
                for (int kf = 0; kf < 4; ++kf)
#pragma unroll
                    for (int j = 0; j < 4; ++j) mx = fmaxf(mx, S[i][kf][j]);
                mx = rows_max(mx);
                const float mnew = fmaxf(mrun[i], mx);
                const float alpha = __builtin_amdgcn_exp2f(mrun[i] - mnew);
                mrun[i] = mnew;
                float ps = 0.f;
#pragma unroll
                for (int kf = 0; kf < 4; ++kf)
#pragma unroll
                    for (int j = 0; j < 4; ++j) { const float e = __builtin_amdgcn_exp2f(S[i][kf][j] - mnew); S[i][kf][j] = e; ps += e; }
                ps = rows_sum(ps);
                lrun[i] = lrun[i] * alpha + ps;
                if (__any(alpha != 1.0f)) {
#pragma unroll
                    for (int f = 0; f < 8; ++f) { O[i][f][0] *= alpha; O[i][f][1] *= alpha; O[i][f][2] *= alpha; O[i][f][3] *= alpha; }
                }
#pragma unroll
                for (int g = 0; g < 2; ++g) {
                    i32x4 w;
                    w[0] = (int)cvt_pk_bf16(S[i][2 * g][0], S[i][2 * g][1]); w[1] = (int)cvt_pk_bf16(S[i][2 * g][2], S[i][2 * g][3]);
                    w[2] = (int)cvt_pk_bf16(S[i][2 * g + 1][0], S[i][2 * g + 1][1]); w[3] = (int)cvt_pk_bf16(S[i][2 * g + 1][2], S[i][2 * g + 1][3]);
                    Pf[i][g] = __builtin_bit_cast(bf16x8, w);
                }
            }
#pragma unroll
            for (int f = 0; f < 8; ++f)
#pragma unroll
                for (int g = 0; g < 2; ++g) {
                    const int dv = f * 16 + fr, x = dv & 15;
                    const uint2 v0 = *(const uint2*)(sV + dv * 128 + (((8 * g + fq) ^ x) * 8));
                    const uint2 v1 = *(const uint2*)(sV + dv * 128 + (((8 * g + 4 + fq) ^ x) * 8));
                    const i32x4 w = (i32x4){(int)v0.x, (int)v0.y, (int)v1.x, (int)v1.y};
                    const bf16x8 vA = __builtin_bit_cast(bf16x8, w);
                    O[0][f] = __builtin_amdgcn_mfma_f32_16x16x32_bf16(vA, Pf[0][g], O[0][f], 0, 0, 0);
                    O[1][f] = __builtin_amdgcn_mfma_f32_16x16x32_bf16(vA, Pf[1][g], O[1][f], 0, 0, 0);
                }
            __syncthreads();
        }
#undef A_ISSUE
#undef A_WRITE
        const float r0 = 1.0f / lrun[0], r1 = lam / lrun[1];
        float ss = 0.f;
#pragma unroll
        for (int f = 0; f < 8; ++f)
#pragma unroll
            for (int j = 0; j < 4; ++j) { const float o = O[0][f][j] * r0 - O[1][f][j] * r1; O[0][f][j] = o; ss += o * o; }
        ss = rows_sum(ss);
        const float rs = rsqrtf(ss * (1.0f / 128.0f) + 1e-5f) * (1.0f - p.lam_init);
        bf16_t* op = p.br + (size_t)(b * SEQ_ + qrow) * DM_ + 1024 + h * 128 + fq * 4;
#pragma unroll
        for (int f = 0; f < 8; ++f) {
            const f32x4 gv = *(const f32x4*)(p.subg + f * 16 + fq * 4);
            uint2 o; o.x = cvt_pk_bf16(O[0][f][0] * rs * gv[0], O[0][f][1] * rs * gv[1]); o.y = cvt_pk_bf16(O[0][f][2] * rs * gv[2], O[0][f][3] * rs * gv[3]);
            *(uint2*)(op + f * 16) = o;
        }
    }
}

#define HY_PPW 2112
#define HY_PADL 1040
#define HY_VLEN 4112
#define HY_LDS (HY_PPW * 4 + 4 * HY_VLEN * 2)
struct HP { const bf16_t* proj; const float* fr; const float* nrm; unsigned* pp; bf16_t* vvt; float* yt; const float* cw; const float* cb; const float* hbias; bf16_t* br; };

__device__ __forceinline__ void phase_hy_pp(const HP& p) {
    for (int idx = bid_opaque() * 512 + tid_opaque(); idx < 512 * HY_PPW; idx += grid_n() * 512) {
        const int c = idx / HY_PPW, u = idx - c * HY_PPW;
        const float inv = 1.0f / p.nrm[c];
        const int s0 = 2080 - u, s1 = 2080 - (u + 1);
        const float f0 = (s0 >= 0 && s0 < SEQ_) ? p.fr[(size_t)s0 * 512 + c] * inv : 0.f;
        const float f1 = (s1 >= 0 && s1 < SEQ_) ? p.fr[(size_t)s1 * 512 + c] * inv : 0.f;
        p.pp[idx] = cvt_pk_bf16(f0, f1);
    }
}
__device__ __forceinline__ void unpack8(const uint4 v, float (&f)[8]) {
    f[0] = __uint_as_float(v.x << 16); f[1] = __uint_as_float(v.x & 0xffff0000u); f[2] = __uint_as_float(v.y << 16); f[3] = __uint_as_float(v.y & 0xffff0000u);
    f[4] = __uint_as_float(v.z << 16); f[5] = __uint_as_float(v.z & 0xffff0000u); f[6] = __uint_as_float(v.w << 16); f[7] = __uint_as_float(v.w & 0xffff0000u);
}
__device__ __forceinline__ void phase_hy_prep(char* shm, const HP& p) {
    bf16_t* tile = (bf16_t*)shm;
    for (int unit = bid_opaque(); unit < NB_ * 32 * 8; unit += grid_n()) {
        const int ct = unit & 7, tt = (unit >> 3) & 31, b = unit >> 8;
        const int tid = tid_opaque(), tl = tid >> 3, c8 = (tid & 7) * 8, c = ct * 64 + c8, t = tt * 64 + tl;
        float s1[8], s2[8];
#pragma unroll
        for (int e = 0; e < 8; ++e) { s1[e] = p.cb[512 + c + e]; s2[e] = p.cb[1024 + c + e]; }
#pragma unroll
        for (int k = 0; k < 3; ++k) {
            const int t2 = t + k - 1;
            if (t2 >= 0 && t2 < SEQ_) {
                const bf16_t* pr = p.proj + (size_t)(b * SEQ_ + t2) * PROJW + O_HY + c;
                float x1[8], xv[8]; unpack8(*(const uint4*)(pr + 512), x1); unpack8(*(const uint4*)(pr + 1024), xv);
                const f32x4 wa = *(const f32x4*)(p.cw + k * 1536 + 512 + c), wb = *(const f32x4*)(p.cw + k * 1536 + 512 + c + 4);
                const f32x4 va = *(const f32x4*)(p.cw + k * 1536 + 1024 + c), vb = *(const f32x4*)(p.cw + k * 1536 + 1024 + c + 4);
#pragma unroll
                for (int e = 0; e < 4; ++e) { s1[e] += wa[e] * x1[e]; s1[e + 4] += wb[e] * x1[e + 4]; s2[e] += va[e] * xv[e]; s2[e + 4] += vb[e] * xv[e + 4]; }
            }
        }
        __syncthreads();
#pragma unroll
        for (int e = 0; e < 8; ++e) tile[(c8 + e) * 72 + tl] = f2bf(s1[e] * s2[e]);
        __syncthreads();
        { const int cl = tid >> 3, t8 = (tid & 7) * 8;
          *(uint4*)(p.vvt + ((size_t)(ct * 64 + cl) * NB_ + b) * SEQ_ + tt * 64 + t8) = *(const uint4*)(tile + cl * 72 + t8); }
    }
}
__device__ __forceinline__ void phase_hy_conv(char* shm, const HP& p) {
    unsigned* pps = (unsigned*)shm;
    bf16_t* vs = (bf16_t*)(shm + HY_PPW * 4);
    for (int c = bid_opaque(); c < 512; c += grid_n()) {
        const int tid = tid_opaque(), wid = tid >> 6, lane = tid & 63, fr = lane & 15, h = lane >> 4;
        __syncthreads();
        for (int i = tid; i < HY_PPW; i += 512) pps[i] = p.pp[(size_t)c * HY_PPW + i];
        for (int i = tid; i < 4 * (HY_VLEN / 8); i += 512) {
            const int b = i / (HY_VLEN / 8), ch = i - b * (HY_VLEN / 8), e0 = ch * 8 - HY_PADL;
            uint4 v = make_uint4(0u, 0u, 0u, 0u);
            if (e0 >= 0 && e0 < SEQ_) v = *(const uint4*)(p.vvt + ((size_t)c * NB_ + b) * SEQ_ + e0);
            *(uint4*)(vs + b * HY_VLEN + ch * 8) = v;
        }
        __syncthreads();
        const int b = wid >> 1, ib = (wid & 1) * 64;
        f32x4 acc[4];
#pragma unroll
        for (int f = 0; f < 4; ++f) acc[f] = (f32x4){0.f, 0.f, 0.f, 0.f};
        const int ua = 1056 - 16 * (h >> 1) - fr + 8 * (h & 1);
        const bf16_t* vb = vs + b * HY_VLEN + HY_PADL + 16 * (ib + fr - (h >> 1)) + 8 * (h & 1);
#define HY_LOAD(d0_, af_, bf_) do { const unsigned* ap_ = pps + (ua - 16 * (d0_)); const i32x4 aw_ = (i32x4){(int)ap_[0], (int)ap_[2], (int)ap_[4], (int)ap_[6]}; af_ = __builtin_bit_cast(bf16x8, aw_); \
        _Pragma("unroll") for (int f = 0; f < 4; ++f) bf_[f] = *(const bf16x8*)(vb + 16 * (16 * f - (d0_))); } while (0)
        bf16x8 afA, afB, bfA[4], bfB[4];
        HY_LOAD(-64, afA, bfA);
        for (int d0 = -64; d0 < 64; d0 += 4) {
            HY_LOAD(d0 + 2, afB, bfB);
            __builtin_amdgcn_sched_barrier(0);
#pragma unroll
            for (int f = 0; f < 4; ++f) acc[f] = __builtin_amdgcn_mfma_f32_16x16x32_bf16(afA, bfA[f], acc[f], 0, 0, 0);
            __builtin_amdgcn_sched_barrier(0);
            HY_LOAD(d0 + 4, afA, bfA);
            __builtin_amdgcn_sched_barrier(0);
#pragma unroll
            for (int f = 0; f < 4; ++f) acc[f] = __builtin_amdgcn_mfma_f32_16x16x32_bf16(afB, bfB[f], acc[f], 0, 0, 0);
            __builtin_amdgcn_sched_barrier(0);
        }
#pragma unroll
        for (int f = 0; f < 4; ++f) acc[f] = __builtin_amdgcn_mfma_f32_16x16x32_bf16(afA, bfA[f], acc[f], 0, 0, 0);
#undef HY_LOAD
        const float hb = p.hbias[c];
#pragma unroll
        for (int f = 0; f < 4; ++f) {
            const int t = 16 * (ib + 16 * f + fr) + 4 * h;
            const bf16_t* vv = vs + b * HY_VLEN + HY_PADL + t;
            f32x4 o; o[0] = acc[f][0] + bf2f(vv[0]) * hb; o[1] = acc[f][1] + bf2f(vv[1]) * hb; o[2] = acc[f][2] + bf2f(vv[2]) * hb; o[3] = acc[f][3] + bf2f(vv[3]) * hb;
            *(f32x4*)(p.yt + ((size_t)c * NB_ + b) * SEQ_ + t) = o;
        }
    }
}
__device__ __forceinline__ void phase_hy_fin(char* shm, const HP& p, int bw0, int bwn) {
    float* tile = (float*)shm;
    const int bq = bid_opaque() - bw0; if (bq < 0 || bq >= bwn) return;
    for (int unit = bq; unit < NB_ * 32 * 8; unit += bwn) {
        const int ct = unit & 7, tt = (unit >> 3) & 31, b = unit >> 8, tid = tid_opaque();
        __syncthreads();
        { const int cl = tid >> 3, t8 = (tid & 7) * 8; const float* src = p.yt + ((size_t)(ct * 64 + cl) * NB_ + b) * SEQ_ + tt * 64 + t8;
          const f32x4 a = *(const f32x4*)src, bq = *(const f32x4*)(src + 4);
#pragma unroll
          for (int q = 0; q < 4; ++q) { tile[cl * 65 + t8 + q] = a[q]; tile[cl * 65 + t8 + 4 + q] = bq[q]; } }
        __syncthreads();
        const int cl = tid & 63, c = ct * 64 + cl, tq = tid >> 6;
        float w0[3];
#pragma unroll
        for (int k = 0; k < 3; ++k) w0[k] = p.cw[k * 1536 + c];
        const float b0 = p.cb[c];
#pragma unroll
        for (int q = 0; q < 8; ++q) {
            const int tl = tq * 8 + q, t = tt * 64 + tl;
            float s = b0;
#pragma unroll
            for (int k = 0; k < 3; ++k) { const int t2 = t + k - 1; if (t2 >= 0 && t2 < SEQ_) s += w0[k] * bf2f(p.proj[(size_t)(b * SEQ_ + t2) * PROJW + O_HY + c]); }
            p.br[(size_t)(b * SEQ_ + t) * DM_ + c] = f2bf(tile[cl * 65 + tl] * s);
        }
    }
}
struct LP { const bf16_t* proj; const float* cw; const float* cb; const bf16_t* wt; const float* ba; const float* bx; const float* lam; float* sumP; float* sumE; bf16_t* br; };
#define LRU_LDS (32768 + 8192 + 64 * 65 * 4 + 2 * 64 * 65 * 4 + 2 * 2 * 16 * 64 * 4)
template <int PASS>
__device__ __forceinline__ void phase_lru(char* shm, const LP& p) {
    char* sW = shm;
    char* sXb = shm + 32768;
    float* X = (float*)(shm + 40960);
    float* H = X + 64 * 65;
    float* SP = H + 2 * 64 * 65;
    float* SE = SP + 2 * 16 * 64;
    for (int unit = bid_opaque(); unit < NB_ * 8 * 32; unit += grid_n()) {
        const int k = unit & 31, b = (unit >> 5) & 3, h = unit >> 7;
        const int tid = tid_opaque();
        __syncthreads();
        for (int i = tid; i < 256 * 8; i += 512) { const int row = i >> 3, ch = i & 7;
            *(uint4*)(sW + lds_rc(row, ch)) = *(const uint4*)(p.wt + ((size_t)h * 256 + row) * 64 + ch * 8); }
        { const int j = tid & 63, tq = tid >> 6, ch = h * 64 + j;
          float w4[4];
#pragma unroll
          for (int q = 0; q < 4; ++q) w4[q] = p.cw[q * 512 + ch];
          const float cbv = p.cb[ch];
#pragma unroll
          for (int q = 0; q < 8; ++q) {
              const int tl = tq * 8 + q, t = k * 64 + tl; float s = cbv;
#pragma unroll
              for (int kk = 0; kk < 4; ++kk) { const int t2 = t + kk - 2; if (t2 >= 0 && t2 < SEQ_) s += w4[kk] * bf2f(p.proj[(size_t)(b * SEQ_ + t2) * PROJW + O_LRU + ch]); }
              X[tl * 65 + j] = s;
              *(bf16_t*)(sXb + lds_rc(tl, j >> 3) + (j & 7) * 2) = f2bf(s);
          } }
        __syncthreads();
        const int wid = tid >> 6, lane = tid & 63, fr = lane & 15, fq = lane >> 4, dir = wid & 1, jf = wid >> 1, j = jf * 16 + fr, ch = h * 64 + j;
        f32x4 G[4][2];
        { const float bav = p.ba[dir * 512 + ch], bxv = p.bx[dir * 512 + ch];
#pragma unroll
          for (int tf = 0; tf < 4; ++tf) { G[tf][0] = (f32x4){bav, bav, bav, bav}; G[tf][1] = (f32x4){bxv, bxv, bxv, bxv}; } }
#pragma unroll
        for (int ks = 0; ks < 2; ++ks) {
            const bf16x8 wA = *(const bf16x8*)(sW + lds_rc((dir * 2 + 0) * 64 + j, ks * 4 + fq));
            const bf16x8 wX = *(const bf16x8*)(sW + lds_rc((dir * 2 + 1) * 64 + j, ks * 4 + fq));
#pragma unroll
            for (int tf = 0; tf < 4; ++tf) {
                const bf16x8 xa = *(const bf16x8*)(sXb + lds_rc(tf * 16 + fr, ks * 4 + fq));
                G[tf][0] = __builtin_amdgcn_mfma_f32_16x16x32_bf16(xa, wA, G[tf][0], 0, 0, 0);
                G[tf][1] = __builtin_amdgcn_mfma_f32_16x16x32_bf16(xa, wX, G[tf][1], 0, 0, 0);
            }
        }
        const float spl = softplus_fast_(-p.lam[dir * 512 + ch]);
        const int tfirst = dir ? (SEQ_ - 1) : 0;
#pragma unroll
        for (int tf = 0; tf < 4; ++tf) {
            float P = 1.f, E = 0.f;
#pragma unroll
            for (int qq = 0; qq < 4; ++qq) {
                const int q = dir ? 3 - qq : qq, tl = tf * 16 + fq * 4 + q, t = k * 64 + tl;
                const float r = sigmoid_fast_(G[tf][0][q]), ig = sigmoid_fast_(G[tf][1][q]);
                const float log_a = -8.0f * r * spl;
                float mult = sqrtf(-expm1f(2.0f * log_a)); if (t == tfirst) mult = 1.0f;
                const float av = __expf(log_a), bv = mult * ig * X[tl * 65 + j];
                G[tf][0][q] = av; G[tf][1][q] = bv;
                E = av * E + bv; P *= av;
            }
            SP[(dir * 16 + tf * 4 + fq) * 64 + j] = P; SE[(dir * 16 + tf * 4 + fq) * 64 + j] = E;
        }
        __syncthreads();
        const size_t sbase = ((size_t)(dir * NB_ + b) * 32) * 512 + ch;
        if (PASS == 0) {
            if (fq == 0) {
                float cP = 1.f, cE = 0.f;
                if (dir == 0) { for (int s = 0; s < 16; ++s) { cE = SP[s * 64 + j] * cE + SE[s * 64 + j]; cP *= SP[s * 64 + j]; } }
                else { for (int s = 15; s >= 0; --s) { cE = SP[(16 + s) * 64 + j] * cE + SE[(16 + s) * 64 + j]; cP *= SP[(16 + s) * 64 + j]; } }
                p.sumP[sbase + (size_t)k * 512] = cP; p.sumE[sbase + (size_t)k * 512] = cE;
            }
        } else {
            float c = 0.f;
            if (dir == 0) { for (int q = 0; q < k; ++q) c = p.sumP[sbase + (size_t)q * 512] * c + p.sumE[sbase + (size_t)q * 512]; }
            else { for (int q = 31; q > k; --q) c = p.sumP[sbase + (size_t)q * 512] * c + p.sumE[sbase + (size_t)q * 512]; }
            float cin[4];
            if (dir == 0) {
#pragma unroll
                for (int s = 0; s < 16; ++s) { if ((s & 3) == fq) cin[s >> 2] = c; c = SP[s * 64 + j] * c + SE[s * 64 + j]; }
            } else {
#pragma unroll
                for (int s = 15; s >= 0; --s) { if ((s & 3) == fq) cin[s >> 2] = c; c = SP[(16 + s) * 64 + j] * c + SE[(16 + s) * 64 + j]; }
            }
            float* Hd = H + dir * 64 * 65;
#pragma unroll
            for (int tf = 0; tf < 4; ++tf) {
                float cc = cin[tf];
#pragma unroll
                for (int qq = 0; qq < 4; ++qq) { const int q = dir ? 3 - qq : qq; cc = G[tf][0][q] * cc + G[tf][1][q]; Hd[(tf * 16 + fq * 4 + q) * 65 + j] = cc; }
            }
            __syncthreads();
            const int j2 = tid & 63, tq = tid >> 6, ch2 = h * 64 + j2;
#pragma unroll
            for (int q = 0; q < 8; ++q) {
                const int tl = tq * 8 + q; const size_t tok = (size_t)(b * SEQ_ + k * 64 + tl);
                const float g = bf2f(p.proj[tok * PROJW + O_LRU + 512 + ch2]);
                p.br[tok * DM_ + 512 + ch2] = f2bf((H[tl * 65 + j2] + H[64 * 65 + tl * 65 + j2]) * gelu_tanh_(g));
            }
        }
    }
}
struct SP_ { const bf16_t* proj; const float* dtraw; const float* cw; const float* cb; const float* dtb; const float* a_log; const float* dsk; const float* ng;
             bf16_t* xa; bf16_t* xT; float* states; float* decay; bf16_t* prev; bf16_t* br; };
#define SSD_Q 128
#define SSD_NC 16

__device__ __forceinline__ void phase_ssd_prep(char* shm, const SP_& p) {
    bf16_t* tile = (bf16_t*)shm;
    for (int unit = bid_opaque(); unit < NB_ * 32 * 16; unit += grid_n()) {
        const int ct = unit & 15, tt = (unit >> 4) & 31, b = unit >> 9;
        const int tid = tid_opaque(), tl = tid >> 3, c8 = (tid & 7) * 8, c = ct * 64 + c8, t = tt * 64 + tl;
        float s[8];
#pragma unroll
        for (int e = 0; e < 8; ++e) s[e] = p.cb[c + e];
#pragma unroll
        for (int k = 0; k < 4; ++k) {
            const int t2 = t + k - 2;
            if (t2 >= 0 && t2 < SEQ_) {
                float x[8]; unpack8(*(const uint4*)(p.proj + (size_t)(b * SEQ_ + t2) * PROJW + O_SSD + 512 + c), x);
                const f32x4 wa = *(const f32x4*)(p.cw + k * 1024 + c), wb = *(const f32x4*)(p.cw + k * 1024 + c + 4);
#pragma unroll
                for (int e = 0; e < 4; ++e) { s[e] += wa[e] * x[e]; s[e + 4] += wb[e] * x[e + 4]; }
            }
        }
        uint4 o; o.x = cvt_pk_bf16(silu_fast_(s[0]), silu_fast_(s[1])); o.y = cvt_pk_bf16(silu_fast_(s[2]), silu_fast_(s[3]));
        o.z = cvt_pk_bf16(silu_fast_(s[4]), silu_fast_(s[5])); o.w = cvt_pk_bf16(silu_fast_(s[6]), silu_fast_(s[7]));
        *(uint4*)(p.xa + (size_t)(b * SEQ_ + t) * 1024 + c) = o;
        __syncthreads();
        tile[(c8 + 0) * 72 + tl] = (bf16_t)(o.x & 0xffffu); tile[(c8 + 1) * 72 + tl] = (bf16_t)(o.x >> 16); tile[(c8 + 2) * 72 + tl] = (bf16_t)(o.y & 0xffffu); tile[(c8 + 3) * 72 + tl] = (bf16_t)(o.y >> 16);
        tile[(c8 + 4) * 72 + tl] = (bf16_t)(o.z & 0xffffu); tile[(c8 + 5) * 72 + tl] = (bf16_t)(o.z >> 16); tile[(c8 + 6) * 72 + tl] = (bf16_t)(o.w & 0xffffu); tile[(c8 + 7) * 72 + tl] = (bf16_t)(o.w >> 16);
        __syncthreads();
        { const int c2 = tid >> 3, t8 = (tid & 7) * 8;
          *(uint4*)(p.xT + ((size_t)b * 1024 + ct * 64 + c2) * SEQ_ + tt * 64 + t8) = *(const uint4*)(tile + c2 * 72 + t8); }
    }
}
__device__ __forceinline__ void ssd_tables(float* dtv, float* cum, const SP_& p, int b, int c, int g) {
    const int tid = tid_opaque();
    for (int i = tid; i < 8 * SSD_Q; i += 512) {
        const int l = i & 127, hd = i >> 7, dir = hd >> 2, j = hd & 3, h = g * 4 + j;
        dtv[i] = softplus_fast_(p.dtraw[(size_t)(b * SEQ_ + c * SSD_Q + l) * 16 + dir * 8 + h] + p.dtb[dir * 8 + h]);
    }
    __syncthreads();
    const int t8 = tid_opaque();
    if (t8 < 8) {
        const int dir = t8 >> 2, j = t8 & 3, h = g * 4 + j; const float a = -__expf(p.a_log[dir * 8 + h]);
        float s = 0.f;
        if (dir == 0) for (int l = 0; l < SSD_Q; ++l) { s += dtv[t8 * 128 + l] * a; cum[t8 * 128 + l] = s; }
        else for (int l = SSD_Q - 1; l >= 0; --l) { s += dtv[t8 * 128 + l] * a; cum[t8 * 128 + l] = s; }
    }
    __syncthreads();
}
#define SSD1_LDS (65536 + 32768 + 8192)
__device__ __forceinline__ void phase_ssd_states(char* shm, const SP_& p) {
    char* sX = shm;
    char* sB = shm + 65536;
    float* dtv = (float*)(shm + 98304); float* cum = dtv + 1024;
    for (int unit = bid_opaque(); unit < NB_ * SSD_NC * 2; unit += grid_n()) {
        const int g = unit & 1, c = (unit >> 1) & 15, b = unit >> 5;
        const int tid = tid_opaque(), wid = tid >> 6, lane = tid & 63, fr = lane & 15, fq = lane >> 4;
        __syncthreads();
        for (int i = tid; i < 256 * 16; i += 512) { const int row = i >> 4, ch = i & 15;
            *(uint4*)(sX + row * 256 + ((ch ^ (row & 15)) * 16)) = *(const uint4*)(p.xT + ((size_t)b * 1024 + g * 256 + row) * SEQ_ + c * SSD_Q + ch * 8); }
        for (int i = tid; i < 128 * 16; i += 512) { const int row = i >> 4, ch = i & 15;
            *(uint4*)(sB + row * 256 + ((ch ^ (row & 15)) * 16)) = *(const uint4*)(p.xT + ((size_t)b * 1024 + 512 + g * 128 + row) * SEQ_ + c * SSD_Q + ch * 8); }
        ssd_tables(dtv, cum, p, b, c, g);
        const int j = wid >> 1, dir = wid & 1, hd = dir * 4 + j, h = g * 4 + j;
        const float* dth = dtv + hd * 128; const float* cm = cum + hd * 128;
        const float cend = dir ? cm[0] : cm[SSD_Q - 1];
        f32x4 acc[4][8];
#pragma unroll
        for (int pf = 0; pf < 4; ++pf)
#pragma unroll
            for (int nf = 0; nf < 8; ++nf) acc[pf][nf] = (f32x4){0.f, 0.f, 0.f, 0.f};
#pragma unroll 1
        for (int ks = 0; ks < 4; ++ks) {
            float sc[8];
#pragma unroll
            for (int e = 0; e < 8; ++e) { const int l = ks * 32 + fq * 8 + e; sc[e] = dth[l] * __expf(cend - cm[l]); }
            bf16x8 af[4];
#pragma unroll
            for (int pf = 0; pf < 4; ++pf) {
                const int row = j * 64 + pf * 16 + fr, ch = ks * 4 + fq;
                const i32x4 raw = *(const i32x4*)(sX + row * 256 + ((ch ^ (row & 15)) * 16));
                i32x4 o;
#pragma unroll
                for (int q = 0; q < 4; ++q) { const unsigned u = (unsigned)raw[q]; o[q] = (int)cvt_pk_bf16(__uint_as_float(u << 16) * sc[2 * q], __uint_as_float(u & 0xffff0000u) * sc[2 * q + 1]); }
                af[pf] = __builtin_bit_cast(bf16x8, o);
            }
#pragma unroll
            for (int nf = 0; nf < 8; ++nf) {
                const int row = nf * 16 + fr, ch = ks * 4 + fq;
                const bf16x8 bfr = *(const bf16x8*)(sB + row * 256 + ((ch ^ (row & 15)) * 16));
#pragma unroll
                for (int pf = 0; pf < 4; ++pf) acc[pf][nf] = __builtin_amdgcn_mfma_f32_16x16x32_bf16(af[pf], bfr, acc[pf][nf], 0, 0, 0);
            }
        }
        float* st = p.states + ((((size_t)(b * SSD_NC + c) * 8 + h) * 2 + dir) * 64) * 128;
        float* rp = st + (size_t)(fq * 4) * 128 + fr;
#pragma unroll
        for (int pf = 0; pf < 4; ++pf)
#pragma unroll
            for (int q = 0; q < 4; ++q) {
                float* r2 = rp + (pf * 16 + q) * 128;
#pragma unroll
                for (int nf = 0; nf < 8; ++nf) r2[nf * 16] = acc[pf][nf][q];
                __builtin_amdgcn_sched_barrier(0);
            }
        if (lane == 0) p.decay[((b * SSD_NC + c) * 8 + h) * 2 + dir] = __expf(cend);
    }
}
__device__ __forceinline__ void phase_ssd_scan(const SP_& p) {
    for (int idx = bid_opaque() * 512 + tid_opaque(); idx < NB_ * 8 * 2 * 64 * 32; idx += grid_n() * 512) {
        const int n4 = idx & 31, pp = (idx >> 5) & 63, dir = (idx >> 11) & 1, h = (idx >> 12) & 7, b = idx >> 15;
        f32x4 s = (f32x4){0.f, 0.f, 0.f, 0.f};
#pragma unroll 1
        for (int half = 0; half < 2; ++half) {
            f32x4 st[8]; float dc[8];
#pragma unroll
            for (int q = 0; q < 8; ++q) {
                const int cc = half * 8 + q, c = dir ? (SSD_NC - 1 - cc) : cc;
                st[q] = *(const f32x4*)(p.states + ((((size_t)(b * SSD_NC + c) * 8 + h) * 2 + dir) * 64 + pp) * 128 + n4 * 4);
                dc[q] = p.decay[((b * SSD_NC + c) * 8 + h) * 2 + dir];
            }
#pragma unroll
            for (int q = 0; q < 8; ++q) {
                const int cc = half * 8 + q, c = dir ? (SSD_NC - 1 - cc) : cc;
                const size_t o = ((((size_t)(b * SSD_NC + c) * 8 + h) * 2 + dir) * 64 + pp) * 128 + n4 * 4;
                uint2 w; w.x = cvt_pk_bf16(s[0], s[1]); w.y = cvt_pk_bf16(s[2], s[3]);
                *(uint2*)(p.prev + o) = w;
                s = s * dc[q] + st[q];
            }
        }
    }
}
#define SSD3_LDS (32768 + 65536 + 32768 + 8192 + 512)
__device__ __forceinline__ void phase_ssd_out(char* shm, const SP_& p) {
    char* sB = shm;
    char* sX = shm + 32768;
    char* sC = shm + 98304;
    float* dtv = (float*)(shm + 131072); float* cum = dtv + 1024; float* ssx = cum + 1024;
    for (int unit = bid_opaque(); unit < NB_ * SSD_NC * 2 * 2; unit += grid_n()) {
        const int half_ = unit & 1, g = (unit >> 1) & 1, c = (unit >> 2) & 15, b = unit >> 6;
        const int tid = tid_opaque(), wid = tid >> 6, lane = tid & 63, fr = lane & 15, fq = lane >> 4;
        __syncthreads();
        for (int i = tid; i < 128 * 16; i += 512) { const int row = i >> 4, ch = i & 15; const bf16_t* src_ = p.xa + (size_t)(b * SEQ_ + c * SSD_Q + row) * 1024 + 512 + g * 128 + ch * 8;
            *(uint4*)(sB + row * 256 + ((ch ^ (row & 15)) * 16)) = *(const uint4*)src_;
            *(uint4*)(sC + row * 256 + ((ch ^ (row & 15)) * 16)) = *(const uint4*)(src_ + 256); }
        for (int i = tid; i < 256 * 16; i += 512) { const int row = i >> 4, ch = i & 15, x = row & 15;
            uint4 v = *(const uint4*)(p.xT + ((size_t)b * 1024 + g * 256 + row) * SEQ_ + c * SSD_Q + ch * 8);
            if (x & 1) v = make_uint4(v.z, v.w, v.x, v.y);
            *(uint4*)(sX + row * 256 + ((ch ^ (x >> 1)) * 16)) = v; }
        ssd_tables(dtv, cum, p, b, c, g);
        const int hp = wid >> 2, lrow = half_ * 64 + (wid & 3) * 16 + fr;
        const size_t tok = (size_t)(b * SEQ_ + c * SSD_Q + lrow);
#define SSD_CF(ks_) (*(const bf16x8*)(sC + lrow * 256 + ((((ks_) * 4 + fq) ^ (lrow & 15)) * 16)))
        f32x4 G[8];
#pragma unroll
        for (int sf = 0; sf < 8; ++sf) {
            f32x4 a = (f32x4){0.f, 0.f, 0.f, 0.f};
#pragma unroll
            for (int ks = 0; ks < 4; ++ks) {
                const int row = sf * 16 + fr, ch = ks * 4 + fq;
                const bf16x8 bfr = *(const bf16x8*)(sB + row * 256 + ((ch ^ (row & 15)) * 16));
                a = __builtin_amdgcn_mfma_f32_16x16x32_bf16(bfr, SSD_CF(ks), a, 0, 0, 0);
            }
            G[sf] = a;
        }
        f32x4 Y[2][4];
#pragma unroll
        for (int jj = 0; jj < 2; ++jj)
#pragma unroll
            for (int pf = 0; pf < 4; ++pf) Y[jj][pf] = (f32x4){0.f, 0.f, 0.f, 0.f};
#pragma unroll
        for (int jj = 0; jj < 2; ++jj) {
            const int j = hp * 2 + jj;
#pragma unroll 1
            for (int dir = 0; dir < 2; ++dir) {
                const int hd = dir * 4 + j, h = g * 4 + j;
                const float* dth = dtv + hd * 128; const float* cm = cum + hd * 128;
                const float cl = cm[lrow];
#pragma unroll
                for (int g2 = 0; g2 < 4; ++g2) {
                    float e[8];
#pragma unroll
                    for (int half = 0; half < 2; ++half)
#pragma unroll
                        for (int q = 0; q < 4; ++q) {
                            const int sf = 2 * g2 + half, s = sf * 16 + fq * 4 + q;
                            const bool keep = dir ? (s >= lrow) : (s <= lrow);
                            const float v = G[sf][q] * __expf(keep ? (cl - cm[s]) : 0.f) * dth[s];
                            e[half * 4 + q] = keep ? v : 0.f;
                        }
                    i32x4 w; w[0] = (int)cvt_pk_bf16(e[0], e[1]); w[1] = (int)cvt_pk_bf16(e[2], e[3]); w[2] = (int)cvt_pk_bf16(e[4], e[5]); w[3] = (int)cvt_pk_bf16(e[6], e[7]);
                    const bf16x8 Pf = __builtin_bit_cast(bf16x8, w);
#pragma unroll
                    for (int pf = 0; pf < 4; ++pf) {
                        const int row = j * 64 + pf * 16 + fr, x = row & 15;
                        const uint2 v0 = *(const uint2*)(sX + row * 256 + (((8 * g2 + fq) ^ x) * 8));
                        const uint2 v1 = *(const uint2*)(sX + row * 256 + (((8 * g2 + 4 + fq) ^ x) * 8));
                        const i32x4 wv = (i32x4){(int)v0.x, (int)v0.y, (int)v1.x, (int)v1.y};
                        Y[jj][pf] = __builtin_amdgcn_mfma_f32_16x16x32_bf16(__builtin_bit_cast(bf16x8, wv), Pf, Y[jj][pf], 0, 0, 0);
                    }
                    __builtin_amdgcn_sched_barrier(0);
                }
                const bf16_t* pv = p.prev + ((((size_t)(b * SSD_NC + c) * 8 + h) * 2 + dir) * 64) * 128;
                const float el = __expf(cl);
#pragma unroll
                for (int pf = 0; pf < 4; ++pf) {
                    f32x4 t = (f32x4){0.f, 0.f, 0.f, 0.f};
#pragma unroll
                    for (int ks = 0; ks < 4; ++ks) {
                        const bf16x8 pa = *(const bf16x8*)(pv + (size_t)(pf * 16 + fr) * 128 + ks * 32 + fq * 8);
                        t = __builtin_amdgcn_mfma_f32_16x16x32_bf16(pa, SSD_CF(ks), t, 0, 0, 0);
                    }
                    Y[jj][pf] += t * el;
                    __builtin_amdgcn_sched_barrier(0);
                }
            }
        }
        const int te = tid_opaque(); const int fqe = (te & 63) >> 4, wde = te >> 6, hpe = wde >> 2; const size_t toke = (size_t)(b * SEQ_ + c * SSD_Q + half_ * 64 + (wde & 3) * 16 + (te & 15));
        float ss = 0.f;
#pragma unroll
        for (int jj = 0; jj < 2; ++jj) {
            const float dk = p.dsk[g * 4 + hpe * 2 + jj];
#pragma unroll
            for (int pf = 0; pf < 4; ++pf) {
                const int cch = g * 256 + (hpe * 2 + jj) * 64 + pf * 16 + fqe * 4;
                const uint2 xv = *(const uint2*)(p.xa + toke * 1024 + cch);
                const uint2 zv = *(const uint2*)(p.proj + toke * PROJW + O_SSD + cch);
                const float xs[4] = {__uint_as_float(xv.x << 16), __uint_as_float(xv.x & 0xffff0000u), __uint_as_float(xv.y << 16), __uint_as_float(xv.y & 0xffff0000u)};
                const float zs[4] = {__uint_as_float(zv.x << 16), __uint_as_float(zv.x & 0xffff0000u), __uint_as_float(zv.y << 16), __uint_as_float(zv.y & 0xffff0000u)};
#pragma unroll
                for (int q = 0; q < 4; ++q) { const float y = (Y[jj][pf][q] + dk * xs[q]) * silu_fast_(zs[q]); Y[jj][pf][q] = y; ss += y * y; }
                __builtin_amdgcn_sched_barrier(0);
            }
        }
        ss = rows_sum(ss);
        if (fqe == 0) ssx[wde * 16 + (te & 15)] = ss;
        __syncthreads();
        ss += ssx[(wde ^ 4) * 16 + (te & 15)];
        const float rs = rsqrtf(ss * (1.0f / 256.0f) + 1e-6f);
#pragma unroll
        for (int jj = 0; jj < 2; ++jj)
#pragma unroll
            for (int pf = 0; pf < 4; ++pf) {
                const int cch = g * 256 + (hpe * 2 + jj) * 64 + pf * 16 + fqe * 4;
                const f32x4 gv = *(const f32x4*)(p.ng + cch);
                uint2 o; o.x = cvt_pk_bf16(Y[jj][pf][0] * rs * gv[0], Y[jj][pf][1] * rs * gv[1]); o.y = cvt_pk_bf16(Y[jj][pf][2] * rs * gv[2], Y[jj][pf][3] * rs * gv[3]);
                *(uint2*)(p.br + toke * DM_ + 1536 + cch) = o;
                __builtin_amdgcn_sched_barrier(0);
            }
    }
}
struct GP {
    const bf16_t* A; const bf16_t* Bt; const float* B; const float* B2; const float* bias; const float* R; float* Cf; bf16_t* Cb; bf16_t* Cb2; bf16_t* Vt; const bf16_t* G;
    const int* idx; const float* gate;
};
#ifndef GS_ROWS
#define GS_ROWS 8
#endif
__device__ __forceinline__ void static_order(int L, int nM, int nN, int& pm, int& pn) {
    const int nwg = nM * nN; int wgid = L;
    { const int q = nwg / 8, r = nwg % 8, xcd = wgid % 8, off = wgid / 8; wgid = (xcd < r ? xcd * (q + 1) : r * (q + 1) + (xcd - r) * q) + off; }
    const int nig = GS_ROWS * nN, gid = wgid / nig, fm = gid * GS_ROWS, gsz = (nM - fm) < GS_ROWS ? (nM - fm) : GS_ROWS;
    pm = fm + ((wgid % nig) % gsz); pn = (wgid % nig) / gsz;
}
#define LANE_IDS(t_) const int wid = (t_) >> 6, lane = (t_) & 63, wr = wid >> 2, wc = wid & 3, fr = lane & 15, fq = lane >> 4; (void)wr; (void)wc; (void)fr; (void)fq;
#define ZERO_ACC(acc, FM_) _Pragma("unroll") for (int m = 0; m < FM_; ++m) _Pragma("unroll") for (int n = 0; n < 4; ++n) acc[m][n] = (f32x4){0.f, 0.f, 0.f, 0.f}

__device__ __forceinline__ void phase_inproj(char* shm, const GP& p) {
    typedef GemmCore<256, false> G;
    for (int L = bid_opaque(); L < 32 * 54; L += grid_n()) {
        int pm, pn; static_order(L, 32, 54, pm, pn);
        const int col0 = pn < 22 ? pn * 256 : O_GATE + (pn - 22) * 256;
        f32x4 acc[8][4]; ZERO_ACC(acc, 8);
        {
            const int t0 = tid_opaque();
            unsigned aoff[G::GLA], boff[4];
#pragma unroll
            for (int i = 0; i < G::GLA; ++i) { int R, C; G::a_coord(t0, i, R, C); aoff[i] = (unsigned)((R * DM_ + C) * 2); }
#pragma unroll
            for (int i = 0; i < 4; ++i) { int cc, C; G::bt_coord(t0, i, cc, C); boff[i] = (unsigned)((cc * DM_ + C) * 2); }
            const char* pf = t0 < 256 ? (const char*)(p.A + (size_t)(pm * 256 + t0) * DM_) : (const char*)(p.Bt + (size_t)(pn * 256 + t0 - 256) * DM_);
            G::run_bt(shm, (const char*)(p.A + (size_t)pm * 256 * DM_), aoff, (const char*)(p.Bt + (size_t)pn * 256 * DM_), boff, DM_ * 2, pf, DM_ / 64, acc);
        }
        const int t1 = tid_opaque(); LANE_IDS(t1)
        const int cl = wc * 64 + 4 * fr;
        if (pn == 14 || pn == 15) {
            const int t0_ = pm * 256 + wr * 128 + fq * 4, bb = t0_ >> 11, tl = t0_ & (SEQ_ - 1);
            bf16_t* vp = p.Vt + (size_t)(bb * 512 + (pn - 14) * 256 + cl) * SEQ_ + tl;
#pragma unroll
            for (int m = 0; m < 8; ++m)
#pragma unroll
                for (int n = 0; n < 4; ++n) {
                    uint2 o; o.x = cvt_pk_bf16(acc[m][n][0], acc[m][n][1]); o.y = cvt_pk_bf16(acc[m][n][2], acc[m][n][3]);
                    *(uint2*)(vp + (size_t)n * SEQ_ + m * 16) = o;
                }
        } else if (pn < 22) {
#pragma unroll
            for (int m = 0; m < 8; ++m)
#pragma unroll
                for (int j = 0; j < 4; ++j) {
                    const int row = pm * 256 + wr * 128 + m * 16 + fq * 4 + j;
                    uint2 o; o.x = cvt_pk_bf16(acc[m][0][j], acc[m][1][j]); o.y = cvt_pk_bf16(acc[m][2][j], acc[m][3][j]);
                    *(uint2*)(p.Cb + (size_t)row * PROJW + pn * 256 + cl) = o;
                }
        } else {
            const int gc = (pn - 22) * 256 + cl;
            const f32x4 bg = *(const f32x4*)(p.bias + gc);
#pragma unroll
            for (int m = 0; m < 8; ++m)
#pragma unroll
                for (int j = 0; j < 4; ++j) {
                    const int row = pm * 256 + wr * 128 + m * 16 + fq * 4 + j;
                    uint2 o; o.x = cvt_pk_bf16(sigmoid_fast_(acc[m][0][j] + bg[0]), sigmoid_fast_(acc[m][1][j] + bg[1])); o.y = cvt_pk_bf16(sigmoid_fast_(acc[m][2][j] + bg[2]), sigmoid_fast_(acc[m][3][j] + bg[3]));
                    *(uint2*)(p.Cb2 + (size_t)row * 8192 + gc) = o;
                }
        }
    }
}
__device__ __forceinline__ void phase_merge(char* shm, const GP& p) {
    typedef GemmCore<128, false> G;
    for (int L = bid_opaque(); L < 64 * 8; L += grid_n()) {
        int pm, pn; static_order(L, 64, 8, pm, pn);
        f32x4 mg[4][4]; ZERO_ACC(mg, 4);
        f32x4 acc[4][4]; ZERO_ACC(acc, 4);
        {
            const int t0 = tid_opaque();
            unsigned aoff[G::GLA], boff[4];
#pragma unroll
            for (int i = 0; i < G::GLA; ++i) { int R, C; G::a_coord(t0, i, R, C); aoff[i] = (unsigned)((R * DM_ + C) * 2); }
#pragma unroll
            for (int i = 0; i < 4; ++i) { int cc, C; G::bt_coord(t0, i, cc, C); boff[i] = (unsigned)((cc * 512 + C) * 2); }
            const bf16_t* gates = p.G;
            auto seg_epi = [&acc, &mg, gates, pm, pn](int k) __attribute__((always_inline)) {
                const int t1 = tid_opaque(); LANE_IDS(t1)
                const bf16_t* gp = gates + (size_t)(pm * 128 + wr * 64 + fq * 4) * 8192 + k * DM_ + pn * 256 + wc * 64 + 4 * fr;
#pragma unroll
                for (int m = 0; m < 4; ++m) {
#pragma unroll
                    for (int j = 0; j < 4; ++j) {
                        const uint2 gv = *(const uint2*)(gp + (size_t)(m * 16 + j) * 8192);
                        mg[m][0][j] += __uint_as_float(gv.x << 16) * acc[m][0][j]; mg[m][1][j] += __uint_as_float(gv.x & 0xffff0000u) * acc[m][1][j];
                        mg[m][2][j] += __uint_as_float(gv.y << 16) * acc[m][2][j]; mg[m][3][j] += __uint_as_float(gv.y & 0xffff0000u) * acc[m][3][j];
                    }
#pragma unroll
                    for (int n = 0; n < 4; ++n) acc[m][n] = (f32x4){0.f, 0.f, 0.f, 0.f};
                    __builtin_amdgcn_sched_barrier(0);
                }
            };
            G::template run_bt_seg<8>(shm, (const char*)(p.A + (size_t)pm * 128 * DM_), aoff, (const char*)(p.Bt + (size_t)pn * 256 * 512), boff, 512 * 2, (size_t)DM_ * 512 * 2,
                                      (const char*)(p.A + (size_t)pm * 128 * DM_), 32, acc, seg_epi);
        }
        const int t2 = tid_opaque(); LANE_IDS(t2)
        bf16_t* op = p.Cb + (size_t)(pm * 128 + wr * 64 + fq * 4) * DM_ + pn * 256 + wc * 64 + 4 * fr;
#pragma unroll
        for (int m = 0; m < 4; ++m)
#pragma unroll
            for (int j = 0; j < 4; ++j) {
                uint2 o; o.x = cvt_pk_bf16(mg[m][0][j], mg[m][1][j]); o.y = cvt_pk_bf16(mg[m][2][j], mg[m][3][j]);
                *(uint2*)(op + (size_t)(m * 16 + j) * DM_) = o;
            }
    }
}
__device__ __forceinline__ void phase_outproj(char* shm, const GP& p) {
    typedef GemmCore<256, false> G;
    for (int L = bid_opaque(); L < 32 * 8; L += grid_n()) {
        int pm, pn; static_order(L, 32, 8, pm, pn);
        f32x4 acc[8][4]; ZERO_ACC(acc, 8);
        {
            const int t0 = tid_opaque();
            unsigned aoff[G::GLA], boff[4];
#pragma unroll
            for (int i = 0; i < G::GLA; ++i) { int R, C; G::a_coord(t0, i, R, C); aoff[i] = (unsigned)((R * DM_ + C) * 2); }
#pragma unroll
            for (int i = 0; i < 4; ++i) { int cc, C; G::bt_coord(t0, i, cc, C); boff[i] = (unsigned)((cc * DM_ + C) * 2); }
            const char* pf = t0 < 256 ? (const char*)(p.A + (size_t)(pm * 256 + t0) * DM_) : (const char*)(p.Bt + (size_t)(pn * 256 + t0 - 256) * DM_);
            G::run_bt(shm, (const char*)(p.A + (size_t)pm * 256 * DM_), aoff, (const char*)(p.Bt + (size_t)pn * 256 * DM_), boff, DM_ * 2, pf, DM_ / 64, acc);
        }
        const int t1 = tid_opaque(); LANE_IDS(t1)
        const size_t o0 = (size_t)(pm * 256 + wr * 128 + fq * 4) * DM_ + pn * 256 + wc * 64 + 4 * fr;
#pragma unroll
        for (int m = 0; m < 8; ++m)
#pragma unroll
            for (int j = 0; j < 4; ++j) {
                const size_t o = o0 + (size_t)(m * 16 + j) * DM_;
                const f32x4 r = *(const f32x4*)(p.R + o);
                *(f32x4*)(p.Cf + o) = (f32x4){r[0] + acc[m][0][j], r[1] + acc[m][1][j], r[2] + acc[m][2][j], r[3] + acc[m][3][j]};
            }
    }
}
__device__ __forceinline__ void phase_moe_up(char* shm, const GP& p) {
    typedef GemmCore<256, true> G;
    for (int L = bid_opaque(); L < 64 * 16; L += grid_n()) {
        const int xcd = L & 7, wg = xcd * 128 + (L >> 3), b = wg & 3, pair = wg >> 2, e = pair >> 4, nt = pair & 15, z = b * 16 + e;
        f32x4 acc[8][4]; ZERO_ACC(acc, 8);
        {
            const int t0 = tid_opaque(); int bk, bc, bw; G::b_coord(t0, bk, bc, bw);
            unsigned aoff[G::GLA];
#pragma unroll
            for (int i = 0; i < G::GLA; ++i) { int R, C; G::a_coord(t0, i, R, C); aoff[i] = (unsigned)(((b * SEQ_ + p.idx[z * 256 + R]) * DM_ + C) * 2); }
            const float* wsel = bw ? p.B2 : p.B;
            G::run(shm, (const char*)p.A, aoff, (const char*)(wsel + (size_t)e * DM_ * DM_ + (size_t)bk * DM_ + nt * 128 + bc), DM_ * 4, DM_ / 64, acc);
        }
        const int t1 = tid_opaque(); LANE_IDS(t1)
        const int hi = (fr >> 3) & 1;
        bf16_t* op = p.Cb + (size_t)(z * 256 + wr * 128 + fq * 4) * DM_ + nt * 128 + wc * 32 + 4 * (fr & 7);
#pragma unroll
        for (int mm = 0; mm < 4; ++mm)
#pragma unroll
            for (int j = 0; j < 4; ++j) {
                float a[4], g[4];
#pragma unroll
                for (int n = 0; n < 4; ++n) {
                    const float lo = acc[mm][n][j], hv = acc[mm + 4][n][j];
                    const float send = hi ? lo : hv;
                    const float recv = __shfl_xor(send, 8, 64);
                    a[n] = hi ? recv : lo;
                    g[n] = hi ? hv : recv;
                }
                uint2 o; o.x = cvt_pk_bf16(silu_fast_(a[0]) * g[0], silu_fast_(a[1]) * g[1]); o.y = cvt_pk_bf16(silu_fast_(a[2]) * g[2], silu_fast_(a[3]) * g[3]);
                *(uint2*)(op + (size_t)((mm + 4 * hi) * 16 + j) * DM_) = o;
            }
    }
}
__device__ __forceinline__ void phase_moe_down(char* shm, const GP& p) {
    typedef GemmCore<256, false> G;
    for (int L = bid_opaque(); L < 64 * 8; L += grid_n()) {
        const int xcd = L & 7, wg = xcd * 64 + (L >> 3), b = wg & 3, pair = wg >> 2, e = pair >> 3, nt = pair & 7, z = b * 16 + e;
        f32x4 acc[8][4]; ZERO_ACC(acc, 8);
        {
            const int t0 = tid_opaque(); int bk, bc, bw; G::b_coord(t0, bk, bc, bw);
            unsigned aoff[G::GLA];
#pragma unroll
            for (int i = 0; i < G::GLA; ++i) { int R, C; G::a_coord(t0, i, R, C); aoff[i] = (unsigned)((R * DM_ + C) * 2); }
            G::run(shm, (const char*)(p.A + (size_t)z * 256 * DM_), aoff, (const char*)(p.B + (size_t)e * DM_ * DM_ + (size_t)bk * DM_ + nt * 256 + bc), DM_ * 4, DM_ / 64, acc);
        }
        const int t1 = tid_opaque(); LANE_IDS(t1)
        const int row0 = z * 256 + wr * 128 + fq * 4;
        bf16_t* op = p.Cb + (size_t)row0 * DM_ + nt * 256 + wc * 64 + 4 * fr;
#pragma unroll
        for (int m = 0; m < 8; ++m)
#pragma unroll
            for (int j = 0; j < 4; ++j) {
                const float gt = p.gate[row0 + m * 16 + j];
                uint2 o; o.x = cvt_pk_bf16(gt * acc[m][0][j], gt * acc[m][1][j]); o.y = cvt_pk_bf16(gt * acc[m][2][j], gt * acc[m][3][j]);
                *(uint2*)(op + (size_t)(m * 16 + j) * DM_) = o;
            }
    }
}
#define XB_TMO      128
#define XB_XCNT(j)  (256  + 64 * (j))
#define XB_XSUB(j)  (1280 + 64 * (j))
#define XB_XGEN(j)  (2304 + 64 * (j))
#define XB_TOP      3328
#define XB_TOPGEN   3392
#define XCD_BAR_WORDS 3456
#define XB_SPIN_CAP (1u << 18)
#define LAS __attribute__((address_space(3)))

__device__ __forceinline__ unsigned xb_ld(unsigned* p)              { return __hip_atomic_load(p, __ATOMIC_RELAXED, __HIP_MEMORY_SCOPE_AGENT); }
__device__ __forceinline__ unsigned xb_add(unsigned* p, unsigned v) { return __hip_atomic_fetch_add(p, v, __ATOMIC_RELAXED, __HIP_MEMORY_SCOPE_AGENT); }
__device__ __forceinline__ unsigned xb_xcc_id() { return (unsigned)__builtin_amdgcn_s_getreg((3 << 11) | 20) & 0xFu; }
#define XB_SPIN(cond, bar) do { unsigned _sp = 0; while (cond) { __builtin_amdgcn_s_sleep(1); \
    if ((++_sp & 255u) == 0u) { if (xb_ld(&(bar)[XB_TMO])) break; if (_sp > XB_SPIN_CAP) { atomicAdd(&(bar)[XB_TMO], 1u); break; } } } } while (0)

struct XcdBarrier {
    unsigned* bar; unsigned x;
    volatile LAS unsigned* st;
};

__device__ __forceinline__ XcdBarrier xcd_barrier_post(unsigned* bar, volatile LAS unsigned* st) {
    XcdBarrier b; b.bar = bar; b.x = xb_xcc_id(); b.st = st;
    if (threadIdx.x == 0) (void)xb_add(&bar[XB_XCNT(b.x)], 1u);
    return b;
}
__device__ __forceinline__ void xcd_barrier_complete(unsigned* bar, unsigned x, unsigned& nloc, unsigned& nx) {
    const unsigned G = gridDim.x * gridDim.y * gridDim.z;
    unsigned sum, cnt, mine, sp = 0u;
    for (;;) {
        sum = 0u; cnt = 0u; mine = 0u;
#pragma unroll
        for (unsigned j = 0; j < 16; ++j) { const unsigned c = xb_ld(&bar[XB_XCNT(j)]); sum += c; cnt += (c > 0u) ? 1u : 0u; mine = (j == x) ? c : mine; }
        if (sum == G) break;
        __builtin_amdgcn_s_sleep(1);
        if ((++sp & 255u) == 0u) { if (xb_ld(&bar[XB_TMO])) break; if (sp > XB_SPIN_CAP) { atomicAdd(&bar[XB_TMO], 1u); break; } }
    }
    nloc = mine > 0u ? mine : 1u; nx = cnt > 0u ? cnt : 1u;
}

__device__ __forceinline__ void xcd_barrier(const XcdBarrier& b) {
    asm volatile("s_waitcnt vmcnt(0)" ::: "memory");
    __syncthreads();
    if (threadIdx.x == 0) {
        unsigned* bar = b.bar; unsigned bx_ = b.x;
        asm volatile("" : "+s"(bar), "+s"(bx_));
        __builtin_amdgcn_s_waitcnt(0);
        unsigned nloc = b.st[0], nx = b.st[1];
        const unsigned old = xb_add(&bar[XB_XSUB(bx_)], 1u);
        const unsigned gen = old / nloc;
        if (old + 1u == (gen + 1u) * nloc) {
            __builtin_amdgcn_fence(__ATOMIC_RELEASE, "agent");
            asm volatile("s_waitcnt vmcnt(0)" ::: "memory");
            const unsigned og = xb_add(&bar[XB_TOP], 1u);
            const unsigned tg = og / nx;
            if (og + 1u == (tg + 1u) * nx) xb_add(&bar[XB_TOPGEN], 1u);
            else XB_SPIN(xb_ld(&bar[XB_TOPGEN]) == tg, bar);
            __builtin_amdgcn_fence(__ATOMIC_ACQUIRE, "agent");
            xb_add(&bar[XB_XGEN(bx_)], 1u);
            asm volatile("s_waitcnt vmcnt(0)" ::: "memory");
        } else {
            XB_SPIN(xb_ld(&bar[XB_XGEN(bx_)]) == gen, bar);
            __builtin_amdgcn_fence(__ATOMIC_ACQUIRE, "agent");
            asm volatile("s_waitcnt vmcnt(0)" ::: "memory");
        }
    }
    __syncthreads();
}

enum { X = 0, N1G, WIN, HCW, HCB, FW1, FB1, FW2, FB2, FW3, FB3, FW4, FREQ, HBIAS, LCW, LCB, LWA, LBA, LWX, LBX, LLAM, DLAM, DSUB, SCW, SCB, SDTB, SALOG, SD, SNG, WBR, BG, WOUT,
       N2G, WR, W1, W3, W2, RELB, FING };
struct MP {
    const float* in[39]; float* out; unsigned* bar;
    float* xres; bf16_t* hb; bf16_t* proj; bf16_t* gates; float* dtraw; bf16_t* br; bf16_t* mrg;
    float* fr; float* nrm; unsigned* hpp; bf16_t* vvt; float* hyt; bf16_t* vt;
    float* sumP; float* sumE; bf16_t* sxa; bf16_t* sxT; float* states; float* sdec; bf16_t* sprev;
    float* aff; int* tidx; float* tgat; int* tinv; bf16_t* hid; bf16_t* ybuf;
    bf16_t* wtin; bf16_t* wtbr; bf16_t* wtout; bf16_t* lruwt;
    int ngrid, pad1;
};
typedef const MP __attribute__((address_space(4)))* MPc;
__device__ __forceinline__ MPc params() { MPc q = (MPc)__builtin_amdgcn_kernarg_segment_ptr(); asm volatile("" : "+s"(q)); return q; }
__device__ __forceinline__ int bid_opaque() { int b = (int)__builtin_amdgcn_workgroup_id_x(); asm volatile("" : "+s"(b)); return b; }
__device__ __forceinline__ int grid_n() { return params()->ngrid; }
#define MEGA_LDS (139264 + 1024)
#define NPH 12

template <int MODE>
__device__ __forceinline__ void phase_norm(char* shm, MPc p, int l) {
    float* hrow = (float*)shm;
    float* red = (float*)(shm + 65536);
    for (int it = bid_opaque(); it < TT_ / 8; it += grid_n()) {
        const int tid = tid_opaque(), wid = tid >> 6, lane = tid & 63;
        const int tok = it * 8 + wid, b = tok >> 11;
        const float* xin = (MODE == 0 && l == 0) ? p->in[X] : p->xres;
        f32x4 v[8];
#pragma unroll
        for (int i = 0; i < 8; ++i) v[i] = *(const f32x4*)(xin + (size_t)tok * DM_ + (i * 64 + lane) * 4);
        if (MODE == 2 || (MODE == 0 && l > 0)) {
            for (int e = 0; e < 16; ++e) {
                const int slot = p->tinv[tok * 16 + e];
                if (slot >= 0) {
                    const bf16_t* yr = p->ybuf + ((size_t)(b * 16 + e) * 256 + slot) * DM_;
#pragma unroll
                    for (int i = 0; i < 8; ++i) { const uint2 y = *(const uint2*)(yr + (i * 64 + lane) * 4);
                        v[i][0] += __uint_as_float(y.x << 16); v[i][1] += __uint_as_float(y.x & 0xffff0000u); v[i][2] += __uint_as_float(y.y << 16); v[i][3] += __uint_as_float(y.y & 0xffff0000u); }
                }
            }
        }
        float ss = 0.f;
#pragma unroll
        for (int i = 0; i < 8; ++i) ss += v[i][0] * v[i][0] + v[i][1] * v[i][1] + v[i][2] * v[i][2] + v[i][3] * v[i][3];
#pragma unroll
        for (int o = 32; o > 0; o >>= 1) ss += __shfl_xor(ss, o, 64);
        const float rs = rsqrtf(ss * (1.0f / DM_) + 1e-6f);
        const float* g = MODE == 0 ? p->in[N1G] + l * DM_ : (MODE == 1 ? p->in[N2G] + l * DM_ : p->in[FING]);
        if (MODE != 2) __syncthreads();
#pragma unroll
        for (int i = 0; i < 8; ++i) {
            const int c = (i * 64 + lane) * 4;
            const f32x4 gv = *(const f32x4*)(g + c);
            const f32x4 y = (f32x4){v[i][0] * rs * gv[0], v[i][1] * rs * gv[1], v[i][2] * rs * gv[2], v[i][3] * rs * gv[3]};
            if (MODE == 0) *(f32x4*)(p->xres + (size_t)tok * DM_ + c) = v[i];
            if (MODE == 2) *(f32x4*)(p->out + (size_t)tok * DM_ + c) = y;
            else {
                uint2 o; o.x = cvt_pk_bf16(y[0], y[1]); o.y = cvt_pk_bf16(y[2], y[3]);
                *(uint2*)(p->hb + (size_t)tok * DM_ + c) = o;
                *(f32x4*)(hrow + wid * DM_ + c) = y;
            }
        }
        if (MODE != 2) {
            __syncthreads();
            const float* W = MODE == 0 ? p->in[WIN] + (size_t)l * DM_ * INC_ + PROJW : p->in[WR] + (size_t)l * DM_ * 16;
            const int ldw = MODE == 0 ? INC_ : 16;
            const int e = tid & 15, part = tid >> 4;
            float acc[8] = {0.f, 0.f, 0.f, 0.f, 0.f, 0.f, 0.f, 0.f};
#pragma unroll 4
            for (int k = part * 64; k < part * 64 + 64; ++k) {
                const float w = W[(size_t)k * ldw + e];
#pragma unroll
                for (int t = 0; t < 8; ++t) acc[t] += hrow[t * DM_ + k] * w;
            }
#pragma unroll
            for (int t = 0; t < 8; ++t) red[(t * 32 + part) * 16 + e] = acc[t];
            __syncthreads();
            if (tid < 128) {
                const int tl = tid >> 4, e2 = tid & 15; float s = 0.f;
                for (int q = 0; q < 32; ++q) s += red[(tl * 32 + q) * 16 + e2];
                const int tk = it * 8 + tl;
                if (MODE == 0) p->dtraw[(size_t)tk * 16 + e2] = s;
                else {
                    float m = s;
#pragma unroll
                    for (int o = 8; o > 0; o >>= 1) m = fmaxf(m, __shfl_xor(m, o, 64));
                    const float ex = expf(s - m); float z = ex;
#pragma unroll
                    for (int o = 8; o > 0; o >>= 1) z += __shfl_xor(z, o, 64);
                    p->aff[(size_t)tk * 16 + e2] = ex / z;
                }
            }
        }
    }
}
__device__ __forceinline__ int block_sum_512(int v, volatile int* red  , int par, int tid) {
#pragma unroll
    for (int o = 32; o > 0; o >>= 1) v += __shfl_xor(v, o, 64);
    if ((tid & 63) == 0) red[par * 8 + (tid >> 6)] = v;
    __syncthreads();
    int s = 0;
#pragma unroll
    for (int w = 0; w < 8; ++w) s += red[par * 8 + w];
    return s;
}
__device__ __forceinline__ int block_exscan_512(int v, volatile int* wsum  , int tid) {
    int inc = v;
#pragma unroll
    for (int o = 1; o < 64; o <<= 1) { const int n = __shfl_up(inc, o, 64); if ((tid & 63) >= o) inc += n; }
    if ((tid & 63) == 63) wsum[tid >> 6] = inc;
    __syncthreads();
    int base = 0;
#pragma unroll
    for (int w = 0; w < 8; ++w) base += (w < (tid >> 6)) ? wsum[w] : 0;
    __syncthreads();
    return base + inc - v;
}
__device__ __forceinline__ void phase_topk(char* shm, MPc p) {
    volatile int* red = (volatile int*)shm;
    volatile int* wsum = red + 16;
    for (int z = bid_opaque(); z < 64; z += grid_n()) {
        const int b = z >> 4, e = z & 15, tid = tid_opaque();
        __syncthreads();
        float v[4]; unsigned u[4];
#pragma unroll
        for (int i = 0; i < 4; ++i) { v[i] = p->aff[(size_t)(b * SEQ_ + tid * 4 + i) * 16 + e]; u[i] = __float_as_uint(v[i]); }
        unsigned T = 0u;
        for (int bit = 30; bit >= 0; --bit) {
            const unsigned cand = T | (1u << bit);
            const int c = block_sum_512((u[0] >= cand) + (u[1] >= cand) + (u[2] >= cand) + (u[3] >= cand), red, bit & 1, tid);
            if (c >= 256) T = cand;
        }
        __syncthreads();
        const int ngt = block_sum_512((u[0] > T) + (u[1] > T) + (u[2] > T) + (u[3] > T), red, 0, tid);
        const int need = 256 - ngt;
        __syncthreads();
        const int eq_l = (u[0] == T) + (u[1] == T) + (u[2] == T) + (u[3] == T);
        int eqr = block_exscan_512(eq_l, wsum, tid);
        int sel[4], nsel = 0;
#pragma unroll
        for (int i = 0; i < 4; ++i) { const bool isq = u[i] == T; sel[i] = (u[i] > T) || (isq && eqr < need); eqr += isq ? 1 : 0; nsel += sel[i]; }
        int slot = block_exscan_512(nsel, wsum, tid);
#pragma unroll
        for (int i = 0; i < 4; ++i) {
            const int t = tid * 4 + i;
            if (sel[i]) { p->tidx[z * 256 + slot] = t; p->tgat[z * 256 + slot] = v[i]; }
            p->tinv[(b * SEQ_ + t) * 16 + e] = sel[i] ? slot : -1;
            slot += sel[i];
        }
    }
}
__device__ __forceinline__ void phase_hy_filter(char* shm, MPc p) {
    float* zz = (float*)shm; float* ha = zz + 8 * 64; float* hbq = ha + 8 * 64;
    for (int u = bid_opaque(); u < 512; u += grid_n()) {
        const int lf = u >> 8, tid = tid_opaque(), wid = tid >> 6, o = tid & 63, i = (u & 255) * 8 + wid;
        const float* fw1 = p->in[FW1] + lf * 33 * 64; const float* fw2 = p->in[FW2] + lf * 4096; const float* fw3 = p->in[FW3] + lf * 4096; const float* fw4 = p->in[FW4] + lf * 64 * 512;
        const float t = (float)i / (float)(SEQ_ - 1);
        const float w = (2.0f * 3.14159265358979323846f / (float)SEQ_) * (float)i;
        __syncthreads();
        if (o == 0) zz[wid * 64] = t;
        if (o < 16) { const float band = 1e-4f + (float)o * ((15.0f - 1e-4f) / 15.0f); zz[wid * 64 + 1 + o] = cosf(band * w); zz[wid * 64 + 17 + o] = -sinf(band * w); }
        __syncthreads();
        const float fq = p->in[FREQ][lf * 64 + o];
        float s = p->in[FB1][lf * 64 + o];
        for (int k = 0; k < 33; ++k) s += zz[wid * 64 + k] * fw1[k * 64 + o];
        ha[wid * 64 + o] = sinf(fq * s);
        __syncthreads();
        s = p->in[FB2][lf * 64 + o];
        for (int k = 0; k < 64; ++k) s += ha[wid * 64 + k] * fw2[k * 64 + o];
        hbq[wid * 64 + o] = sinf(fq * s);
        __syncthreads();
        s = p->in[FB3][lf * 64 + o];
        for (int k = 0; k < 64; ++k) s += hbq[wid * 64 + k] * fw3[k * 64 + o];
        __syncthreads();
        ha[wid * 64 + o] = sinf(fq * s);
        __syncthreads();
        { const float d0 = logf(1e-2f) / 1.5f, d1 = logf(1e-2f) / 0.3f;
          const int c = tid;
          float a8[8] = {0.f, 0.f, 0.f, 0.f, 0.f, 0.f, 0.f, 0.f};
          for (int k = 0; k < 64; ++k) { const float wv = fw4[k * 512 + c];
#pragma unroll
              for (int q = 0; q < 8; ++q) a8[q] += ha[q * 64 + k] * wv; }
          const float delta = fabsf(d0 + (float)c * ((d1 - d0) / 511.0f));
#pragma unroll
          for (int q = 0; q < 8; ++q) { const int iq = (u & 255) * 8 + q; const float tq = (float)iq / (float)(SEQ_ - 1);
              p->fr[((size_t)lf * SEQ_ + iq) * 512 + c] = a8[q] * __expf(-2.0f * fabsf(tq - 0.5f) * delta); } }
    }
}
__device__ __forceinline__ void phase_hy_norm(MPc p) {
    for (int u = bid_opaque(); u < 128; u += grid_n()) {
        const int tid = tid_opaque(), pr = u * 8 + (tid >> 6), lane = tid & 63, lf = pr >> 9, c = pr & 511;
        float s = 0.f;
        for (int q = 0; q < 32; ++q) s += fabsf(p->fr[((size_t)lf * SEQ_ + lane + 64 * q) * 512 + c]);
#pragma unroll
        for (int o = 32; o > 0; o >>= 1) s += __shfl_xor(s, o, 64);
        if (lane == 0) p->nrm[pr] = s;
    }
}

__device__ __forceinline__ GP mk_gp(MPc p, int l, int which) {
    GP g{};
    if (which == 0) { g.A = p->hb; g.Bt = p->wtin + (size_t)l * 13824 * DM_; g.bias = p->in[BG] + (size_t)l * 4 * DM_; g.Cb = p->proj; g.Cb2 = p->gates; g.Vt = p->vt; }
    if (which == 1) { g.A = p->br; g.Bt = p->wtbr + (size_t)l * 4 * DM_ * 512; g.G = p->gates; g.Cb = p->mrg; }
    if (which == 2) { g.A = p->mrg; g.Bt = p->wtout + (size_t)l * DM_ * DM_; g.R = p->xres; g.Cf = p->xres; }
    if (which == 3) { g.A = p->hb; g.B = p->in[W1] + (size_t)l * 16 * DM_ * DM_; g.B2 = p->in[W3] + (size_t)l * 16 * DM_ * DM_; g.idx = p->tidx; g.Cb = p->hid; }
    if (which == 4) { g.A = p->hid; g.B = p->in[W2] + (size_t)l * 16 * DM_ * DM_; g.gate = p->tgat; g.Cb = p->ybuf; }
    return g;
}
__device__ __forceinline__ HP mk_hp(MPc p, int l) {
    HP h{}; h.proj = p->proj; h.fr = p->fr + (size_t)l * SEQ_ * 512; h.nrm = p->nrm + l * 512; h.pp = p->hpp + (size_t)l * 512 * HY_PPW; h.vvt = p->vvt; h.yt = p->hyt;
    h.cw = p->in[HCW] + l * 3 * 1536; h.cb = p->in[HCB] + l * 1536; h.hbias = p->in[HBIAS] + l * 512; h.br = p->br; return h;
}
__device__ __forceinline__ LP mk_lp(MPc p, int l) {
    LP q{}; q.proj = p->proj; q.cw = p->in[LCW] + l * 4 * 512; q.cb = p->in[LCB] + l * 512; q.wt = p->lruwt + (size_t)l * 8 * 256 * 64; q.ba = p->in[LBA] + l * 1024;
    q.bx = p->in[LBX] + l * 1024; q.lam = p->in[LLAM] + l * 1024; q.sumP = p->sumP; q.sumE = p->sumE; q.br = p->br; return q;
}
__device__ __forceinline__ SP_ mk_sp(MPc p, int l) {
    SP_ s{}; s.proj = p->proj; s.dtraw = p->dtraw; s.cw = p->in[SCW] + l * 4 * 1024; s.cb = p->in[SCB] + l * 1024; s.dtb = p->in[SDTB] + l * 16; s.a_log = p->in[SALOG] + l * 16; s.dsk = p->in[SD] + l * 8; s.ng = p->in[SNG] + l * 512;
    s.xa = p->sxa; s.xT = p->sxT; s.states = p->states; s.decay = p->sdec; s.prev = p->sprev; s.br = p->br; return s;
}
__device__ __forceinline__ AP mk_ap(MPc p, int l) {
    AP a{}; a.proj = p->proj; a.vt = p->vt; a.rel_bias = p->in[RELB]; a.dlam = p->in[DLAM] + l * 256; a.subg = p->in[DSUB] + l * 128; a.br = p->br; a.lam_init = l == 0 ? 0.2f : 0.35550906759096926f; return a;
}
__device__ __forceinline__ void wconv_tile(float* tile, const float* src, size_t ld_src, bf16_t* dst, size_t ld_dst, int tid) {
    __syncthreads();
    { const int kr = tid >> 4, n4 = (tid & 15) * 4;
#pragma unroll
      for (int h = 0; h < 2; ++h) { const f32x4 v = *(const f32x4*)(src + (size_t)(kr + 32 * h) * ld_src + n4); float* t = tile + (kr + 32 * h) * 65 + n4; t[0] = v[0]; t[1] = v[1]; t[2] = v[2]; t[3] = v[3]; } }
    __syncthreads();
    { const int n = tid >> 3, k8 = (tid & 7) * 8; const float* t = tile + k8 * 65 + n;
      uint4 o; o.x = cvt_pk_bf16(t[0], t[65]); o.y = cvt_pk_bf16(t[130], t[195]); o.z = cvt_pk_bf16(t[260], t[325]); o.w = cvt_pk_bf16(t[390], t[455]);
      *(uint4*)(dst + (size_t)n * ld_dst + k8) = o; }
}
__device__ __forceinline__ void phase_wconv(char* shm, MPc p, int l, int bw0, int bwn) {
    const int bq = bid_opaque() - bw0; if (bq < 0 || bq >= bwn) return;
    for (int e0 = bq * 512 + tid_opaque(); e0 < 8 * 256 * 64; e0 += bwn * 512) {
        const int e = l * 8 * 256 * 64 + e0; const int i = e & 63, n = (e >> 6) & 255, h = (e >> 14) & 7, j = n & 63, g = (n >> 6) & 1, dir = n >> 7;
        const float* w = (g ? p->in[LWX] : p->in[LWA]) + ((size_t)((l * 2 + dir) * 8 + h) * 64 + i) * 64 + j;
        p->lruwt[e] = f2bf(*w);
    }
    float* tile = (float*)shm;
    const int NJ_IN = 32 * 216, NJ_BR = 4 * 8 * 32, NJ_OUT = 32 * 32, NJ = NJ_IN + NJ_BR + NJ_OUT;
    for (int u = bq; u < NJ; u += bwn) {
        int j = u; const int tid = tid_opaque();
        if (j < NJ_IN) { const int nt = j % 216, kt = j / 216, n0 = nt * 64, ns = n0 < PROJW ? n0 : n0 + 16;
            wconv_tile(tile, p->in[WIN] + (size_t)l * DM_ * INC_ + (size_t)kt * 64 * INC_ + ns, INC_, p->wtin + ((size_t)l * 13824 + n0) * DM_ + kt * 64, DM_, tid); }
        else if (j < NJ_IN + NJ_BR) { j -= NJ_IN; const int nt = j & 31, kt = (j >> 5) & 7, k = j >> 8;
            wconv_tile(tile, p->in[WBR] + ((size_t)(l * 4 + k) * 512 + kt * 64) * DM_ + nt * 64, DM_, p->wtbr + (((size_t)(l * 4 + k) * DM_) + nt * 64) * 512 + kt * 64, 512, tid); }
        else { j -= NJ_IN + NJ_BR; const int nt = j & 31, kt = j >> 5;
            wconv_tile(tile, p->in[WOUT] + ((size_t)l * DM_ + kt * 64) * DM_ + nt * 64, DM_, p->wtout + ((size_t)l * DM_ + nt * 64) * DM_ + kt * 64, DM_, tid); }
    }
}
#define PH_ON(id) (ONLY < 0 || ONLY == (id))
#define PH_SYNC(id) do { if (ONLY < 0) xcd_barrier(bar); } while (0)
template <int ONLY>
__global__ void __launch_bounds__(512, 2) k_mega(MP p_unused) {
    extern __shared__ __attribute__((aligned(1024))) char shm[];
    XcdBarrier bar{};
    if (ONLY < 0) {
        volatile LAS unsigned* xbw = (volatile LAS unsigned*)(shm + MEGA_LDS - 16);
        if (threadIdx.x == 0) { xbw[0] = 0u; xbw[1] = 0u; }
        __syncthreads();
        bar = xcd_barrier_post(params()->bar, xbw);
        if (threadIdx.x == 0) { unsigned nloc, nx; xcd_barrier_complete(bar.bar, bar.x, nloc, nx); xbw[0] = nloc; xbw[1] = nx; }
        __syncthreads();
    }
    constexpr int L0 = ONLY < 0 ? 0 : (ONLY >= 2 * NPH ? 2 : ONLY / NPH), L1 = ONLY < 0 ? 2 : (ONLY >= 2 * NPH ? 2 : ONLY / NPH + 1);
#pragma unroll 1
    for (int l = L0; l < L1; ++l) {
        const int id0 = l * NPH;
        if (PH_ON(id0 + 0)) { phase_norm<0>(shm, params(), l); if (l == 0) { phase_hy_filter(shm, params()); phase_wconv(shm, params(), 0, 0, grid_n()); } }
        PH_SYNC(id0 + 0);
        if (PH_ON(id0 + 1)) { if (l == 0) phase_hy_norm(params()); const GP g = mk_gp(params(), l, 0); phase_inproj(shm, g); }
        PH_SYNC(id0 + 1);
        if (PH_ON(id0 + 2)) {
            { const AP a = mk_ap(params(), l); phase_attn(shm, a); }
            if (l == 0) { const HP h0 = mk_hp(params(), 0); phase_hy_pp(h0); const HP h1 = mk_hp(params(), 1); phase_hy_pp(h1); }
            { const HP h = mk_hp(params(), l); phase_hy_prep(shm, h); }
            { const SP_ s = mk_sp(params(), l); phase_ssd_prep(shm, s); }
            { const LP q = mk_lp(params(), l); phase_lru<0>(shm, q); }
        }
        PH_SYNC(id0 + 2);
        if (PH_ON(id0 + 3)) {
            { const HP h = mk_hp(params(), l); phase_hy_conv(shm, h); }
            { const SP_ s = mk_sp(params(), l); phase_ssd_states(shm, s); }
            { const LP q = mk_lp(params(), l); phase_lru<1>(shm, q); }
        }
        PH_SYNC(id0 + 3);
        if (PH_ON(id0 + 4)) { const SP_ s = mk_sp(params(), l); phase_ssd_scan(s); }
        PH_SYNC(id0 + 4);
        if (PH_ON(id0 + 5)) { { const SP_ s = mk_sp(params(), l); phase_ssd_out(shm, s); }
            { const HP h = mk_hp(params(), l); phase_hy_fin(shm, h, 0, grid_n()); }
            if (l == 0) phase_wconv(shm, params(), 1, 0, grid_n()); }
        PH_SYNC(id0 + 5);
        if (PH_ON(id0 + 6)) { const GP g = mk_gp(params(), l, 1); phase_merge(shm, g); }
        PH_SYNC(id0 + 6);
        if (PH_ON(id0 + 7)) { const GP g = mk_gp(params(), l, 2); phase_outproj(shm, g); }
        PH_SYNC(id0 + 7);
        if (PH_ON(id0 + 8)) phase_norm<1>(shm, params(), l);
        PH_SYNC(id0 + 8);
        if (PH_ON(id0 + 9)) phase_topk(shm, params());
        PH_SYNC(id0 + 9);
        if (PH_ON(id0 + 10)) { const GP g = mk_gp(params(), l, 3); phase_moe_up(shm, g); }
        PH_SYNC(id0 + 10);
        if (PH_ON(id0 + 11)) { const GP g = mk_gp(params(), l, 4); phase_moe_down(shm, g); }
        PH_SYNC(id0 + 11);
    }
    if (PH_ON(2 * NPH)) phase_norm<2>(shm, params(), 0);
}
template <int I> struct PhaseLauncher { static void go(int grid, hipStream_t st, const MP& p) { (void)hipFuncSetAttribute((const void*)k_mega<I>, hipFuncAttributeMaxDynamicSharedMemorySize, MEGA_LDS); hipLaunchKernelGGL(k_mega<I>, dim3(grid), dim3(512), MEGA_LDS, st, p); PhaseLauncher<I + 1>::go(grid, st, p); } };
template <> struct PhaseLauncher<2 * NPH + 1> { static void go(int, hipStream_t, const MP&) {} };

#ifndef MK_N_LAUNCHES
#define MK_N_LAUNCHES 1
#endif
extern "C" void kernel_launch(void* const* d_in, const int* in_sizes, int n_in, void* d_out, int out_size, void* d_ws, size_t ws_size, hipStream_t stream) {
    static int grid = 0;
    if (grid == 0) {
        int dev = 0, cus = 0;
        if (hipGetDevice(&dev) != hipSuccess || hipDeviceGetAttribute(&cus, hipDeviceAttributeMultiprocessorCount, dev) != hipSuccess) { fprintf(stderr, "kernel_launch: device query failed\n"); grid = -1; return; }
        if (hipFuncSetAttribute((const void*)k_mega<-1>, hipFuncAttributeMaxDynamicSharedMemorySize, MEGA_LDS) != hipSuccess) { fprintf(stderr, "kernel_launch: hipFuncSetAttribute failed\n"); grid = -1; return; }
        (void)hipGetLastError();
        grid = cus;
    }
    if (grid < 0) return;
    char* w = (char*)d_ws; size_t off = 0;
    auto alloc = [&](size_t bytes) { void* q = w + off; off += (bytes + 255) & ~(size_t)255; return q; };
    MP p{};
    for (int i = 0; i < 39; ++i) p.in[i] = (const float*)d_in[i];
    p.out = (float*)d_out; p.ngrid = grid;
    p.bar = (unsigned*)alloc(XCD_BAR_WORDS * 4);
    p.xres = (float*)alloc((size_t)TT_ * DM_ * 4);
    p.hb = (bf16_t*)alloc((size_t)TT_ * DM_ * 2);
    p.proj = (bf16_t*)alloc((size_t)TT_ * PROJW * 2);
    p.gates = (bf16_t*)alloc((size_t)TT_ * 8192 * 2);
    p.dtraw = (float*)alloc((size_t)TT_ * 16 * 4);
    p.br = (bf16_t*)alloc((size_t)TT_ * DM_ * 2);
    p.mrg = (bf16_t*)alloc((size_t)TT_ * DM_ * 2);
    p.fr = (float*)alloc((size_t)2 * SEQ_ * 512 * 4);
    p.nrm = (float*)alloc(2 * 512 * 4);
    p.hpp = (unsigned*)alloc((size_t)2 * 512 * HY_PPW * 4);
    p.vvt = (bf16_t*)alloc((size_t)512 * NB_ * SEQ_ * 2);
    p.hyt = (float*)alloc((size_t)512 * NB_ * SEQ_ * 4);
    p.vt = (bf16_t*)alloc((size_t)NB_ * 512 * SEQ_ * 2);
    p.sumP = (float*)alloc((size_t)2 * NB_ * 32 * 512 * 4);
    p.sumE = (float*)alloc((size_t)2 * NB_ * 32 * 512 * 4);
    p.sxa = (bf16_t*)alloc((size_t)TT_ * 1024 * 2);
    p.sxT = (bf16_t*)alloc((size_t)TT_ * 1024 * 2);
    p.states = (float*)alloc((size_t)NB_ * SSD_NC * 16 * 64 * 128 * 4);
    p.sdec = (float*)alloc(NB_ * SSD_NC * 16 * 4);
    p.sprev = (bf16_t*)alloc((size_t)NB_ * SSD_NC * 16 * 64 * 128 * 2);
    p.aff = (float*)alloc((size_t)TT_ * 16 * 4);
    p.tidx = (int*)alloc(64 * 256 * 4);
    p.tgat = (float*)alloc(64 * 256 * 4);
    p.tinv = (int*)alloc((size_t)TT_ * 16 * 4);
    p.hid = (bf16_t*)alloc((size_t)64 * 256 * DM_ * 2);
    p.ybuf = (bf16_t*)alloc((size_t)64 * 256 * DM_ * 2);
    p.wtin = (bf16_t*)alloc((size_t)2 * 13824 * DM_ * 2);
    p.wtbr = (bf16_t*)alloc((size_t)2 * 4 * DM_ * 512 * 2);
    p.wtout = (bf16_t*)alloc((size_t)2 * DM_ * DM_ * 2);
    p.lruwt = (bf16_t*)alloc((size_t)2 * 8 * 256 * 64 * 2);
    if (off > ws_size) { fprintf(stderr, "kernel_launch: workspace too small (%zu > %zu)\n", off, ws_size); return; }
    (void)hipMemsetAsync(p.bar, 0, XCD_BAR_WORDS * 4, stream);
#if MK_N_LAUNCHES == 1
    hipLaunchKernelGGL(k_mega<-1>, dim3(grid), dim3(512), MEGA_LDS, stream, p);
#else
    PhaseLauncher<0>::go(grid, stream, p);
#endif
}
```

```cpp
#include <hip/hip_runtime.h>
#include <math.h>
#include <stdint.h>
#include <stdio.h>

#define NB_ 4
#define SEQ_ 2048
#define DM_ 2048
#define TT_ 8192
#define INC_ 13840
#define O_HY 0
#define O_LRU 1536
#define O_DA 2560
#define O_SSD 4096
#define O_GATE 5648
typedef short bf16x8 __attribute__((ext_vector_type(8)));
typedef float f32x4 __attribute__((ext_vector_type(4)));
typedef float f32x2 __attribute__((ext_vector_type(2)));
typedef int i32x4 __attribute__((ext_vector_type(4)));
typedef unsigned short bf16_t;
__device__ __forceinline__ int bid_opaque();
__device__ __forceinline__ int grid_n();

typedef __bf16 bf16x2_t __attribute__((ext_vector_type(2)));
__device__ __forceinline__ unsigned cvt_pk_bf16(float lo, float hi) { const f32x2 v = {lo, hi}; return __builtin_bit_cast(unsigned, __builtin_convertvector(v, bf16x2_t)); }
__device__ __forceinline__ int tid_opaque() { int t = (int)__builtin_amdgcn_workitem_id_x(); asm volatile("" : "+v"(t)); return t; }
__device__ __forceinline__ float bf2f(bf16_t v) { return __uint_as_float((unsigned)v << 16); }
__device__ __forceinline__ bf16_t f2bf(float f) { return (bf16_t)(cvt_pk_bf16(f, 0.f) & 0xffffu); }

__device__ __forceinline__ int lds_rc(int r, int chunk) { return r * 128 + ((chunk ^ ((r >> 1) & 7)) << 4); }
#define GEMM_LDS_BYTES(BM) (2 * ((BM) * 128 + 256 * 128))
#ifndef GEMM_L2PF
#define GEMM_L2PF 0
#endif
#ifndef GEMM_BT_AH
#define GEMM_BT_AH 8
#endif

#define GEMM_KTILE(buf, HOOK) do { const char* sS = shm + (buf) * STAGE; bf16x8 Bc[4], Bn[4], Ar[4]; \
        _Pragma("unroll") for (int n = 0; n < 4; ++n) Bc[n] = *(const bf16x8*)(sS + broff0 + n * 2048); \
        _Pragma("unroll") for (int q = 0; q < 3; ++q) Ar[q] = *(const bf16x8*)(sS + aroff0 + q * 2048); \
        __builtin_amdgcn_sched_barrier(0); \
        _Pragma("unroll") for (int g = 0; g < 2 * FM; ++g) { \
            if (g + 3 < 2 * FM) Ar[(g + 3) & 3] = *(const bf16x8*)(sS + ((g + 3) / FM ? aroff1 : aroff0) + ((g + 3) % FM) * 2048); \
            if (g == FM - 4) { _Pragma("unroll") for (int n = 0; n < 4; ++n) Bn[n] = *(const bf16x8*)(sS + broff1 + n * 2048); } \
            __builtin_amdgcn_sched_barrier(0); \
            _Pragma("unroll") for (int n = 0; n < 4; ++n) acc[g % FM][n] = __builtin_amdgcn_mfma_f32_16x16x32_bf16(Ar[g & 3], (g < FM ? Bc[n] : Bn[n]), acc[g % FM][n], 0, 0, 0); \
            HOOK(g); \
            __builtin_amdgcn_sched_barrier(0); } } while (0)
template <int BM, bool DUAL>
struct GemmCore {
    static constexpr int FM = BM / 32;
    static constexpr int GLA = BM * 128 / 8192;
    static constexpr int TILE_A = BM * 128, TILE_B = 256 * 128, STAGE = TILE_A + TILE_B;

    template <class AccT>
    static __device__ __forceinline__ void run(char* shm, const char* abase, const unsigned (&aoff)[GLA], const char* bl, unsigned ldb, int nt, AccT& acc) {
        const int tid = tid_opaque(), wid = tid >> 6, lane = tid & 63, wr = wid >> 2, wc = wid & 3, fr = lane & 15, fq = lane >> 4;
        const int kq = lane & 3, ngl = lane >> 2, ksub = wid & 1, grp = wid >> 1;
        i32x4 sa[GLA];
        f32x4 sb[8];
        const int awoff = lds_rc(tid >> 3, tid & 7);
        const int bwoff = TILE_A + lds_rc(grp * 64 + ngl, ksub * 4 + kq);
        const int aroff0 = lds_rc(wr * (BM / 2) + fr, fq), aroff1 = lds_rc(wr * (BM / 2) + fr, 4 + fq);
        const int broff0 = TILE_A + lds_rc(wc * 64 + fr, fq), broff1 = TILE_A + lds_rc(wc * 64 + fr, 4 + fq);
#define G_ISSUE(kt) do { const char* ab_ = abase + (size_t)(kt) * 128; _Pragma("unroll") for (int i = 0; i < GLA; ++i) sa[i] = *(const i32x4*)(ab_ + aoff[i]); \
        _Pragma("unroll") for (int r = 0; r < 8; ++r) sb[r] = *(const f32x4*)(bl + (size_t)((kt) * 64 + r) * ldb); \
        __builtin_amdgcn_sched_barrier(0); } while (0)
#define G_WRITE(buf) do { char* sbase = shm + (buf) * STAGE; _Pragma("unroll") for (int i = 0; i < GLA; ++i) *(i32x4*)(sbase + awoff + i * 8192) = sa[i]; \
        _Pragma("unroll") for (int i = 0; i < 4; ++i) { i32x4 w; w[0] = (int)cvt_pk_bf16(sb[0][i], sb[1][i]); w[1] = (int)cvt_pk_bf16(sb[2][i], sb[3][i]); \
              w[2] = (int)cvt_pk_bf16(sb[4][i], sb[5][i]); w[3] = (int)cvt_pk_bf16(sb[6][i], sb[7][i]); *(i32x4*)(sbase + bwoff + i * 2048) = w; } } while (0)
        G_ISSUE(0); G_WRITE(0); if (nt > 1) G_ISSUE(1); __syncthreads();
        for (int t = 0; t < nt; ++t) {
            const int cur = t & 1; const bool w_ok = t + 1 < nt, i_ok = t + 2 < nt;
            char* wb_ = shm + (cur ^ 1) * STAGE; const char* ab2_ = abase + (size_t)(t + 2) * 128; const char* bl2_ = bl + (size_t)(t + 2) * 64 * ldb;
#define G_HOOK(g) do { if ((g) < GLA) { if (w_ok) *(i32x4*)(wb_ + awoff + (g) * 8192) = sa[(g)]; if (i_ok) sa[(g)] = *(const i32x4*)(ab2_ + aoff[(g)]); } \
            else if ((g) >= 8 && (g) < 12) { if (w_ok) { const int i = (g) - 8; i32x4 w; w[0] = (int)cvt_pk_bf16(sb[0][i], sb[1][i]); w[1] = (int)cvt_pk_bf16(sb[2][i], sb[3][i]); \
                  w[2] = (int)cvt_pk_bf16(sb[4][i], sb[5][i]); w[3] = (int)cvt_pk_bf16(sb[6][i], sb[7][i]); *(i32x4*)(wb_ + bwoff + i * 2048) = w; } } \
            else if ((g) >= 12) { if (i_ok) { const int r = ((g) - 12) * 2; sb[r] = *(const f32x4*)(bl2_ + (size_t)r * ldb); sb[r + 1] = *(const f32x4*)(bl2_ + (size_t)(r + 1) * ldb); } } } while (0)
            GEMM_KTILE(cur, G_HOOK);
#undef G_HOOK
            __syncthreads();
        }
#undef G_ISSUE
#undef G_WRITE
    }
    struct NoEpi { __device__ __forceinline__ void operator()(int) const {} };
    template <class AccT>
    static __device__ __forceinline__ void run_bt(char* shm, const char* abase, const unsigned (&aoff)[GLA], const char* bbase, const unsigned (&boff)[4], unsigned ldbt, const char* pf_in, int nt, AccT& acc) {
        run_bt_seg<1 << 20>(shm, abase, aoff, bbase, boff, ldbt, 0, pf_in, nt, acc, NoEpi());
    }
    template <int SEG, class AccT, class Epi>
    static __device__ __forceinline__ void run_bt_seg(char* shm, const char* abase, const unsigned (&aoff)[GLA], const char* bbase, const unsigned (&boff)[4], unsigned ldbt, size_t segstride, const char* pf_in, int nt, AccT& acc, Epi seg_epi) {
        const int tid = tid_opaque(), wid = tid >> 6, lane = tid & 63, wr = wid >> 2, wc = wid & 3, fr = lane & 15, fq = lane >> 4;
        i32x4 sa[GLA], sbt[4];
        const unsigned astr = 64u * DM_ * 2u, bstr = 64u * ldbt;
        const int awoff = lds_rc(tid >> 3, tid & 7);
        const int aroff0 = lds_rc(wr * (BM / 2) + fr, fq), aroff1 = lds_rc(wr * (BM / 2) + fr, 4 + fq);
        const int broff0 = TILE_A + lds_rc(wc * 64 + fr, fq), broff1 = TILE_A + lds_rc(wc * 64 + fr, 4 + fq);
#define T_ISSUE(kt) do { const char* ab_ = abase + (size_t)(kt) * 128 + aoff[0]; const char* bb_ = bbase + (size_t)((kt) / SEG) * segstride + (size_t)((kt) % SEG) * 128 + boff[0]; \
        _Pragma("unroll") for (int i = 0; i < GLA; ++i) sa[i] = *(const i32x4*)(ab_ + (size_t)i * astr); \
        _Pragma("unroll") for (int i = 0; i < 4; ++i) sbt[i] = *(const i32x4*)(bb_ + (size_t)i * bstr); \
        __builtin_amdgcn_sched_barrier(0); } while (0)
#define T_WRITE(buf) do { char* sbase = shm + (buf) * STAGE; _Pragma("unroll") for (int i = 0; i < GLA; ++i) *(i32x4*)(sbase + awoff + i * 8192) = sa[i]; \
        _Pragma("unroll") for (int i = 0; i < 4; ++i) *(i32x4*)(sbase + TILE_A + awoff + i * 8192) = sbt[i]; } while (0)
        const unsigned long long pf0 = (unsigned long long)pf_in;
        const unsigned long long pfu = ((unsigned long long)(unsigned)__builtin_amdgcn_readfirstlane((int)(pf0 >> 32)) << 32) | (unsigned)__builtin_amdgcn_readfirstlane((int)(unsigned)pf0);
        const char* pf = (const char*)pfu; const unsigned pfo = (unsigned)(pf0 - pfu);
        unsigned pfa = 0u, pfb = 0u;
        T_ISSUE(0); T_WRITE(0); if (nt > 1) T_ISSUE(1);
#if GEMM_L2PF
        if (nt > 2) pfa = *(const unsigned*)(pf + 2 * 128 + pfo);
#endif
        __syncthreads();
        for (int t = 0; t < nt; ++t) {
            const int cur = t & 1;
            const bool w_ok = t + 1 < nt, i_ok = t + 2 < nt;
            char* wb_ = shm + (cur ^ 1) * STAGE; const char* ab2_ = abase + (size_t)(t + 2) * 128 + aoff[0];
            const char* bb2_ = bbase + (size_t)((t + 2) / SEG) * segstride + (size_t)((t + 2) % SEG) * 128 + boff[0];
#define T_HOOK(g) do { if ((g) < GLA) { if (w_ok) *(i32x4*)(wb_ + awoff + (g) * 8192) = sa[(g)]; if (i_ok) sa[(g)] = *(const i32x4*)(ab2_ + (size_t)(g) * astr); } \
            else if ((g) < GLA + 4) { const int i = (g) - GLA; if (w_ok) *(i32x4*)(wb_ + TILE_A + awoff + i * 8192) = sbt[i]; if (i_ok) sbt[i] = *(const i32x4*)(bb2_ + (size_t)i * bstr); } } while (0)
#if GEMM_L2PF
            if (t + 3 < nt) pfb = *(const unsigned*)(pf + (size_t)(t + 3) * 128 + pfo);
            asm volatile("" :: "v"(pfa));
            pfa = pfb;
#endif
            GEMM_KTILE(cur, T_HOOK);
#undef T_HOOK
            __syncthreads();
            if ((t % SEG) == SEG - 1) seg_epi(t / SEG);
        }
#undef T_ISSUE
#undef T_WRITE
    }
    static __device__ __forceinline__ void bt_coord(int tid, int i, int& col, int& C) { const int R = (tid >> 3) + 64 * i; C = (tid & 7) * 8;
        col = (R & ~63) + 4 * (R & 15) + ((R >> 4) & 3); }
    static __device__ __forceinline__ void a_coord(int tid, int i, int& R, int& C) { R = (tid >> 3) + 64 * i; C = (tid & 7) * 8; }
    static __device__ __forceinline__ void b_coord(int tid, int& k, int& col, int& which) { const int wid = tid >> 6, lane = tid & 63; const int kq = lane & 3, ngl = lane >> 2, ksub = wid & 1, grp = wid >> 1;
        k = ksub * 32 + kq * 8; if (DUAL) { which = ngl >> 3; col = grp * 32 + 4 * (ngl & 7); } else { which = 0; col = grp * 64 + 4 * ngl; } }
};
#define PROJW 5632
__device__ __forceinline__ float sigmoidf_(float x) { return 1.0f / (1.0f + expf(-x)); }
__device__ __forceinline__ float siluf_(float x) { return x / (1.0f + expf(-x)); }
__device__ __forceinline__ float softplusf_(float x) { return x > 20.f ? x : log1pf(expf(x)); }
__device__ __forceinline__ float sigmoid_fast_(float x) { return __builtin_amdgcn_rcpf(1.0f + __expf(-x)); }
__device__ __forceinline__ float silu_fast_(float x) { return x * __builtin_amdgcn_rcpf(1.0f + __expf(-x)); }
__device__ __forceinline__ float softplus_fast_(float x) { const float e = __expf(x); const float sm = e * (1.0f - e * (0.5f - e * (1.0f / 3.0f))); return x > 15.f ? x : (e < 0.01f ? sm : __logf(1.0f + e)); }
__device__ __forceinline__ float gelu_tanh_(float x) { return 0.5f * x * (1.0f + tanhf(0.7978845608028654f * (x + 0.044715f * x * x * x))); }

__device__ __forceinline__ float block_sum_256(float v, float* red) {
    for (int o = 32; o > 0; o >>= 1) v += __shfl_down(v, o, 64);
    __syncthreads();
    if ((tid_opaque() & 63) == 0) red[tid_opaque() >> 6] = v;
    __syncthreads();
    float r = red[0] + red[1] + red[2] + red[3];
    __syncthreads();
    return r;
}
__device__ __forceinline__ float block_max_256(float v, float* red) {
    for (int o = 32; o > 0; o >>= 1) v = fmaxf(v, __shfl_down(v, o, 64));
    __syncthreads();
    if ((tid_opaque() & 63) == 0) red[tid_opaque() >> 6] = v;
    __syncthreads();
    float r = fmaxf(fmaxf(red[0], red[1]), fmaxf(red[2], red[3]));
    __syncthreads();
    return r;
}

__device__ __forceinline__ int t5_bucket(int rel) {
    const int ret = rel > 0 ? 16 : 0; const int n = rel < 0 ? -rel : rel;
    if (n < 8) return ret + n;
    const float v = logf((float)n / 8.0f) / 2.772588722239781f * 8.0f;
    int large = 8 + (int)v; if (large > 15) large = 15;
    return ret + large;
}
struct AP { const bf16_t* proj; const bf16_t* vt; const float* rel_bias; const float* dlam; const float* subg; bf16_t* br; float lam_init; };
#define ATT_LDS (2 * 32768 + 2048)
__device__ __forceinline__ void phase_attn(char* shm, const AP& p) {
    float* btab = (float*)(shm + 65536);
    const float LOG2E = 1.4426950408889634f;
    for (int unit = bid_opaque(); unit < NB_ * 4 * 16; unit += grid_n()) {
        const int xq = unit & 7, sq = unit >> 3, bh = (xq * 2 + (sq >> 4)) & 15, qt = sq & 15, h = bh & 3, b = bh >> 2;
        const int tid = tid_opaque(), wid = tid >> 6, lane = tid & 63, fr = lane & 15, fq = lane >> 4;
        __syncthreads();
        if (tid < 257) btab[tid] = p.rel_bias[t5_bucket(tid - 128) * 4 + h] * LOG2E;
        float l0 = 0.f, l1 = 0.f;
        for (int d = 0; d < 64; ++d) { l0 += p.dlam[d] * p.dlam[64 + d]; l1 += p.dlam[128 + d] * p.dlam[192 + d]; }
        const float lam = expf(l0) - expf(l1) + p.lam_init;
        const int q0 = qt * 128, qrow = q0 + wid * 16 + fr;
        bf16x8 qf[2][2];
        { const bf16_t* qp = p.proj + (size_t)(b * SEQ_ + qrow) * PROJW + O_DA + h * 128 + fq * 8;
#pragma unroll
          for (int i = 0; i < 2; ++i)
#pragma unroll
            for (int s = 0; s < 2; ++s) qf[i][s] = *(const bf16x8*)(qp + i * 64 + s * 32); }
        const bf16_t* kg[2]; const bf16_t* vg[2]; int kl[2], vl[2]; bool vswap[2];
#pragma unroll
        for (int u = 0; u < 2; ++u) {
            const int c = tid + u * 512;
            const int krow = c >> 4, kch = c & 15;
            kg[u] = p.proj + (size_t)(b * SEQ_ + krow) * PROJW + O_DA + 512 + h * 128 + kch * 8;
            kl[u] = krow * 256 + ((kch ^ (krow & 15)) * 16);
            const int dv = c >> 3, ch16 = c & 7;
            vg[u] = p.vt + (size_t)(b * 512 + h * 128 + dv) * SEQ_ + ch16 * 8;
            vl[u] = 16384 + dv * 128 + ((ch16 ^ ((dv & 15) >> 1)) * 16); vswap[u] = dv & 1;
        }
        i32x4 sk[2], sv[2];
#define A_ISSUE(kt) do { _Pragma("unroll") for (int u = 0; u < 2; ++u) { sk[u] = *(const i32x4*)(kg[u] + (size_t)(kt) * 64 * PROJW); sv[u] = *(const i32x4*)(vg[u] + (kt) * 64); } } while (0)
#define A_WRITE(buf) do { char* sb_ = shm + (buf) * 32768; _Pragma("unroll") for (int u = 0; u < 2; ++u) { *(i32x4*)(sb_ + kl[u]) = sk[u]; \
            i32x4 w_ = sv[u]; if (vswap[u]) w_ = (i32x4){sv[u][2], sv[u][3], sv[u][0], sv[u][1]}; *(i32x4*)(sb_ + vl[u]) = w_; } } while (0)
        f32x4 O[2][8];
#pragma unroll
        for (int i = 0; i < 2; ++i)
#pragma unroll
            for (int f = 0; f < 8; ++f) O[i][f] = (f32x4){0.f, 0.f, 0.f, 0.f};
        float mrun[2] = {-1e30f, -1e30f}, lrun[2] = {0.f, 0.f};
        A_ISSUE(0); A_WRITE(0); A_ISSUE(1); __syncthreads();
        const int NT = SEQ_ / 64;
        for (int kt = 0; kt < NT; ++kt) {
            const int cur = kt & 1;
            if (kt + 1 < NT) A_WRITE(cur ^ 1);
            if (kt + 2 < NT) A_ISSUE(kt + 2);
            const char* sK = shm + cur * 32768; const char* sV = sK + 16384;
            f32x4 S[2][4];
#pragma unroll
            for (int i = 0; i < 2; ++i)
#pragma unroll
                for (int kf = 0; kf < 4; ++kf) {
                    f32x4 a = (f32x4){0.f, 0.f, 0.f, 0.f};
#pragma unroll
                    for (int s = 0; s < 2; ++s) {
                        const int row = kf * 16 + fr, ch = i * 8 + s * 4 + fq;
                        const bf16x8 kfA = *(const bf16x8*)(sK + row * 256 + ((ch ^ (row & 15)) * 16));
                        a = __builtin_amdgcn_mfma_f32_16x16x32_bf16(kfA, qf[i][s], a, 0, 0, 0);
                    }
                    S[i][kf] = a;
                }
            const int k0 = kt * 64;
            const bool far_hi = (k0 >= q0 + 127 + 128), far_lo = (k0 + 63 <= q0 - 128);
            const float c1 = 0.125f * LOG2E;
            if (far_hi || far_lo) {
                const float bc_ = far_hi ? btab[256] : btab[0];
#pragma unroll
                for (int i = 0; i < 2; ++i)
#pragma unroll
                    for (int kf = 0; kf < 4; ++kf)
#pragma unroll
                        for (int j = 0; j < 4; ++j) S[i][kf][j] = S[i][kf][j] * c1 + bc_;
            } else {
#pragma unroll
                for (int kf = 0; kf < 4; ++kf)
#pragma unroll
                    for (int j = 0; j < 4; ++j) {
                        int rel = (k0 + kf * 16 + fq * 4 + j) - qrow; rel = rel < -128 ? -128 : (rel > 128 ? 128 : rel);
                        const float bv_ = btab[rel + 128];
                        S[0][kf][j] = S[0][kf][j] * c1 + bv_; S[1][kf][j] = S[1][kf][j] * c1 + bv_;
                    }
            }
            bf16x8 Pf[2][2];
#pragma unroll
            for (int i = 0; i < 2; ++i) {
                float mx = S[i][0][0];
#pragma unroll
                for (int kf = 0; kf < 4; ++kf)
#pragma unroll
                    for (int j = 0; j < 4; ++j) mx = fmaxf(mx, S[i][kf][j]);
                mx = fmaxf(mx, __shfl_xor(mx, 16, 64)); mx = fmaxf(mx, __shfl_xor(mx, 32, 64));
                const float mnew = fmaxf(mrun[i], mx);
                const float alpha = __builtin_amdgcn_exp2f(mrun[i] - mnew);
                mrun[i] = mnew;
                float ps = 0.f;
#pragma unroll
                for (int kf = 0; kf < 4; ++kf)
#pragma unroll
                    for (int j = 0; j < 4; ++j) { const float e = __builtin_amdgcn_exp2f(S[i][kf][j] - mnew); S[i][kf][j] = e; ps += e; }
                ps += __shfl_xor(ps, 16, 64); ps += __shfl_xor(ps, 32, 64);
                lrun[i] = lrun[i] * alpha + ps;
                if (__any(alpha != 1.0f)) {
#pragma unroll
                    for (int f = 0; f < 8; ++f) { O[i][f][0] *= alpha; O[i][f][1] *= alpha; O[i][f][2] *= alpha; O[i][f][3] *= alpha; }
                }
#pragma unroll
                for (int g = 0; g < 2; ++g) {
                    i32x4 w;
                    w[0] = (int)cvt_pk_bf16(S[i][2 * g][0], S[i][2 * g][1]); w[1] = (int)cvt_pk_bf16(S[i][2 * g][2], S[i][2 * g][3]);
                    w[2] = (int)cvt_pk_bf16(S[i][2 * g + 1][0], S[i][2 * g + 1][1]); w[3] = (int)cvt_pk_bf16(S[i][2 * g + 1][2], S[i][2 * g + 1][3]);
                    Pf[i][g] = __builtin_bit_cast(bf16x8, w);
                }
            }
#pragma unroll
            for (int f = 0; f < 8; ++f)
#pragma unroll
                for (int g = 0; g < 2; ++g) {
                    const int dv = f * 16 + fr, x = dv & 15;
                    const uint2 v0 = *(const uint2*)(sV + dv * 128 + (((8 * g + fq) ^ x) * 8));
                    const uint2 v1 = *(const uint2*)(sV + dv * 128 + (((8 * g + 4 + fq) ^ x) * 8));
                    const i32x4 w = (i32x4){(int)v0.x, (int)v0.y, (int)v1.x, (int)v1.y};
                    const bf16x8 vA = __builtin_bit_cast(bf16x8, w);
                    O[0][f] = __builtin_amdgcn_mfma_f32_16x16x32_bf16(vA, Pf[0][g], O[0][f], 0, 0, 0);
                    O[1][f] = __builtin_amdgcn_mfma_f32_16x16x32_bf16(vA, Pf[1][g], O[1][f], 0, 0, 0);
                }
            __syncthreads();
        }
#undef A_ISSUE
#undef A_WRITE
        const float r0 = 1.0f / lrun[0], r1 = lam / lrun[1];
        float ss = 0.f;
#pragma unroll
        for (int f = 0; f < 8; ++f)
#pragma unroll
            for (int j = 0; j < 4; ++j) { const float o = O[0][f][j] * r0 - O[1][f][j] * r1; O[0][f][j] = o; ss += o * o; }
        ss += __shfl_xor(ss, 16, 64); ss += __shfl_xor(ss, 32, 64);
        const float rs = rsqrtf(ss * (1.0f / 128.0f) + 1e-5f) * (1.0f - p.lam_init);
        bf16_t* op = p.br + (size_t)(b * SEQ_ + qrow) * DM_ + 1024 + h * 128 + fq * 4;
#pragma unroll
        for (int f = 0; f < 8; ++f) {
            const f32x4 gv = *(const f32x4*)(p.subg + f * 16 + fq * 4);
            uint2 o; o.x = cvt_pk_bf16(O[0][f][0] * rs * gv[0], O[0][f][1] * rs * gv[1]); o.y = cvt_pk_bf16(O[0][f][2] * rs * gv[2], O[0][f][3] * rs * gv[3]);
            *(uint2*)(op + f * 16) = o;
        }
    }
}

#define HY_PPW 2112
#define HY_PADL 1040
#define HY_VLEN 4112
#define HY_LDS (HY_PPW * 4 + 4 * HY_VLEN * 2)
struct HP { const bf16_t* proj; const float* fr; const float* nrm; unsigned* pp; bf16_t* vvt; float* yt; const float* cw; const float* cb; const float* hbias; bf16_t* br; };

__device__ __forceinline__ void phase_hy_pp(const HP& p) {
    for (int idx = bid_opaque() * 512 + tid_opaque(); idx < 512 * HY_PPW; idx += grid_n() * 512) {
        const int c = idx / HY_PPW, u = idx - c * HY_PPW;
        const float inv = 1.0f / p.nrm[c];
        const int s0 = 2080 - u, s1 = 2080 - (u + 1);
        const float f0 = (s0 >= 0 && s0 < SEQ_) ? p.fr[(size_t)s0 * 512 + c] * inv : 0.f;
        const float f1 = (s1 >= 0 && s1 < SEQ_) ? p.fr[(size_t)s1 * 512 + c] * inv : 0.f;
        p.pp[idx] = cvt_pk_bf16(f0, f1);
    }
}
__device__ __forceinline__ void unpack8(const uint4 v, float (&f)[8]) {
    f[0] = __uint_as_float(v.x << 16); f[1] = __uint_as_float(v.x & 0xffff0000u); f[2] = __uint_as_float(v.y << 16); f[3] = __uint_as_float(v.y & 0xffff0000u);
    f[4] = __uint_as_float(v.z << 16); f[5] = __uint_as_float(v.z & 0xffff0000u); f[6] = __uint_as_float(v.w << 16); f[7] = __uint_as_float(v.w & 0xffff0000u);
}
__device__ __forceinline__ void phase_hy_prep(char* shm, const HP& p) {
    bf16_t* tile = (bf16_t*)shm;
    for (int unit = bid_opaque(); unit < NB_ * 32 * 8; unit += grid_n()) {
        const int ct = unit & 7, tt = (unit >> 3) & 31, b = unit >> 8;
        const int tid = tid_opaque(), tl = tid >> 3, c8 = (tid & 7) * 8, c = ct * 64 + c8, t = tt * 64 + tl;
        float s1[8], s2[8];
#pragma unroll
        for (int e = 0; e < 8; ++e) { s1[e] = p.cb[512 + c + e]; s2[e] = p.cb[1024 + c + e]; }
#pragma unroll
        for (int k = 0; k < 3; ++k) {
            const int t2 = t + k - 1;
            if (t2 >= 0 && t2 < SEQ_) {
                const bf16_t* pr = p.proj + (size_t)(b * SEQ_ + t2) * PROJW + O_HY + c;
                float x1[8], xv[8]; unpack8(*(const uint4*)(pr + 512), x1); unpack8(*(const uint4*)(pr + 1024), xv);
                const f32x4 wa = *(const f32x4*)(p.cw + k * 1536 + 512 + c), wb = *(const f32x4*)(p.cw + k * 1536 + 512 + c + 4);
                const f32x4 va = *(const f32x4*)(p.cw + k * 1536 + 1024 + c), vb = *(const f32x4*)(p.cw + k * 1536 + 1024 + c + 4);
#pragma unroll
                for (int e = 0; e < 4; ++e) { s1[e] += wa[e] * x1[e]; s1[e + 4] += wb[e] * x1[e + 4]; s2[e] += va[e] * xv[e]; s2[e + 4] += vb[e] * xv[e + 4]; }
            }
        }
        __syncthreads();
#pragma unroll
        for (int e = 0; e < 8; ++e) tile[(c8 + e) * 72 + tl] = f2bf(s1[e] * s2[e]);
        __syncthreads();
        { const int cl = tid >> 3, t8 = (tid & 7) * 8;
          *(uint4*)(p.vvt + ((size_t)(ct * 64 + cl) * NB_ + b) * SEQ_ + tt * 64 + t8) = *(const uint4*)(tile + cl * 72 + t8); }
    }
}
__device__ __forceinline__ void phase_hy_conv(char* shm, const HP& p) {
    unsigned* pps = (unsigned*)shm;
    bf16_t* vs = (bf16_t*)(shm + HY_PPW * 4);
    for (int c = bid_opaque(); c < 512; c += grid_n()) {
        const int tid = tid_opaque(), wid = tid >> 6, lane = tid & 63, fr = lane & 15, h = lane >> 4;
        __syncthreads();
        for (int i = tid; i < HY_PPW; i += 512) pps[i] = p.pp[(size_t)c * HY_PPW + i];
        for (int i = tid; i < 4 * (HY_VLEN / 8); i += 512) {
            const int b = i / (HY_VLEN / 8), ch = i - b * (HY_VLEN / 8), e0 = ch * 8 - HY_PADL;
            uint4 v = make_uint4(0u, 0u, 0u, 0u);
            if (e0 >= 0 && e0 < SEQ_) v = *(const uint4*)(p.vvt + ((size_t)c * NB_ + b) * SEQ_ + e0);
            *(uint4*)(vs + b * HY_VLEN + ch * 8) = v;
        }
        __syncthreads();
        const int b = wid >> 1, ib = (wid & 1) * 64;
        f32x4 acc[4];
#pragma unroll
        for (int f = 0; f < 4; ++f) acc[f] = (f32x4){0.f, 0.f, 0.f, 0.f};
        const int ua = 1056 - 16 * (h >> 1) - fr + 8 * (h & 1);
        const bf16_t* vb = vs + b * HY_VLEN + HY_PADL + 16 * (ib + fr - (h >> 1)) + 8 * (h & 1);
#define HY_LOAD(d0_, af_, bf_) do { const unsigned* ap_ = pps + (ua - 16 * (d0_)); const i32x4 aw_ = (i32x4){(int)ap_[0], (int)ap_[2], (int)ap_[4], (int)ap_[6]}; af_ = __builtin_bit_cast(bf16x8, aw_); \
        _Pragma("unroll") for (int f = 0; f < 4; ++f) bf_[f] = *(const bf16x8*)(vb + 16 * (16 * f - (d0_))); } while (0)
        bf16x8 afA, afB, bfA[4], bfB[4];
        HY_LOAD(-64, afA, bfA);
        for (int d0 = -64; d0 < 64; d0 += 4) {
            HY_LOAD(d0 + 2, afB, bfB);
            __builtin_amdgcn_sched_barrier(0);
#pragma unroll
            for (int f = 0; f < 4; ++f) acc[f] = __builtin_amdgcn_mfma_f32_16x16x32_bf16(afA, bfA[f], acc[f], 0, 0, 0);
            __builtin_amdgcn_sched_barrier(0);
            HY_LOAD(d0 + 4, afA, bfA);
            __builtin_amdgcn_sched_barrier(0);
#pragma unroll
            for (int f = 0; f < 4; ++f) acc[f] = __builtin_amdgcn_mfma_f32_16x16x32_bf16(afB, bfB[f], acc[f], 0, 0, 0);
            __builtin_amdgcn_sched_barrier(0);
        }
#pragma unroll
        for (int f = 0; f < 4; ++f) acc[f] = __builtin_amdgcn_mfma_f32_16x16x32_bf16(afA, bfA[f], acc[f], 0, 0, 0);
#undef HY_LOAD
        const float hb = p.hbias[c];
#pragma unroll
        for (int f = 0; f < 4; ++f) {
            const int t = 16 * (ib + 16 * f + fr) + 4 * h;
            const bf16_t* vv = vs + b * HY_VLEN + HY_PADL + t;
            f32x4 o; o[0] = acc[f][0] + bf2f(vv[0]) * hb; o[1] = acc[f][1] + bf2f(vv[1]) * hb; o[2] = acc[f][2] + bf2f(vv[2]) * hb; o[3] = acc[f][3] + bf2f(vv[3]) * hb;
            *(f32x4*)(p.yt + ((size_t)c * NB_ + b) * SEQ_ + t) = o;
        }
    }
}
__device__ __forceinline__ void phase_hy_fin(char* shm, const HP& p, int bw0, int bwn) {
    float* tile = (float*)shm;
    const int bq = bid_opaque() - bw0; if (bq < 0 || bq >= bwn) return;
    for (int unit = bq; unit < NB_ * 32 * 8; unit += bwn) {
        const int ct = unit & 7, tt = (unit >> 3) & 31, b = unit >> 8, tid = tid_opaque();
        __syncthreads();
        { const int cl = tid >> 3, t8 = (tid & 7) * 8; const float* src = p.yt + ((size_t)(ct * 64 + cl) * NB_ + b) * SEQ_ + tt * 64 + t8;
          const f32x4 a = *(const f32x4*)src, bq = *(const f32x4*)(src + 4);
#pragma unroll
          for (int q = 0; q < 4; ++q) { tile[cl * 65 + t8 + q] = a[q]; tile[cl * 65 + t8 + 4 + q] = bq[q]; } }
        __syncthreads();
        const int cl = tid & 63, c = ct * 64 + cl, tq = tid >> 6;
        float w0[3];
#pragma unroll
        for (int k = 0; k < 3; ++k) w0[k] = p.cw[k * 1536 + c];
        const float b0 = p.cb[c];
#pragma unroll
        for (int q = 0; q < 8; ++q) {
            const int tl = tq * 8 + q, t = tt * 64 + tl;
            float s = b0;
#pragma unroll
            for (int k = 0; k < 3; ++k) { const int t2 = t + k - 1; if (t2 >= 0 && t2 < SEQ_) s += w0[k] * bf2f(p.proj[(size_t)(b * SEQ_ + t2) * PROJW + O_HY + c]); }
            p.br[(size_t)(b * SEQ_ + t) * DM_ + c] = f2bf(tile[cl * 65 + tl] * s);
        }
    }
}
struct LP { const bf16_t* proj; const float* cw; const float* cb; const bf16_t* wt; const float* ba; const float* bx; const float* lam; float* sumP; float* sumE; bf16_t* br; };
#define LRU_LDS (32768 + 8192 + 64 * 65 * 4 + 2 * 64 * 65 * 4 + 2 * 2 * 16 * 64 * 4)
template <int PASS>
__device__ __forceinline__ void phase_lru(char* shm, const LP& p) {
    char* sW = shm;
    char* sXb = shm + 32768;
    float* X = (float*)(shm + 40960);
    float* H = X + 64 * 65;
    float* SP = H + 2 * 64 * 65;
    float* SE = SP + 2 * 16 * 64;
    for (int unit = bid_opaque(); unit < NB_ * 8 * 32; unit += grid_n()) {
        const int k = unit & 31, b = (unit >> 5) & 3, h = unit >> 7;
        const int tid = tid_opaque();
        __syncthreads();
        for (int i = tid; i < 256 * 8; i += 512) { const int row = i >> 3, ch = i & 7;
            *(uint4*)(sW + lds_rc(row, ch)) = *(const uint4*)(p.wt + ((size_t)h * 256 + row) * 64 + ch * 8); }
        { const int j = tid & 63, tq = tid >> 6, ch = h * 64 + j;
          float w4[4];
#pragma unroll
          for (int q = 0; q < 4; ++q) w4[q] = p.cw[q * 512 + ch];
          const float cbv = p.cb[ch];
#pragma unroll
          for (int q = 0; q < 8; ++q) {
              const int tl = tq * 8 + q, t = k * 64 + tl; float s = cbv;
#pragma unroll
              for (int kk = 0; kk < 4; ++kk) { const int t2 = t + kk - 2; if (t2 >= 0 && t2 < SEQ_) s += w4[kk] * bf2f(p.proj[(size_t)(b * SEQ_ + t2) * PROJW + O_LRU + ch]); }
              X[tl * 65 + j] = s;
              *(bf16_t*)(sXb + lds_rc(tl, j >> 3) + (j & 7) * 2) = f2bf(s);
          } }
        __syncthreads();
        const int wid = tid >> 6, lane = tid & 63, fr = lane & 15, fq = lane >> 4, dir = wid & 1, jf = wid >> 1, j = jf * 16 + fr, ch = h * 64 + j;
        f32x4 G[4][2];
        { const float bav = p.ba[dir * 512 + ch], bxv = p.bx[dir * 512 + ch];
#pragma unroll
          for (int tf = 0; tf < 4; ++tf) { G[tf][0] = (f32x4){bav, bav, bav, bav}; G[tf][1] = (f32x4){bxv, bxv, bxv, bxv}; } }
#pragma unroll
        for (int ks = 0; ks < 2; ++ks) {
            const bf16x8 wA = *(const bf16x8*)(sW + lds_rc((dir * 2 + 0) * 64 + j, ks * 4 + fq));
            const bf16x8 wX = *(const bf16x8*)(sW + lds_rc((dir * 2 + 1) * 64 + j, ks * 4 + fq));
#pragma unroll
            for (int tf = 0; tf < 4; ++tf) {
                const bf16x8 xa = *(const bf16x8*)(sXb + lds_rc(tf * 16 + fr, ks * 4 + fq));
                G[tf][0] = __builtin_amdgcn_mfma_f32_16x16x32_bf16(xa, wA, G[tf][0], 0, 0, 0);
                G[tf][1] = __builtin_amdgcn_mfma_f32_16x16x32_bf16(xa, wX, G[tf][1], 0, 0, 0);
            }
        }
        const float spl = softplus_fast_(-p.lam[dir * 512 + ch]);
        const int tfirst = dir ? (SEQ_ - 1) : 0;
#pragma unroll
        for (int tf = 0; tf < 4; ++tf) {
            float P = 1.f, E = 0.f;
#pragma unroll
            for (int qq = 0; qq < 4; ++qq) {
                const int q = dir ? 3 - qq : qq, tl = tf * 16 + fq * 4 + q, t = k * 64 + tl;
                const float r = sigmoid_fast_(G[tf][0][q]), ig = sigmoid_fast_(G[tf][1][q]);
                const float log_a = -8.0f * r * spl;
                float mult = sqrtf(-expm1f(2.0f * log_a)); if (t == tfirst) mult = 1.0f;
                const float av = __expf(log_a), bv = mult * ig * X[tl * 65 + j];
                G[tf][0][q] = av; G[tf][1][q] = bv;
                E = av * E + bv; P *= av;
            }
            SP[(dir * 16 + tf * 4 + fq) * 64 + j] = P; SE[(dir * 16 + tf * 4 + fq) * 64 + j] = E;
        }
        __syncthreads();
        const size_t sbase = ((size_t)(dir * NB_ + b) * 32) * 512 + ch;
        if (PASS == 0) {
            if (fq == 0) {
                float cP = 1.f, cE = 0.f;
                if (dir == 0) { for (int s = 0; s < 16; ++s) { cE = SP[s * 64 + j] * cE + SE[s * 64 + j]; cP *= SP[s * 64 + j]; } }
                else { for (int s = 15; s >= 0; --s) { cE = SP[(16 + s) * 64 + j] * cE + SE[(16 + s) * 64 + j]; cP *= SP[(16 + s) * 64 + j]; } }
                p.sumP[sbase + (size_t)k * 512] = cP; p.sumE[sbase + (size_t)k * 512] = cE;
            }
        } else {
            float c = 0.f;
            if (dir == 0) { for (int q = 0; q < k; ++q) c = p.sumP[sbase + (size_t)q * 512] * c + p.sumE[sbase + (size_t)q * 512]; }
            else { for (int q = 31; q > k; --q) c = p.sumP[sbase + (size_t)q * 512] * c + p.sumE[sbase + (size_t)q * 512]; }
            float cin[4];
            if (dir == 0) {
#pragma unroll
                for (int s = 0; s < 16; ++s) { if ((s & 3) == fq) cin[s >> 2] = c; c = SP[s * 64 + j] * c + SE[s * 64 + j]; }
            } else {
#pragma unroll
                for (int s = 15; s >= 0; --s) { if ((s & 3) == fq) cin[s >> 2] = c; c = SP[(16 + s) * 64 + j] * c + SE[(16 + s) * 64 + j]; }
            }
            float* Hd = H + dir * 64 * 65;
#pragma unroll
            for (int tf = 0; tf < 4; ++tf) {
                float cc = cin[tf];
#pragma unroll
                for (int qq = 0; qq < 4; ++qq) { const int q = dir ? 3 - qq : qq; cc = G[tf][0][q] * cc + G[tf][1][q]; Hd[(tf * 16 + fq * 4 + q) * 65 + j] = cc; }
            }
            __syncthreads();
            const int j2 = tid & 63, tq = tid >> 6, ch2 = h * 64 + j2;
#pragma unroll
            for (int q = 0; q < 8; ++q) {
                const int tl = tq * 8 + q; const size_t tok = (size_t)(b * SEQ_ + k * 64 + tl);
                const float g = bf2f(p.proj[tok * PROJW + O_LRU + 512 + ch2]);
                p.br[tok * DM_ + 512 + ch2] = f2bf((H[tl * 65 + j2] + H[64 * 65 + tl * 65 + j2]) * gelu_tanh_(g));
            }
        }
    }
}
struct SP_ { const bf16_t* proj; const float* dtraw; const float* cw; const float* cb; const float* dtb; const float* a_log; const float* dsk; const float* ng;
             bf16_t* xa; bf16_t* xT; float* states; float* decay; bf16_t* prev; bf16_t* br; };
#define SSD_Q 128
#define SSD_NC 16

__device__ __forceinline__ void phase_ssd_prep(char* shm, const SP_& p) {
    bf16_t* tile = (bf16_t*)shm;
    for (int unit = bid_opaque(); unit < NB_ * 32 * 16; unit += grid_n()) {
        const int ct = unit & 15, tt = (unit >> 4) & 31, b = unit >> 9;
        const int tid = tid_opaque(), tl = tid >> 3, c8 = (tid & 7) * 8, c = ct * 64 + c8, t = tt * 64 + tl;
        float s[8];
#pragma unroll
        for (int e = 0; e < 8; ++e) s[e] = p.cb[c + e];
#pragma unroll
        for (int k = 0; k < 4; ++k) {
            const int t2 = t + k - 2;
            if (t2 >= 0 && t2 < SEQ_) {
                float x[8]; unpack8(*(const uint4*)(p.proj + (size_t)(b * SEQ_ + t2) * PROJW + O_SSD + 512 + c), x);
                const f32x4 wa = *(const f32x4*)(p.cw + k * 1024 + c), wb = *(const f32x4*)(p.cw + k * 1024 + c + 4);
#pragma unroll
                for (int e = 0; e < 4; ++e) { s[e] += wa[e] * x[e]; s[e + 4] += wb[e] * x[e + 4]; }
            }
        }
        uint4 o; o.x = cvt_pk_bf16(silu_fast_(s[0]), silu_fast_(s[1])); o.y = cvt_pk_bf16(silu_fast_(s[2]), silu_fast_(s[3]));
        o.z = cvt_pk_bf16(silu_fast_(s[4]), silu_fast_(s[5])); o.w = cvt_pk_bf16(silu_fast_(s[6]), silu_fast_(s[7]));
        *(uint4*)(p.xa + (size_t)(b * SEQ_ + t) * 1024 + c) = o;
        __syncthreads();
        tile[(c8 + 0) * 72 + tl] = (bf16_t)(o.x & 0xffffu); tile[(c8 + 1) * 72 + tl] = (bf16_t)(o.x >> 16); tile[(c8 + 2) * 72 + tl] = (bf16_t)(o.y & 0xffffu); tile[(c8 + 3) * 72 + tl] = (bf16_t)(o.y >> 16);
        tile[(c8 + 4) * 72 + tl] = (bf16_t)(o.z & 0xffffu); tile[(c8 + 5) * 72 + tl] = (bf16_t)(o.z >> 16); tile[(c8 + 6) * 72 + tl] = (bf16_t)(o.w & 0xffffu); tile[(c8 + 7) * 72 + tl] = (bf16_t)(o.w >> 16);
        __syncthreads();
        { const int c2 = tid >> 3, t8 = (tid & 7) * 8;
          *(uint4*)(p.xT + ((size_t)b * 1024 + ct * 64 + c2) * SEQ_ + tt * 64 + t8) = *(const uint4*)(tile + c2 * 72 + t8); }
    }
}
__device__ __forceinline__ void ssd_tables(float* dtv, float* cum, const SP_& p, int b, int c, int g) {
    const int tid = tid_opaque();
    for (int i = tid; i < 8 * SSD_Q; i += 512) {
        const int l = i & 127, hd = i >> 7, dir = hd >> 2, j = hd & 3, h = g * 4 + j;
        dtv[i] = softplus_fast_(p.dtraw[(size_t)(b * SEQ_ + c * SSD_Q + l) * 16 + dir * 8 + h] + p.dtb[dir * 8 + h]);
    }
    __syncthreads();
    const int t8 = tid_opaque();
    if (t8 < 8) {
        const int dir = t8 >> 2, j = t8 & 3, h = g * 4 + j; const float a = -__expf(p.a_log[dir * 8 + h]);
        float s = 0.f;
        if (dir == 0) for (int l = 0; l < SSD_Q; ++l) { s += dtv[t8 * 128 + l] * a; cum[t8 * 128 + l] = s; }
        else for (int l = SSD_Q - 1; l >= 0; --l) { s += dtv[t8 * 128 + l] * a; cum[t8 * 128 + l] = s; }
    }
    __syncthreads();
}
#define SSD1_LDS (65536 + 32768 + 8192)
__device__ __forceinline__ void phase_ssd_states(char* shm, const SP_& p) {
    char* sX = shm;
    char* sB = shm + 65536;
    float* dtv = (float*)(shm + 98304); float* cum = dtv + 1024;
    for (int unit = bid_opaque(); unit < NB_ * SSD_NC * 2; unit += grid_n()) {
        const int g = unit & 1, c = (unit >> 1) & 15, b = unit >> 5;
        const int tid = tid_opaque(), wid = tid >> 6, lane = tid & 63, fr = lane & 15, fq = lane >> 4;
        __syncthreads();
        for (int i = tid; i < 256 * 16; i += 512) { const int row = i >> 4, ch = i & 15;
            *(uint4*)(sX + row * 256 + ((ch ^ (row & 15)) * 16)) = *(const uint4*)(p.xT + ((size_t)b * 1024 + g * 256 + row) * SEQ_ + c * SSD_Q + ch * 8); }
        for (int i = tid; i < 128 * 16; i += 512) { const int row = i >> 4, ch = i & 15;
            *(uint4*)(sB + row * 256 + ((ch ^ (row & 15)) * 16)) = *(const uint4*)(p.xT + ((size_t)b * 1024 + 512 + g * 128 + row) * SEQ_ + c * SSD_Q + ch * 8); }
        ssd_tables(dtv, cum, p, b, c, g);
        const int j = wid >> 1, dir = wid & 1, hd = dir * 4 + j, h = g * 4 + j;
        const float* dth = dtv + hd * 128; const float* cm = cum + hd * 128;
        const float cend = dir ? cm[0] : cm[SSD_Q - 1];
        f32x4 acc[4][8];
#pragma unroll
        for (int pf = 0; pf < 4; ++pf)
#pragma unroll
            for (int nf = 0; nf < 8; ++nf) acc[pf][nf] = (f32x4){0.f, 0.f, 0.f, 0.f};
#pragma unroll 1
        for (int ks = 0; ks < 4; ++ks) {
            float sc[8];
#pragma unroll
            for (int e = 0; e < 8; ++e) { const int l = ks * 32 + fq * 8 + e; sc[e] = dth[l] * __expf(cend - cm[l]); }
            bf16x8 af[4];
#pragma unroll
            for (int pf = 0; pf < 4; ++pf) {
                const int row = j * 64 + pf * 16 + fr, ch = ks * 4 + fq;
                const i32x4 raw = *(const i32x4*)(sX + row * 256 + ((ch ^ (row & 15)) * 16));
                i32x4 o;
#pragma unroll
                for (int q = 0; q < 4; ++q) { const unsigned u = (unsigned)raw[q]; o[q] = (int)cvt_pk_bf16(__uint_as_float(u << 16) * sc[2 * q], __uint_as_float(u & 0xffff0000u) * sc[2 * q + 1]); }
                af[pf] = __builtin_bit_cast(bf16x8, o);
            }
#pragma unroll
            for (int nf = 0; nf < 8; ++nf) {
                const int row = nf * 16 + fr, ch = ks * 4 + fq;
                const bf16x8 bfr = *(const bf16x8*)(sB + row * 256 + ((ch ^ (row & 15)) * 16));
#pragma unroll
                for (int pf = 0; pf < 4; ++pf) acc[pf][nf] = __builtin_amdgcn_mfma_f32_16x16x32_bf16(af[pf], bfr, acc[pf][nf], 0, 0, 0);
            }
        }
        float* st = p.states + ((((size_t)(b * SSD_NC + c) * 8 + h) * 2 + dir) * 64) * 128;
        float* rp = st + (size_t)(fq * 4) * 128 + fr;
#pragma unroll
        for (int pf = 0; pf < 4; ++pf)
#pragma unroll
            for (int q = 0; q < 4; ++q) {
                float* r2 = rp + (pf * 16 + q) * 128;
#pragma unroll
                for (int nf = 0; nf < 8; ++nf) r2[nf * 16] = acc[pf][nf][q];
                __builtin_amdgcn_sched_barrier(0);
            }
        if (lane == 0) p.decay[((b * SSD_NC + c) * 8 + h) * 2 + dir] = __expf(cend);
    }
}
__device__ __forceinline__ void phase_ssd_scan(const SP_& p) {
    for (int idx = bid_opaque() * 512 + tid_opaque(); idx < NB_ * 8 * 2 * 64 * 32; idx += grid_n() * 512) {
        const int n4 = idx & 31, pp = (idx >> 5) & 63, dir = (idx >> 11) & 1, h = (idx >> 12) & 7, b = idx >> 15;
        f32x4 s = (f32x4){0.f, 0.f, 0.f, 0.f};
#pragma unroll 1
        for (int half = 0; half < 2; ++half) {
            f32x4 st[8]; float dc[8];
#pragma unroll
            for (int q = 0; q < 8; ++q) {
                const int cc = half * 8 + q, c = dir ? (SSD_NC - 1 - cc) : cc;
                st[q] = *(const f32x4*)(p.states + ((((size_t)(b * SSD_NC + c) * 8 + h) * 2 + dir) * 64 + pp) * 128 + n4 * 4);
                dc[q] = p.decay[((b * SSD_NC + c) * 8 + h) * 2 + dir];
            }
#pragma unroll
            for (int q = 0; q < 8; ++q) {
                const int cc = half * 8 + q, c = dir ? (SSD_NC - 1 - cc) : cc;
                const size_t o = ((((size_t)(b * SSD_NC + c) * 8 + h) * 2 + dir) * 64 + pp) * 128 + n4 * 4;
                uint2 w; w.x = cvt_pk_bf16(s[0], s[1]); w.y = cvt_pk_bf16(s[2], s[3]);
                *(uint2*)(p.prev + o) = w;
                s = s * dc[q] + st[q];
            }
        }
    }
}
#define SSD3_LDS (32768 + 65536 + 32768 + 8192 + 512)
__device__ __forceinline__ void phase_ssd_out(char* shm, const SP_& p) {
    char* sB = shm;
    char* sX = shm + 32768;
    char* sC = shm + 98304;
    float* dtv = (float*)(shm + 131072); float* cum = dtv + 1024; float* ssx = cum + 1024;
    for (int unit = bid_opaque(); unit < NB_ * SSD_NC * 2 * 2; unit += grid_n()) {
        const int half_ = unit & 1, g = (unit >> 1) & 1, c = (unit >> 2) & 15, b = unit >> 6;
        const int tid = tid_opaque(), wid = tid >> 6, lane = tid & 63, fr = lane & 15, fq = lane >> 4;
        __syncthreads();
        for (int i = tid; i < 128 * 16; i += 512) { const int row = i >> 4, ch = i & 15; const bf16_t* src_ = p.xa + (size_t)(b * SEQ_ + c * SSD_Q + row) * 1024 + 512 + g * 128 + ch * 8;
            *(uint4*)(sB + row * 256 + ((ch ^ (row & 15)) * 16)) = *(const uint4*)src_;
            *(uint4*)(sC + row * 256 + ((ch ^ (row & 15)) * 16)) = *(const uint4*)(src_ + 256); }
        for (int i = tid; i < 256 * 16; i += 512) { const int row = i >> 4, ch = i & 15, x = row & 15;
            uint4 v = *(const uint4*)(p.xT + ((size_t)b * 1024 + g * 256 + row) * SEQ_ + c * SSD_Q + ch * 8);
            if (x & 1) v = make_uint4(v.z, v.w, v.x, v.y);
            *(uint4*)(sX + row * 256 + ((ch ^ (x >> 1)) * 16)) = v; }
        ssd_tables(dtv, cum, p, b, c, g);
        const int hp = wid >> 2, lrow = half_ * 64 + (wid & 3) * 16 + fr;
        const size_t tok = (size_t)(b * SEQ_ + c * SSD_Q + lrow);
#define SSD_CF(ks_) (*(const bf16x8*)(sC + lrow * 256 + ((((ks_) * 4 + fq) ^ (lrow & 15)) * 16)))
        f32x4 G[8];
#pragma unroll
        for (int sf = 0; sf < 8; ++sf) {
            f32x4 a = (f32x4){0.f, 0.f, 0.f, 0.f};
#pragma unroll
            for (int ks = 0; ks < 4; ++ks) {
                const int row = sf * 16 + fr, ch = ks * 4 + fq;
                const bf16x8 bfr = *(const bf16x8*)(sB + row * 256 + ((ch ^ (row & 15)) * 16));
                a = __builtin_amdgcn_mfma_f32_16x16x32_bf16(bfr, SSD_CF(ks), a, 0, 0, 0);
            }
            G[sf] = a;
        }
        f32x4 Y[2][4];
#pragma unroll
        for (int jj = 0; jj < 2; ++jj)
#pragma unroll
            for (int pf = 0; pf < 4; ++pf) Y[jj][pf] = (f32x4){0.f, 0.f, 0.f, 0.f};
#pragma unroll
        for (int jj = 0; jj < 2; ++jj) {
            const int j = hp * 2 + jj;
#pragma unroll 1
            for (int dir = 0; dir < 2; ++dir) {
                const int hd = dir * 4 + j, h = g * 4 + j;
                const float* dth = dtv + hd * 128; const float* cm = cum + hd * 128;
                const float cl = cm[lrow];
#pragma unroll
                for (int g2 = 0; g2 < 4; ++g2) {
                    float e[8];
#pragma unroll
                    for (int half = 0; half < 2; ++half)
#pragma unroll
                        for (int q = 0; q < 4; ++q) {
                            const int sf = 2 * g2 + half, s = sf * 16 + fq * 4 + q;
                            const bool keep = dir ? (s >= lrow) : (s <= lrow);
                            const float v = G[sf][q] * __expf(keep ? (cl - cm[s]) : 0.f) * dth[s];
                            e[half * 4 + q] = keep ? v : 0.f;
                        }
                    i32x4 w; w[0] = (int)cvt_pk_bf16(e[0], e[1]); w[1] = (int)cvt_pk_bf16(e[2], e[3]); w[2] = (int)cvt_pk_bf16(e[4], e[5]); w[3] = (int)cvt_pk_bf16(e[6], e[7]);
                    const bf16x8 Pf = __builtin_bit_cast(bf16x8, w);
#pragma unroll
                    for (int pf = 0; pf < 4; ++pf) {
                        const int row = j * 64 + pf * 16 + fr, x = row & 15;
                        const uint2 v0 = *(const uint2*)(sX + row * 256 + (((8 * g2 + fq) ^ x) * 8));
                        const uint2 v1 = *(const uint2*)(sX + row * 256 + (((8 * g2 + 4 + fq) ^ x) * 8));
                        const i32x4 wv = (i32x4){(int)v0.x, (int)v0.y, (int)v1.x, (int)v1.y};
                        Y[jj][pf] = __builtin_amdgcn_mfma_f32_16x16x32_bf16(__builtin_bit_cast(bf16x8, wv), Pf, Y[jj][pf], 0, 0, 0);
                    }
                    __builtin_amdgcn_sched_barrier(0);
                }
                const bf16_t* pv = p.prev + ((((size_t)(b * SSD_NC + c) * 8 + h) * 2 + dir) * 64) * 128;
                const float el = __expf(cl);
#pragma unroll
                for (int pf = 0; pf < 4; ++pf) {
                    f32x4 t = (f32x4){0.f, 0.f, 0.f, 0.f};
#pragma unroll
                    for (int ks = 0; ks < 4; ++ks) {
                        const bf16x8 pa = *(const bf16x8*)(pv + (size_t)(pf * 16 + fr) * 128 + ks * 32 + fq * 8);
                        t = __builtin_amdgcn_mfma_f32_16x16x32_bf16(pa, SSD_CF(ks), t, 0, 0, 0);
                    }
                    Y[jj][pf] += t * el;
                    __builtin_amdgcn_sched_barrier(0);
                }
            }
        }
        const int te = tid_opaque(); const int fqe = (te & 63) >> 4, wde = te >> 6, hpe = wde >> 2; const size_t toke = (size_t)(b * SEQ_ + c * SSD_Q + half_ * 64 + (wde & 3) * 16 + (te & 15));
        float ss = 0.f;
#pragma unroll
        for (int jj = 0; jj < 2; ++jj) {
            const float dk = p.dsk[g * 4 + hpe * 2 + jj];
#pragma unroll
            for (int pf = 0; pf < 4; ++pf) {
                const int cch = g * 256 + (hpe * 2 + jj) * 64 + pf * 16 + fqe * 4;
                const uint2 xv = *(const uint2*)(p.xa + toke * 1024 + cch);
                const uint2 zv = *(const uint2*)(p.proj + toke * PROJW + O_SSD + cch);
                const float xs[4] = {__uint_as_float(xv.x << 16), __uint_as_float(xv.x & 0xffff0000u), __uint_as_float(xv.y << 16), __uint_as_float(xv.y & 0xffff0000u)};
                const float zs[4] = {__uint_as_float(zv.x << 16), __uint_as_float(zv.x & 0xffff0000u), __uint_as_float(zv.y << 16), __uint_as_float(zv.y & 0xffff0000u)};
#pragma unroll
                for (int q = 0; q < 4; ++q) { const float y = (Y[jj][pf][q] + dk * xs[q]) * silu_fast_(zs[q]); Y[jj][pf][q] = y; ss += y * y; }
                __builtin_amdgcn_sched_barrier(0);
            }
        }
        ss += __shfl_xor(ss, 16, 64); ss += __shfl_xor(ss, 32, 64);
        if (fqe == 0) ssx[wde * 16 + (te & 15)] = ss;
        __syncthreads();
        ss += ssx[(wde ^ 4) * 16 + (te & 15)];
        const float rs = rsqrtf(ss * (1.0f / 256.0f) + 1e-6f);
#pragma unroll
        for (int jj = 0; jj < 2; ++jj)
#pragma unroll
            for (int pf = 0; pf < 4; ++pf) {
                const int cch = g * 256 + (hpe * 2 + jj) * 64 + pf * 16 + fqe * 4;
                const f32x4 gv = *(const f32x4*)(p.ng + cch);
                uint2 o; o.x = cvt_pk_bf16(Y[jj][pf][0] * rs * gv[0], Y[jj][pf][1] * rs * gv[1]); o.y = cvt_pk_bf16(Y[jj][pf][2] * rs * gv[2], Y[jj][pf][3] * rs * gv[3]);
                *(uint2*)(p.br + toke * DM_ + 1536 + cch) = o;
                __builtin_amdgcn_sched_barrier(0);
            }
    }
}
struct GP {
    const bf16_t* A; const bf16_t* Bt; const float* B; const float* B2; const float* bias; const float* R; float* Cf; bf16_t* Cb; bf16_t* Cb2; bf16_t* Vt; const bf16_t* G;
    const int* idx; const float* gate;
};
#ifndef GS_ROWS
#define GS_ROWS 8
#endif
__device__ __forceinline__ void static_order(int L, int nM, int nN, int& pm, int& pn) {
    const int nwg = nM * nN; int wgid = L;
    { const int q = nwg / 8, r = nwg % 8, xcd = wgid % 8, off = wgid / 8; wgid = (xcd < r ? xcd * (q + 1) : r * (q + 1) + (xcd - r) * q) + off; }
    const int nig = GS_ROWS * nN, gid = wgid / nig, fm = gid * GS_ROWS, gsz = (nM - fm) < GS_ROWS ? (nM - fm) : GS_ROWS;
    pm = fm + ((wgid % nig) % gsz); pn = (wgid % nig) / gsz;
}
#define LANE_IDS(t_) const int wid = (t_) >> 6, lane = (t_) & 63, wr = wid >> 2, wc = wid & 3, fr = lane & 15, fq = lane >> 4; (void)wr; (void)wc; (void)fr; (void)fq;
#define ZERO_ACC(acc, FM_) _Pragma("unroll") for (int m = 0; m < FM_; ++m) _Pragma("unroll") for (int n = 0; n < 4; ++n) acc[m][n] = (f32x4){0.f, 0.f, 0.f, 0.f}

__device__ __forceinline__ void phase_inproj(char* shm, const GP& p) {
    typedef GemmCore<256, false> G;
    for (int L = bid_opaque(); L < 32 * 54; L += grid_n()) {
        int pm, pn; static_order(L, 32, 54, pm, pn);
        const int col0 = pn < 22 ? pn * 256 : O_GATE + (pn - 22) * 256;
        f32x4 acc[8][4]; ZERO_ACC(acc, 8);
        {
            const int t0 = tid_opaque();
            unsigned aoff[G::GLA], boff[4];
#pragma unroll
            for (int i = 0; i < G::GLA; ++i) { int R, C; G::a_coord(t0, i, R, C); aoff[i] = (unsigned)((R * DM_ + C) * 2); }
#pragma unroll
            for (int i = 0; i < 4; ++i) { int cc, C; G::bt_coord(t0, i, cc, C); boff[i] = (unsigned)((cc * DM_ + C) * 2); }
            const char* pf = t0 < 256 ? (const char*)(p.A + (size_t)(pm * 256 + t0) * DM_) : (const char*)(p.Bt + (size_t)(pn * 256 + t0 - 256) * DM_);
            G::run_bt(shm, (const char*)(p.A + (size_t)pm * 256 * DM_), aoff, (const char*)(p.Bt + (size_t)pn * 256 * DM_), boff, DM_ * 2, pf, DM_ / 64, acc);
        }
        const int t1 = tid_opaque(); LANE_IDS(t1)
        const int cl = wc * 64 + 4 * fr;
        if (pn == 14 || pn == 15) {
            const int t0_ = pm * 256 + wr * 128 + fq * 4, bb = t0_ >> 11, tl = t0_ & (SEQ_ - 1);
            bf16_t* vp = p.Vt + (size_t)(bb * 512 + (pn - 14) * 256 + cl) * SEQ_ + tl;
#pragma unroll
            for (int m = 0; m < 8; ++m)
#pragma unroll
                for (int n = 0; n < 4; ++n) {
                    uint2 o; o.x = cvt_pk_bf16(acc[m][n][0], acc[m][n][1]); o.y = cvt_pk_bf16(acc[m][n][2], acc[m][n][3]);
                    *(uint2*)(vp + (size_t)n * SEQ_ + m * 16) = o;
                }
        } else if (pn < 22) {
#pragma unroll
            for (int m = 0; m < 8; ++m)
#pragma unroll
                for (int j = 0; j < 4; ++j) {
                    const int row = pm * 256 + wr * 128 + m * 16 + fq * 4 + j;
                    uint2 o; o.x = cvt_pk_bf16(acc[m][0][j], acc[m][1][j]); o.y = cvt_pk_bf16(acc[m][2][j], acc[m][3][j]);
                    *(uint2*)(p.Cb + (size_t)row * PROJW + pn * 256 + cl) = o;
                }
        } else {
            const int gc = (pn - 22) * 256 + cl;
            const f32x4 bg = *(const f32x4*)(p.bias + gc);
#pragma unroll
            for (int m = 0; m < 8; ++m)
#pragma unroll
                for (int j = 0; j < 4; ++j) {
                    const int row = pm * 256 + wr * 128 + m * 16 + fq * 4 + j;
                    uint2 o; o.x = cvt_pk_bf16(sigmoid_fast_(acc[m][0][j] + bg[0]), sigmoid_fast_(acc[m][1][j] + bg[1])); o.y = cvt_pk_bf16(sigmoid_fast_(acc[m][2][j] + bg[2]), sigmoid_fast_(acc[m][3][j] + bg[3]));
                    *(uint2*)(p.Cb2 + (size_t)row * 8192 + gc) = o;
                }
        }
    }
}
__device__ __forceinline__ void phase_merge(char* shm, const GP& p) {
    typedef GemmCore<128, false> G;
    for (int L = bid_opaque(); L < 64 * 8; L += grid_n()) {
        int pm, pn; static_order(L, 64, 8, pm, pn);
        f32x4 mg[4][4]; ZERO_ACC(mg, 4);
        f32x4 acc[4][4]; ZERO_ACC(acc, 4);
        {
            const int t0 = tid_opaque();
            unsigned aoff[G::GLA], boff[4];
#pragma unroll
            for (int i = 0; i < G::GLA; ++i) { int R, C; G::a_coord(t0, i, R, C); aoff[i] = (unsigned)((R * DM_ + C) * 2); }
#pragma unroll
            for (int i = 0; i < 4; ++i) { int cc, C; G::bt_coord(t0, i, cc, C); boff[i] = (unsigned)((cc * 512 + C) * 2); }
            const bf16_t* gates = p.G;
            auto seg_epi = [&acc, &mg, gates, pm, pn](int k) __attribute__((always_inline)) {
                const int t1 = tid_opaque(); LANE_IDS(t1)
                const bf16_t* gp = gates + (size_t)(pm * 128 + wr * 64 + fq * 4) * 8192 + k * DM_ + pn * 256 + wc * 64 + 4 * fr;
#pragma unroll
                for (int m = 0; m < 4; ++m) {
#pragma unroll
                    for (int j = 0; j < 4; ++j) {
                        const uint2 gv = *(const uint2*)(gp + (size_t)(m * 16 + j) * 8192);
                        mg[m][0][j] += __uint_as_float(gv.x << 16) * acc[m][0][j]; mg[m][1][j] += __uint_as_float(gv.x & 0xffff0000u) * acc[m][1][j];
                        mg[m][2][j] += __uint_as_float(gv.y << 16) * acc[m][2][j]; mg[m][3][j] += __uint_as_float(gv.y & 0xffff0000u) * acc[m][3][j];
                    }
#pragma unroll
                    for (int n = 0; n < 4; ++n) acc[m][n] = (f32x4){0.f, 0.f, 0.f, 0.f};
                    __builtin_amdgcn_sched_barrier(0);
                }
            };
            G::template run_bt_seg<8>(shm, (const char*)(p.A + (size_t)pm * 128 * DM_), aoff, (const char*)(p.Bt + (size_t)pn * 256 * 512), boff, 512 * 2, (size_t)DM_ * 512 * 2,
                                      (const char*)(p.A + (size_t)pm * 128 * DM_), 32, acc, seg_epi);
        }
        const int t2 = tid_opaque(); LANE_IDS(t2)
        bf16_t* op = p.Cb + (size_t)(pm * 128 + wr * 64 + fq * 4) * DM_ + pn * 256 + wc * 64 + 4 * fr;
#pragma unroll
        for (int m = 0; m < 4; ++m)
#pragma unroll
            for (int j = 0; j < 4; ++j) {
                uint2 o; o.x = cvt_pk_bf16(mg[m][0][j], mg[m][1][j]); o.y = cvt_pk_bf16(mg[m][2][j], mg[m][3][j]);
                *(uint2*)(op + (size_t)(m * 16 + j) * DM_) = o;
            }
    }
}
__device__ __forceinline__ void phase_outproj(char* shm, const GP& p) {
    typedef GemmCore<256, false> G;
    for (int L = bid_opaque(); L < 32 * 8; L += grid_n()) {
        int pm, pn; static_order(L, 32, 8, pm, pn);
        f32x4 acc[8][4]; ZERO_ACC(acc, 8);
        {
            const int t0 = tid_opaque();
            unsigned aoff[G::GLA], boff[4];
#pragma unroll
            for (int i = 0; i < G::GLA; ++i) { int R, C; G::a_coord(t0, i, R, C); aoff[i] = (unsigned)((R * DM_ + C) * 2); }
#pragma unroll
            for (int i = 0; i < 4; ++i) { int cc, C; G::bt_coord(t0, i, cc, C); boff[i] = (unsigned)((cc * DM_ + C) * 2); }
            const char* pf = t0 < 256 ? (const char*)(p.A + (size_t)(pm * 256 + t0) * DM_) : (const char*)(p.Bt + (size_t)(pn * 256 + t0 - 256) * DM_);
            G::run_bt(shm, (const char*)(p.A + (size_t)pm * 256 * DM_), aoff, (const char*)(p.Bt + (size_t)pn * 256 * DM_), boff, DM_ * 2, pf, DM_ / 64, acc);
        }
        const int t1 = tid_opaque(); LANE_IDS(t1)
        const size_t o0 = (size_t)(pm * 256 + wr * 128 + fq * 4) * DM_ + pn * 256 + wc * 64 + 4 * fr;
#pragma unroll
        for (int m = 0; m < 8; ++m)
#pragma unroll
            for (int j = 0; j < 4; ++j) {
                const size_t o = o0 + (size_t)(m * 16 + j) * DM_;
                const f32x4 r = *(const f32x4*)(p.R + o);
                *(f32x4*)(p.Cf + o) = (f32x4){r[0] + acc[m][0][j], r[1] + acc[m][1][j], r[2] + acc[m][2][j], r[3] + acc[m][3][j]};
            }
    }
}
__device__ __forceinline__ void phase_moe_up(char* shm, const GP& p) {
    typedef GemmCore<256, true> G;
    for (int L = bid_opaque(); L < 64 * 16; L += grid_n()) {
        const int xcd = L & 7, wg = xcd * 128 + (L >> 3), b = wg & 3, pair = wg >> 2, e = pair >> 4, nt = pair & 15, z = b * 16 + e;
        f32x4 acc[8][4]; ZERO_ACC(acc, 8);
        {
            const int t0 = tid_opaque(); int bk, bc, bw; G::b_coord(t0, bk, bc, bw);
            unsigned aoff[G::GLA];
#pragma unroll
            for (int i = 0; i < G::GLA; ++i) { int R, C; G::a_coord(t0, i, R, C); aoff[i] = (unsigned)(((b * SEQ_ + p.idx[z * 256 + R]) * DM_ + C) * 2); }
            const float* wsel = bw ? p.B2 : p.B;
            G::run(shm, (const char*)p.A, aoff, (const char*)(wsel + (size_t)e * DM_ * DM_ + (size_t)bk * DM_ + nt * 128 + bc), DM_ * 4, DM_ / 64, acc);
        }
        const int t1 = tid_opaque(); LANE_IDS(t1)
        const int hi = (fr >> 3) & 1;
        bf16_t* op = p.Cb + (size_t)(z * 256 + wr * 128 + fq * 4) * DM_ + nt * 128 + wc * 32 + 4 * (fr & 7);
#pragma unroll
        for (int mm = 0; mm < 4; ++mm)
#pragma unroll
            for (int j = 0; j < 4; ++j) {
                float a[4], g[4];
#pragma unroll
                for (int n = 0; n < 4; ++n) {
                    const float lo = acc[mm][n][j], hv = acc[mm + 4][n][j];
                    const float send = hi ? lo : hv;
                    const float recv = __shfl_xor(send, 8, 64);
                    a[n] = hi ? recv : lo;
                    g[n] = hi ? hv : recv;
                }
                uint2 o; o.x = cvt_pk_bf16(silu_fast_(a[0]) * g[0], silu_fast_(a[1]) * g[1]); o.y = cvt_pk_bf16(silu_fast_(a[2]) * g[2], silu_fast_(a[3]) * g[3]);
                *(uint2*)(op + (size_t)((mm + 4 * hi) * 16 + j) * DM_) = o;
            }
    }
}
__device__ __forceinline__ void phase_moe_down(char* shm, const GP& p) {
    typedef GemmCore<256, false> G;
    for (int L = bid_opaque(); L < 64 * 8; L += grid_n()) {
        const int xcd = L & 7, wg = xcd * 64 + (L >> 3), b = wg & 3, pair = wg >> 2, e = pair >> 3, nt = pair & 7, z = b * 16 + e;
        f32x4 acc[8][4]; ZERO_ACC(acc, 8);
        {
            const int t0 = tid_opaque(); int bk, bc, bw; G::b_coord(t0, bk, bc, bw);
            unsigned aoff[G::GLA];
#pragma unroll
            for (int i = 0; i < G::GLA; ++i) { int R, C; G::a_coord(t0, i, R, C); aoff[i] = (unsigned)((R * DM_ + C) * 2); }
            G::run(shm, (const char*)(p.A + (size_t)z * 256 * DM_), aoff, (const char*)(p.B + (size_t)e * DM_ * DM_ + (size_t)bk * DM_ + nt * 256 + bc), DM_ * 4, DM_ / 64, acc);
        }
        const int t1 = tid_opaque(); LANE_IDS(t1)
        const int row0 = z * 256 + wr * 128 + fq * 4;
        bf16_t* op = p.Cb + (size_t)row0 * DM_ + nt * 256 + wc * 64 + 4 * fr;
#pragma unroll
        for (int m = 0; m < 8; ++m)
#pragma unroll
            for (int j = 0; j < 4; ++j) {
                const float gt = p.gate[row0 + m * 16 + j];
                uint2 o; o.x = cvt_pk_bf16(gt * acc[m][0][j], gt * acc[m][1][j]); o.y = cvt_pk_bf16(gt * acc[m][2][j], gt * acc[m][3][j]);
                *(uint2*)(op + (size_t)(m * 16 + j) * DM_) = o;
            }
    }
}

namespace pg8 {
#define PG8_LAS __attribute__((address_space(3)))
constexpr int BM = 256, BK = 64, HALF = 128, HTB = HALF * BK * 2  , STAGE_BYTES = 8 * HTB;
__device__ __forceinline__ int lds_byte(int r, int c) { const int st = (r >> 4) * 2 + (c >> 5), rr = r & 15, cc = c & 31, ob = rr * 64 + cc * 2; return st * 1024 + (ob ^ (((ob >> 9) & 1) << 5)); }
__device__ __forceinline__ void stage_rc(int b, int& R, int& C) { const int st = b / 1024, sb = b % 1024, swz = sb ^ (((sb >> 9) & 1) << 5); R = (st >> 1) * 16 + swz / 64; C = (st & 1) * 32 + (swz % 64) / 2; }
__device__ __forceinline__ int perm32(int rho) { const int n = rho >> 4, i = rho & 15; return 8 * (i >> 2) + 4 * n + (i & 3); }
struct Unit { int pm, pn; };
struct Gemm { const bf16_t* A; const bf16_t* Bt; int M, N, K; };
struct MegaOrder {
    int nM, nN, G, c;
    __device__ __forceinline__ bool next(int i, Unit& u) const { const int L = i * G + c; if (L >= nM * nN) return false; int pm, pn; static_order(L, nM, nN, pm, pn); u.pm = pm; u.pn = pn; return true; }
    __device__ __forceinline__ void a_ready(const Unit&) const {}
    __device__ __forceinline__ void done(const Unit&) const {}
};
__device__ __forceinline__ uint4 pack8_bf16(const f32x4& a, const f32x4& b) { return make_uint4(cvt_pk_bf16(a[0], a[1]), cvt_pk_bf16(a[2], a[3]), cvt_pk_bf16(b[0], b[1]), cvt_pk_bf16(b[2], b[3])); }
struct EpiInproj {
    static constexpr bool PERM = true, AFTER_DRAIN = false;
    bf16_t* proj; bf16_t* gates; bf16_t* vt; const float* bgate;
    __device__ __forceinline__ void operator()(const f32x4 (&acc)[2][2][4][2], const Unit& u, int wr, int wc, int fr, int fq) const {
        const int row0 = u.pm * BM + wr * 64 + fr, cb = wc * 32 + 8 * fq;
        if (u.pn == 14 || u.pn == 15) {
            const int bb = row0 >> 11;
#pragma unroll
            for (int ai = 0; ai < 2; ++ai)
#pragma unroll
                for (int m = 0; m < 4; ++m) { const int t = (row0 + ai * HALF + m * 16) & (SEQ_ - 1);
#pragma unroll
                    for (int bj = 0; bj < 2; ++bj)
#pragma unroll
                        for (int n = 0; n < 2; ++n)
#pragma unroll
                            for (int e = 0; e < 4; ++e) vt[(size_t)(bb * 512 + (u.pn - 14) * 256 + bj * HALF + cb + 4 * n + e) * SEQ_ + t] = f2bf(acc[ai][bj][m][n][e]); }
        } else if (u.pn < 22) {
#pragma unroll
            for (int ai = 0; ai < 2; ++ai)
#pragma unroll
                for (int m = 0; m < 4; ++m) { bf16_t* rowp = proj + (size_t)(row0 + ai * HALF + m * 16) * PROJW + u.pn * BM + cb;
#pragma unroll
                    for (int bj = 0; bj < 2; ++bj) *(uint4*)(rowp + bj * HALF) = pack8_bf16(acc[ai][bj][m][0], acc[ai][bj][m][1]); }
        } else {
            const int gc = (u.pn - 22) * BM + cb;
            f32x4 bv[2][2];
#pragma unroll
            for (int bj = 0; bj < 2; ++bj) { bv[bj][0] = *(const f32x4*)(bgate + gc + bj * HALF); bv[bj][1] = *(const f32x4*)(bgate + gc + bj * HALF + 4); }
#pragma unroll
            for (int ai = 0; ai < 2; ++ai)
#pragma unroll
                for (int m = 0; m < 4; ++m) { bf16_t* rowp = gates + (size_t)(row0 + ai * HALF + m * 16) * 8192 + gc;
#pragma unroll
                    for (int bj = 0; bj < 2; ++bj) { f32x4 v0 = acc[ai][bj][m][0] + bv[bj][0], v1 = acc[ai][bj][m][1] + bv[bj][1];
#pragma unroll
                        for (int e = 0; e < 4; ++e) { v0[e] = sigmoid_fast_(v0[e]); v1[e] = sigmoid_fast_(v1[e]); }
                        *(uint4*)(rowp + bj * HALF) = pack8_bf16(v0, v1); } }
        }
    }
};
struct EpiOutproj {
    static constexpr bool PERM = false, AFTER_DRAIN = false;
    const float* R; float* C;
    __device__ __forceinline__ void operator()(const f32x4 (&acc)[2][2][4][2], const Unit& u, int wr, int wc, int fr, int fq) const {
        const int row0 = u.pm * BM + wr * 64 + fr, col0 = u.pn * BM + wc * 32 + 4 * fq;
#pragma unroll
        for (int ai = 0; ai < 2; ++ai)
#pragma unroll
            for (int m = 0; m < 4; ++m) { const size_t ro = (size_t)(row0 + ai * HALF + m * 16) * DM_ + col0;
#pragma unroll
                for (int bj = 0; bj < 2; ++bj)
#pragma unroll
                    for (int n = 0; n < 2; ++n) { const size_t o = ro + bj * HALF + n * 16; *(f32x4*)(C + o) = *(const f32x4*)(R + o) + acc[ai][bj][m][n]; } }
    }
};
template <class Epi, class Sched, bool STAMP = false>
__device__ __forceinline__ void gemm_phase(PG8_LAS unsigned char* lds, const Gemm g, const Sched& S, const Epi& E, unsigned long long* stamps) {
    const int tid = tid_opaque(), wid = __builtin_amdgcn_readfirstlane(tid >> 6), lane = tid & 63, wr = wid >> 2, wc = wid & 3, fr = lane & 15, fq = lane >> 4;
    const int K = g.K, nt = K / BK;
    int ts_lo = 0, ts_hi = 0, nts = 0; const unsigned long long rt_entry = STAMP ? (unsigned long long)wall_clock64() : 0ull;
#define PG8_STAMP() do { if (STAMP && wid == 0 && nts < 64) { const unsigned long long _c = (unsigned long long)clock64(); \
        ts_lo = (lane == nts) ? (int)(unsigned)_c : ts_lo; ts_hi = (lane == nts) ? (int)(unsigned)(_c >> 32) : ts_hi; ++nts; } } while (0)
    PG8_STAMP();
    unsigned voffA[2], voffB[2];
#pragma unroll
    for (int i = 0; i < 2; ++i) { int R, C; stage_rc(tid * 16 + i * 8192, R, C); const int Rb = Epi::PERM ? ((R & ~31) + perm32(R & 31)) : R;
        voffA[i] = (unsigned)(R * K + C) * 2u; voffB[i] = (unsigned)(Rb * K + C) * 2u; }
    const size_t kstep = (size_t)(BK * 2);
    const size_t hstep = (size_t)HALF * K * 2;
    const size_t tstep = 2 * hstep;
    const unsigned ldsw = (unsigned)wid * 1024u;
    const int aoff = lds_byte(wr * 64 + fr, fq * 8), boff = lds_byte(wc * 32 + fr, fq * 8);
#define PG8_SA(b, h) (((b) * 2 + (h)) * HTB)
#define PG8_SB(b, h) ((4 + (b) * 2 + (h)) * HTB)
#define PG8_STAGE(bufoff, gbase, voff) do { _Pragma("unroll") for (int _i = 0; _i < 2; ++_i) \
        __builtin_amdgcn_global_load_lds((const unsigned*)((const char*)(gbase) + (voff)[_i]), (PG8_LAS unsigned*)(lds + (bufoff) + ldsw + _i * 8192), 16, 0, 0); } while (0)
#define PG8_LDA(dst, b, h) do { _Pragma("unroll") for (int m = 0; m < 4; ++m) _Pragma("unroll") for (int k = 0; k < 2; ++k) dst[m][k] = *(const PG8_LAS bf16x8*)(lds + PG8_SA(b, h) + aoff + m * 2048 + k * 1024); } while (0)
#define PG8_LDB(dst, b, h) do { _Pragma("unroll") for (int n = 0; n < 2; ++n) _Pragma("unroll") for (int k = 0; k < 2; ++k) dst[n][k] = *(const PG8_LAS bf16x8*)(lds + PG8_SB(b, h) + boff + n * 2048 + k * 1024); } while (0)
#define PG8_MMA(ai, bj, At, Bt) do { __builtin_amdgcn_s_setprio(1); _Pragma("unroll") for (int m = 0; m < 4; ++m) _Pragma("unroll") for (int n = 0; n < 2; ++n) _Pragma("unroll") for (int k = 0; k < 2; ++k) \
        acc[ai][bj][m][n] = __builtin_amdgcn_mfma_f32_16x16x32_bf16(Bt[n][k], At[m][k], acc[ai][bj][m][n], 0, 0, 0); __builtin_amdgcn_s_setprio(0); } while (0)
#define PG8_WAIT_V(n) asm volatile("s_waitcnt vmcnt(" #n ")" ::: "memory")
#define PG8_WAIT_L(n) asm volatile("s_waitcnt lgkmcnt(" #n ")" ::: "memory")
#define PG8_BAR __builtin_amdgcn_s_barrier()
#define PG8_SCHED __builtin_amdgcn_sched_barrier(0)
    Unit cur, nxt; int ui = 0;
    if (!S.next(0, cur)) return;
    f32x4 acc[2][2][4][2];
#pragma unroll
    for (int a = 0; a < 2; ++a)
#pragma unroll
        for (int b = 0; b < 2; ++b)
#pragma unroll
            for (int m = 0; m < 4; ++m)
#pragma unroll
                for (int n = 0; n < 2; ++n) acc[a][b][m][n] = (f32x4){0.f, 0.f, 0.f, 0.f};
    bf16x8 At[4][2], B0[2][2], B1[2][2];
    const char* cA = (const char*)g.A + (size_t)cur.pm * tstep; const char* cB = (const char*)g.Bt + (size_t)cur.pn * tstep;
    S.a_ready(cur);
    PG8_STAGE(PG8_SB(0, 0), cB, voffB); PG8_STAGE(PG8_SA(0, 0), cA, voffA); PG8_STAGE(PG8_SB(0, 1), cB + hstep, voffB); PG8_STAGE(PG8_SA(0, 1), cA + hstep, voffA);
    if (wr == 1) PG8_BAR;
    PG8_WAIT_V(4); PG8_BAR;
    PG8_STAGE(PG8_SB(1, 0), cB + kstep, voffB); PG8_STAGE(PG8_SA(1, 0), cA + kstep, voffA); PG8_STAGE(PG8_SB(1, 1), cB + hstep + kstep, voffB);
    PG8_WAIT_V(6); PG8_BAR;
    PG8_STAMP();
    for (;;) {
        const bool has_next = S.next(ui + 1, nxt);
        const char* nA = has_next ? (const char*)g.A + (size_t)nxt.pm * tstep : cA; const char* nB = has_next ? (const char*)g.Bt + (size_t)nxt.pn * tstep : cB;
        for (int t = 0; t < nt; t += 2) {
            const bool last = (t == nt - 2);
            const char* a1 = cA + (size_t)(t + 1) * kstep;
            const char* a2 = last ? nA : cA + (size_t)(t + 2) * kstep; const char* b2 = last ? nB : cB + (size_t)(t + 2) * kstep;
            const char* a3 = a2 + kstep; const char* b3 = b2 + kstep;
            if (last && has_next) S.a_ready(nxt);
            PG8_LDB(B0, 0, 0); PG8_SCHED; PG8_LDA(At, 0, 0); PG8_STAGE(PG8_SA(1, 1), a1 + hstep, voffA);
            PG8_WAIT_L(8); PG8_BAR; PG8_WAIT_L(0); PG8_MMA(0, 0, At, B0); PG8_BAR; PG8_SCHED;
            PG8_LDB(B1, 0, 1); PG8_STAGE(PG8_SB(0, 0), b2, voffB);
            PG8_BAR; PG8_WAIT_L(0); PG8_MMA(0, 1, At, B1); PG8_BAR;
            PG8_LDA(At, 0, 1); PG8_STAGE(PG8_SA(0, 0), a2, voffA);
            PG8_BAR; PG8_WAIT_L(0); PG8_MMA(1, 0, At, B0); PG8_BAR; PG8_SCHED;
            PG8_STAGE(PG8_SB(0, 1), b2 + hstep, voffB);
            PG8_WAIT_V(6); PG8_BAR; PG8_MMA(1, 1, At, B1); PG8_BAR;
            PG8_LDB(B0, 1, 0); PG8_SCHED; PG8_LDA(At, 1, 0); PG8_STAGE(PG8_SA(0, 1), a2 + hstep, voffA);
            PG8_WAIT_L(8); PG8_BAR; PG8_WAIT_L(0); PG8_MMA(0, 0, At, B0); PG8_BAR; PG8_SCHED;
            PG8_LDB(B1, 1, 1); PG8_STAGE(PG8_SB(1, 0), b3, voffB);
            PG8_BAR; PG8_WAIT_L(0); PG8_MMA(0, 1, At, B1); PG8_BAR;
            PG8_LDA(At, 1, 1); PG8_STAGE(PG8_SA(1, 0), a3, voffA);
            PG8_BAR; PG8_WAIT_L(0); PG8_MMA(1, 0, At, B0); PG8_BAR; PG8_SCHED;
            PG8_STAGE(PG8_SB(1, 1), b3 + hstep, voffB);
            PG8_WAIT_V(6); PG8_BAR; PG8_MMA(1, 1, At, B1); PG8_BAR;
        }
        PG8_STAMP();
        if constexpr (!Epi::AFTER_DRAIN) { E(acc, cur, wr, wc, fr, fq); S.done(cur); }
        PG8_STAMP();
        if (!has_next) break;
#pragma unroll
        for (int a = 0; a < 2; ++a)
#pragma unroll
            for (int b = 0; b < 2; ++b)
#pragma unroll
                for (int m = 0; m < 4; ++m)
#pragma unroll
                    for (int n = 0; n < 2; ++n) acc[a][b][m][n] = (f32x4){0.f, 0.f, 0.f, 0.f};
        cur = nxt; cA = nA; cB = nB; ++ui;
    }
    PG8_WAIT_V(0);
    if (wr == 0) PG8_BAR;
    PG8_BAR;
    if constexpr (Epi::AFTER_DRAIN) { E.fused(acc, cur, wr, wc, fr, fq, lds, wid, lane); S.done(cur); }
    PG8_STAMP();
    if (STAMP && wid == 0) { stamps[lane] = lane < nts ? (((unsigned long long)(unsigned)ts_hi << 32) | (unsigned)ts_lo) : 0ull;
        if (lane == 62) stamps[62] = rt_entry; if (lane == 63) stamps[63] = (unsigned long long)wall_clock64(); }
#undef PG8_STAMP
#undef PG8_SA
#undef PG8_SB
#undef PG8_STAGE
#undef PG8_LDA
#undef PG8_LDB
#undef PG8_MMA
#undef PG8_WAIT_V
#undef PG8_WAIT_L
#undef PG8_BAR
#undef PG8_SCHED
}
}
#define XB_TMO      128
#define XB_XCNT(j)  (256  + 64 * (j))
#define XB_XSUB(j)  (1280 + 64 * (j))
#define XB_XGEN(j)  (2304 + 64 * (j))
#define XB_TOP      3328
#define XB_TOPGEN   3392
#define XCD_BAR_WORDS 3456
#define XB_SPIN_CAP (1u << 18)
#define LAS __attribute__((address_space(3)))

__device__ __forceinline__ unsigned xb_ld(unsigned* p)              { return __hip_atomic_load(p, __ATOMIC_RELAXED, __HIP_MEMORY_SCOPE_AGENT); }
__device__ __forceinline__ unsigned xb_add(unsigned* p, unsigned v) { return __hip_atomic_fetch_add(p, v, __ATOMIC_RELAXED, __HIP_MEMORY_SCOPE_AGENT); }
__device__ __forceinline__ unsigned xb_xcc_id() { return (unsigned)__builtin_amdgcn_s_getreg((3 << 11) | 20) & 0xFu; }
#define XB_SPIN(cond, bar) do { unsigned _sp = 0; while (cond) { __builtin_amdgcn_s_sleep(1); \
    if ((++_sp & 255u) == 0u) { if (xb_ld(&(bar)[XB_TMO])) break; if (_sp > XB_SPIN_CAP) { atomicAdd(&(bar)[XB_TMO], 1u); break; } } } } while (0)

struct XcdBarrier {
    unsigned* bar; unsigned x;
    volatile LAS unsigned* st;
};

__device__ __forceinline__ XcdBarrier xcd_barrier_post(unsigned* bar, volatile LAS unsigned* st) {
    XcdBarrier b; b.bar = bar; b.x = xb_xcc_id(); b.st = st;
    if (threadIdx.x == 0) (void)xb_add(&bar[XB_XCNT(b.x)], 1u);
    return b;
}
__device__ __forceinline__ void xcd_barrier_complete(unsigned* bar, unsigned x, unsigned& nloc, unsigned& nx) {
    const unsigned G = gridDim.x * gridDim.y * gridDim.z;
    unsigned sum, cnt, mine, sp = 0u;
    for (;;) {
        sum = 0u; cnt = 0u; mine = 0u;
#pragma unroll
        for (unsigned j = 0; j < 16; ++j) { const unsigned c = xb_ld(&bar[XB_XCNT(j)]); sum += c; cnt += (c > 0u) ? 1u : 0u; mine = (j == x) ? c : mine; }
        if (sum == G) break;
        __builtin_amdgcn_s_sleep(1);
        if ((++sp & 255u) == 0u) { if (xb_ld(&bar[XB_TMO])) break; if (sp > XB_SPIN_CAP) { atomicAdd(&bar[XB_TMO], 1u); break; } }
    }
    nloc = mine > 0u ? mine : 1u; nx = cnt > 0u ? cnt : 1u;
}

__device__ __forceinline__ void xcd_barrier(const XcdBarrier& b) {
    asm volatile("s_waitcnt vmcnt(0)" ::: "memory");
    __syncthreads();
    if (threadIdx.x == 0) {
        unsigned* bar = b.bar; unsigned bx_ = b.x;
        asm volatile("" : "+s"(bar), "+s"(bx_));
        __builtin_amdgcn_s_waitcnt(0);
        unsigned nloc = b.st[0], nx = b.st[1];
        const unsigned old = xb_add(&bar[XB_XSUB(bx_)], 1u);
        const unsigned gen = old / nloc;
        if (old + 1u == (gen + 1u) * nloc) {
            __builtin_amdgcn_fence(__ATOMIC_RELEASE, "agent");
            asm volatile("s_waitcnt vmcnt(0)" ::: "memory");
            const unsigned og = xb_add(&bar[XB_TOP], 1u);
            const unsigned tg = og / nx;
            if (og + 1u == (tg + 1u) * nx) xb_add(&bar[XB_TOPGEN], 1u);
            else XB_SPIN(xb_ld(&bar[XB_TOPGEN]) == tg, bar);
            __builtin_amdgcn_fence(__ATOMIC_ACQUIRE, "agent");
            xb_add(&bar[XB_XGEN(bx_)], 1u);
            asm volatile("s_waitcnt vmcnt(0)" ::: "memory");
        } else {
            XB_SPIN(xb_ld(&bar[XB_XGEN(bx_)]) == gen, bar);
            __builtin_amdgcn_fence(__ATOMIC_ACQUIRE, "agent");
            asm volatile("s_waitcnt vmcnt(0)" ::: "memory");
        }
    }
    __syncthreads();
}

enum { X = 0, N1G, WIN, HCW, HCB, FW1, FB1, FW2, FB2, FW3, FB3, FW4, FREQ, HBIAS, LCW, LCB, LWA, LBA, LWX, LBX, LLAM, DLAM, DSUB, SCW, SCB, SDTB, SALOG, SD, SNG, WBR, BG, WOUT,
       N2G, WR, W1, W3, W2, RELB, FING };
struct MP {
    const float* in[39]; float* out; unsigned* bar;
    float* xres; bf16_t* hb; bf16_t* proj; bf16_t* gates; float* dtraw; bf16_t* br; bf16_t* mrg;
    float* fr; float* nrm; unsigned* hpp; bf16_t* vvt; float* hyt; bf16_t* vt;
    float* sumP; float* sumE; bf16_t* sxa; bf16_t* sxT; float* states; float* sdec; bf16_t* sprev;
    float* aff; int* tidx; float* tgat; int* tinv; bf16_t* hid; bf16_t* ybuf;
    bf16_t* wtin; bf16_t* wtbr; bf16_t* wtout; bf16_t* lruwt;
    int ngrid, pad1;
};
typedef const MP __attribute__((address_space(4)))* MPc;
__device__ __forceinline__ MPc params() { MPc q = (MPc)__builtin_amdgcn_kernarg_segment_ptr(); asm volatile("" : "+s"(q)); return q; }
__device__ __forceinline__ int bid_opaque() { int b = (int)__builtin_amdgcn_workgroup_id_x(); asm volatile("" : "+s"(b)); return b; }
__device__ __forceinline__ int grid_n() { return params()->ngrid; }
#define MEGA_LDS (139264 + 1024)
#define NPH 12

template <int MODE>
__device__ __forceinline__ void phase_norm(char* shm, MPc p, int l) {
    float* hrow = (float*)shm;
    float* red = (float*)(shm + 65536);
    for (int it = bid_opaque(); it < TT_ / 8; it += grid_n()) {
        const int tid = tid_opaque(), wid = tid >> 6, lane = tid & 63;
        const int tok = it * 8 + wid, b = tok >> 11;
        const float* xin = (MODE == 0 && l == 0) ? p->in[X] : p->xres;
        f32x4 v[8];
#pragma unroll
        for (int i = 0; i < 8; ++i) v[i] = *(const f32x4*)(xin + (size_t)tok * DM_ + (i * 64 + lane) * 4);
        if (MODE == 2 || (MODE == 0 && l > 0)) {
            for (int e = 0; e < 16; ++e) {
                const int slot = p->tinv[tok * 16 + e];
                if (slot >= 0) {
                    const bf16_t* yr = p->ybuf + ((size_t)(b * 16 + e) * 256 + slot) * DM_;
#pragma unroll
                    for (int i = 0; i < 8; ++i) { const uint2 y = *(const uint2*)(yr + (i * 64 + lane) * 4);
                        v[i][0] += __uint_as_float(y.x << 16); v[i][1] += __uint_as_float(y.x & 0xffff0000u); v[i][2] += __uint_as_float(y.y << 16); v[i][3] += __uint_as_float(y.y & 0xffff0000u); }
                }
            }
        }
        float ss = 0.f;
#pragma unroll
        for (int i = 0; i < 8; ++i) ss += v[i][0] * v[i][0] + v[i][1] * v[i][1] + v[i][2] * v[i][2] + v[i][3] * v[i][3];
#pragma unroll
        for (int o = 32; o > 0; o >>= 1) ss += __shfl_xor(ss, o, 64);
        const float rs = rsqrtf(ss * (1.0f / DM_) + 1e-6f);
        const float* g = MODE == 0 ? p->in[N1G] + l * DM_ : (MODE == 1 ? p->in[N2G] + l * DM_ : p->in[FING]);
        if (MODE != 2) __syncthreads();
#pragma unroll
        for (int i = 0; i < 8; ++i) {
            const int c = (i * 64 + lane) * 4;
            const f32x4 gv = *(const f32x4*)(g + c);
            const f32x4 y = (f32x4){v[i][0] * rs * gv[0], v[i][1] * rs * gv[1], v[i][2] * rs * gv[2], v[i][3] * rs * gv[3]};
            if (MODE == 0) *(f32x4*)(p->xres + (size_t)tok * DM_ + c) = v[i];
            if (MODE == 2) *(f32x4*)(p->out + (size_t)tok * DM_ + c) = y;
            else {
                uint2 o; o.x = cvt_pk_bf16(y[0], y[1]); o.y = cvt_pk_bf16(y[2], y[3]);
                *(uint2*)(p->hb + (size_t)tok * DM_ + c) = o;
                *(f32x4*)(hrow + wid * DM_ + c) = y;
            }
        }
        if (MODE != 2) {
            __syncthreads();
            const float* W = MODE == 0 ? p->in[WIN] + (size_t)l * DM_ * INC_ + PROJW : p->in[WR] + (size_t)l * DM_ * 16;
            const int ldw = MODE == 0 ? INC_ : 16;
            const int e = tid & 15, part = tid >> 4;
            float acc[8] = {0.f, 0.f, 0.f, 0.f, 0.f, 0.f, 0.f, 0.f};
#pragma unroll 4
            for (int k = part * 64; k < part * 64 + 64; ++k) {
                const float w = W[(size_t)k * ldw + e];
#pragma unroll
                for (int t = 0; t < 8; ++t) acc[t] += hrow[t * DM_ + k] * w;
            }
#pragma unroll
            for (int t = 0; t < 8; ++t) red[(t * 32 + part) * 16 + e] = acc[t];
            __syncthreads();
            if (tid < 128) {
                const int tl = tid >> 4, e2 = tid & 15; float s = 0.f;
                for (int q = 0; q < 32; ++q) s += red[(tl * 32 + q) * 16 + e2];
                const int tk = it * 8 + tl;
                if (MODE == 0) p->dtraw[(size_t)tk * 16 + e2] = s;
                else {
                    float m = s;
#pragma unroll
                    for (int o = 8; o > 0; o >>= 1) m = fmaxf(m, __shfl_xor(m, o, 64));
                    const float ex = expf(s - m); float z = ex;
#pragma unroll
                    for (int o = 8; o > 0; o >>= 1) z += __shfl_xor(z, o, 64);
                    p->aff[(size_t)tk * 16 + e2] = ex / z;
                }
            }
        }
    }
}
__device__ __forceinline__ int block_sum_512(int v, volatile int* red  , int par, int tid) {
#pragma unroll
    for (int o = 32; o > 0; o >>= 1) v += __shfl_xor(v, o, 64);
    if ((tid & 63) == 0) red[par * 8 + (tid >> 6)] = v;
    __syncthreads();
    int s = 0;
#pragma unroll
    for (int w = 0; w < 8; ++w) s += red[par * 8 + w];
    return s;
}
__device__ __forceinline__ int block_exscan_512(int v, volatile int* wsum  , int tid) {
    int inc = v;
#pragma unroll
    for (int o = 1; o < 64; o <<= 1) { const int n = __shfl_up(inc, o, 64); if ((tid & 63) >= o) inc += n; }
    if ((tid & 63) == 63) wsum[tid >> 6] = inc;
    __syncthreads();
    int base = 0;
#pragma unroll
    for (int w = 0; w < 8; ++w) base += (w < (tid >> 6)) ? wsum[w] : 0;
    __syncthreads();
    return base + inc - v;
}
__device__ __forceinline__ void phase_topk(char* shm, MPc p) {
    volatile int* red = (volatile int*)shm;
    volatile int* wsum = red + 16;
    for (int z = bid_opaque(); z < 64; z += grid_n()) {
        const int b = z >> 4, e = z & 15, tid = tid_opaque();
        __syncthreads();
        float v[4]; unsigned u[4];
#pragma unroll
        for (int i = 0; i < 4; ++i) { v[i] = p->aff[(size_t)(b * SEQ_ + tid * 4 + i) * 16 + e]; u[i] = __float_as_uint(v[i]); }
        unsigned T = 0u;
        for (int bit = 30; bit >= 0; --bit) {
            const unsigned cand = T | (1u << bit);
            const int c = block_sum_512((u[0] >= cand) + (u[1] >= cand) + (u[2] >= cand) + (u[3] >= cand), red, bit & 1, tid);
            if (c >= 256) T = cand;
        }
        __syncthreads();
        const int ngt = block_sum_512((u[0] > T) + (u[1] > T) + (u[2] > T) + (u[3] > T), red, 0, tid);
        const int need = 256 - ngt;
        __syncthreads();
        const int eq_l = (u[0] == T) + (u[1] == T) + (u[2] == T) + (u[3] == T);
        int eqr = block_exscan_512(eq_l, wsum, tid);
        int sel[4], nsel = 0;
#pragma unroll
        for (int i = 0; i < 4; ++i) { const bool isq = u[i] == T; sel[i] = (u[i] > T) || (isq && eqr < need); eqr += isq ? 1 : 0; nsel += sel[i]; }
        int slot = block_exscan_512(nsel, wsum, tid);
#pragma unroll
        for (int i = 0; i < 4; ++i) {
            const int t = tid * 4 + i;
            if (sel[i]) { p->tidx[z * 256 + slot] = t; p->tgat[z * 256 + slot] = v[i]; }
            p->tinv[(b * SEQ_ + t) * 16 + e] = sel[i] ? slot : -1;
            slot += sel[i];
        }
    }
}
__device__ __forceinline__ void phase_hy_filter(char* shm, MPc p) {
    float* zz = (float*)shm; float* ha = zz + 8 * 64; float* hbq = ha + 8 * 64;
    for (int u = bid_opaque(); u < 512; u += grid_n()) {
        const int lf = u >> 8, tid = tid_opaque(), wid = tid >> 6, o = tid & 63, i = (u & 255) * 8 + wid;
        const float* fw1 = p->in[FW1] + lf * 33 * 64; const float* fw2 = p->in[FW2] + lf * 4096; const float* fw3 = p->in[FW3] + lf * 4096; const float* fw4 = p->in[FW4] + lf * 64 * 512;
        const float t = (float)i / (float)(SEQ_ - 1);
        const float w = (2.0f * 3.14159265358979323846f / (float)SEQ_) * (float)i;
        __syncthreads();
        if (o == 0) zz[wid * 64] = t;
        if (o < 16) { const float band = 1e-4f + (float)o * ((15.0f - 1e-4f) / 15.0f); zz[wid * 64 + 1 + o] = cosf(band * w); zz[wid * 64 + 17 + o] = -sinf(band * w); }
        __syncthreads();
        const float fq = p->in[FREQ][lf * 64 + o];
        float s = p->in[FB1][lf * 64 + o];
        for (int k = 0; k < 33; ++k) s += zz[wid * 64 + k] * fw1[k * 64 + o];
        ha[wid * 64 + o] = sinf(fq * s);
        __syncthreads();
        s = p->in[FB2][lf * 64 + o];
        for (int k = 0; k < 64; ++k) s += ha[wid * 64 + k] * fw2[k * 64 + o];
        hbq[wid * 64 + o] = sinf(fq * s);
        __syncthreads();
        s = p->in[FB3][lf * 64 + o];
        for (int k = 0; k < 64; ++k) s += hbq[wid * 64 + k] * fw3[k * 64 + o];
        __syncthreads();
        ha[wid * 64 + o] = sinf(fq * s);
        __syncthreads();
        { const float d0 = logf(1e-2f) / 1.5f, d1 = logf(1e-2f) / 0.3f;
          const int c = tid;
          float a8[8] = {0.f, 0.f, 0.f, 0.f, 0.f, 0.f, 0.f, 0.f};
          for (int k = 0; k < 64; ++k) { const float wv = fw4[k * 512 + c];
#pragma unroll
              for (int q = 0; q < 8; ++q) a8[q] += ha[q * 64 + k] * wv; }
          const float delta = fabsf(d0 + (float)c * ((d1 - d0) / 511.0f));
#pragma unroll
          for (int q = 0; q < 8; ++q) { const int iq = (u & 255) * 8 + q; const float tq = (float)iq / (float)(SEQ_ - 1);
              p->fr[((size_t)lf * SEQ_ + iq) * 512 + c] = a8[q] * __expf(-2.0f * fabsf(tq - 0.5f) * delta); } }
    }
}
__device__ __forceinline__ void phase_hy_norm(MPc p) {
    for (int u = bid_opaque(); u < 128; u += grid_n()) {
        const int tid = tid_opaque(), pr = u * 8 + (tid >> 6), lane = tid & 63, lf = pr >> 9, c = pr & 511;
        float s = 0.f;
        for (int q = 0; q < 32; ++q) s += fabsf(p->fr[((size_t)lf * SEQ_ + lane + 64 * q) * 512 + c]);
#pragma unroll
        for (int o = 32; o > 0; o >>= 1) s += __shfl_xor(s, o, 64);
        if (lane == 0) p->nrm[pr] = s;
    }
}

__device__ __forceinline__ GP mk_gp(MPc p, int l, int which) {
    GP g{};
    if (which == 0) { g.A = p->hb; g.Bt = p->wtin + (size_t)l * 13824 * DM_; g.bias = p->in[BG] + (size_t)l * 4 * DM_; g.Cb = p->proj; g.Cb2 = p->gates; g.Vt = p->vt; }
    if (which == 1) { g.A = p->br; g.Bt = p->wtbr + (size_t)l * 4 * DM_ * 512; g.G = p->gates; g.Cb = p->mrg; }
    if (which == 2) { g.A = p->mrg; g.Bt = p->wtout + (size_t)l * DM_ * DM_; g.R = p->xres; g.Cf = p->xres; }
    if (which == 3) { g.A = p->hb; g.B = p->in[W1] + (size_t)l * 16 * DM_ * DM_; g.B2 = p->in[W3] + (size_t)l * 16 * DM_ * DM_; g.idx = p->tidx; g.Cb = p->hid; }
    if (which == 4) { g.A = p->hid; g.B = p->in[W2] + (size_t)l * 16 * DM_ * DM_; g.gate = p->tgat; g.Cb = p->ybuf; }
    return g;
}
__device__ __forceinline__ HP mk_hp(MPc p, int l) {
    HP h{}; h.proj = p->proj; h.fr = p->fr + (size_t)l * SEQ_ * 512; h.nrm = p->nrm + l * 512; h.pp = p->hpp + (size_t)l * 512 * HY_PPW; h.vvt = p->vvt; h.yt = p->hyt;
    h.cw = p->in[HCW] + l * 3 * 1536; h.cb = p->in[HCB] + l * 1536; h.hbias = p->in[HBIAS] + l * 512; h.br = p->br; return h;
}
__device__ __forceinline__ LP mk_lp(MPc p, int l) {
    LP q{}; q.proj = p->proj; q.cw = p->in[LCW] + l * 4 * 512; q.cb = p->in[LCB] + l * 512; q.wt = p->lruwt + (size_t)l * 8 * 256 * 64; q.ba = p->in[LBA] + l * 1024;
    q.bx = p->in[LBX] + l * 1024; q.lam = p->in[LLAM] + l * 1024; q.sumP = p->sumP; q.sumE = p->sumE; q.br = p->br; return q;
}
__device__ __forceinline__ SP_ mk_sp(MPc p, int l) {
    SP_ s{}; s.proj = p->proj; s.dtraw = p->dtraw; s.cw = p->in[SCW] + l * 4 * 1024; s.cb = p->in[SCB] + l * 1024; s.dtb = p->in[SDTB] + l * 16; s.a_log = p->in[SALOG] + l * 16; s.dsk = p->in[SD] + l * 8; s.ng = p->in[SNG] + l * 512;
    s.xa = p->sxa; s.xT = p->sxT; s.states = p->states; s.decay = p->sdec; s.prev = p->sprev; s.br = p->br; return s;
}
__device__ __forceinline__ AP mk_ap(MPc p, int l) {
    AP a{}; a.proj = p->proj; a.vt = p->vt; a.rel_bias = p->in[RELB]; a.dlam = p->in[DLAM] + l * 256; a.subg = p->in[DSUB] + l * 128; a.br = p->br; a.lam_init = l == 0 ? 0.2f : 0.35550906759096926f; return a;
}
__device__ __forceinline__ void wconv_tile(float* tile, const float* src, size_t ld_src, bf16_t* dst, size_t ld_dst, int tid) {
    __syncthreads();
    { const int kr = tid >> 4, n4 = (tid & 15) * 4;
#pragma unroll
      for (int h = 0; h < 2; ++h) { const f32x4 v = *(const f32x4*)(src + (size_t)(kr + 32 * h) * ld_src + n4); float* t = tile + (kr + 32 * h) * 65 + n4; t[0] = v[0]; t[1] = v[1]; t[2] = v[2]; t[3] = v[3]; } }
    __syncthreads();
    { const int n = tid >> 3, k8 = (tid & 7) * 8; const float* t = tile + k8 * 65 + n;
      uint4 o; o.x = cvt_pk_bf16(t[0], t[65]); o.y = cvt_pk_bf16(t[130], t[195]); o.z = cvt_pk_bf16(t[260], t[325]); o.w = cvt_pk_bf16(t[390], t[455]);
      *(uint4*)(dst + (size_t)n * ld_dst + k8) = o; }
}
__device__ __forceinline__ void phase_wconv(char* shm, MPc p, int l, int bw0, int bwn) {
    const int bq = bid_opaque() - bw0; if (bq < 0 || bq >= bwn) return;
    for (int e0 = bq * 512 + tid_opaque(); e0 < 8 * 256 * 64; e0 += bwn * 512) {
        const int e = l * 8 * 256 * 64 + e0; const int i = e & 63, n = (e >> 6) & 255, h = (e >> 14) & 7, j = n & 63, g = (n >> 6) & 1, dir = n >> 7;
        const float* w = (g ? p->in[LWX] : p->in[LWA]) + ((size_t)((l * 2 + dir) * 8 + h) * 64 + i) * 64 + j;
        p->lruwt[e] = f2bf(*w);
    }
    float* tile = (float*)shm;
    const int NJ_IN = 32 * 216, NJ_BR = 4 * 8 * 32, NJ_OUT = 32 * 32, NJ = NJ_IN + NJ_BR + NJ_OUT;
    for (int u = bq; u < NJ; u += bwn) {
        int j = u; const int tid = tid_opaque();
        if (j < NJ_IN) { const int nt = j % 216, kt = j / 216, n0 = nt * 64, ns = n0 < PROJW ? n0 : n0 + 16;
            wconv_tile(tile, p->in[WIN] + (size_t)l * DM_ * INC_ + (size_t)kt * 64 * INC_ + ns, INC_, p->wtin + ((size_t)l * 13824 + n0) * DM_ + kt * 64, DM_, tid); }
        else if (j < NJ_IN + NJ_BR) { j -= NJ_IN; const int nt = j & 31, kt = (j >> 5) & 7, k = j >> 8;
            wconv_tile(tile, p->in[WBR] + ((size_t)(l * 4 + k) * 512 + kt * 64) * DM_ + nt * 64, DM_, p->wtbr + (((size_t)(l * 4 + k) * DM_) + nt * 64) * 512 + kt * 64, 512, tid); }
        else { j -= NJ_IN + NJ_BR; const int nt = j & 31, kt = j >> 5;
            wconv_tile(tile, p->in[WOUT] + ((size_t)l * DM_ + kt * 64) * DM_ + nt * 64, DM_, p->wtout + ((size_t)l * DM_ + nt * 64) * DM_ + kt * 64, DM_, tid); }
    }
}
#define PH_ON(id) (ONLY < 0 || ONLY == (id))
#define PH_SYNC(id) do { if (ONLY < 0) xcd_barrier(bar); } while (0)
template <int ONLY>
__global__ void __launch_bounds__(512, 2) k_mega(MP p_unused) {
    extern __shared__ __attribute__((aligned(1024))) char shm[];
    XcdBarrier bar{};
    if (ONLY < 0) {
        volatile LAS unsigned* xbw = (volatile LAS unsigned*)(shm + MEGA_LDS - 16);
        if (threadIdx.x == 0) { xbw[0] = 0u; xbw[1] = 0u; }
        __syncthreads();
        bar = xcd_barrier_post(params()->bar, xbw);
        if (threadIdx.x == 0) { unsigned nloc, nx; xcd_barrier_complete(bar.bar, bar.x, nloc, nx); xbw[0] = nloc; xbw[1] = nx; }
        __syncthreads();
    }
    constexpr int L0 = ONLY < 0 ? 0 : (ONLY >= 2 * NPH ? 2 : ONLY / NPH), L1 = ONLY < 0 ? 2 : (ONLY >= 2 * NPH ? 2 : ONLY / NPH + 1);
#pragma unroll 1
    for (int l = L0; l < L1; ++l) {
        const int id0 = l * NPH;
        if (PH_ON(id0 + 0)) { phase_norm<0>(shm, params(), l); if (l == 0) { phase_hy_filter(shm, params()); phase_wconv(shm, params(), 0, 0, grid_n()); } }
        PH_SYNC(id0 + 0);
        if (PH_ON(id0 + 1)) { if (l == 0) phase_hy_norm(params()); const GP g = mk_gp(params(), l, 0);
            const pg8::Gemm gg{g.A, g.Bt, TT_, 13824, DM_}; const pg8::MegaOrder so{32, 54, grid_n(), bid_opaque()}; const pg8::EpiInproj ep{g.Cb, g.Cb2, g.Vt, g.bias};
            pg8::gemm_phase<pg8::EpiInproj, pg8::MegaOrder, false>((PG8_LAS unsigned char*)shm, gg, so, ep, nullptr); }
        PH_SYNC(id0 + 1);
        if (PH_ON(id0 + 2)) {
            { const AP a = mk_ap(params(), l); phase_attn(shm, a); }
            if (l == 0) { const HP h0 = mk_hp(params(), 0); phase_hy_pp(h0); const HP h1 = mk_hp(params(), 1); phase_hy_pp(h1); }
            { const HP h = mk_hp(params(), l); phase_hy_prep(shm, h); }
            { const SP_ s = mk_sp(params(), l); phase_ssd_prep(shm, s); }
            { const LP q = mk_lp(params(), l); phase_lru<0>(shm, q); }
        }
        PH_SYNC(id0 + 2);
        if (PH_ON(id0 + 3)) {
            { const HP h = mk_hp(params(), l); phase_hy_conv(shm, h); }
            { const SP_ s = mk_sp(params(), l); phase_ssd_states(shm, s); }
            { const LP q = mk_lp(params(), l); phase_lru<1>(shm, q); }
        }
        PH_SYNC(id0 + 3);
        if (PH_ON(id0 + 4)) { const SP_ s = mk_sp(params(), l); phase_ssd_scan(s); }
        PH_SYNC(id0 + 4);
        if (PH_ON(id0 + 5)) { { const SP_ s = mk_sp(params(), l); phase_ssd_out(shm, s); }
            { const HP h = mk_hp(params(), l); phase_hy_fin(shm, h, 0, grid_n()); }
            if (l == 0) phase_wconv(shm, params(), 1, 0, grid_n()); }
        PH_SYNC(id0 + 5);
        if (PH_ON(id0 + 6)) { const GP g = mk_gp(params(), l, 1); phase_merge(shm, g); }
        PH_SYNC(id0 + 6);
        if (PH_ON(id0 + 7)) { const GP g = mk_gp(params(), l, 2);
            const pg8::Gemm gg{g.A, g.Bt, TT_, DM_, DM_}; const pg8::MegaOrder so{32, 8, grid_n(), bid_opaque()}; const pg8::EpiOutproj ep{g.R, g.Cf};
            pg8::gemm_phase<pg8::EpiOutproj, pg8::MegaOrder, false>((PG8_LAS unsigned char*)shm, gg, so, ep, nullptr); }
        PH_SYNC(id0 + 7);
        if (PH_ON(id0 + 8)) phase_norm<1>(shm, params(), l);
        PH_SYNC(id0 + 8);
        if (PH_ON(id0 + 9)) phase_topk(shm, params());
        PH_SYNC(id0 + 9);
        if (PH_ON(id0 + 10)) { const GP g = mk_gp(params(), l, 3); phase_moe_up(shm, g); }
        PH_SYNC(id0 + 10);
        if (PH_ON(id0 + 11)) { const GP g = mk_gp(params(), l, 4); phase_moe_down(shm, g); }
        PH_SYNC(id0 + 11);
    }
    if (PH_ON(2 * NPH)) phase_norm<2>(shm, params(), 0);
}
template <int I> struct PhaseLauncher { static void go(int grid, hipStream_t st, const MP& p) { (void)hipFuncSetAttribute((const void*)k_mega<I>, hipFuncAttributeMaxDynamicSharedMemorySize, MEGA_LDS); hipLaunchKernelGGL(k_mega<I>, dim3(grid), dim3(512), MEGA_LDS, st, p); PhaseLauncher<I + 1>::go(grid, st, p); } };
template <> struct PhaseLauncher<2 * NPH + 1> { static void go(int, hipStream_t, const MP&) {} };

#ifndef MK_N_LAUNCHES
#define MK_N_LAUNCHES 1
#endif
extern "C" void kernel_launch(void* const* d_in, const int* in_sizes, int n_in, void* d_out, int out_size, void* d_ws, size_t ws_size, hipStream_t stream) {
    static int grid = 0;
    if (grid == 0) {
        int dev = 0, cus = 0;
        if (hipGetDevice(&dev) != hipSuccess || hipDeviceGetAttribute(&cus, hipDeviceAttributeMultiprocessorCount, dev) != hipSuccess) { fprintf(stderr, "kernel_launch: device query failed\n"); grid = -1; return; }
        if (hipFuncSetAttribute((const void*)k_mega<-1>, hipFuncAttributeMaxDynamicSharedMemorySize, MEGA_LDS) != hipSuccess) { fprintf(stderr, "kernel_launch: hipFuncSetAttribute failed\n"); grid = -1; return; }
        (void)hipGetLastError();
        grid = cus;
    }
    if (grid < 0) return;
    char* w = (char*)d_ws; size_t off = 0;
    auto alloc = [&](size_t bytes) { void* q = w + off; off += (bytes + 255) & ~(size_t)255; return q; };
    MP p{};
    for (int i = 0; i < 39; ++i) p.in[i] = (const float*)d_in[i];
    p.out = (float*)d_out; p.ngrid = grid;
    p.bar = (unsigned*)alloc(XCD_BAR_WORDS * 4);
    p.xres = (float*)alloc((size_t)TT_ * DM_ * 4);
    p.hb = (bf16_t*)alloc((size_t)TT_ * DM_ * 2);
    p.proj = (bf16_t*)alloc((size_t)TT_ * PROJW * 2);
    p.gates = (bf16_t*)alloc((size_t)TT_ * 8192 * 2);
    p.dtraw = (float*)alloc((size_t)TT_ * 16 * 4);
    p.br = (bf16_t*)alloc((size_t)TT_ * DM_ * 2);
    p.mrg = (bf16_t*)alloc((size_t)TT_ * DM_ * 2);
    p.fr = (float*)alloc((size_t)2 * SEQ_ * 512 * 4);
    p.nrm = (float*)alloc(2 * 512 * 4);
    p.hpp = (unsigned*)alloc((size_t)2 * 512 * HY_PPW * 4);
    p.vvt = (bf16_t*)alloc((size_t)512 * NB_ * SEQ_ * 2);
    p.hyt = (float*)alloc((size_t)512 * NB_ * SEQ_ * 4);
    p.vt = (bf16_t*)alloc((size_t)NB_ * 512 * SEQ_ * 2);
    p.sumP = (float*)alloc((size_t)2 * NB_ * 32 * 512 * 4);
    p.sumE = (float*)alloc((size_t)2 * NB_ * 32 * 512 * 4);
    p.sxa = (bf16_t*)alloc((size_t)TT_ * 1024 * 2);
    p.sxT = (bf16_t*)alloc((size_t)TT_ * 1024 * 2);
    p.states = (float*)alloc((size_t)NB_ * SSD_NC * 16 * 64 * 128 * 4);
    p.sdec = (float*)alloc(NB_ * SSD_NC * 16 * 4);
    p.sprev = (bf16_t*)alloc((size_t)NB_ * SSD_NC * 16 * 64 * 128 * 2);
    p.aff = (float*)alloc((size_t)TT_ * 16 * 4);
    p.tidx = (int*)alloc(64 * 256 * 4);
    p.tgat = (float*)alloc(64 * 256 * 4);
    p.tinv = (int*)alloc((size_t)TT_ * 16 * 4);
    p.hid = (bf16_t*)alloc((size_t)64 * 256 * DM_ * 2);
    p.ybuf = (bf16_t*)alloc((size_t)64 * 256 * DM_ * 2);
    p.wtin = (bf16_t*)alloc((size_t)2 * 13824 * DM_ * 2);
    p.wtbr = (bf16_t*)alloc((size_t)2 * 4 * DM_ * 512 * 2);
    p.wtout = (bf16_t*)alloc((size_t)2 * DM_ * DM_ * 2);
    p.lruwt = (bf16_t*)alloc((size_t)2 * 8 * 256 * 64 * 2);
    if (off > ws_size) { fprintf(stderr, "kernel_launch: workspace too small (%zu > %zu)\n", off, ws_size); return; }
    (void)hipMemsetAsync(p.bar, 0, XCD_BAR_WORDS * 4, stream);
#if MK_N_LAUNCHES == 1
    hipLaunchKernelGGL(k_mega<-1>, dim3(grid), dim3(512), MEGA_LDS, stream, p);
#else
    PhaseLauncher<0>::go(grid, stream, p);
#endif
}
```

```cpp
#include <hip/hip_runtime.h>
#include <math.h>
#include <stdint.h>
#include <stdio.h>

#define NB_ 4
#define SEQ_ 2048
#define DM_ 2048
#define TT_ 8192
#define INC_ 13840
#define O_HY 0
#define O_LRU 1536
#define O_DA 2560
#define O_SSD 4096
#define O_GATE 5648
typedef short bf16x8 __attribute__((ext_vector_type(8)));
typedef float f32x4 __attribute__((ext_vector_type(4)));
typedef float f32x2 __attribute__((ext_vector_type(2)));
typedef int i32x4 __attribute__((ext_vector_type(4)));
typedef unsigned short bf16_t;
__device__ __forceinline__ int bid_opaque();
__device__ __forceinline__ int grid_n();

typedef __bf16 bf16x2_t __attribute__((ext_vector_type(2)));
__device__ __forceinline__ unsigned cvt_pk_bf16(float lo, float hi) { const f32x2 v = {lo, hi}; return __builtin_bit_cast(unsigned, __builtin_convertvector(v, bf16x2_t)); }
__device__ __forceinline__ int tid_opaque() { int t = (int)__builtin_amdgcn_workitem_id_x(); asm volatile("" : "+v"(t)); return t; }
__device__ __forceinline__ float bf2f(bf16_t v) { return __uint_as_float((unsigned)v << 16); }
__device__ __forceinline__ bf16_t f2bf(float f) { return (bf16_t)(cvt_pk_bf16(f, 0.f) & 0xffffu); }

__device__ __forceinline__ int lds_rc(int r, int chunk) { return r * 128 + ((chunk ^ ((r >> 1) & 7)) << 4); }
#define GEMM_LDS_BYTES(BM) (2 * ((BM) * 128 + 256 * 128))
#ifndef GEMM_L2PF
#define GEMM_L2PF 0
#endif
#ifndef GEMM_BT_AH
#define GEMM_BT_AH 8
#endif

#define GEMM_KTILE(buf, HOOK) do { const char* sS = shm + (buf) * STAGE; bf16x8 Bc[4], Bn[4], Ar[4]; \
        _Pragma("unroll") for (int n = 0; n < 4; ++n) Bc[n] = *(const bf16x8*)(sS + broff0 + n * 2048); \
        _Pragma("unroll") for (int q = 0; q < 3; ++q) Ar[q] = *(const bf16x8*)(sS + aroff0 + q * 2048); \
        __builtin_amdgcn_sched_barrier(0); \
        _Pragma("unroll") for (int g = 0; g < 2 * FM; ++g) { \
            if (g + 3 < 2 * FM) Ar[(g + 3) & 3] = *(const bf16x8*)(sS + ((g + 3) / FM ? aroff1 : aroff0) + ((g + 3) % FM) * 2048); \
            if (g == FM - 4) { _Pragma("unroll") for (int n = 0; n < 4; ++n) Bn[n] = *(const bf16x8*)(sS + broff1 + n * 2048); } \
            __builtin_amdgcn_sched_barrier(0); \
            _Pragma("unroll") for (int n = 0; n < 4; ++n) acc[g % FM][n] = __builtin_amdgcn_mfma_f32_16x16x32_bf16(Ar[g & 3], (g < FM ? Bc[n] : Bn[n]), acc[g % FM][n], 0, 0, 0); \
            HOOK(g); \
            __builtin_amdgcn_sched_barrier(0); } } while (0)
template <int BM, bool DUAL>
struct GemmCore {
    static constexpr int FM = BM / 32;
    static constexpr int GLA = BM * 128 / 8192;
    static constexpr int TILE_A = BM * 128, TILE_B = 256 * 128, STAGE = TILE_A + TILE_B;

    template <class AccT>
    static __device__ __forceinline__ void run(char* shm, const char* abase, const unsigned (&aoff)[GLA], const char* bl, unsigned ldb, int nt, AccT& acc) {
        const int tid = tid_opaque(), wid = tid >> 6, lane = tid & 63, wr = wid >> 2, wc = wid & 3, fr = lane & 15, fq = lane >> 4;
        const int kq = lane & 3, ngl = lane >> 2, ksub = wid & 1, grp = wid >> 1;
        i32x4 sa[GLA];
        f32x4 sb[8];
        const int awoff = lds_rc(tid >> 3, tid & 7);
        const int bwoff = TILE_A + lds_rc(grp * 64 + ngl, ksub * 4 + kq);
        const int aroff0 = lds_rc(wr * (BM / 2) + fr, fq), aroff1 = lds_rc(wr * (BM / 2) + fr, 4 + fq);
        const int broff0 = TILE_A + lds_rc(wc * 64 + fr, fq), broff1 = TILE_A + lds_rc(wc * 64 + fr, 4 + fq);
#define G_ISSUE(kt) do { const char* ab_ = abase + (size_t)(kt) * 128; _Pragma("unroll") for (int i = 0; i < GLA; ++i) sa[i] = *(const i32x4*)(ab_ + aoff[i]); \
        _Pragma("unroll") for (int r = 0; r < 8; ++r) sb[r] = *(const f32x4*)(bl + (size_t)((kt) * 64 + r) * ldb); \
        __builtin_amdgcn_sched_barrier(0); } while (0)
#define G_WRITE(buf) do { char* sbase = shm + (buf) * STAGE; _Pragma("unroll") for (int i = 0; i < GLA; ++i) *(i32x4*)(sbase + awoff + i * 8192) = sa[i]; \
        _Pragma("unroll") for (int i = 0; i < 4; ++i) { i32x4 w; w[0] = (int)cvt_pk_bf16(sb[0][i], sb[1][i]); w[1] = (int)cvt_pk_bf16(sb[2][i], sb[3][i]); \
              w[2] = (int)cvt_pk_bf16(sb[4][i], sb[5][i]); w[3] = (int)cvt_pk_bf16(sb[6][i], sb[7][i]); *(i32x4*)(sbase + bwoff + i * 2048) = w; } } while (0)
        G_ISSUE(0); G_WRITE(0); if (nt > 1) G_ISSUE(1); __syncthreads();
        for (int t = 0; t < nt; ++t) {
            const int cur = t & 1; const bool w_ok = t + 1 < nt, i_ok = t + 2 < nt;
            char* wb_ = shm + (cur ^ 1) * STAGE; const char* ab2_ = abase + (size_t)(t + 2) * 128; const char* bl2_ = bl + (size_t)(t + 2) * 64 * ldb;
#define G_HOOK(g) do { if ((g) < GLA) { if (w_ok) *(i32x4*)(wb_ + awoff + (g) * 8192) = sa[(g)]; if (i_ok) sa[(g)] = *(const i32x4*)(ab2_ + aoff[(g)]); } \
            else if ((g) >= 8 && (g) < 12) { if (w_ok) { const int i = (g) - 8; i32x4 w; w[0] = (int)cvt_pk_bf16(sb[0][i], sb[1][i]); w[1] = (int)cvt_pk_bf16(sb[2][i], sb[3][i]); \
                  w[2] = (int)cvt_pk_bf16(sb[4][i], sb[5][i]); w[3] = (int)cvt_pk_bf16(sb[6][i], sb[7][i]); *(i32x4*)(wb_ + bwoff + i * 2048) = w; } } \
            else if ((g) >= 12) { if (i_ok) { const int r = ((g) - 12) * 2; sb[r] = *(const f32x4*)(bl2_ + (size_t)r * ldb); sb[r + 1] = *(const f32x4*)(bl2_ + (size_t)(r + 1) * ldb); } } } while (0)
            GEMM_KTILE(cur, G_HOOK);
#undef G_HOOK
            __syncthreads();
        }
#undef G_ISSUE
#undef G_WRITE
    }
    struct NoEpi { __device__ __forceinline__ void operator()(int) const {} };
    template <class AccT>
    static __device__ __forceinline__ void run_bt(char* shm, const char* abase, const unsigned (&aoff)[GLA], const char* bbase, const unsigned (&boff)[4], unsigned ldbt, const char* pf_in, int nt, AccT& acc) {
        run_bt_seg<1 << 20>(shm, abase, aoff, bbase, boff, ldbt, 0, pf_in, nt, acc, NoEpi());
    }
    template <int SEG, class AccT, class Epi>
    static __device__ __forceinline__ void run_bt_seg(char* shm, const char* abase, const unsigned (&aoff)[GLA], const char* bbase, const unsigned (&boff)[4], unsigned ldbt, size_t segstride, const char* pf_in, int nt, AccT& acc, Epi seg_epi) {
        const int tid = tid_opaque(), wid = tid >> 6, lane = tid & 63, wr = wid >> 2, wc = wid & 3, fr = lane & 15, fq = lane >> 4;
        i32x4 sa[GLA], sbt[4];
        const unsigned astr = 64u * DM_ * 2u, bstr = 64u * ldbt;
        const int awoff = lds_rc(tid >> 3, tid & 7);
        const int aroff0 = lds_rc(wr * (BM / 2) + fr, fq), aroff1 = lds_rc(wr * (BM / 2) + fr, 4 + fq);
        const int broff0 = TILE_A + lds_rc(wc * 64 + fr, fq), broff1 = TILE_A + lds_rc(wc * 64 + fr, 4 + fq);
#define T_ISSUE(kt) do { const char* ab_ = abase + (size_t)(kt) * 128 + aoff[0]; const char* bb_ = bbase + (size_t)((kt) / SEG) * segstride + (size_t)((kt) % SEG) * 128 + boff[0]; \
        _Pragma("unroll") for (int i = 0; i < GLA; ++i) sa[i] = *(const i32x4*)(ab_ + (size_t)i * astr); \
        _Pragma("unroll") for (int i = 0; i < 4; ++i) sbt[i] = *(const i32x4*)(bb_ + (size_t)i * bstr); \
        __builtin_amdgcn_sched_barrier(0); } while (0)
#define T_WRITE(buf) do { char* sbase = shm + (buf) * STAGE; _Pragma("unroll") for (int i = 0; i < GLA; ++i) *(i32x4*)(sbase + awoff + i * 8192) = sa[i]; \
        _Pragma("unroll") for (int i = 0; i < 4; ++i) *(i32x4*)(sbase + TILE_A + awoff + i * 8192) = sbt[i]; } while (0)
        const unsigned long long pf0 = (unsigned long long)pf_in;
        const unsigned long long pfu = ((unsigned long long)(unsigned)__builtin_amdgcn_readfirstlane((int)(pf0 >> 32)) << 32) | (unsigned)__builtin_amdgcn_readfirstlane((int)(unsigned)pf0);
        const char* pf = (const char*)pfu; const unsigned pfo = (unsigned)(pf0 - pfu);
        unsigned pfa = 0u, pfb = 0u;
        T_ISSUE(0); T_WRITE(0); if (nt > 1) T_ISSUE(1);
#if GEMM_L2PF
        if (nt > 2) pfa = *(const unsigned*)(pf + 2 * 128 + pfo);
#endif
        __syncthreads();
        for (int t = 0; t < nt; ++t) {
            const int cur = t & 1;
            const bool w_ok = t + 1 < nt, i_ok = t + 2 < nt;
            char* wb_ = shm + (cur ^ 1) * STAGE; const char* ab2_ = abase + (size_t)(t + 2) * 128 + aoff[0];
            const char* bb2_ = bbase + (size_t)((t + 2) / SEG) * segstride + (size_t)((t + 2) % SEG) * 128 + boff[0];
#define T_HOOK(g) do { if ((g) < GLA) { if (w_ok) *(i32x4*)(wb_ + awoff + (g) * 8192) = sa[(g)]; if (i_ok) sa[(g)] = *(const i32x4*)(ab2_ + (size_t)(g) * astr); } \
            else if ((g) < GLA + 4) { const int i = (g) - GLA; if (w_ok) *(i32x4*)(wb_ + TILE_A + awoff + i * 8192) = sbt[i]; if (i_ok) sbt[i] = *(const i32x4*)(bb2_ + (size_t)i * bstr); } } while (0)
#if GEMM_L2PF
            if (t + 3 < nt) pfb = *(const unsigned*)(pf + (size_t)(t + 3) * 128 + pfo);
            asm volatile("" :: "v"(pfa));
            pfa = pfb;
#endif
            GEMM_KTILE(cur, T_HOOK);
#undef T_HOOK
            __syncthreads();
            if ((t % SEG) == SEG - 1) seg_epi(t / SEG);
        }
#undef T_ISSUE
#undef T_WRITE
    }
    static __device__ __forceinline__ void bt_coord(int tid, int i, int& col, int& C) { const int R = (tid >> 3) + 64 * i; C = (tid & 7) * 8;
        col = (R & ~63) + 4 * (R & 15) + ((R >> 4) & 3); }
    static __device__ __forceinline__ void a_coord(int tid, int i, int& R, int& C) { R = (tid >> 3) + 64 * i; C = (tid & 7) * 8; }
    static __device__ __forceinline__ void b_coord(int tid, int& k, int& col, int& which) { const int wid = tid >> 6, lane = tid & 63; const int kq = lane & 3, ngl = lane >> 2, ksub = wid & 1, grp = wid >> 1;
        k = ksub * 32 + kq * 8; if (DUAL) { which = ngl >> 3; col = grp * 32 + 4 * (ngl & 7); } else { which = 0; col = grp * 64 + 4 * ngl; } }
};
#define PROJW 5632
__device__ __forceinline__ float sigmoidf_(float x) { return 1.0f / (1.0f + expf(-x)); }
__device__ __forceinline__ float siluf_(float x) { return x / (1.0f + expf(-x)); }
__device__ __forceinline__ float softplusf_(float x) { return x > 20.f ? x : log1pf(expf(x)); }
__device__ __forceinline__ float sigmoid_fast_(float x) { return __builtin_amdgcn_rcpf(1.0f + __expf(-x)); }
__device__ __forceinline__ float silu_fast_(float x) { return x * __builtin_amdgcn_rcpf(1.0f + __expf(-x)); }
__device__ __forceinline__ float softplus_fast_(float x) { const float e = __expf(x); const float sm = e * (1.0f - e * (0.5f - e * (1.0f / 3.0f))); return x > 15.f ? x : (e < 0.01f ? sm : __logf(1.0f + e)); }
__device__ __forceinline__ float gelu_tanh_(float x) { const float u2 = 1.5957691216057308f * (x + 0.044715f * x * x * x); return x * __builtin_amdgcn_rcpf(1.0f + __expf(-u2)); }

__device__ __forceinline__ float block_sum_256(float v, float* red) {
    for (int o = 32; o > 0; o >>= 1) v += __shfl_down(v, o, 64);
    __syncthreads();
    if ((tid_opaque() & 63) == 0) red[tid_opaque() >> 6] = v;
    __syncthreads();
    float r = red[0] + red[1] + red[2] + red[3];
    __syncthreads();
    return r;
}
__device__ __forceinline__ float block_max_256(float v, float* red) {
    for (int o = 32; o > 0; o >>= 1) v = fmaxf(v, __shfl_down(v, o, 64));
    __syncthreads();
    if ((tid_opaque() & 63) == 0) red[tid_opaque() >> 6] = v;
    __syncthreads();
    float r = fmaxf(fmaxf(red[0], red[1]), fmaxf(red[2], red[3]));
    __syncthreads();
    return r;
}

__device__ __forceinline__ int t5_bucket(int rel) {
    const int ret = rel > 0 ? 16 : 0; const int n = rel < 0 ? -rel : rel;
    if (n < 8) return ret + n;
    const float v = logf((float)n / 8.0f) / 2.772588722239781f * 8.0f;
    int large = 8 + (int)v; if (large > 15) large = 15;
    return ret + large;
}
struct AP { const bf16_t* proj; const bf16_t* vt; const float* rel_bias; const float* dlam; const float* subg; bf16_t* br; float lam_init; };
#define ATT_LDS (2 * 32768 + 2048)
__device__ __forceinline__ void phase_attn(char* shm, const AP& p) {
    float* btab = (float*)(shm + 65536);
    const float LOG2E = 1.4426950408889634f;
    for (int unit = bid_opaque(); unit < NB_ * 4 * 16; unit += grid_n()) {
        const int xq = unit & 7, sq = unit >> 3, bh = (xq * 2 + (sq >> 4)) & 15, qt = sq & 15, h = bh & 3, b = bh >> 2;
        const int tid = tid_opaque(), wid = tid >> 6, lane = tid & 63, fr = lane & 15, fq = lane >> 4;
        __syncthreads();
        if (tid < 257) btab[tid] = p.rel_bias[t5_bucket(tid - 128) * 4 + h] * LOG2E;
        float l0 = 0.f, l1 = 0.f;
        for (int d = 0; d < 64; ++d) { l0 += p.dlam[d] * p.dlam[64 + d]; l1 += p.dlam[128 + d] * p.dlam[192 + d]; }
        const float lam = expf(l0) - expf(l1) + p.lam_init;
        const int q0 = qt * 128, qrow = q0 + wid * 16 + fr;
        bf16x8 qf[2][2];
        { const bf16_t* qp = p.proj + (size_t)(b * SEQ_ + qrow) * PROJW + O_DA + h * 128 + fq * 8;
#pragma unroll
          for (int i = 0; i < 2; ++i)
#pragma unroll
            for (int s = 0; s < 2; ++s) qf[i][s] = *(const bf16x8*)(qp + i * 64 + s * 32); }
        const bf16_t* kg[2]; const bf16_t* vg[2]; int kl[2], vl[2]; bool vswap[2];
#pragma unroll
        for (int u = 0; u < 2; ++u) {
            const int c = tid + u * 512;
            const int krow = c >> 4, kch = c & 15;
            kg[u] = p.proj + (size_t)(b * SEQ_ + krow) * PROJW + O_DA + 512 + h * 128 + kch * 8;
            kl[u] = krow * 256 + ((kch ^ (krow & 15)) * 16);
            const int dv = c >> 3, ch16 = c & 7;
            vg[u] = p.vt + (size_t)(b * 512 + h * 128 + dv) * SEQ_ + ch16 * 8;
            vl[u] = 16384 + dv * 128 + ((ch16 ^ ((dv & 15) >> 1)) * 16); vswap[u] = dv & 1;
        }
        i32x4 sk[2], sv[2];
#define A_ISSUE(kt) do { _Pragma("unroll") for (int u = 0; u < 2; ++u) { sk[u] = *(const i32x4*)(kg[u] + (size_t)(kt) * 64 * PROJW); sv[u] = *(const i32x4*)(vg[u] + (kt) * 64); } } while (0)
#define A_WRITE(buf) do { char* sb_ = shm + (buf) * 32768; _Pragma("unroll") for (int u = 0; u < 2; ++u) { *(i32x4*)(sb_ + kl[u]) = sk[u]; \
            i32x4 w_ = sv[u]; if (vswap[u]) w_ = (i32x4){sv[u][2], sv[u][3], sv[u][0], sv[u][1]}; *(i32x4*)(sb_ + vl[u]) = w_; } } while (0)
        f32x4 O[2][8];
#pragma unroll
        for (int i = 0; i < 2; ++i)
#pragma unroll
            for (int f = 0; f < 8; ++f) O[i][f] = (f32x4){0.f, 0.f, 0.f, 0.f};
        float mrun[2] = {-1e30f, -1e30f}, lrun[2] = {0.f, 0.f};
        A_ISSUE(0); A_WRITE(0); A_ISSUE(1); __syncthreads();
        const int NT = SEQ_ / 64;
        for (int kt = 0; kt < NT; ++kt) {
            const int cur = kt & 1;
            if (kt + 1 < NT) A_WRITE(cur ^ 1);
            if (kt + 2 < NT) A_ISSUE(kt + 2);
            const char* sK = shm + cur * 32768; const char* sV = sK + 16384;
            f32x4 S[2][4];
#pragma unroll
            for (int i = 0; i < 2; ++i)
#pragma unroll
                for (int kf = 0; kf < 4; ++kf) {
                    f32x4 a = (f32x4){0.f, 0.f, 0.f, 0.f};
#pragma unroll
                    for (int s = 0; s < 2; ++s) {
                        const int row = kf * 16 + fr, ch = i * 8 + s * 4 + fq;
                        const bf16x8 kfA = *(const bf16x8*)(sK + row * 256 + ((ch ^ (row & 15)) * 16));
                        a = __builtin_amdgcn_mfma_f32_16x16x32_bf16(kfA, qf[i][s], a, 0, 0, 0);
                    }
                    S[i][kf] = a;
                }
            const int k0 = kt * 64;
            const bool far_hi = (k0 >= q0 + 127 + 128), far_lo = (k0 + 63 <= q0 - 128);
            const float c1 = 0.125f * LOG2E;
            if (far_hi || far_lo) {
                const float bc_ = far_hi ? btab[256] : btab[0];
#pragma unroll
                for (int i = 0; i < 2; ++i)
#pragma unroll
                    for (int kf = 0; kf < 4; ++kf)
#pragma unroll
                        for (int j = 0; j < 4; ++j) S[i][kf][j] = S[i][kf][j] * c1 + bc_;
            } else {
#pragma unroll
                for (int kf = 0; kf < 4; ++kf)
#pragma unroll
                    for (int j = 0; j < 4; ++j) {
                        int rel = (k0 + kf * 16 + fq * 4 + j) - qrow; rel = rel < -128 ? -128 : (rel > 128 ? 128 : rel);
                        const float bv_ = btab[rel + 128];
                        S[0][kf][j] = S[0][kf][j] * c1 + bv_; S[1][kf][j] = S[1][kf][j] * c1 + bv_;
                    }
            }
            bf16x8 Pf[2][2];
#pragma unroll
            for (int i = 0; i < 2; ++i) {
                float mx = S[i][0][0];
#pragma unroll
                for (int kf = 0; kf < 4; ++kf)
#pragma unroll
                    for (int j = 0; j < 4; ++j) mx = fmaxf(mx, S[i][kf][j]);
                mx = fmaxf(mx, __shfl_xor(mx, 16, 64)); mx = fmaxf(mx, __shfl_xor(mx, 32, 64));
                const float mnew = fmaxf(mrun[i], mx);
                const float alpha = __builtin_amdgcn_exp2f(mrun[i] - mnew);
                mrun[i] = mnew;
                float ps = 0.f;
#pragma unroll
                for (int kf = 0; kf < 4; ++kf)
#pragma unroll
                    for (int j = 0; j < 4; ++j) { const float e = __builtin_amdgcn_exp2f(S[i][kf][j] - mnew); S[i][kf][j] = e; ps += e; }
                ps += __shfl_xor(ps, 16, 64); ps += __shfl_xor(ps, 32, 64);
                lrun[i] = lrun[i] * alpha + ps;
                if (__any(alpha != 1.0f)) {
#pragma unroll
                    for (int f = 0; f < 8; ++f) { O[i][f][0] *= alpha; O[i][f][1] *= alpha; O[i][f][2] *= alpha; O[i][f][3] *= alpha; }
                }
#pragma unroll
                for (int g = 0; g < 2; ++g) {
                    i32x4 w;
                    w[0] = (int)cvt_pk_bf16(S[i][2 * g][0], S[i][2 * g][1]); w[1] = (int)cvt_pk_bf16(S[i][2 * g][2], S[i][2 * g][3]);
                    w[2] = (int)cvt_pk_bf16(S[i][2 * g + 1][0], S[i][2 * g + 1][1]); w[3] = (int)cvt_pk_bf16(S[i][2 * g + 1][2], S[i][2 * g + 1][3]);
                    Pf[i][g] = __builtin_bit_cast(bf16x8, w);
                }
            }
#pragma unroll
            for (int f = 0; f < 8; ++f)
#pragma unroll
                for (int g = 0; g < 2; ++g) {
                    const int dv = f * 16 + fr, x = dv & 15;
                    const uint2 v0 = *(const uint2*)(sV + dv * 128 + (((8 * g + fq) ^ x) * 8));
                    const uint2 v1 = *(const uint2*)(sV + dv * 128 + (((8 * g + 4 + fq) ^ x) * 8));
                    const i32x4 w = (i32x4){(int)v0.x, (int)v0.y, (int)v1.x, (int)v1.y};
                    const bf16x8 vA = __builtin_bit_cast(bf16x8, w);
                    O[0][f] = __builtin_amdgcn_mfma_f32_16x16x32_bf16(vA, Pf[0][g], O[0][f], 0, 0, 0);
                    O[1][f] = __builtin_amdgcn_mfma_f32_16x16x32_bf16(vA, Pf[1][g], O[1][f], 0, 0, 0);
                }
            __syncthreads();
        }
#undef A_ISSUE
#undef A_WRITE
        const float r0 = 1.0f / lrun[0], r1 = lam / lrun[1];
        float ss = 0.f;
#pragma unroll
        for (int f = 0; f < 8; ++f)
#pragma unroll
            for (int j = 0; j < 4; ++j) { const float o = O[0][f][j] * r0 - O[1][f][j] * r1; O[0][f][j] = o; ss += o * o; }
        ss += __shfl_xor(ss, 16, 64); ss += __shfl_xor(ss, 32, 64);
        const float rs = rsqrtf(ss * (1.0f / 128.0f) + 1e-5f) * (1.0f - p.lam_init);
        bf16_t* op = p.br + (size_t)(b * SEQ_ + qrow) * DM_ + 1024 + h * 128 + fq * 4;
#pragma unroll
        for (int f = 0; f < 8; ++f) {
            const f32x4 gv = *(const f32x4*)(p.subg + f * 16 + fq * 4);
            uint2 o; o.x = cvt_pk_bf16(O[0][f][0] * rs * gv[0], O[0][f][1] * rs * gv[1]); o.y = cvt_pk_bf16(O[0][f][2] * rs * gv[2], O[0][f][3] * rs * gv[3]);
            *(uint2*)(op + f * 16) = o;
        }
    }
}

#define HY_PPW 2112
#define HY_PADL 1040
#define HY_VLEN 4112
#define HY_LDS (HY_PPW * 4 + 4 * HY_VLEN * 2)
struct HP { const bf16_t* proj; const float* fr; const float* nrm; unsigned* pp; bf16_t* vvt; float* yt; const float* cw; const float* cb; const float* hbias; bf16_t* br; };

__device__ __forceinline__ void phase_hy_pp(const HP& p) {
    for (int idx = bid_opaque() * 512 + tid_opaque(); idx < 512 * HY_PPW; idx += grid_n() * 512) {
        const int c = idx / HY_PPW, u = idx - c * HY_PPW;
        const float inv = 1.0f / p.nrm[c];
        const int s0 = 2080 - u, s1 = 2080 - (u + 1);
        const float f0 = (s0 >= 0 && s0 < SEQ_) ? p.fr[(size_t)s0 * 512 + c] * inv : 0.f;
        const float f1 = (s1 >= 0 && s1 < SEQ_) ? p.fr[(size_t)s1 * 512 + c] * inv : 0.f;
        p.pp[idx] = cvt_pk_bf16(f0, f1);
    }
}
__device__ __forceinline__ void unpack8(const uint4 v, float (&f)[8]) {
    f[0] = __uint_as_float(v.x << 16); f[1] = __uint_as_float(v.x & 0xffff0000u); f[2] = __uint_as_float(v.y << 16); f[3] = __uint_as_float(v.y & 0xffff0000u);
    f[4] = __uint_as_float(v.z << 16); f[5] = __uint_as_float(v.z & 0xffff0000u); f[6] = __uint_as_float(v.w << 16); f[7] = __uint_as_float(v.w & 0xffff0000u);
}
__device__ __forceinline__ void phase_hy_prep(char* shm, const HP& p) {
    bf16_t* tile = (bf16_t*)shm;
    for (int unit = bid_opaque(); unit < NB_ * 32 * 8; unit += grid_n()) {
        const int ct = unit & 7, tt = (unit >> 3) & 31, b = unit >> 8;
        const int tid = tid_opaque(), tl = tid >> 3, c8 = (tid & 7) * 8, c = ct * 64 + c8, t = tt * 64 + tl;
        float s1[8], s2[8];
#pragma unroll
        for (int e = 0; e < 8; ++e) { s1[e] = p.cb[512 + c + e]; s2[e] = p.cb[1024 + c + e]; }
#pragma unroll
        for (int k = 0; k < 3; ++k) {
            const int t2 = t + k - 1;
            if (t2 >= 0 && t2 < SEQ_) {
                const bf16_t* pr = p.proj + (size_t)(b * SEQ_ + t2) * PROJW + O_HY + c;
                float x1[8], xv[8]; unpack8(*(const uint4*)(pr + 512), x1); unpack8(*(const uint4*)(pr + 1024), xv);
                const f32x4 wa = *(const f32x4*)(p.cw + k * 1536 + 512 + c), wb = *(const f32x4*)(p.cw + k * 1536 + 512 + c + 4);
                const f32x4 va = *(const f32x4*)(p.cw + k * 1536 + 1024 + c), vb = *(const f32x4*)(p.cw + k * 1536 + 1024 + c + 4);
#pragma unroll
                for (int e = 0; e < 4; ++e) { s1[e] += wa[e] * x1[e]; s1[e + 4] += wb[e] * x1[e + 4]; s2[e] += va[e] * xv[e]; s2[e + 4] += vb[e] * xv[e + 4]; }
            }
        }
        __syncthreads();
#pragma unroll
        for (int e = 0; e < 8; ++e) tile[(c8 + e) * 72 + tl] = f2bf(s1[e] * s2[e]);
        __syncthreads();
        { const int cl = tid >> 3, t8 = (tid & 7) * 8;
          *(uint4*)(p.vvt + ((size_t)(ct * 64 + cl) * NB_ + b) * SEQ_ + tt * 64 + t8) = *(const uint4*)(tile + cl * 72 + t8); }
    }
}
__device__ __forceinline__ void phase_hy_conv(char* shm, const HP& p) {
    unsigned* pps = (unsigned*)shm;
    bf16_t* vs = (bf16_t*)(shm + HY_PPW * 4);
    for (int c = bid_opaque(); c < 512; c += grid_n()) {
        const int tid = tid_opaque(), wid = tid >> 6, lane = tid & 63, fr = lane & 15, h = lane >> 4;
        __syncthreads();
        for (int i = tid; i < HY_PPW; i += 512) pps[i] = p.pp[(size_t)c * HY_PPW + i];
        for (int i = tid; i < 4 * (HY_VLEN / 8); i += 512) {
            const int b = i / (HY_VLEN / 8), ch = i - b * (HY_VLEN / 8), e0 = ch * 8 - HY_PADL;
            uint4 v = make_uint4(0u, 0u, 0u, 0u);
            if (e0 >= 0 && e0 < SEQ_) v = *(const uint4*)(p.vvt + ((size_t)c * NB_ + b) * SEQ_ + e0);
            *(uint4*)(vs + b * HY_VLEN + ch * 8) = v;
        }
        __syncthreads();
        const int b = wid >> 1, ib = (wid & 1) * 64;
        f32x4 acc[4];
#pragma unroll
        for (int f = 0; f < 4; ++f) acc[f] = (f32x4){0.f, 0.f, 0.f, 0.f};
        const int ua = 1056 - 16 * (h >> 1) - fr + 8 * (h & 1);
        const bf16_t* vb = vs + b * HY_VLEN + HY_PADL + 16 * (ib + fr - (h >> 1)) + 8 * (h & 1);
#define HY_LOAD(d0_, af_, bf_) do { const unsigned* ap_ = pps + (ua - 16 * (d0_)); const i32x4 aw_ = (i32x4){(int)ap_[0], (int)ap_[2], (int)ap_[4], (int)ap_[6]}; af_ = __builtin_bit_cast(bf16x8, aw_); \
        _Pragma("unroll") for (int f = 0; f < 4; ++f) bf_[f] = *(const bf16x8*)(vb + 16 * (16 * f - (d0_))); } while (0)
        bf16x8 afA, afB, bfA[4], bfB[4];
        HY_LOAD(-64, afA, bfA);
        for (int d0 = -64; d0 < 64; d0 += 4) {
            HY_LOAD(d0 + 2, afB, bfB);
            __builtin_amdgcn_sched_barrier(0);
#pragma unroll
            for (int f = 0; f < 4; ++f) acc[f] = __builtin_amdgcn_mfma_f32_16x16x32_bf16(afA, bfA[f], acc[f], 0, 0, 0);
            __builtin_amdgcn_sched_barrier(0);
            HY_LOAD(d0 + 4, afA, bfA);
            __builtin_amdgcn_sched_barrier(0);
#pragma unroll
            for (int f = 0; f < 4; ++f) acc[f] = __builtin_amdgcn_mfma_f32_16x16x32_bf16(afB, bfB[f], acc[f], 0, 0, 0);
            __builtin_amdgcn_sched_barrier(0);
        }
#pragma unroll
        for (int f = 0; f < 4; ++f) acc[f] = __builtin_amdgcn_mfma_f32_16x16x32_bf16(afA, bfA[f], acc[f], 0, 0, 0);
#undef HY_LOAD
        const float hb = p.hbias[c];
#pragma unroll
        for (int f = 0; f < 4; ++f) {
            const int t = 16 * (ib + 16 * f + fr) + 4 * h;
            const bf16_t* vv = vs + b * HY_VLEN + HY_PADL + t;
            f32x4 o; o[0] = acc[f][0] + bf2f(vv[0]) * hb; o[1] = acc[f][1] + bf2f(vv[1]) * hb; o[2] = acc[f][2] + bf2f(vv[2]) * hb; o[3] = acc[f][3] + bf2f(vv[3]) * hb;
            *(f32x4*)(p.yt + ((size_t)c * NB_ + b) * SEQ_ + t) = o;
        }
    }
}
__device__ __forceinline__ void phase_hy_fin(char* shm, const HP& p, int bw0, int bwn) {
    float* tile = (float*)shm;
    const int bq = bid_opaque() - bw0; if (bq < 0 || bq >= bwn) return;
    for (int unit = bq; unit < NB_ * 32 * 8; unit += bwn) {
        const int ct = unit & 7, tt = (unit >> 3) & 31, b = unit >> 8, tid = tid_opaque();
        __syncthreads();
        { const int cl = tid >> 3, t8 = (tid & 7) * 8; const float* src = p.yt + ((size_t)(ct * 64 + cl) * NB_ + b) * SEQ_ + tt * 64 + t8;
          const f32x4 a = *(const f32x4*)src, bq = *(const f32x4*)(src + 4);
#pragma unroll
          for (int q = 0; q < 4; ++q) { tile[cl * 65 + t8 + q] = a[q]; tile[cl * 65 + t8 + 4 + q] = bq[q]; } }
        __syncthreads();
        const int cl = tid & 63, c = ct * 64 + cl, tq = tid >> 6;
        float w0[3];
#pragma unroll
        for (int k = 0; k < 3; ++k) w0[k] = p.cw[k * 1536 + c];
        const float b0 = p.cb[c];
#pragma unroll
        for (int q = 0; q < 8; ++q) {
            const int tl = tq * 8 + q, t = tt * 64 + tl;
            float s = b0;
#pragma unroll
            for (int k = 0; k < 3; ++k) { const int t2 = t + k - 1; if (t2 >= 0 && t2 < SEQ_) s += w0[k] * bf2f(p.proj[(size_t)(b * SEQ_ + t2) * PROJW + O_HY + c]); }
            p.br[(size_t)(b * SEQ_ + t) * DM_ + c] = f2bf(tile[cl * 65 + tl] * s);
        }
    }
}
struct LP { const bf16_t* proj; const float* cw; const float* cb; const bf16_t* wt; const float* ba; const float* bx; const float* lam; float* sumP; float* sumE; bf16_t* br; };
#define LRU_LDS (32768 + 8192 + 64 * 65 * 4 + 2 * 64 * 65 * 4 + 2 * 2 * 16 * 64 * 4)
template <int PASS>
__device__ __forceinline__ void phase_lru(char* shm, const LP& p) {
    char* sW = shm;
    char* sXb = shm + 32768;
    float* X = (float*)(shm + 40960);
    float* H = X + 64 * 65;
    float* SP = H + 2 * 64 * 65;
    float* SE = SP + 2 * 16 * 64;
    for (int unit = bid_opaque(); unit < NB_ * 8 * 32; unit += grid_n()) {
        const int k = unit & 31, b = (unit >> 5) & 3, h = unit >> 7;
        const int tid = tid_opaque();
        __syncthreads();
        for (int i = tid; i < 256 * 8; i += 512) { const int row = i >> 3, ch = i & 7;
            *(uint4*)(sW + lds_rc(row, ch)) = *(const uint4*)(p.wt + ((size_t)h * 256 + row) * 64 + ch * 8); }
        { const int j = tid & 63, tq = tid >> 6, ch = h * 64 + j;
          float w4[4];
#pragma unroll
          for (int q = 0; q < 4; ++q) w4[q] = p.cw[q * 512 + ch];
          const float cbv = p.cb[ch];
#pragma unroll
          for (int q = 0; q < 8; ++q) {
              const int tl = tq * 8 + q, t = k * 64 + tl; float s = cbv;
#pragma unroll
              for (int kk = 0; kk < 4; ++kk) { const int t2 = t + kk - 2; if (t2 >= 0 && t2 < SEQ_) s += w4[kk] * bf2f(p.proj[(size_t)(b * SEQ_ + t2) * PROJW + O_LRU + ch]); }
              X[tl * 65 + j] = s;
              *(bf16_t*)(sXb + lds_rc(tl, j >> 3) + (j & 7) * 2) = f2bf(s);
          } }
        __syncthreads();
        const int wid = tid >> 6, lane = tid & 63, fr = lane & 15, fq = lane >> 4, dir = wid & 1, jf = wid >> 1, j = jf * 16 + fr, ch = h * 64 + j;
        f32x4 G[4][2];
        { const float bav = p.ba[dir * 512 + ch], bxv = p.bx[dir * 512 + ch];
#pragma unroll
          for (int tf = 0; tf < 4; ++tf) { G[tf][0] = (f32x4){bav, bav, bav, bav}; G[tf][1] = (f32x4){bxv, bxv, bxv, bxv}; } }
#pragma unroll
        for (int ks = 0; ks < 2; ++ks) {
            const bf16x8 wA = *(const bf16x8*)(sW + lds_rc((dir * 2 + 0) * 64 + j, ks * 4 + fq));
            const bf16x8 wX = *(const bf16x8*)(sW + lds_rc((dir * 2 + 1) * 64 + j, ks * 4 + fq));
#pragma unroll
            for (int tf = 0; tf < 4; ++tf) {
                const bf16x8 xa = *(const bf16x8*)(sXb + lds_rc(tf * 16 + fr, ks * 4 + fq));
                G[tf][0] = __builtin_amdgcn_mfma_f32_16x16x32_bf16(xa, wA, G[tf][0], 0, 0, 0);
                G[tf][1] = __builtin_amdgcn_mfma_f32_16x16x32_bf16(xa, wX, G[tf][1], 0, 0, 0);
            }
        }
        const float spl = softplus_fast_(-p.lam[dir * 512 + ch]);
        const int tfirst = dir ? (SEQ_ - 1) : 0;
#pragma unroll
        for (int tf = 0; tf < 4; ++tf) {
            float P = 1.f, E = 0.f;
#pragma unroll
            for (int qq = 0; qq < 4; ++qq) {
                const int q = dir ? 3 - qq : qq, tl = tf * 16 + fq * 4 + q, t = k * 64 + tl;
                const float r = sigmoid_fast_(G[tf][0][q]), ig = sigmoid_fast_(G[tf][1][q]);
                const float log_a = -8.0f * r * spl;
                const float x2 = 2.0f * log_a;
                const float om = x2 > -0.02f ? -x2 * (1.0f + x2 * (0.5f + x2 * (1.0f / 6.0f))) : 1.0f - __expf(x2);
                float mult = __builtin_amdgcn_sqrtf(om); if (t == tfirst) mult = 1.0f;
                const float av = __expf(log_a), bv = mult * ig * X[tl * 65 + j];
                G[tf][0][q] = av; G[tf][1][q] = bv;
                E = av * E + bv; P *= av;
            }
            SP[(dir * 16 + tf * 4 + fq) * 64 + j] = P; SE[(dir * 16 + tf * 4 + fq) * 64 + j] = E;
        }
        __syncthreads();
        const size_t sbase = ((size_t)(dir * NB_ + b) * 32) * 512 + ch;
        if (PASS == 0) {
            if (fq == 0) {
                float cP = 1.f, cE = 0.f;
                if (dir == 0) { for (int s = 0; s < 16; ++s) { cE = SP[s * 64 + j] * cE + SE[s * 64 + j]; cP *= SP[s * 64 + j]; } }
                else { for (int s = 15; s >= 0; --s) { cE = SP[(16 + s) * 64 + j] * cE + SE[(16 + s) * 64 + j]; cP *= SP[(16 + s) * 64 + j]; } }
                p.sumP[sbase + (size_t)k * 512] = cP; p.sumE[sbase + (size_t)k * 512] = cE;
            }
        } else {
            float c = 0.f;
            if (dir == 0) { for (int q = 0; q < k; ++q) c = p.sumP[sbase + (size_t)q * 512] * c + p.sumE[sbase + (size_t)q * 512]; }
            else { for (int q = 31; q > k; --q) c = p.sumP[sbase + (size_t)q * 512] * c + p.sumE[sbase + (size_t)q * 512]; }
            float cin[4];
            if (dir == 0) {
#pragma unroll
                for (int s = 0; s < 16; ++s) { if ((s & 3) == fq) cin[s >> 2] = c; c = SP[s * 64 + j] * c + SE[s * 64 + j]; }
            } else {
#pragma unroll
                for (int s = 15; s >= 0; --s) { if ((s & 3) == fq) cin[s >> 2] = c; c = SP[(16 + s) * 64 + j] * c + SE[(16 + s) * 64 + j]; }
            }
            float* Hd = H + dir * 64 * 65;
#pragma unroll
            for (int tf = 0; tf < 4; ++tf) {
                float cc = cin[tf];
#pragma unroll
                for (int qq = 0; qq < 4; ++qq) { const int q = dir ? 3 - qq : qq; cc = G[tf][0][q] * cc + G[tf][1][q]; Hd[(tf * 16 + fq * 4 + q) * 65 + j] = cc; }
            }
            __syncthreads();
            const int j2 = tid & 63, tq = tid >> 6, ch2 = h * 64 + j2;
#pragma unroll
            for (int q = 0; q < 8; ++q) {
                const int tl = tq * 8 + q; const size_t tok = (size_t)(b * SEQ_ + k * 64 + tl);
                const float g = bf2f(p.proj[tok * PROJW + O_LRU + 512 + ch2]);
                p.br[tok * DM_ + 512 + ch2] = f2bf((H[tl * 65 + j2] + H[64 * 65 + tl * 65 + j2]) * gelu_tanh_(g));
            }
        }
    }
}
struct SP_ { const bf16_t* proj; const float* dtraw; const float* cw; const float* cb; const float* dtb; const float* a_log; const float* dsk; const float* ng;
             bf16_t* xa; bf16_t* xT; float* states; float* decay; bf16_t* prev; bf16_t* br; };
#define SSD_Q 128
#define SSD_NC 16

__device__ __forceinline__ void phase_ssd_prep(char* shm, const SP_& p) {
    bf16_t* tile = (bf16_t*)shm;
    for (int unit = bid_opaque(); unit < NB_ * 32 * 16; unit += grid_n()) {
        const int ct = unit & 15, tt = (unit >> 4) & 31, b = unit >> 9;
        const int tid = tid_opaque(), tl = tid >> 3, c8 = (tid & 7) * 8, c = ct * 64 + c8, t = tt * 64 + tl;
        float s[8];
#pragma unroll
        for (int e = 0; e < 8; ++e) s[e] = p.cb[c + e];
#pragma unroll
        for (int k = 0; k < 4; ++k) {
            const int t2 = t + k - 2;
            if (t2 >= 0 && t2 < SEQ_) {
                float x[8]; unpack8(*(const uint4*)(p.proj + (size_t)(b * SEQ_ + t2) * PROJW + O_SSD + 512 + c), x);
                const f32x4 wa = *(const f32x4*)(p.cw + k * 1024 + c), wb = *(const f32x4*)(p.cw + k * 1024 + c + 4);
#pragma unroll
                for (int e = 0; e < 4; ++e) { s[e] += wa[e] * x[e]; s[e + 4] += wb[e] * x[e + 4]; }
            }
        }
        uint4 o; o.x = cvt_pk_bf16(silu_fast_(s[0]), silu_fast_(s[1])); o.y = cvt_pk_bf16(silu_fast_(s[2]), silu_fast_(s[3]));
        o.z = cvt_pk_bf16(silu_fast_(s[4]), silu_fast_(s[5])); o.w = cvt_pk_bf16(silu_fast_(s[6]), silu_fast_(s[7]));
        *(uint4*)(p.xa + (size_t)(b * SEQ_ + t) * 1024 + c) = o;
        __syncthreads();
        tile[(c8 + 0) * 72 + tl] = (bf16_t)(o.x & 0xffffu); tile[(c8 + 1) * 72 + tl] = (bf16_t)(o.x >> 16); tile[(c8 + 2) * 72 + tl] = (bf16_t)(o.y & 0xffffu); tile[(c8 + 3) * 72 + tl] = (bf16_t)(o.y >> 16);
        tile[(c8 + 4) * 72 + tl] = (bf16_t)(o.z & 0xffffu); tile[(c8 + 5) * 72 + tl] = (bf16_t)(o.z >> 16); tile[(c8 + 6) * 72 + tl] = (bf16_t)(o.w & 0xffffu); tile[(c8 + 7) * 72 + tl] = (bf16_t)(o.w >> 16);
        __syncthreads();
        { const int c2 = tid >> 3, t8 = (tid & 7) * 8;
          *(uint4*)(p.xT + ((size_t)b * 1024 + ct * 64 + c2) * SEQ_ + tt * 64 + t8) = *(const uint4*)(tile + c2 * 72 + t8); }
    }
}
__device__ __forceinline__ void ssd_tables(float* dtv, float* cum, const SP_& p, int b, int c, int g) {
    const int tid = tid_opaque();
    for (int i = tid; i < 8 * SSD_Q; i += 512) {
        const int l = i & 127, hd = i >> 7, dir = hd >> 2, j = hd & 3, h = g * 4 + j;
        dtv[i] = softplus_fast_(p.dtraw[(size_t)(b * SEQ_ + c * SSD_Q + l) * 16 + dir * 8 + h] + p.dtb[dir * 8 + h]);
    }
    __syncthreads();
    const int t8 = tid_opaque();
    if (t8 < 8) {
        const int dir = t8 >> 2, j = t8 & 3, h = g * 4 + j; const float a = -__expf(p.a_log[dir * 8 + h]);
        float s = 0.f;
        if (dir == 0) for (int l = 0; l < SSD_Q; ++l) { s += dtv[t8 * 128 + l] * a; cum[t8 * 128 + l] = s; }
        else for (int l = SSD_Q - 1; l >= 0; --l) { s += dtv[t8 * 128 + l] * a; cum[t8 * 128 + l] = s; }
    }
    __syncthreads();
}
#define SSD1_LDS (65536 + 32768 + 8192)
__device__ __forceinline__ void phase_ssd_states(char* shm, const SP_& p) {
    char* sX = shm;
    char* sB = shm + 65536;
    float* dtv = (float*)(shm + 98304); float* cum = dtv + 1024;
    for (int unit = bid_opaque(); unit < NB_ * SSD_NC * 2 * 2; unit += grid_n()) {
        const int hp = unit & 1, g = (unit >> 1) & 1, c = (unit >> 2) & 15, b = unit >> 6;
        const int tid = tid_opaque(), wid = tid >> 6, lane = tid & 63, fr = lane & 15, fq = lane >> 4;
        __syncthreads();
        for (int i = tid; i < 128 * 16; i += 512) { const int row = i >> 4, ch = i & 15;
            *(uint4*)(sX + row * 256 + ((ch ^ (row & 15)) * 16)) = *(const uint4*)(p.xT + ((size_t)b * 1024 + g * 256 + hp * 128 + row) * SEQ_ + c * SSD_Q + ch * 8); }
        for (int i = tid; i < 128 * 16; i += 512) { const int row = i >> 4, ch = i & 15;
            *(uint4*)(sB + row * 256 + ((ch ^ (row & 15)) * 16)) = *(const uint4*)(p.xT + ((size_t)b * 1024 + 512 + g * 128 + row) * SEQ_ + c * SSD_Q + ch * 8); }
        ssd_tables(dtv, cum, p, b, c, g);
        const int jj = wid >> 2, dir = (wid >> 1) & 1, nh = wid & 1, j = hp * 2 + jj, hd = dir * 4 + j, h = g * 4 + j;
        const float* dth = dtv + hd * 128; const float* cm = cum + hd * 128;
        const float cend = dir ? cm[0] : cm[SSD_Q - 1];
        f32x4 acc[4][4];
#pragma unroll
        for (int pf = 0; pf < 4; ++pf)
#pragma unroll
            for (int nf = 0; nf < 4; ++nf) acc[pf][nf] = (f32x4){0.f, 0.f, 0.f, 0.f};
#pragma unroll 1
        for (int ks = 0; ks < 4; ++ks) {
            float sc[8];
#pragma unroll
            for (int e = 0; e < 8; ++e) { const int l = ks * 32 + fq * 8 + e; sc[e] = dth[l] * __expf(cend - cm[l]); }
            bf16x8 af[4];
#pragma unroll
            for (int pf = 0; pf < 4; ++pf) {
                const int row = jj * 64 + pf * 16 + fr, ch = ks * 4 + fq;
                const i32x4 raw = *(const i32x4*)(sX + row * 256 + ((ch ^ (row & 15)) * 16));
                i32x4 o;
#pragma unroll
                for (int q = 0; q < 4; ++q) { const unsigned u = (unsigned)raw[q]; o[q] = (int)cvt_pk_bf16(__uint_as_float(u << 16) * sc[2 * q], __uint_as_float(u & 0xffff0000u) * sc[2 * q + 1]); }
                af[pf] = __builtin_bit_cast(bf16x8, o);
            }
#pragma unroll
            for (int nf = 0; nf < 4; ++nf) {
                const int row = nh * 64 + nf * 16 + fr, ch = ks * 4 + fq;
                const bf16x8 bfr = *(const bf16x8*)(sB + row * 256 + ((ch ^ (row & 15)) * 16));
#pragma unroll
                for (int pf = 0; pf < 4; ++pf) acc[pf][nf] = __builtin_amdgcn_mfma_f32_16x16x32_bf16(bfr, af[pf], acc[pf][nf], 0, 0, 0);
            }
        }
        float* st = p.states + ((((size_t)(b * SSD_NC + c) * 8 + h) * 2 + dir) * 64) * 128;
        float* rp = st + (size_t)fr * 128 + nh * 64 + fq * 4;
#pragma unroll
        for (int pf = 0; pf < 4; ++pf)
#pragma unroll
            for (int nf = 0; nf < 4; ++nf) *(f32x4*)(rp + pf * 16 * 128 + nf * 16) = acc[pf][nf];
        if (lane == 0 && nh == 0) p.decay[((b * SSD_NC + c) * 8 + h) * 2 + dir] = __expf(cend);
    }
}
__device__ __forceinline__ void phase_ssd_scan(const SP_& p) {
    for (int idx = bid_opaque() * 512 + tid_opaque(); idx < NB_ * 8 * 2 * 64 * 32; idx += grid_n() * 512) {
        const int n4 = idx & 31, pp = (idx >> 5) & 63, dir = (idx >> 11) & 1, h = (idx >> 12) & 7, b = idx >> 15;
        f32x4 s = (f32x4){0.f, 0.f, 0.f, 0.f};
#pragma unroll 1
        for (int half = 0; half < 2; ++half) {
            f32x4 st[8]; float dc[8];
#pragma unroll
            for (int q = 0; q < 8; ++q) {
                const int cc = half * 8 + q, c = dir ? (SSD_NC - 1 - cc) : cc;
                st[q] = *(const f32x4*)(p.states + ((((size_t)(b * SSD_NC + c) * 8 + h) * 2 + dir) * 64 + pp) * 128 + n4 * 4);
                dc[q] = p.decay[((b * SSD_NC + c) * 8 + h) * 2 + dir];
            }
#pragma unroll
            for (int q = 0; q < 8; ++q) {
                const int cc = half * 8 + q, c = dir ? (SSD_NC - 1 - cc) : cc;
                const size_t o = ((((size_t)(b * SSD_NC + c) * 8 + h) * 2 + dir) * 64 + pp) * 128 + n4 * 4;
                uint2 w; w.x = cvt_pk_bf16(s[0], s[1]); w.y = cvt_pk_bf16(s[2], s[3]);
                *(uint2*)(p.prev + o) = w;
                s = s * dc[q] + st[q];
            }
        }
    }
}
#define SSD3_LDS (32768 + 65536 + 32768 + 8192 + 512)
__device__ __forceinline__ void phase_ssd_out(char* shm, const SP_& p) {
    char* sB = shm;
    char* sX = shm + 32768;
    char* sC = shm + 98304;
    float* dtv = (float*)(shm + 131072); float* cum = dtv + 1024; float* ssx = cum + 1024;
    for (int unit = bid_opaque(); unit < NB_ * SSD_NC * 2 * 2; unit += grid_n()) {
        const int half_ = unit & 1, g = (unit >> 1) & 1, c = (unit >> 2) & 15, b = unit >> 6;
        const int tid = tid_opaque(), wid = tid >> 6, lane = tid & 63, fr = lane & 15, fq = lane >> 4;
        __syncthreads();
        for (int i = tid; i < 128 * 16; i += 512) { const int row = i >> 4, ch = i & 15; const bf16_t* src_ = p.xa + (size_t)(b * SEQ_ + c * SSD_Q + row) * 1024 + 512 + g * 128 + ch * 8;
            *(uint4*)(sB + row * 256 + ((ch ^ (row & 15)) * 16)) = *(const uint4*)src_;
            *(uint4*)(sC + row * 256 + ((ch ^ (row & 15)) * 16)) = *(const uint4*)(src_ + 256); }
        for (int i = tid; i < 256 * 16; i += 512) { const int row = i >> 4, ch = i & 15, x = row & 15;
            uint4 v = *(const uint4*)(p.xT + ((size_t)b * 1024 + g * 256 + row) * SEQ_ + c * SSD_Q + ch * 8);
            if (x & 1) v = make_uint4(v.z, v.w, v.x, v.y);
            *(uint4*)(sX + row * 256 + ((ch ^ (x >> 1)) * 16)) = v; }
        ssd_tables(dtv, cum, p, b, c, g);
        const int hp = wid >> 2, lrow = half_ * 64 + (wid & 3) * 16 + fr;
        const size_t tok = (size_t)(b * SEQ_ + c * SSD_Q + lrow);
#define SSD_CF(ks_) (*(const bf16x8*)(sC + lrow * 256 + ((((ks_) * 4 + fq) ^ (lrow & 15)) * 16)))
        f32x4 G[8];
#pragma unroll
        for (int sf = 0; sf < 8; ++sf) {
            f32x4 a = (f32x4){0.f, 0.f, 0.f, 0.f};
#pragma unroll
            for (int ks = 0; ks < 4; ++ks) {
                const int row = sf * 16 + fr, ch = ks * 4 + fq;
                const bf16x8 bfr = *(const bf16x8*)(sB + row * 256 + ((ch ^ (row & 15)) * 16));
                a = __builtin_amdgcn_mfma_f32_16x16x32_bf16(bfr, SSD_CF(ks), a, 0, 0, 0);
            }
            G[sf] = a;
        }
        f32x4 Y[2][4];
#pragma unroll
        for (int jj = 0; jj < 2; ++jj)
#pragma unroll
            for (int pf = 0; pf < 4; ++pf) Y[jj][pf] = (f32x4){0.f, 0.f, 0.f, 0.f};
#pragma unroll
        for (int jj = 0; jj < 2; ++jj) {
            const int j = hp * 2 + jj;
#pragma unroll 1
            for (int dir = 0; dir < 2; ++dir) {
                const int hd = dir * 4 + j, h = g * 4 + j;
                const float* dth = dtv + hd * 128; const float* cm = cum + hd * 128;
                const float cl = cm[lrow];
#pragma unroll
                for (int g2 = 0; g2 < 4; ++g2) {
                    float e[8];
#pragma unroll
                    for (int half = 0; half < 2; ++half)
#pragma unroll
                        for (int q = 0; q < 4; ++q) {
                            const int sf = 2 * g2 + half, s = sf * 16 + fq * 4 + q;
                            const bool keep = dir ? (s >= lrow) : (s <= lrow);
                            const float v = G[sf][q] * __expf(keep ? (cl - cm[s]) : 0.f) * dth[s];
                            e[half * 4 + q] = keep ? v : 0.f;
                        }
                    i32x4 w; w[0] = (int)cvt_pk_bf16(e[0], e[1]); w[1] = (int)cvt_pk_bf16(e[2], e[3]); w[2] = (int)cvt_pk_bf16(e[4], e[5]); w[3] = (int)cvt_pk_bf16(e[6], e[7]);
                    const bf16x8 Pf = __builtin_bit_cast(bf16x8, w);
#pragma unroll
                    for (int pf = 0; pf < 4; ++pf) {
                        const int row = j * 64 + pf * 16 + fr, x = row & 15;
                        const uint2 v0 = *(const uint2*)(sX + row * 256 + (((8 * g2 + fq) ^ x) * 8));
                        const uint2 v1 = *(const uint2*)(sX + row * 256 + (((8 * g2 + 4 + fq) ^ x) * 8));
                        const i32x4 wv = (i32x4){(int)v0.x, (int)v0.y, (int)v1.x, (int)v1.y};
                        Y[jj][pf] = __builtin_amdgcn_mfma_f32_16x16x32_bf16(__builtin_bit_cast(bf16x8, wv), Pf, Y[jj][pf], 0, 0, 0);
                    }
                    __builtin_amdgcn_sched_barrier(0);
                }
                const bf16_t* pv = p.prev + ((((size_t)(b * SSD_NC + c) * 8 + h) * 2 + dir) * 64) * 128;
                const float el = __expf(cl);
#pragma unroll
                for (int pf = 0; pf < 4; ++pf) {
                    f32x4 t = (f32x4){0.f, 0.f, 0.f, 0.f};
#pragma unroll
                    for (int ks = 0; ks < 4; ++ks) {
                        const bf16x8 pa = *(const bf16x8*)(pv + (size_t)(pf * 16 + fr) * 128 + ks * 32 + fq * 8);
                        t = __builtin_amdgcn_mfma_f32_16x16x32_bf16(pa, SSD_CF(ks), t, 0, 0, 0);
                    }
                    Y[jj][pf] += t * el;
                    __builtin_amdgcn_sched_barrier(0);
                }
            }
        }
        const int te = tid_opaque(); const int fqe = (te & 63) >> 4, wde = te >> 6, hpe = wde >> 2; const size_t toke = (size_t)(b * SEQ_ + c * SSD_Q + half_ * 64 + (wde & 3) * 16 + (te & 15));
        float ss = 0.f;
#pragma unroll
        for (int jj = 0; jj < 2; ++jj) {
            const float dk = p.dsk[g * 4 + hpe * 2 + jj];
#pragma unroll
            for (int pf = 0; pf < 4; ++pf) {
                const int cch = g * 256 + (hpe * 2 + jj) * 64 + pf * 16 + fqe * 4;
                const uint2 xv = *(const uint2*)(p.xa + toke * 1024 + cch);
                const uint2 zv = *(const uint2*)(p.proj + toke * PROJW + O_SSD + cch);
                const float xs[4] = {__uint_as_float(xv.x << 16), __uint_as_float(xv.x & 0xffff0000u), __uint_as_float(xv.y << 16), __uint_as_float(xv.y & 0xffff0000u)};
                const float zs[4] = {__uint_as_float(zv.x << 16), __uint_as_float(zv.x & 0xffff0000u), __uint_as_float(zv.y << 16), __uint_as_float(zv.y & 0xffff0000u)};
#pragma unroll
                for (int q = 0; q < 4; ++q) { const float y = (Y[jj][pf][q] + dk * xs[q]) * silu_fast_(zs[q]); Y[jj][pf][q] = y; ss += y * y; }
                __builtin_amdgcn_sched_barrier(0);
            }
        }
        ss += __shfl_xor(ss, 16, 64); ss += __shfl_xor(ss, 32, 64);
        if (fqe == 0) ssx[wde * 16 + (te & 15)] = ss;
        __syncthreads();
        ss += ssx[(wde ^ 4) * 16 + (te & 15)];
        const float rs = rsqrtf(ss * (1.0f / 256.0f) + 1e-6f);
#pragma unroll
        for (int jj = 0; jj < 2; ++jj)
#pragma unroll
            for (int pf = 0; pf < 4; ++pf) {
                const int cch = g * 256 + (hpe * 2 + jj) * 64 + pf * 16 + fqe * 4;
                const f32x4 gv = *(const f32x4*)(p.ng + cch);
                uint2 o; o.x = cvt_pk_bf16(Y[jj][pf][0] * rs * gv[0], Y[jj][pf][1] * rs * gv[1]); o.y = cvt_pk_bf16(Y[jj][pf][2] * rs * gv[2], Y[jj][pf][3] * rs * gv[3]);
                *(uint2*)(p.br + toke * DM_ + 1536 + cch) = o;
                __builtin_amdgcn_sched_barrier(0);
            }
    }
}
struct GP {
    const bf16_t* A; const bf16_t* Bt; const float* B; const float* B2; const float* bias; const float* R; float* Cf; bf16_t* Cb; bf16_t* Cb2; bf16_t* Vt; const bf16_t* G;
    const int* idx; const float* gate;
};
#ifndef GS_ROWS
#define GS_ROWS 8
#endif
__device__ __forceinline__ void static_order(int L, int nM, int nN, int& pm, int& pn) {
    const int nwg = nM * nN; int wgid = L;
    { const int q = nwg / 8, r = nwg % 8, xcd = wgid % 8, off = wgid / 8; wgid = (xcd < r ? xcd * (q + 1) : r * (q + 1) + (xcd - r) * q) + off; }
    const int nig = GS_ROWS * nN, gid = wgid / nig, fm = gid * GS_ROWS, gsz = (nM - fm) < GS_ROWS ? (nM - fm) : GS_ROWS;
    pm = fm + ((wgid % nig) % gsz); pn = (wgid % nig) / gsz;
}
#define LANE_IDS(t_) const int wid = (t_) >> 6, lane = (t_) & 63, wr = wid >> 2, wc = wid & 3, fr = lane & 15, fq = lane >> 4; (void)wr; (void)wc; (void)fr; (void)fq;
#define ZERO_ACC(acc, FM_) _Pragma("unroll") for (int m = 0; m < FM_; ++m) _Pragma("unroll") for (int n = 0; n < 4; ++n) acc[m][n] = (f32x4){0.f, 0.f, 0.f, 0.f}

__device__ __forceinline__ void phase_inproj(char* shm, const GP& p) {
    typedef GemmCore<256, false> G;
    for (int L = bid_opaque(); L < 32 * 54; L += grid_n()) {
        int pm, pn; static_order(L, 32, 54, pm, pn);
        const int col0 = pn < 22 ? pn * 256 : O_GATE + (pn - 22) * 256;
        f32x4 acc[8][4]; ZERO_ACC(acc, 8);
        {
            const int t0 = tid_opaque();
            unsigned aoff[G::GLA], boff[4];
#pragma unroll
            for (int i = 0; i < G::GLA; ++i) { int R, C; G::a_coord(t0, i, R, C); aoff[i] = (unsigned)((R * DM_ + C) * 2); }
#pragma unroll
            for (int i = 0; i < 4; ++i) { int cc, C; G::bt_coord(t0, i, cc, C); boff[i] = (unsigned)((cc * DM_ + C) * 2); }
            const char* pf = t0 < 256 ? (const char*)(p.A + (size_t)(pm * 256 + t0) * DM_) : (const char*)(p.Bt + (size_t)(pn * 256 + t0 - 256) * DM_);
            G::run_bt(shm, (const char*)(p.A + (size_t)pm * 256 * DM_), aoff, (const char*)(p.Bt + (size_t)pn * 256 * DM_), boff, DM_ * 2, pf, DM_ / 64, acc);
        }
        const int t1 = tid_opaque(); LANE_IDS(t1)
        const int cl = wc * 64 + 4 * fr;
        if (pn == 14 || pn == 15) {
            const int t0_ = pm * 256 + wr * 128 + fq * 4, bb = t0_ >> 11, tl = t0_ & (SEQ_ - 1);
            bf16_t* vp = p.Vt + (size_t)(bb * 512 + (pn - 14) * 256 + cl) * SEQ_ + tl;
#pragma unroll
            for (int m = 0; m < 8; ++m)
#pragma unroll
                for (int n = 0; n < 4; ++n) {
                    uint2 o; o.x = cvt_pk_bf16(acc[m][n][0], acc[m][n][1]); o.y = cvt_pk_bf16(acc[m][n][2], acc[m][n][3]);
                    *(uint2*)(vp + (size_t)n * SEQ_ + m * 16) = o;
                }
        } else if (pn < 22) {
#pragma unroll
            for (int m = 0; m < 8; ++m)
#pragma unroll
                for (int j = 0; j < 4; ++j) {
                    const int row = pm * 256 + wr * 128 + m * 16 + fq * 4 + j;
                    uint2 o; o.x = cvt_pk_bf16(acc[m][0][j], acc[m][1][j]); o.y = cvt_pk_bf16(acc[m][2][j], acc[m][3][j]);
                    *(uint2*)(p.Cb + (size_t)row * PROJW + pn * 256 + cl) = o;
                }
        } else {
            const int gc = (pn - 22) * 256 + cl;
            const f32x4 bg = *(const f32x4*)(p.bias + gc);
#pragma unroll
            for (int m = 0; m < 8; ++m)
#pragma unroll
                for (int j = 0; j < 4; ++j) {
                    const int row = pm * 256 + wr * 128 + m * 16 + fq * 4 + j;
                    uint2 o; o.x = cvt_pk_bf16(sigmoid_fast_(acc[m][0][j] + bg[0]), sigmoid_fast_(acc[m][1][j] + bg[1])); o.y = cvt_pk_bf16(sigmoid_fast_(acc[m][2][j] + bg[2]), sigmoid_fast_(acc[m][3][j] + bg[3]));
                    *(uint2*)(p.Cb2 + (size_t)row * 8192 + gc) = o;
                }
        }
    }
}
__device__ __forceinline__ void phase_merge(char* shm, const GP& p) {
    typedef GemmCore<128, false> G;
    for (int L = bid_opaque(); L < 64 * 8; L += grid_n()) {
        int pm, pn; static_order(L, 64, 8, pm, pn);
        f32x4 mg[4][4]; ZERO_ACC(mg, 4);
        f32x4 acc[4][4]; ZERO_ACC(acc, 4);
        {
            const int t0 = tid_opaque();
            unsigned aoff[G::GLA], boff[4];
#pragma unroll
            for (int i = 0; i < G::GLA; ++i) { int R, C; G::a_coord(t0, i, R, C); aoff[i] = (unsigned)((R * DM_ + C) * 2); }
#pragma unroll
            for (int i = 0; i < 4; ++i) { int cc, C; G::bt_coord(t0, i, cc, C); boff[i] = (unsigned)((cc * 512 + C) * 2); }
            const bf16_t* gates = p.G;
            auto seg_epi = [&acc, &mg, gates, pm, pn](int k) __attribute__((always_inline)) {
                const int t1 = tid_opaque(); LANE_IDS(t1)
                const bf16_t* gp = gates + (size_t)(pm * 128 + wr * 64 + fq * 4) * 8192 + k * DM_ + pn * 256 + wc * 64 + 4 * fr;
#pragma unroll
                for (int m = 0; m < 4; ++m) {
#pragma unroll
                    for (int j = 0; j < 4; ++j) {
                        const uint2 gv = *(const uint2*)(gp + (size_t)(m * 16 + j) * 8192);
                        mg[m][0][j] += __uint_as_float(gv.x << 16) * acc[m][0][j]; mg[m][1][j] += __uint_as_float(gv.x & 0xffff0000u) * acc[m][1][j];
                        mg[m][2][j] += __uint_as_float(gv.y << 16) * acc[m][2][j]; mg[m][3][j] += __uint_as_float(gv.y & 0xffff0000u) * acc[m][3][j];
                    }
#pragma unroll
                    for (int n = 0; n < 4; ++n) acc[m][n] = (f32x4){0.f, 0.f, 0.f, 0.f};
                    __builtin_amdgcn_sched_barrier(0);
                }
            };
            G::template run_bt_seg<8>(shm, (const char*)(p.A + (size_t)pm * 128 * DM_), aoff, (const char*)(p.Bt + (size_t)pn * 256 * 512), boff, 512 * 2, (size_t)DM_ * 512 * 2,
                                      (const char*)(p.A + (size_t)pm * 128 * DM_), 32, acc, seg_epi);
        }
        const int t2 = tid_opaque(); LANE_IDS(t2)
        bf16_t* op = p.Cb + (size_t)(pm * 128 + wr * 64 + fq * 4) * DM_ + pn * 256 + wc * 64 + 4 * fr;
#pragma unroll
        for (int m = 0; m < 4; ++m)
#pragma unroll
            for (int j = 0; j < 4; ++j) {
                uint2 o; o.x = cvt_pk_bf16(mg[m][0][j], mg[m][1][j]); o.y = cvt_pk_bf16(mg[m][2][j], mg[m][3][j]);
                *(uint2*)(op + (size_t)(m * 16 + j) * DM_) = o;
            }
    }
}
__device__ __forceinline__ void phase_outproj(char* shm, const GP& p) {
    typedef GemmCore<256, false> G;
    for (int L = bid_opaque(); L < 32 * 8; L += grid_n()) {
        int pm, pn; static_order(L, 32, 8, pm, pn);
        f32x4 acc[8][4]; ZERO_ACC(acc, 8);
        {
            const int t0 = tid_opaque();
            unsigned aoff[G::GLA], boff[4];
#pragma unroll
            for (int i = 0; i < G::GLA; ++i) { int R, C; G::a_coord(t0, i, R, C); aoff[i] = (unsigned)((R * DM_ + C) * 2); }
#pragma unroll
            for (int i = 0; i < 4; ++i) { int cc, C; G::bt_coord(t0, i, cc, C); boff[i] = (unsigned)((cc * DM_ + C) * 2); }
            const char* pf = t0 < 256 ? (const char*)(p.A + (size_t)(pm * 256 + t0) * DM_) : (const char*)(p.Bt + (size_t)(pn * 256 + t0 - 256) * DM_);
            G::run_bt(shm, (const char*)(p.A + (size_t)pm * 256 * DM_), aoff, (const char*)(p.Bt + (size_t)pn * 256 * DM_), boff, DM_ * 2, pf, DM_ / 64, acc);
        }
        const int t1 = tid_opaque(); LANE_IDS(t1)
        const size_t o0 = (size_t)(pm * 256 + wr * 128 + fq * 4) * DM_ + pn * 256 + wc * 64 + 4 * fr;
#pragma unroll
        for (int m = 0; m < 8; ++m)
#pragma unroll
            for (int j = 0; j < 4; ++j) {
                const size_t o = o0 + (size_t)(m * 16 + j) * DM_;
                const f32x4 r = *(const f32x4*)(p.R + o);
                *(f32x4*)(p.Cf + o) = (f32x4){r[0] + acc[m][0][j], r[1] + acc[m][1][j], r[2] + acc[m][2][j], r[3] + acc[m][3][j]};
            }
    }
}
__device__ __forceinline__ void phase_moe_up(char* shm, const GP& p) {
    typedef GemmCore<256, true> G;
    for (int L = bid_opaque(); L < 64 * 16; L += grid_n()) {
        const int xcd = L & 7, wg = xcd * 128 + (L >> 3), b = wg & 3, pair = wg >> 2, e = pair >> 4, nt = pair & 15, z = b * 16 + e;
        f32x4 acc[8][4]; ZERO_ACC(acc, 8);
        {
            const int t0 = tid_opaque(); int bk, bc, bw; G::b_coord(t0, bk, bc, bw);
            unsigned aoff[G::GLA];
#pragma unroll
            for (int i = 0; i < G::GLA; ++i) { int R, C; G::a_coord(t0, i, R, C); aoff[i] = (unsigned)(((b * SEQ_ + p.idx[z * 256 + R]) * DM_ + C) * 2); }
            const float* wsel = bw ? p.B2 : p.B;
            G::run(shm, (const char*)p.A, aoff, (const char*)(wsel + (size_t)e * DM_ * DM_ + (size_t)bk * DM_ + nt * 128 + bc), DM_ * 4, DM_ / 64, acc);
        }
        const int t1 = tid_opaque(); LANE_IDS(t1)
        const int hi = (fr >> 3) & 1;
        bf16_t* op = p.Cb + (size_t)(z * 256 + wr * 128 + fq * 4) * DM_ + nt * 128 + wc * 32 + 4 * (fr & 7);
#pragma unroll
        for (int mm = 0; mm < 4; ++mm)
#pragma unroll
            for (int j = 0; j < 4; ++j) {
                float a[4], g[4];
#pragma unroll
                for (int n = 0; n < 4; ++n) {
                    const float lo = acc[mm][n][j], hv = acc[mm + 4][n][j];
                    const float send = hi ? lo : hv;
                    const float recv = __shfl_xor(send, 8, 64);
                    a[n] = hi ? recv : lo;
                    g[n] = hi ? hv : recv;
                }
                uint2 o; o.x = cvt_pk_bf16(silu_fast_(a[0]) * g[0], silu_fast_(a[1]) * g[1]); o.y = cvt_pk_bf16(silu_fast_(a[2]) * g[2], silu_fast_(a[3]) * g[3]);
                *(uint2*)(op + (size_t)((mm + 4 * hi) * 16 + j) * DM_) = o;
            }
    }
}
__device__ __forceinline__ void phase_moe_down(char* shm, const GP& p) {
    typedef GemmCore<256, false> G;
    for (int L = bid_opaque(); L < 64 * 8; L += grid_n()) {
        const int xcd = L & 7, wg = xcd * 64 + (L >> 3), b = wg & 3, pair = wg >> 2, e = pair >> 3, nt = pair & 7, z = b * 16 + e;
        f32x4 acc[8][4]; ZERO_ACC(acc, 8);
        {
            const int t0 = tid_opaque(); int bk, bc, bw; G::b_coord(t0, bk, bc, bw);
            unsigned aoff[G::GLA];
#pragma unroll
            for (int i = 0; i < G::GLA; ++i) { int R, C; G::a_coord(t0, i, R, C); aoff[i] = (unsigned)((R * DM_ + C) * 2); }
            G::run(shm, (const char*)(p.A + (size_t)z * 256 * DM_), aoff, (const char*)(p.B + (size_t)e * DM_ * DM_ + (size_t)bk * DM_ + nt * 256 + bc), DM_ * 4, DM_ / 64, acc);
        }
        const int t1 = tid_opaque(); LANE_IDS(t1)
        const int row0 = z * 256 + wr * 128 + fq * 4;
        bf16_t* op = p.Cb + (size_t)row0 * DM_ + nt * 256 + wc * 64 + 4 * fr;
#pragma unroll
        for (int m = 0; m < 8; ++m)
#pragma unroll
            for (int j = 0; j < 4; ++j) {
                const float gt = p.gate[row0 + m * 16 + j];
                uint2 o; o.x = cvt_pk_bf16(gt * acc[m][0][j], gt * acc[m][1][j]); o.y = cvt_pk_bf16(gt * acc[m][2][j], gt * acc[m][3][j]);
                *(uint2*)(op + (size_t)(m * 16 + j) * DM_) = o;
            }
    }
}

namespace pg8 {
#define PG8_LAS __attribute__((address_space(3)))
constexpr int BM = 256, BK = 64, HALF = 128, HTB = HALF * BK * 2  , STAGE_BYTES = 8 * HTB;
__device__ __forceinline__ int lds_byte(int r, int c) { const int st = (r >> 4) * 2 + (c >> 5), rr = r & 15, cc = c & 31, ob = rr * 64 + cc * 2; return st * 1024 + (ob ^ (((ob >> 9) & 1) << 5)); }
__device__ __forceinline__ void stage_rc(int b, int& R, int& C) { const int st = b / 1024, sb = b % 1024, swz = sb ^ (((sb >> 9) & 1) << 5); R = (st >> 1) * 16 + swz / 64; C = (st & 1) * 32 + (swz % 64) / 2; }
__device__ __forceinline__ int perm32(int rho) { const int n = rho >> 4, i = rho & 15; return 8 * (i >> 2) + 4 * n + (i & 3); }
struct Unit { int pm, pn, kz; };
struct Gemm { const bf16_t* A; const bf16_t* Bt; int M, N, K, lda, ldb; };
struct MegaOrder {
    int nM, nN, G, c;
    __device__ __forceinline__ bool next(int i, Unit& u) const { const int L = i * G + c; if (L >= nM * nN) return false; int pm, pn; static_order(L, nM, nN, pm, pn); u.pm = pm; u.pn = pn; u.kz = 0; return true; }
    __device__ __forceinline__ void base(const Gemm& g, const Unit& u, const char*& a, const char*& b) const { a = (const char*)g.A + (size_t)u.pm * BM * g.lda * 2; b = (const char*)g.Bt + (size_t)u.pn * BM * g.ldb * 2; }
    __device__ __forceinline__ void a_ready(const Unit&) const {}
    __device__ __forceinline__ void done(const Unit&) const {}
};
__device__ __forceinline__ uint4 pack8_bf16(const f32x4& a, const f32x4& b) { return make_uint4(cvt_pk_bf16(a[0], a[1]), cvt_pk_bf16(a[2], a[3]), cvt_pk_bf16(b[0], b[1]), cvt_pk_bf16(b[2], b[3])); }
struct EpiInproj {
    static constexpr bool PERM = true, AFTER_DRAIN = false;
    bf16_t* proj; bf16_t* gates; bf16_t* vt; const float* bgate;
    __device__ __forceinline__ void operator()(const f32x4 (&acc)[2][2][4][2], const Unit& u, int wr, int wc, int fr, int fq) const {
        const int row0 = u.pm * BM + wr * 64 + fr, cb = wc * 32 + 8 * fq;
        if (u.pn == 14 || u.pn == 15) {
            const int bb = row0 >> 11;
#pragma unroll
            for (int ai = 0; ai < 2; ++ai)
#pragma unroll
                for (int m = 0; m < 4; ++m) { const int t = (row0 + ai * HALF + m * 16) & (SEQ_ - 1);
#pragma unroll
                    for (int bj = 0; bj < 2; ++bj)
#pragma unroll
                        for (int n = 0; n < 2; ++n)
#pragma unroll
                            for (int e = 0; e < 4; ++e) vt[(size_t)(bb * 512 + (u.pn - 14) * 256 + bj * HALF + cb + 4 * n + e) * SEQ_ + t] = f2bf(acc[ai][bj][m][n][e]); }
        } else if (u.pn < 22) {
#pragma unroll
            for (int ai = 0; ai < 2; ++ai)
#pragma unroll
                for (int m = 0; m < 4; ++m) { bf16_t* rowp = proj + (size_t)(row0 + ai * HALF + m * 16) * PROJW + u.pn * BM + cb;
#pragma unroll
                    for (int bj = 0; bj < 2; ++bj) *(uint4*)(rowp + bj * HALF) = pack8_bf16(acc[ai][bj][m][0], acc[ai][bj][m][1]); }
        } else {
            const int gc = (u.pn - 22) * BM + cb;
            f32x4 bv[2][2];
#pragma unroll
            for (int bj = 0; bj < 2; ++bj) { bv[bj][0] = *(const f32x4*)(bgate + gc + bj * HALF); bv[bj][1] = *(const f32x4*)(bgate + gc + bj * HALF + 4); }
#pragma unroll
            for (int ai = 0; ai < 2; ++ai)
#pragma unroll
                for (int m = 0; m < 4; ++m) { bf16_t* rowp = gates + (size_t)(row0 + ai * HALF + m * 16) * 8192 + gc;
#pragma unroll
                    for (int bj = 0; bj < 2; ++bj) { f32x4 v0 = acc[ai][bj][m][0] + bv[bj][0], v1 = acc[ai][bj][m][1] + bv[bj][1];
#pragma unroll
                        for (int e = 0; e < 4; ++e) { v0[e] = sigmoid_fast_(v0[e]); v1[e] = sigmoid_fast_(v1[e]); }
                        *(uint4*)(rowp + bj * HALF) = pack8_bf16(v0, v1); } }
        }
    }
};
struct EpiOutproj {
    static constexpr bool PERM = false, AFTER_DRAIN = false;
    const float* R; float* C;
    __device__ __forceinline__ void operator()(const f32x4 (&acc)[2][2][4][2], const Unit& u, int wr, int wc, int fr, int fq) const {
        const int row0 = u.pm * BM + wr * 64 + fr, col0 = u.pn * BM + wc * 32 + 4 * fq;
#pragma unroll
        for (int ai = 0; ai < 2; ++ai)
#pragma unroll
            for (int m = 0; m < 4; ++m) { const size_t ro = (size_t)(row0 + ai * HALF + m * 16) * DM_ + col0;
#pragma unroll
                for (int bj = 0; bj < 2; ++bj)
#pragma unroll
                    for (int n = 0; n < 2; ++n) { const size_t o = ro + bj * HALF + n * 16; *(f32x4*)(C + o) = *(const f32x4*)(R + o) + acc[ai][bj][m][n]; } }
    }
};
struct MergeOrder {
    int G, c;
    __device__ __forceinline__ bool next(int i, Unit& u) const { const int L = (i >> 2) * G + c; if (L >= 32 * 8) return false; int pm, pn; static_order(L, 32, 8, pm, pn); u.pm = pm; u.pn = pn; u.kz = i & 3; return true; }
    __device__ __forceinline__ void base(const Gemm& g, const Unit& u, const char*& a, const char*& b) const {
        a = (const char*)g.A + ((size_t)u.pm * BM * DM_ + u.kz * 512) * 2; b = (const char*)g.Bt + ((size_t)u.kz * DM_ + u.pn * BM) * 512 * 2; }
    __device__ __forceinline__ void a_ready(const Unit&) const {}
    __device__ __forceinline__ void done(const Unit&) const {}
};
struct EpiMerge {
    static constexpr bool PERM = true, AFTER_DRAIN = false;
    const bf16_t* gates; float* m32; bf16_t* out;
    __device__ __forceinline__ void operator()(const f32x4 (&acc)[2][2][4][2], const Unit& u, int wr, int wc, int fr, int fq) const {
        const int row0 = u.pm * BM + wr * 64 + fr, col0 = u.pn * BM + wc * 32 + 8 * fq;
#pragma unroll
        for (int ai = 0; ai < 2; ++ai)
#pragma unroll
            for (int m = 0; m < 4; ++m) {
                const size_t row = (size_t)(row0 + ai * HALF + m * 16);
#pragma unroll
                for (int bj = 0; bj < 2; ++bj) {
                    const int col = col0 + bj * HALF;
                    const uint4 gv = *(const uint4*)(gates + row * 8192 + u.kz * DM_ + col);
                    f32x4 v0 = acc[ai][bj][m][0], v1 = acc[ai][bj][m][1];
                    v0[0] *= __uint_as_float(gv.x << 16); v0[1] *= __uint_as_float(gv.x & 0xffff0000u); v0[2] *= __uint_as_float(gv.y << 16); v0[3] *= __uint_as_float(gv.y & 0xffff0000u);
                    v1[0] *= __uint_as_float(gv.z << 16); v1[1] *= __uint_as_float(gv.z & 0xffff0000u); v1[2] *= __uint_as_float(gv.w << 16); v1[3] *= __uint_as_float(gv.w & 0xffff0000u);
                    float* mp = m32 + row * DM_ + col;
                    if (u.kz > 0) { v0 += *(const f32x4*)mp; v1 += *(const f32x4*)(mp + 4); }
                    if (u.kz < 3) { *(f32x4*)mp = v0; *(f32x4*)(mp + 4) = v1; }
                    else *(uint4*)(out + row * DM_ + col) = pack8_bf16(v0, v1);
                }
            }
    }
};
template <class Epi, class Sched, bool STAMP = false>
__device__ __forceinline__ void gemm_phase(PG8_LAS unsigned char* lds, const Gemm g, const Sched& S, const Epi& E, unsigned long long* stamps) {
    const int tid = tid_opaque(), wid = __builtin_amdgcn_readfirstlane(tid >> 6), lane = tid & 63, wr = wid >> 2, wc = wid & 3, fr = lane & 15, fq = lane >> 4;
    const int K = g.K, nt = K / BK;
    int ts_lo = 0, ts_hi = 0, nts = 0; const unsigned long long rt_entry = STAMP ? (unsigned long long)wall_clock64() : 0ull;
#define PG8_STAMP() do { if (STAMP && wid == 0 && nts < 64) { const unsigned long long _c = (unsigned long long)clock64(); \
        ts_lo = (lane == nts) ? (int)(unsigned)_c : ts_lo; ts_hi = (lane == nts) ? (int)(unsigned)(_c >> 32) : ts_hi; ++nts; } } while (0)
    PG8_STAMP();
    unsigned voffA[2], voffB[2];
#pragma unroll
    for (int i = 0; i < 2; ++i) { int R, C; stage_rc(tid * 16 + i * 8192, R, C); const int Rb = Epi::PERM ? ((R & ~31) + perm32(R & 31)) : R;
        voffA[i] = (unsigned)(R * g.lda + C) * 2u; voffB[i] = (unsigned)(Rb * g.ldb + C) * 2u; }
    const size_t kstep = (size_t)(BK * 2);
    const size_t hstepA = (size_t)HALF * g.lda * 2, hstepB = (size_t)HALF * g.ldb * 2;
    const unsigned ldsw = (unsigned)wid * 1024u;
    const int aoff = lds_byte(wr * 64 + fr, fq * 8), boff = lds_byte(wc * 32 + fr, fq * 8);
#define PG8_SA(b, h) (((b) * 2 + (h)) * HTB)
#define PG8_SB(b, h) ((4 + (b) * 2 + (h)) * HTB)
#define PG8_STAGE(bufoff, gbase, voff) do { _Pragma("unroll") for (int _i = 0; _i < 2; ++_i) \
        __builtin_amdgcn_global_load_lds((const unsigned*)((const char*)(gbase) + (voff)[_i]), (PG8_LAS unsigned*)(lds + (bufoff) + ldsw + _i * 8192), 16, 0, 0); } while (0)
#define PG8_LDA(dst, b, h) do { _Pragma("unroll") for (int m = 0; m < 4; ++m) _Pragma("unroll") for (int k = 0; k < 2; ++k) dst[m][k] = *(const PG8_LAS bf16x8*)(lds + PG8_SA(b, h) + aoff + m * 2048 + k * 1024); } while (0)
#define PG8_LDB(dst, b, h) do { _Pragma("unroll") for (int n = 0; n < 2; ++n) _Pragma("unroll") for (int k = 0; k < 2; ++k) dst[n][k] = *(const PG8_LAS bf16x8*)(lds + PG8_SB(b, h) + boff + n * 2048 + k * 1024); } while (0)
#define PG8_MMA(ai, bj, At, Bt) do { __builtin_amdgcn_s_setprio(1); _Pragma("unroll") for (int m = 0; m < 4; ++m) _Pragma("unroll") for (int n = 0; n < 2; ++n) _Pragma("unroll") for (int k = 0; k < 2; ++k) \
        acc[ai][bj][m][n] = __builtin_amdgcn_mfma_f32_16x16x32_bf16(Bt[n][k], At[m][k], acc[ai][bj][m][n], 0, 0, 0); __builtin_amdgcn_s_setprio(0); } while (0)
#define PG8_WAIT_V(n) asm volatile("s_waitcnt vmcnt(" #n ")" ::: "memory")
#define PG8_WAIT_L(n) asm volatile("s_waitcnt lgkmcnt(" #n ")" ::: "memory")
#define PG8_BAR __builtin_amdgcn_s_barrier()
#define PG8_SCHED __builtin_amdgcn_sched_barrier(0)
    Unit cur, nxt; int ui = 0;
    if (!S.next(0, cur)) return;
    f32x4 acc[2][2][4][2];
#pragma unroll
    for (int a = 0; a < 2; ++a)
#pragma unroll
        for (int b = 0; b < 2; ++b)
#pragma unroll
            for (int m = 0; m < 4; ++m)
#pragma unroll
                for (int n = 0; n < 2; ++n) acc[a][b][m][n] = (f32x4){0.f, 0.f, 0.f, 0.f};
    bf16x8 At[4][2], B0[2][2], B1[2][2];
    const char* cA; const char* cB; S.base(g, cur, cA, cB);
    S.a_ready(cur);
    PG8_STAGE(PG8_SB(0, 0), cB, voffB); PG8_STAGE(PG8_SA(0, 0), cA, voffA); PG8_STAGE(PG8_SB(0, 1), cB + hstepB, voffB); PG8_STAGE(PG8_SA(0, 1), cA + hstepA, voffA);
    if (wr == 1) PG8_BAR;
    PG8_WAIT_V(4); PG8_BAR;
    PG8_STAGE(PG8_SB(1, 0), cB + kstep, voffB); PG8_STAGE(PG8_SA(1, 0), cA + kstep, voffA); PG8_STAGE(PG8_SB(1, 1), cB + hstepB + kstep, voffB);
    PG8_WAIT_V(6); PG8_BAR;
    PG8_STAMP();
    for (;;) {
        const bool has_next = S.next(ui + 1, nxt);
        const char* nA = cA; const char* nB = cB; if (has_next) S.base(g, nxt, nA, nB);
        for (int t = 0; t < nt; t += 2) {
            const bool last = (t == nt - 2);
            const char* a1 = cA + (size_t)(t + 1) * kstep;
            const char* a2 = last ? nA : cA + (size_t)(t + 2) * kstep; const char* b2 = last ? nB : cB + (size_t)(t + 2) * kstep;
            const char* a3 = a2 + kstep; const char* b3 = b2 + kstep;
            if (last && has_next) S.a_ready(nxt);
            PG8_LDB(B0, 0, 0); PG8_SCHED; PG8_LDA(At, 0, 0); PG8_STAGE(PG8_SA(1, 1), a1 + hstepA, voffA);
            PG8_WAIT_L(8); PG8_BAR; PG8_WAIT_L(0); PG8_MMA(0, 0, At, B0); PG8_BAR; PG8_SCHED;
            PG8_LDB(B1, 0, 1); PG8_STAGE(PG8_SB(0, 0), b2, voffB);
            PG8_BAR; PG8_WAIT_L(0); PG8_MMA(0, 1, At, B1); PG8_BAR;
            PG8_LDA(At, 0, 1); PG8_STAGE(PG8_SA(0, 0), a2, voffA);
            PG8_BAR; PG8_WAIT_L(0); PG8_MMA(1, 0, At, B0); PG8_BAR; PG8_SCHED;
            PG8_STAGE(PG8_SB(0, 1), b2 + hstepB, voffB);
            PG8_WAIT_V(6); PG8_BAR; PG8_MMA(1, 1, At, B1); PG8_BAR;
            PG8_LDB(B0, 1, 0); PG8_SCHED; PG8_LDA(At, 1, 0); PG8_STAGE(PG8_SA(0, 1), a2 + hstepA, voffA);
            PG8_WAIT_L(8); PG8_BAR; PG8_WAIT_L(0); PG8_MMA(0, 0, At, B0); PG8_BAR; PG8_SCHED;
            PG8_LDB(B1, 1, 1); PG8_STAGE(PG8_SB(1, 0), b3, voffB);
            PG8_BAR; PG8_WAIT_L(0); PG8_MMA(0, 1, At, B1); PG8_BAR;
            PG8_LDA(At, 1, 1); PG8_STAGE(PG8_SA(1, 0), a3, voffA);
            PG8_BAR; PG8_WAIT_L(0); PG8_MMA(1, 0, At, B0); PG8_BAR; PG8_SCHED;
            PG8_STAGE(PG8_SB(1, 1), b3 + hstepB, voffB);
            PG8_WAIT_V(6); PG8_BAR; PG8_MMA(1, 1, At, B1); PG8_BAR;
        }
        PG8_STAMP();
        if constexpr (!Epi::AFTER_DRAIN) { E(acc, cur, wr, wc, fr, fq); S.done(cur); }
        PG8_STAMP();
        if (!has_next) break;
#pragma unroll
        for (int a = 0; a < 2; ++a)
#pragma unroll
            for (int b = 0; b < 2; ++b)
#pragma unroll
                for (int m = 0; m < 4; ++m)
#pragma unroll
                    for (int n = 0; n < 2; ++n) acc[a][b][m][n] = (f32x4){0.f, 0.f, 0.f, 0.f};
        cur = nxt; cA = nA; cB = nB; ++ui;
    }
    PG8_WAIT_V(0);
    if (wr == 0) PG8_BAR;
    PG8_BAR;
    if constexpr (Epi::AFTER_DRAIN) { E.fused(acc, cur, wr, wc, fr, fq, lds, wid, lane); S.done(cur); }
    PG8_STAMP();
    if (STAMP && wid == 0) { stamps[lane] = lane < nts ? (((unsigned long long)(unsigned)ts_hi << 32) | (unsigned)ts_lo) : 0ull;
        if (lane == 62) stamps[62] = rt_entry; if (lane == 63) stamps[63] = (unsigned long long)wall_clock64(); }
#undef PG8_STAMP
#undef PG8_SA
#undef PG8_SB
#undef PG8_STAGE
#undef PG8_LDA
#undef PG8_LDB
#undef PG8_MMA
#undef PG8_WAIT_V
#undef PG8_WAIT_L
#undef PG8_BAR
#undef PG8_SCHED
}
}
#define XB_TMO      128
#define XB_XCNT(j)  (256  + 64 * (j))
#define XB_XSUB(j)  (1280 + 64 * (j))
#define XB_XGEN(j)  (2304 + 64 * (j))
#define XB_TOP      3328
#define XB_TOPGEN   3392
#define XCD_BAR_WORDS 3456
#define XB_SPIN_CAP (1u << 18)
#define LAS __attribute__((address_space(3)))

__device__ __forceinline__ unsigned xb_ld(unsigned* p)              { return __hip_atomic_load(p, __ATOMIC_RELAXED, __HIP_MEMORY_SCOPE_AGENT); }
__device__ __forceinline__ unsigned xb_add(unsigned* p, unsigned v) { return __hip_atomic_fetch_add(p, v, __ATOMIC_RELAXED, __HIP_MEMORY_SCOPE_AGENT); }
__device__ __forceinline__ unsigned xb_xcc_id() { return (unsigned)__builtin_amdgcn_s_getreg((3 << 11) | 20) & 0xFu; }
#define XB_SPIN(cond, bar) do { unsigned _sp = 0; while (cond) { __builtin_amdgcn_s_sleep(1); \
    if ((++_sp & 255u) == 0u) { if (xb_ld(&(bar)[XB_TMO])) break; if (_sp > XB_SPIN_CAP) { atomicAdd(&(bar)[XB_TMO], 1u); break; } } } } while (0)

struct XcdBarrier {
    unsigned* bar; unsigned x;
    volatile LAS unsigned* st;
};

__device__ __forceinline__ XcdBarrier xcd_barrier_post(unsigned* bar, volatile LAS unsigned* st) {
    XcdBarrier b; b.bar = bar; b.x = xb_xcc_id(); b.st = st;
    if (threadIdx.x == 0) (void)xb_add(&bar[XB_XCNT(b.x)], 1u);
    return b;
}
__device__ __forceinline__ void xcd_barrier_complete(unsigned* bar, unsigned x, unsigned& nloc, unsigned& nx) {
    const unsigned G = gridDim.x * gridDim.y * gridDim.z;
    unsigned sum, cnt, mine, sp = 0u;
    for (;;) {
        sum = 0u; cnt = 0u; mine = 0u;
#pragma unroll
        for (unsigned j = 0; j < 16; ++j) { const unsigned c = xb_ld(&bar[XB_XCNT(j)]); sum += c; cnt += (c > 0u) ? 1u : 0u; mine = (j == x) ? c : mine; }
        if (sum == G) break;
        __builtin_amdgcn_s_sleep(1);
        if ((++sp & 255u) == 0u) { if (xb_ld(&bar[XB_TMO])) break; if (sp > XB_SPIN_CAP) { atomicAdd(&bar[XB_TMO], 1u); break; } }
    }
    nloc = mine > 0u ? mine : 1u; nx = cnt > 0u ? cnt : 1u;
}

__device__ __forceinline__ void xcd_barrier(const XcdBarrier& b) {
    asm volatile("s_waitcnt vmcnt(0)" ::: "memory");
    __syncthreads();
    if (threadIdx.x == 0) {
        unsigned* bar = b.bar; unsigned bx_ = b.x;
        asm volatile("" : "+s"(bar), "+s"(bx_));
        __builtin_amdgcn_s_waitcnt(0);
        unsigned nloc = b.st[0], nx = b.st[1];
        const unsigned old = xb_add(&bar[XB_XSUB(bx_)], 1u);
        const unsigned gen = old / nloc;
        if (old + 1u == (gen + 1u) * nloc) {
            __builtin_amdgcn_fence(__ATOMIC_RELEASE, "agent");
            asm volatile("s_waitcnt vmcnt(0)" ::: "memory");
            const unsigned og = xb_add(&bar[XB_TOP], 1u);
            const unsigned tg = og / nx;
            if (og + 1u == (tg + 1u) * nx) xb_add(&bar[XB_TOPGEN], 1u);
            else XB_SPIN(xb_ld(&bar[XB_TOPGEN]) == tg, bar);
            __builtin_amdgcn_fence(__ATOMIC_ACQUIRE, "agent");
            xb_add(&bar[XB_XGEN(bx_)], 1u);
            asm volatile("s_waitcnt vmcnt(0)" ::: "memory");
        } else {
            XB_SPIN(xb_ld(&bar[XB_XGEN(bx_)]) == gen, bar);
            __builtin_amdgcn_fence(__ATOMIC_ACQUIRE, "agent");
            asm volatile("s_waitcnt vmcnt(0)" ::: "memory");
        }
    }
    __syncthreads();
}

enum { X = 0, N1G, WIN, HCW, HCB, FW1, FB1, FW2, FB2, FW3, FB3, FW4, FREQ, HBIAS, LCW, LCB, LWA, LBA, LWX, LBX, LLAM, DLAM, DSUB, SCW, SCB, SDTB, SALOG, SD, SNG, WBR, BG, WOUT,
       N2G, WR, W1, W3, W2, RELB, FING };
struct MP {
    const float* in[39]; float* out; unsigned* bar;
    float* xres; bf16_t* hb; bf16_t* proj; bf16_t* gates; float* dtraw; bf16_t* br; bf16_t* mrg;
    float* fr; float* nrm; unsigned* hpp; bf16_t* vvt; float* hyt; bf16_t* vt;
    float* sumP; float* sumE; bf16_t* sxa; bf16_t* sxT; float* states; float* sdec; bf16_t* sprev;
    float* aff; int* tidx; float* tgat; int* tinv; bf16_t* hid; bf16_t* ybuf;
    bf16_t* wtin; bf16_t* wtbr; bf16_t* wtout; bf16_t* lruwt; float* m32;
    int ngrid, pad1;
};
typedef const MP __attribute__((address_space(4)))* MPc;
__device__ __forceinline__ MPc params() { MPc q = (MPc)__builtin_amdgcn_kernarg_segment_ptr(); asm volatile("" : "+s"(q)); return q; }
__device__ __forceinline__ int bid_opaque() { int b = (int)__builtin_amdgcn_workgroup_id_x(); asm volatile("" : "+s"(b)); return b; }
__device__ __forceinline__ int grid_n() { return params()->ngrid; }
#define MEGA_LDS (139264 + 1024)
#define NPH 12

template <int MODE>
__device__ __forceinline__ void phase_norm(char* shm, MPc p, int l) {
    float* hrow = (float*)shm;
    float* red = (float*)(shm + 65536);
    for (int it = bid_opaque(); it < TT_ / 8; it += grid_n()) {
        const int tid = tid_opaque(), wid = tid >> 6, lane = tid & 63;
        const int tok = it * 8 + wid, b = tok >> 11;
        const float* xin = (MODE == 0 && l == 0) ? p->in[X] : p->xres;
        f32x4 v[8];
#pragma unroll
        for (int i = 0; i < 8; ++i) v[i] = *(const f32x4*)(xin + (size_t)tok * DM_ + (i * 64 + lane) * 4);
        if (MODE == 2 || (MODE == 0 && l > 0)) {
            for (int e = 0; e < 16; ++e) {
                const int slot = p->tinv[tok * 16 + e];
                if (slot >= 0) {
                    const bf16_t* yr = p->ybuf + ((size_t)(b * 16 + e) * 256 + slot) * DM_;
#pragma unroll
                    for (int i = 0; i < 8; ++i) { const uint2 y = *(const uint2*)(yr + (i * 64 + lane) * 4);
                        v[i][0] += __uint_as_float(y.x << 16); v[i][1] += __uint_as_float(y.x & 0xffff0000u); v[i][2] += __uint_as_float(y.y << 16); v[i][3] += __uint_as_float(y.y & 0xffff0000u); }
                }
            }
        }
        float ss = 0.f;
#pragma unroll
        for (int i = 0; i < 8; ++i) ss += v[i][0] * v[i][0] + v[i][1] * v[i][1] + v[i][2] * v[i][2] + v[i][3] * v[i][3];
#pragma unroll
        for (int o = 32; o > 0; o >>= 1) ss += __shfl_xor(ss, o, 64);
        const float rs = rsqrtf(ss * (1.0f / DM_) + 1e-6f);
        const float* g = MODE == 0 ? p->in[N1G] + l * DM_ : (MODE == 1 ? p->in[N2G] + l * DM_ : p->in[FING]);
        if (MODE != 2) __syncthreads();
#pragma unroll
        for (int i = 0; i < 8; ++i) {
            const int c = (i * 64 + lane) * 4;
            const f32x4 gv = *(const f32x4*)(g + c);
            const f32x4 y = (f32x4){v[i][0] * rs * gv[0], v[i][1] * rs * gv[1], v[i][2] * rs * gv[2], v[i][3] * rs * gv[3]};
            if (MODE == 0) *(f32x4*)(p->xres + (size_t)tok * DM_ + c) = v[i];
            if (MODE == 2) *(f32x4*)(p->out + (size_t)tok * DM_ + c) = y;
            else {
                uint2 o; o.x = cvt_pk_bf16(y[0], y[1]); o.y = cvt_pk_bf16(y[2], y[3]);
                *(uint2*)(p->hb + (size_t)tok * DM_ + c) = o;
                *(f32x4*)(hrow + wid * DM_ + c) = y;
            }
        }
        if (MODE != 2) {
            __syncthreads();
            const float* W = MODE == 0 ? p->in[WIN] + (size_t)l * DM_ * INC_ + PROJW : p->in[WR] + (size_t)l * DM_ * 16;
            const int ldw = MODE == 0 ? INC_ : 16;
            const int e = tid & 15, part = tid >> 4;
            float acc[8] = {0.f, 0.f, 0.f, 0.f, 0.f, 0.f, 0.f, 0.f};
#pragma unroll 4
            for (int k = part * 64; k < part * 64 + 64; ++k) {
                const float w = W[(size_t)k * ldw + e];
#pragma unroll
                for (int t = 0; t < 8; ++t) acc[t] += hrow[t * DM_ + k] * w;
            }
#pragma unroll
            for (int t = 0; t < 8; ++t) red[(t * 32 + part) * 16 + e] = acc[t];
            __syncthreads();
            if (tid < 128) {
                const int tl = tid >> 4, e2 = tid & 15; float s = 0.f;
                for (int q = 0; q < 32; ++q) s += red[(tl * 32 + q) * 16 + e2];
                const int tk = it * 8 + tl;
                if (MODE == 0) p->dtraw[(size_t)tk * 16 + e2] = s;
                else {
                    float m = s;
#pragma unroll
                    for (int o = 8; o > 0; o >>= 1) m = fmaxf(m, __shfl_xor(m, o, 64));
                    const float ex = expf(s - m); float z = ex;
#pragma unroll
                    for (int o = 8; o > 0; o >>= 1) z += __shfl_xor(z, o, 64);
                    p->aff[(size_t)tk * 16 + e2] = ex / z;
                }
            }
        }
    }
}
__device__ __forceinline__ int block_sum_512(int v, volatile int* red  , int par, int tid) {
#pragma unroll
    for (int o = 32; o > 0; o >>= 1) v += __shfl_xor(v, o, 64);
    if ((tid & 63) == 0) red[par * 8 + (tid >> 6)] = v;
    __syncthreads();
    int s = 0;
#pragma unroll
    for (int w = 0; w < 8; ++w) s += red[par * 8 + w];
    return s;
}
__device__ __forceinline__ int block_exscan_512(int v, volatile int* wsum  , int tid) {
    int inc = v;
#pragma unroll
    for (int o = 1; o < 64; o <<= 1) { const int n = __shfl_up(inc, o, 64); if ((tid & 63) >= o) inc += n; }
    if ((tid & 63) == 63) wsum[tid >> 6] = inc;
    __syncthreads();
    int base = 0;
#pragma unroll
    for (int w = 0; w < 8; ++w) base += (w < (tid >> 6)) ? wsum[w] : 0;
    __syncthreads();
    return base + inc - v;
}
__device__ __forceinline__ void phase_topk(char* shm, MPc p) {
    volatile int* red = (volatile int*)shm;
    volatile int* wsum = red + 16;
    for (int z = bid_opaque(); z < 64; z += grid_n()) {
        const int b = z >> 4, e = z & 15, tid = tid_opaque();
        __syncthreads();
        float v[4]; unsigned u[4];
#pragma unroll
        for (int i = 0; i < 4; ++i) { v[i] = p->aff[(size_t)(b * SEQ_ + tid * 4 + i) * 16 + e]; u[i] = __float_as_uint(v[i]); }
        unsigned T = 0u;
        for (int bit = 30; bit >= 0; --bit) {
            const unsigned cand = T | (1u << bit);
            const int c = block_sum_512((u[0] >= cand) + (u[1] >= cand) + (u[2] >= cand) + (u[3] >= cand), red, bit & 1, tid);
            if (c >= 256) T = cand;
        }
        __syncthreads();
        const int ngt = block_sum_512((u[0] > T) + (u[1] > T) + (u[2] > T) + (u[3] > T), red, 0, tid);
        const int need = 256 - ngt;
        __syncthreads();
        const int eq_l = (u[0] == T) + (u[1] == T) + (u[2] == T) + (u[3] == T);
        int eqr = block_exscan_512(eq_l, wsum, tid);
        int sel[4], nsel = 0;
#pragma unroll
        for (int i = 0; i < 4; ++i) { const bool isq = u[i] == T; sel[i] = (u[i] > T) || (isq && eqr < need); eqr += isq ? 1 : 0; nsel += sel[i]; }
        int slot = block_exscan_512(nsel, wsum, tid);
#pragma unroll
        for (int i = 0; i < 4; ++i) {
            const int t = tid * 4 + i;
            if (sel[i]) { p->tidx[z * 256 + slot] = t; p->tgat[z * 256 + slot] = v[i]; }
            p->tinv[(b * SEQ_ + t) * 16 + e] = sel[i] ? slot : -1;
            slot += sel[i];
        }
    }
}
__device__ __forceinline__ void phase_hy_filter(char* shm, MPc p) {
    float* zz = (float*)shm; float* ha = zz + 8 * 64; float* hbq = ha + 8 * 64;
    for (int u = bid_opaque(); u < 512; u += grid_n()) {
        const int lf = u >> 8, tid = tid_opaque(), wid = tid >> 6, o = tid & 63, i = (u & 255) * 8 + wid;
        const float* fw1 = p->in[FW1] + lf * 33 * 64; const float* fw2 = p->in[FW2] + lf * 4096; const float* fw3 = p->in[FW3] + lf * 4096; const float* fw4 = p->in[FW4] + lf * 64 * 512;
        const float t = (float)i / (float)(SEQ_ - 1);
        const float w = (2.0f * 3.14159265358979323846f / (float)SEQ_) * (float)i;
        __syncthreads();
        if (o == 0) zz[wid * 64] = t;
        if (o < 16) { const float band = 1e-4f + (float)o * ((15.0f - 1e-4f) / 15.0f); zz[wid * 64 + 1 + o] = __cosf(band * w); zz[wid * 64 + 17 + o] = -__sinf(band * w); }
        __syncthreads();
        const float fq = p->in[FREQ][lf * 64 + o];
        float s = p->in[FB1][lf * 64 + o];
        for (int k = 0; k < 33; ++k) s += zz[wid * 64 + k] * fw1[k * 64 + o];
        ha[wid * 64 + o] = __sinf(fq * s);
        __syncthreads();
        s = p->in[FB2][lf * 64 + o];
        for (int k = 0; k < 64; ++k) s += ha[wid * 64 + k] * fw2[k * 64 + o];
        hbq[wid * 64 + o] = __sinf(fq * s);
        __syncthreads();
        s = p->in[FB3][lf * 64 + o];
        for (int k = 0; k < 64; ++k) s += hbq[wid * 64 + k] * fw3[k * 64 + o];
        __syncthreads();
        ha[wid * 64 + o] = __sinf(fq * s);
        __syncthreads();
        { const float d0 = logf(1e-2f) / 1.5f, d1 = logf(1e-2f) / 0.3f;
          const int c = tid;
          float a8[8] = {0.f, 0.f, 0.f, 0.f, 0.f, 0.f, 0.f, 0.f};
          for (int k = 0; k < 64; ++k) { const float wv = fw4[k * 512 + c];
#pragma unroll
              for (int q = 0; q < 8; ++q) a8[q] += ha[q * 64 + k] * wv; }
          const float delta = fabsf(d0 + (float)c * ((d1 - d0) / 511.0f));
#pragma unroll
          for (int q = 0; q < 8; ++q) { const int iq = (u & 255) * 8 + q; const float tq = (float)iq / (float)(SEQ_ - 1);
              p->fr[((size_t)lf * SEQ_ + iq) * 512 + c] = a8[q] * __expf(-2.0f * fabsf(tq - 0.5f) * delta); } }
    }
}
__device__ __forceinline__ void phase_hy_norm(MPc p) {
    for (int u = bid_opaque(); u < 128; u += grid_n()) {
        const int tid = tid_opaque(), pr = u * 8 + (tid >> 6), lane = tid & 63, lf = pr >> 9, c = pr & 511;
        float s = 0.f;
        for (int q = 0; q < 32; ++q) s += fabsf(p->fr[((size_t)lf * SEQ_ + lane + 64 * q) * 512 + c]);
#pragma unroll
        for (int o = 32; o > 0; o >>= 1) s += __shfl_xor(s, o, 64);
        if (lane == 0) p->nrm[pr] = s;
    }
}

__device__ __forceinline__ GP mk_gp(MPc p, int l, int which) {
    GP g{};
    if (which == 0) { g.A = p->hb; g.Bt = p->wtin + (size_t)l * 13824 * DM_; g.bias = p->in[BG] + (size_t)l * 4 * DM_; g.Cb = p->proj; g.Cb2 = p->gates; g.Vt = p->vt; }
    if (which == 1) { g.A = p->br; g.Bt = p->wtbr + (size_t)l * 4 * DM_ * 512; g.G = p->gates; g.Cb = p->mrg; }
    if (which == 2) { g.A = p->mrg; g.Bt = p->wtout + (size_t)l * DM_ * DM_; g.R = p->xres; g.Cf = p->xres; }
    if (which == 3) { g.A = p->hb; g.B = p->in[W1] + (size_t)l * 16 * DM_ * DM_; g.B2 = p->in[W3] + (size_t)l * 16 * DM_ * DM_; g.idx = p->tidx; g.Cb = p->hid; }
    if (which == 4) { g.A = p->hid; g.B = p->in[W2] + (size_t)l * 16 * DM_ * DM_; g.gate = p->tgat; g.Cb = p->ybuf; }
    return g;
}
__device__ __forceinline__ HP mk_hp(MPc p, int l) {
    HP h{}; h.proj = p->proj; h.fr = p->fr + (size_t)l * SEQ_ * 512; h.nrm = p->nrm + l * 512; h.pp = p->hpp + (size_t)l * 512 * HY_PPW; h.vvt = p->vvt; h.yt = p->hyt;
    h.cw = p->in[HCW] + l * 3 * 1536; h.cb = p->in[HCB] + l * 1536; h.hbias = p->in[HBIAS] + l * 512; h.br = p->br; return h;
}
__device__ __forceinline__ LP mk_lp(MPc p, int l) {
    LP q{}; q.proj = p->proj; q.cw = p->in[LCW] + l * 4 * 512; q.cb = p->in[LCB] + l * 512; q.wt = p->lruwt + (size_t)l * 8 * 256 * 64; q.ba = p->in[LBA] + l * 1024;
    q.bx = p->in[LBX] + l * 1024; q.lam = p->in[LLAM] + l * 1024; q.sumP = p->sumP; q.sumE = p->sumE; q.br = p->br; return q;
}
__device__ __forceinline__ SP_ mk_sp(MPc p, int l) {
    SP_ s{}; s.proj = p->proj; s.dtraw = p->dtraw; s.cw = p->in[SCW] + l * 4 * 1024; s.cb = p->in[SCB] + l * 1024; s.dtb = p->in[SDTB] + l * 16; s.a_log = p->in[SALOG] + l * 16; s.dsk = p->in[SD] + l * 8; s.ng = p->in[SNG] + l * 512;
    s.xa = p->sxa; s.xT = p->sxT; s.states = p->states; s.decay = p->sdec; s.prev = p->sprev; s.br = p->br; return s;
}
__device__ __forceinline__ AP mk_ap(MPc p, int l) {
    AP a{}; a.proj = p->proj; a.vt = p->vt; a.rel_bias = p->in[RELB]; a.dlam = p->in[DLAM] + l * 256; a.subg = p->in[DSUB] + l * 128; a.br = p->br; a.lam_init = l == 0 ? 0.2f : 0.35550906759096926f; return a;
}
__device__ __forceinline__ void wconv_tile(float* tile, const float* src, size_t ld_src, bf16_t* dst, size_t ld_dst, int tid) {
    __syncthreads();
    { const int kr = tid >> 4, n4 = (tid & 15) * 4;
#pragma unroll
      for (int h = 0; h < 2; ++h) { const f32x4 v = *(const f32x4*)(src + (size_t)(kr + 32 * h) * ld_src + n4); float* t = tile + (kr + 32 * h) * 65 + n4; t[0] = v[0]; t[1] = v[1]; t[2] = v[2]; t[3] = v[3]; } }
    __syncthreads();
    { const int n = tid >> 3, k8 = (tid & 7) * 8; const float* t = tile + k8 * 65 + n;
      uint4 o; o.x = cvt_pk_bf16(t[0], t[65]); o.y = cvt_pk_bf16(t[130], t[195]); o.z = cvt_pk_bf16(t[260], t[325]); o.w = cvt_pk_bf16(t[390], t[455]);
      *(uint4*)(dst + (size_t)n * ld_dst + k8) = o; }
}
__device__ __forceinline__ void phase_wconv(char* shm, MPc p, int l, int bw0, int bwn) {
    const int bq = bid_opaque() - bw0; if (bq < 0 || bq >= bwn) return;
    for (int e0 = bq * 512 + tid_opaque(); e0 < 8 * 256 * 64; e0 += bwn * 512) {
        const int e = l * 8 * 256 * 64 + e0; const int i = e & 63, n = (e >> 6) & 255, h = (e >> 14) & 7, j = n & 63, g = (n >> 6) & 1, dir = n >> 7;
        const float* w = (g ? p->in[LWX] : p->in[LWA]) + ((size_t)((l * 2 + dir) * 8 + h) * 64 + i) * 64 + j;
        p->lruwt[e] = f2bf(*w);
    }
    float* tile = (float*)shm;
    const int NJ_IN = 32 * 216, NJ_BR = 4 * 8 * 32, NJ_OUT = 32 * 32, NJ = NJ_IN + NJ_BR + NJ_OUT;
    for (int u = bq; u < NJ; u += bwn) {
        int j = u; const int tid = tid_opaque();
        if (j < NJ_IN) { const int nt = j % 216, kt = j / 216, n0 = nt * 64, ns = n0 < PROJW ? n0 : n0 + 16;
            wconv_tile(tile, p->in[WIN] + (size_t)l * DM_ * INC_ + (size_t)kt * 64 * INC_ + ns, INC_, p->wtin + ((size_t)l * 13824 + n0) * DM_ + kt * 64, DM_, tid); }
        else if (j < NJ_IN + NJ_BR) { j -= NJ_IN; const int nt = j & 31, kt = (j >> 5) & 7, k = j >> 8;
            wconv_tile(tile, p->in[WBR] + ((size_t)(l * 4 + k) * 512 + kt * 64) * DM_ + nt * 64, DM_, p->wtbr + (((size_t)(l * 4 + k) * DM_) + nt * 64) * 512 + kt * 64, 512, tid); }
        else { j -= NJ_IN + NJ_BR; const int nt = j & 31, kt = j >> 5;
            wconv_tile(tile, p->in[WOUT] + ((size_t)l * DM_ + kt * 64) * DM_ + nt * 64, DM_, p->wtout + ((size_t)l * DM_ + nt * 64) * DM_ + kt * 64, DM_, tid); }
    }
}
#define PH_ON(id) (ONLY < 0 || ONLY == (id))
#define PH_SYNC(id) do { if (ONLY < 0) xcd_barrier(bar); } while (0)
template <int ONLY>
__global__ void __launch_bounds__(512, 2) k_mega(MP p_unused) {
    extern __shared__ __attribute__((aligned(1024))) char shm[];
    XcdBarrier bar{};
    if (ONLY < 0) {
        volatile LAS unsigned* xbw = (volatile LAS unsigned*)(shm + MEGA_LDS - 16);
        if (threadIdx.x == 0) { xbw[0] = 0u; xbw[1] = 0u; }
        __syncthreads();
        bar = xcd_barrier_post(params()->bar, xbw);
        if (threadIdx.x == 0) { unsigned nloc, nx; xcd_barrier_complete(bar.bar, bar.x, nloc, nx); xbw[0] = nloc; xbw[1] = nx; }
        __syncthreads();
    }
    constexpr int L0 = ONLY < 0 ? 0 : (ONLY >= 2 * NPH ? 2 : ONLY / NPH), L1 = ONLY < 0 ? 2 : (ONLY >= 2 * NPH ? 2 : ONLY / NPH + 1);
#pragma unroll 1
    for (int l = L0; l < L1; ++l) {
        const int id0 = l * NPH;
        if (PH_ON(id0 + 0)) { phase_norm<0>(shm, params(), l); if (l == 0) { phase_hy_filter(shm, params()); phase_wconv(shm, params(), 0, 0, grid_n()); } }
        PH_SYNC(id0 + 0);
        if (PH_ON(id0 + 1)) { if (l == 0) phase_hy_norm(params()); const GP g = mk_gp(params(), l, 0);
            const pg8::Gemm gg{g.A, g.Bt, TT_, 13824, DM_, DM_, DM_}; const pg8::MegaOrder so{32, 54, grid_n(), bid_opaque()}; const pg8::EpiInproj ep{g.Cb, g.Cb2, g.Vt, g.bias};
            pg8::gemm_phase<pg8::EpiInproj, pg8::MegaOrder, false>((PG8_LAS unsigned char*)shm, gg, so, ep, nullptr); }
        PH_SYNC(id0 + 1);
        if (PH_ON(id0 + 2)) {
            { const AP a = mk_ap(params(), l); phase_attn(shm, a); }
            if (l == 0) { const HP h0 = mk_hp(params(), 0); phase_hy_pp(h0); const HP h1 = mk_hp(params(), 1); phase_hy_pp(h1); }
            { const HP h = mk_hp(params(), l); phase_hy_prep(shm, h); }
            { const SP_ s = mk_sp(params(), l); phase_ssd_prep(shm, s); }
            { const LP q = mk_lp(params(), l); phase_lru<0>(shm, q); }
        }
        PH_SYNC(id0 + 2);
        if (PH_ON(id0 + 3)) {
            { const HP h = mk_hp(params(), l); phase_hy_conv(shm, h); }
            { const SP_ s = mk_sp(params(), l); phase_ssd_states(shm, s); }
            { const LP q = mk_lp(params(), l); phase_lru<1>(shm, q); }
        }
        PH_SYNC(id0 + 3);
        if (PH_ON(id0 + 4)) { const SP_ s = mk_sp(params(), l); phase_ssd_scan(s); }
        PH_SYNC(id0 + 4);
        if (PH_ON(id0 + 5)) { { const SP_ s = mk_sp(params(), l); phase_ssd_out(shm, s); }
            { const HP h = mk_hp(params(), l); phase_hy_fin(shm, h, 0, grid_n()); }
            if (l == 0) phase_wconv(shm, params(), 1, 0, grid_n()); }
        PH_SYNC(id0 + 5);
        if (PH_ON(id0 + 6)) { const GP g = mk_gp(params(), l, 1); phase_merge(shm, g); }
        PH_SYNC(id0 + 6);
        if (PH_ON(id0 + 7)) { const GP g = mk_gp(params(), l, 2);
            const pg8::Gemm gg{g.A, g.Bt, TT_, DM_, DM_, DM_, DM_}; const pg8::MegaOrder so{32, 8, grid_n(), bid_opaque()}; const pg8::EpiOutproj ep{g.R, g.Cf};
            pg8::gemm_phase<pg8::EpiOutproj, pg8::MegaOrder, false>((PG8_LAS unsigned char*)shm, gg, so, ep, nullptr); }
        PH_SYNC(id0 + 7);
        if (PH_ON(id0 + 8)) phase_norm<1>(shm, params(), l);
        PH_SYNC(id0 + 8);
        if (PH_ON(id0 + 9)) phase_topk(shm, params());
        PH_SYNC(id0 + 9);
        if (PH_ON(id0 + 10)) { const GP g = mk_gp(params(), l, 3); phase_moe_up(shm, g); }
        PH_SYNC(id0 + 10);
        if (PH_ON(id0 + 11)) { const GP g = mk_gp(params(), l, 4); phase_moe_down(shm, g); }
        PH_SYNC(id0 + 11);
    }
    if (PH_ON(2 * NPH)) phase_norm<2>(shm, params(), 0);
}
template <int I> struct PhaseLauncher { static void go(int grid, hipStream_t st, const MP& p) { (void)hipFuncSetAttribute((const void*)k_mega<I>, hipFuncAttributeMaxDynamicSharedMemorySize, MEGA_LDS); hipLaunchKernelGGL(k_mega<I>, dim3(grid), dim3(512), MEGA_LDS, st, p); PhaseLauncher<I + 1>::go(grid, st, p); } };
template <> struct PhaseLauncher<2 * NPH + 1> { static void go(int, hipStream_t, const MP&) {} };

#ifndef MK_N_LAUNCHES
#define MK_N_LAUNCHES 1
#endif
extern "C" void kernel_launch(void* const* d_in, const int* in_sizes, int n_in, void* d_out, int out_size, void* d_ws, size_t ws_size, hipStream_t stream) {
    static int grid = 0;
    if (grid == 0) {
        int dev = 0, cus = 0;
        if (hipGetDevice(&dev) != hipSuccess || hipDeviceGetAttribute(&cus, hipDeviceAttributeMultiprocessorCount, dev) != hipSuccess) { fprintf(stderr, "kernel_launch: device query failed\n"); grid = -1; return; }
        if (hipFuncSetAttribute((const void*)k_mega<-1>, hipFuncAttributeMaxDynamicSharedMemorySize, MEGA_LDS) != hipSuccess) { fprintf(stderr, "kernel_launch: hipFuncSetAttribute failed\n"); grid = -1; return; }
        (void)hipGetLastError();
        grid = cus;
    }
    if (grid < 0) return;
    char* w = (char*)d_ws; size_t off = 0;
    auto alloc = [&](size_t bytes) { void* q = w + off; off += (bytes + 255) & ~(size_t)255; return q; };
    MP p{};
    for (int i = 0; i < 39; ++i) p.in[i] = (const float*)d_in[i];
    p.out = (float*)d_out; p.ngrid = grid;
    p.bar = (unsigned*)alloc(XCD_BAR_WORDS * 4);
    p.xres = (float*)alloc((size_t)TT_ * DM_ * 4);
    p.hb = (bf16_t*)alloc((size_t)TT_ * DM_ * 2);
    p.proj = (bf16_t*)alloc((size_t)TT_ * PROJW * 2);
    p.gates = (bf16_t*)alloc((size_t)TT_ * 8192 * 2);
    p.dtraw = (float*)alloc((size_t)TT_ * 16 * 4);
    p.br = (bf16_t*)alloc((size_t)TT_ * DM_ * 2);
    p.mrg = (bf16_t*)alloc((size_t)TT_ * DM_ * 2);
    p.fr = (float*)alloc((size_t)2 * SEQ_ * 512 * 4);
    p.nrm = (float*)alloc(2 * 512 * 4);
    p.hpp = (unsigned*)alloc((size_t)2 * 512 * HY_PPW * 4);
    p.vvt = (bf16_t*)alloc((size_t)512 * NB_ * SEQ_ * 2);
    p.hyt = (float*)alloc((size_t)512 * NB_ * SEQ_ * 4);
    p.vt = (bf16_t*)alloc((size_t)NB_ * 512 * SEQ_ * 2);
    p.sumP = (float*)alloc((size_t)2 * NB_ * 32 * 512 * 4);
    p.sumE = (float*)alloc((size_t)2 * NB_ * 32 * 512 * 4);
    p.sxa = (bf16_t*)alloc((size_t)TT_ * 1024 * 2);
    p.sxT = (bf16_t*)alloc((size_t)TT_ * 1024 * 2);
    p.states = (float*)alloc((size_t)NB_ * SSD_NC * 16 * 64 * 128 * 4);
    p.sdec = (float*)alloc(NB_ * SSD_NC * 16 * 4);
    p.sprev = (bf16_t*)alloc((size_t)NB_ * SSD_NC * 16 * 64 * 128 * 2);
    p.aff = (float*)alloc((size_t)TT_ * 16 * 4);
    p.tidx = (int*)alloc(64 * 256 * 4);
    p.tgat = (float*)alloc(64 * 256 * 4);
    p.tinv = (int*)alloc((size_t)TT_ * 16 * 4);
    p.hid = (bf16_t*)alloc((size_t)64 * 256 * DM_ * 2);
    p.ybuf = (bf16_t*)alloc((size_t)64 * 256 * DM_ * 2);
    p.wtin = (bf16_t*)alloc((size_t)2 * 13824 * DM_ * 2);
    p.wtbr = (bf16_t*)alloc((size_t)2 * 4 * DM_ * 512 * 2);
    p.wtout = (bf16_t*)alloc((size_t)2 * DM_ * DM_ * 2);
    p.lruwt = (bf16_t*)alloc((size_t)2 * 8 * 256 * 64 * 2);
    p.m32 = (float*)alloc((size_t)TT_ * DM_ * 4);
    if (off > ws_size) { fprintf(stderr, "kernel_launch: workspace too small (%zu > %zu)\n", off, ws_size); return; }
    (void)hipMemsetAsync(p.bar, 0, XCD_BAR_WORDS * 4, stream);
#if MK_N_LAUNCHES == 1
    hipLaunchKernelGGL(k_mega<-1>, dim3(grid), dim3(512), MEGA_LDS, stream, p);
#else
    PhaseLauncher<0>::go(grid, stream, p);
#endif
}
```

```cpp
#include <hip/hip_runtime.h>
#include <math.h>
#include <stdint.h>
#include <stdio.h>

#define NB_ 4
#define SEQ_ 2048
#define DM_ 2048
#define TT_ 8192
#define INC_ 13840
#define O_HY 0
#define O_LRU 1536
#define O_DA 2560
#define O_SSD 4096
#define O_GATE 5648
typedef short bf16x8 __attribute__((ext_vector_type(8)));
typedef float f32x4 __attribute__((ext_vector_type(4)));
typedef float f32x2 __attribute__((ext_vector_type(2)));
typedef int i32x4 __attribute__((ext_vector_type(4)));
typedef unsigned short bf16_t;
__device__ __forceinline__ int bid_opaque();
__device__ __forceinline__ int grid_n();

typedef __bf16 bf16x2_t __attribute__((ext_vector_type(2)));
__device__ __forceinline__ unsigned cvt_pk_bf16(float lo, float hi) { const f32x2 v = {lo, hi}; return __builtin_bit_cast(unsigned, __builtin_convertvector(v, bf16x2_t)); }
__device__ __forceinline__ int tid_opaque() { int t = (int)__builtin_amdgcn_workitem_id_x(); asm volatile("" : "+v"(t)); return t; }
__device__ __forceinline__ float bf2f(bf16_t v) { return __uint_as_float((unsigned)v << 16); }
__device__ __forceinline__ bf16_t f2bf(float f) { return (bf16_t)(cvt_pk_bf16(f, 0.f) & 0xffffu); }

__device__ __forceinline__ int lds_rc(int r, int chunk) { return r * 128 + ((chunk ^ ((r >> 1) & 7)) << 4); }
#define GEMM_LDS_BYTES(BM) (2 * ((BM) * 128 + 256 * 128))
#ifndef GEMM_L2PF
#define GEMM_L2PF 0
#endif
#ifndef GEMM_BT_AH
#define GEMM_BT_AH 8
#endif

#define GEMM_KTILE(buf, HOOK) do { const char* sS = shm + (buf) * STAGE; bf16x8 Bc[4], Bn[4], Ar[4]; \
        _Pragma("unroll") for (int n = 0; n < 4; ++n) Bc[n] = *(const bf16x8*)(sS + broff0 + n * 2048); \
        _Pragma("unroll") for (int q = 0; q < 3; ++q) Ar[q] = *(const bf16x8*)(sS + aroff0 + q * 2048); \
        __builtin_amdgcn_sched_barrier(0); \
        _Pragma("unroll") for (int g = 0; g < 2 * FM; ++g) { \
            if (g + 3 < 2 * FM) Ar[(g + 3) & 3] = *(const bf16x8*)(sS + ((g + 3) / FM ? aroff1 : aroff0) + ((g + 3) % FM) * 2048); \
            if (g == FM - 4) { _Pragma("unroll") for (int n = 0; n < 4; ++n) Bn[n] = *(const bf16x8*)(sS + broff1 + n * 2048); } \
            __builtin_amdgcn_sched_barrier(0); \
            _Pragma("unroll") for (int n = 0; n < 4; ++n) acc[g % FM][n] = __builtin_amdgcn_mfma_f32_16x16x32_bf16(Ar[g & 3], (g < FM ? Bc[n] : Bn[n]), acc[g % FM][n], 0, 0, 0); \
            HOOK(g); \
            __builtin_amdgcn_sched_barrier(0); } } while (0)
template <int BM, bool DUAL>
struct GemmCore {
    static constexpr int FM = BM / 32;
    static constexpr int GLA = BM * 128 / 8192;
    static constexpr int TILE_A = BM * 128, TILE_B = 256 * 128, STAGE = TILE_A + TILE_B;

    template <class AccT>
    static __device__ __forceinline__ void run(char* shm, const char* abase, const unsigned (&aoff)[GLA], const char* bl, unsigned ldb, int nt, AccT& acc) {
        const int tid = tid_opaque(), wid = tid >> 6, lane = tid & 63, wr = wid >> 2, wc = wid & 3, fr = lane & 15, fq = lane >> 4;
        const int kq = lane & 3, ngl = lane >> 2, ksub = wid & 1, grp = wid >> 1;
        i32x4 sa[GLA];
        f32x4 sb[8];
        const int awoff = lds_rc(tid >> 3, tid & 7);
        const int bwoff = TILE_A + lds_rc(grp * 64 + ngl, ksub * 4 + kq);
        const int aroff0 = lds_rc(wr * (BM / 2) + fr, fq), aroff1 = lds_rc(wr * (BM / 2) + fr, 4 + fq);
        const int broff0 = TILE_A + lds_rc(wc * 64 + fr, fq), broff1 = TILE_A + lds_rc(wc * 64 + fr, 4 + fq);
#define G_ISSUE(kt) do { const char* ab_ = abase + (size_t)(kt) * 128; _Pragma("unroll") for (int i = 0; i < GLA; ++i) sa[i] = *(const i32x4*)(ab_ + aoff[i]); \
        _Pragma("unroll") for (int r = 0; r < 8; ++r) sb[r] = *(const f32x4*)(bl + (size_t)((kt) * 64 + r) * ldb); \
        __builtin_amdgcn_sched_barrier(0); } while (0)
#define G_WRITE(buf) do { char* sbase = shm + (buf) * STAGE; _Pragma("unroll") for (int i = 0; i < GLA; ++i) *(i32x4*)(sbase + awoff + i * 8192) = sa[i]; \
        _Pragma("unroll") for (int i = 0; i < 4; ++i) { i32x4 w; w[0] = (int)cvt_pk_bf16(sb[0][i], sb[1][i]); w[1] = (int)cvt_pk_bf16(sb[2][i], sb[3][i]); \
              w[2] = (int)cvt_pk_bf16(sb[4][i], sb[5][i]); w[3] = (int)cvt_pk_bf16(sb[6][i], sb[7][i]); *(i32x4*)(sbase + bwoff + i * 2048) = w; } } while (0)
        G_ISSUE(0); G_WRITE(0); if (nt > 1) G_ISSUE(1); __syncthreads();
        for (int t = 0; t < nt; ++t) {
            const int cur = t & 1; const bool w_ok = t + 1 < nt, i_ok = t + 2 < nt;
            char* wb_ = shm + (cur ^ 1) * STAGE; const char* ab2_ = abase + (size_t)(t + 2) * 128; const char* bl2_ = bl + (size_t)(t + 2) * 64 * ldb;
#define G_HOOK(g) do { if ((g) < GLA) { if (w_ok) *(i32x4*)(wb_ + awoff + (g) * 8192) = sa[(g)]; if (i_ok) sa[(g)] = *(const i32x4*)(ab2_ + aoff[(g)]); } \
            else if ((g) >= 8 && (g) < 12) { if (w_ok) { const int i = (g) - 8; i32x4 w; w[0] = (int)cvt_pk_bf16(sb[0][i], sb[1][i]); w[1] = (int)cvt_pk_bf16(sb[2][i], sb[3][i]); \
                  w[2] = (int)cvt_pk_bf16(sb[4][i], sb[5][i]); w[3] = (int)cvt_pk_bf16(sb[6][i], sb[7][i]); *(i32x4*)(wb_ + bwoff + i * 2048) = w; } } \
            else if ((g) >= 12) { if (i_ok) { const int r = ((g) - 12) * 2; sb[r] = *(const f32x4*)(bl2_ + (size_t)r * ldb); sb[r + 1] = *(const f32x4*)(bl2_ + (size_t)(r + 1) * ldb); } } } while (0)
            GEMM_KTILE(cur, G_HOOK);
#undef G_HOOK
            __syncthreads();
        }
#undef G_ISSUE
#undef G_WRITE
    }
    struct NoEpi { __device__ __forceinline__ void operator()(int) const {} };
    template <class AccT>
    static __device__ __forceinline__ void run_bt(char* shm, const char* abase, const unsigned (&aoff)[GLA], const char* bbase, const unsigned (&boff)[4], unsigned ldbt, const char* pf_in, int nt, AccT& acc) {
        run_bt_seg<1 << 20>(shm, abase, aoff, bbase, boff, ldbt, 0, pf_in, nt, acc, NoEpi());
    }
    template <int SEG, class AccT, class Epi>
    static __device__ __forceinline__ void run_bt_seg(char* shm, const char* abase, const unsigned (&aoff)[GLA], const char* bbase, const unsigned (&boff)[4], unsigned ldbt, size_t segstride, const char* pf_in, int nt, AccT& acc, Epi seg_epi) {
        const int tid = tid_opaque(), wid = tid >> 6, lane = tid & 63, wr = wid >> 2, wc = wid & 3, fr = lane & 15, fq = lane >> 4;
        i32x4 sa[GLA], sbt[4];
        const unsigned astr = 64u * DM_ * 2u, bstr = 64u * ldbt;
        const int awoff = lds_rc(tid >> 3, tid & 7);
        const int aroff0 = lds_rc(wr * (BM / 2) + fr, fq), aroff1 = lds_rc(wr * (BM / 2) + fr, 4 + fq);
        const int broff0 = TILE_A + lds_rc(wc * 64 + fr, fq), broff1 = TILE_A + lds_rc(wc * 64 + fr, 4 + fq);
#define T_ISSUE(kt) do { const char* ab_ = abase + (size_t)(kt) * 128 + aoff[0]; const char* bb_ = bbase + (size_t)((kt) / SEG) * segstride + (size_t)((kt) % SEG) * 128 + boff[0]; \
        _Pragma("unroll") for (int i = 0; i < GLA; ++i) sa[i] = *(const i32x4*)(ab_ + (size_t)i * astr); \
        _Pragma("unroll") for (int i = 0; i < 4; ++i) sbt[i] = *(const i32x4*)(bb_ + (size_t)i * bstr); \
        __builtin_amdgcn_sched_barrier(0); } while (0)
#define T_WRITE(buf) do { char* sbase = shm + (buf) * STAGE; _Pragma("unroll") for (int i = 0; i < GLA; ++i) *(i32x4*)(sbase + awoff + i * 8192) = sa[i]; \
        _Pragma("unroll") for (int i = 0; i < 4; ++i) *(i32x4*)(sbase + TILE_A + awoff + i * 8192) = sbt[i]; } while (0)
        const unsigned long long pf0 = (unsigned long long)pf_in;
        const unsigned long long pfu = ((unsigned long long)(unsigned)__builtin_amdgcn_readfirstlane((int)(pf0 >> 32)) << 32) | (unsigned)__builtin_amdgcn_readfirstlane((int)(unsigned)pf0);
        const char* pf = (const char*)pfu; const unsigned pfo = (unsigned)(pf0 - pfu);
        unsigned pfa = 0u, pfb = 0u;
        T_ISSUE(0); T_WRITE(0); if (nt > 1) T_ISSUE(1);
#if GEMM_L2PF
        if (nt > 2) pfa = *(const unsigned*)(pf + 2 * 128 + pfo);
#endif
        __syncthreads();
        for (int t = 0; t < nt; ++t) {
            const int cur = t & 1;
            const bool w_ok = t + 1 < nt, i_ok = t + 2 < nt;
            char* wb_ = shm + (cur ^ 1) * STAGE; const char* ab2_ = abase + (size_t)(t + 2) * 128 + aoff[0];
            const char* bb2_ = bbase + (size_t)((t + 2) / SEG) * segstride + (size_t)((t + 2) % SEG) * 128 + boff[0];
#define T_HOOK(g) do { if ((g) < GLA) { if (w_ok) *(i32x4*)(wb_ + awoff + (g) * 8192) = sa[(g)]; if (i_ok) sa[(g)] = *(const i32x4*)(ab2_ + (size_t)(g) * astr); } \
            else if ((g) < GLA + 4) { const int i = (g) - GLA; if (w_ok) *(i32x4*)(wb_ + TILE_A + awoff + i * 8192) = sbt[i]; if (i_ok) sbt[i] = *(const i32x4*)(bb2_ + (size_t)i * bstr); } } while (0)
#if GEMM_L2PF
            if (t + 3 < nt) pfb = *(const unsigned*)(pf + (size_t)(t + 3) * 128 + pfo);
            asm volatile("" :: "v"(pfa));
            pfa = pfb;
#endif
            GEMM_KTILE(cur, T_HOOK);
#undef T_HOOK
            __syncthreads();
            if ((t % SEG) == SEG - 1) seg_epi(t / SEG);
        }
#undef T_ISSUE
#undef T_WRITE
    }
    static __device__ __forceinline__ void bt_coord(int tid, int i, int& col, int& C) { const int R = (tid >> 3) + 64 * i; C = (tid & 7) * 8;
        col = (R & ~63) + 4 * (R & 15) + ((R >> 4) & 3); }
    static __device__ __forceinline__ void a_coord(int tid, int i, int& R, int& C) { R = (tid >> 3) + 64 * i; C = (tid & 7) * 8; }
    static __device__ __forceinline__ void b_coord(int tid, int& k, int& col, int& which) { const int wid = tid >> 6, lane = tid & 63; const int kq = lane & 3, ngl = lane >> 2, ksub = wid & 1, grp = wid >> 1;
        k = ksub * 32 + kq * 8; if (DUAL) { which = ngl >> 3; col = grp * 32 + 4 * (ngl & 7); } else { which = 0; col = grp * 64 + 4 * ngl; } }
};
#define PROJW 5632
__device__ __forceinline__ float sigmoidf_(float x) { return 1.0f / (1.0f + expf(-x)); }
__device__ __forceinline__ float siluf_(float x) { return x / (1.0f + expf(-x)); }
__device__ __forceinline__ float softplusf_(float x) { return x > 20.f ? x : log1pf(expf(x)); }
__device__ __forceinline__ float sigmoid_fast_(float x) { return __builtin_amdgcn_rcpf(1.0f + __expf(-x)); }
__device__ __forceinline__ float silu_fast_(float x) { return x * __builtin_amdgcn_rcpf(1.0f + __expf(-x)); }
__device__ __forceinline__ float softplus_fast_(float x) { const float e = __expf(x); const float sm = e * (1.0f - e * (0.5f - e * (1.0f / 3.0f))); return x > 15.f ? x : (e < 0.01f ? sm : __logf(1.0f + e)); }
__device__ __forceinline__ float gelu_tanh_(float x) { const float u2 = 1.5957691216057308f * (x + 0.044715f * x * x * x); return x * __builtin_amdgcn_rcpf(1.0f + __expf(-u2)); }

__device__ __forceinline__ float block_sum_256(float v, float* red) {
    for (int o = 32; o > 0; o >>= 1) v += __shfl_down(v, o, 64);
    __syncthreads();
    if ((tid_opaque() & 63) == 0) red[tid_opaque() >> 6] = v;
    __syncthreads();
    float r = red[0] + red[1] + red[2] + red[3];
    __syncthreads();
    return r;
}
__device__ __forceinline__ float block_max_256(float v, float* red) {
    for (int o = 32; o > 0; o >>= 1) v = fmaxf(v, __shfl_down(v, o, 64));
    __syncthreads();
    if ((tid_opaque() & 63) == 0) red[tid_opaque() >> 6] = v;
    __syncthreads();
    float r = fmaxf(fmaxf(red[0], red[1]), fmaxf(red[2], red[3]));
    __syncthreads();
    return r;
}

__device__ __forceinline__ int t5_bucket(int rel) {
    const int ret = rel > 0 ? 16 : 0; const int n = rel < 0 ? -rel : rel;
    if (n < 8) return ret + n;
    const float v = logf((float)n / 8.0f) / 2.772588722239781f * 8.0f;
    int large = 8 + (int)v; if (large > 15) large = 15;
    return ret + large;
}
struct AP { const bf16_t* proj; const bf16_t* vt; const float* rel_bias; const float* dlam; const float* subg; bf16_t* br; float lam_init; };
#define ATT_LDS (2 * 32768 + 2048)
__device__ __forceinline__ void phase_attn(char* shm, const AP& p) {
    float* btab = (float*)(shm + 65536);
    const float LOG2E = 1.4426950408889634f;
    for (int unit = bid_opaque(); unit < NB_ * 4 * 16; unit += grid_n()) {
        const int xq = unit & 7, sq = unit >> 3, bh = (xq * 2 + (sq >> 4)) & 15, qt = sq & 15, h = bh & 3, b = bh >> 2;
        const int tid = tid_opaque(), wid = tid >> 6, lane = tid & 63, fr = lane & 15, fq = lane >> 4;
        __syncthreads();
        if (tid < 257) btab[tid] = p.rel_bias[t5_bucket(tid - 128) * 4 + h] * LOG2E;
        float l0 = 0.f, l1 = 0.f;
        for (int d = 0; d < 64; ++d) { l0 += p.dlam[d] * p.dlam[64 + d]; l1 += p.dlam[128 + d] * p.dlam[192 + d]; }
        const float lam = expf(l0) - expf(l1) + p.lam_init;
        const int q0 = qt * 128, qrow = q0 + wid * 16 + fr;
        bf16x8 qf[2][2];
        { const bf16_t* qp = p.proj + (size_t)(b * SEQ_ + qrow) * PROJW + O_DA + h * 128 + fq * 8;
#pragma unroll
          for (int i = 0; i < 2; ++i)
#pragma unroll
            for (int s = 0; s < 2; ++s) qf[i][s] = *(const bf16x8*)(qp + i * 64 + s * 32); }
        const bf16_t* kg[2]; const bf16_t* vg[2]; int kl[2], vl[2]; bool vswap[2];
#pragma unroll
        for (int u = 0; u < 2; ++u) {
            const int c = tid + u * 512;
            const int krow = c >> 4, kch = c & 15;
            kg[u] = p.proj + (size_t)(b * SEQ_ + krow) * PROJW + O_DA + 512 + h * 128 + kch * 8;
            kl[u] = krow * 256 + ((kch ^ (krow & 15)) * 16);
            const int dv = c >> 3, ch16 = c & 7;
            vg[u] = p.vt + (size_t)(b * 512 + h * 128 + dv) * SEQ_ + ch16 * 8;
            vl[u] = 16384 + dv * 128 + ((ch16 ^ ((dv & 15) >> 1)) * 16); vswap[u] = dv & 1;
        }
        i32x4 sk[2], sv[2];
#define A_ISSUE(kt) do { _Pragma("unroll") for (int u = 0; u < 2; ++u) { sk[u] = *(const i32x4*)(kg[u] + (size_t)(kt) * 64 * PROJW); sv[u] = *(const i32x4*)(vg[u] + (kt) * 64); } } while (0)
#define A_WRITE(buf) do { char* sb_ = shm + (buf) * 32768; _Pragma("unroll") for (int u = 0; u < 2; ++u) { *(i32x4*)(sb_ + kl[u]) = sk[u]; \
            i32x4 w_ = sv[u]; if (vswap[u]) w_ = (i32x4){sv[u][2], sv[u][3], sv[u][0], sv[u][1]}; *(i32x4*)(sb_ + vl[u]) = w_; } } while (0)
        f32x4 O[2][8];
#pragma unroll
        for (int i = 0; i < 2; ++i)
#pragma unroll
            for (int f = 0; f < 8; ++f) O[i][f] = (f32x4){0.f, 0.f, 0.f, 0.f};
        float mrun[2] = {-1e30f, -1e30f}, lrun[2] = {0.f, 0.f};
        A_ISSUE(0); A_WRITE(0); A_ISSUE(1); __syncthreads();
        const int NT = SEQ_ / 64;
        for (int kt = 0; kt < NT; ++kt) {
            const int cur = kt & 1;
            if (kt + 1 < NT) A_WRITE(cur ^ 1);
            if (kt + 2 < NT) A_ISSUE(kt + 2);
            const char* sK = shm + cur * 32768; const char* sV = sK + 16384;
            f32x4 S[2][4];
#pragma unroll
            for (int i = 0; i < 2; ++i)
#pragma unroll
                for (int kf = 0; kf < 4; ++kf) {
                    f32x4 a = (f32x4){0.f, 0.f, 0.f, 0.f};
#pragma unroll
                    for (int s = 0; s < 2; ++s) {
                        const int row = kf * 16 + fr, ch = i * 8 + s * 4 + fq;
                        const bf16x8 kfA = *(const bf16x8*)(sK + row * 256 + ((ch ^ (row & 15)) * 16));
                        a = __builtin_amdgcn_mfma_f32_16x16x32_bf16(kfA, qf[i][s], a, 0, 0, 0);
                    }
                    S[i][kf] = a;
                }
            const int k0 = kt * 64;
            const bool far_hi = (k0 >= q0 + 127 + 128), far_lo = (k0 + 63 <= q0 - 128);
            const float c1 = 0.125f * LOG2E;
            if (far_hi || far_lo) {
                const float bc_ = far_hi ? btab[256] : btab[0];
#pragma unroll
                for (int i = 0; i < 2; ++i)
#pragma unroll
                    for (int kf = 0; kf < 4; ++kf)
#pragma unroll
                        for (int j = 0; j < 4; ++j) S[i][kf][j] = S[i][kf][j] * c1 + bc_;
            } else {
#pragma unroll
                for (int kf = 0; kf < 4; ++kf)
#pragma unroll
                    for (int j = 0; j < 4; ++j) {
                        int rel = (k0 + kf * 16 + fq * 4 + j) - qrow; rel = rel < -128 ? -128 : (rel > 128 ? 128 : rel);
                        const float bv_ = btab[rel + 128];
                        S[0][kf][j] = S[0][kf][j] * c1 + bv_; S[1][kf][j] = S[1][kf][j] * c1 + bv_;
                    }
            }
            bf16x8 Pf[2][2];
#pragma unroll
            for (int i = 0; i < 2; ++i) {
                float mx = S[i][0][0];
#pragma unroll
                for (int kf = 0; kf < 4; ++kf)
#pragma unroll
                    for (int j = 0; j < 4; ++j) mx = fmaxf(mx, S[i][kf][j]);
                mx = fmaxf(mx, __shfl_xor(mx, 16, 64)); mx = fmaxf(mx, __shfl_xor(mx, 32, 64));
                const float mnew = fmaxf(mrun[i], mx);
                const float alpha = __builtin_amdgcn_exp2f(mrun[i] - mnew);
                mrun[i] = mnew;
                float ps = 0.f;
#pragma unroll
                for (int kf = 0; kf < 4; ++kf)
#pragma unroll
                    for (int j = 0; j < 4; ++j) { const float e = __builtin_amdgcn_exp2f(S[i][kf][j] - mnew); S[i][kf][j] = e; ps += e; }
                ps += __shfl_xor(ps, 16, 64); ps += __shfl_xor(ps, 32, 64);
                lrun[i] = lrun[i] * alpha + ps;
                if (__any(alpha != 1.0f)) {
#pragma unroll
                    for (int f = 0; f < 8; ++f) { O[i][f][0] *= alpha; O[i][f][1] *= alpha; O[i][f][2] *= alpha; O[i][f][3] *= alpha; }
                }
#pragma unroll
                for (int g = 0; g < 2; ++g) {
                    i32x4 w;
                    w[0] = (int)cvt_pk_bf16(S[i][2 * g][0], S[i][2 * g][1]); w[1] = (int)cvt_pk_bf16(S[i][2 * g][2], S[i][2 * g][3]);
                    w[2] = (int)cvt_pk_bf16(S[i][2 * g + 1][0], S[i][2 * g + 1][1]); w[3] = (int)cvt_pk_bf16(S[i][2 * g + 1][2], S[i][2 * g + 1][3]);
                    Pf[i][g] = __builtin_bit_cast(bf16x8, w);
                }
            }
#pragma unroll
            for (int f = 0; f < 8; ++f)
#pragma unroll
                for (int g = 0; g < 2; ++g) {
                    const int dv = f * 16 + fr, x = dv & 15;
                    const uint2 v0 = *(const uint2*)(sV + dv * 128 + (((8 * g + fq) ^ x) * 8));
                    const uint2 v1 = *(const uint2*)(sV + dv * 128 + (((8 * g + 4 + fq) ^ x) * 8));
                    const i32x4 w = (i32x4){(int)v0.x, (int)v0.y, (int)v1.x, (int)v1.y};
                    const bf16x8 vA = __builtin_bit_cast(bf16x8, w);
                    O[0][f] = __builtin_amdgcn_mfma_f32_16x16x32_bf16(vA, Pf[0][g], O[0][f], 0, 0, 0);
                    O[1][f] = __builtin_amdgcn_mfma_f32_16x16x32_bf16(vA, Pf[1][g], O[1][f], 0, 0, 0);
                }
            __syncthreads();
        }
#undef A_ISSUE
#undef A_WRITE
        const float r0 = 1.0f / lrun[0], r1 = lam / lrun[1];
        float ss = 0.f;
#pragma unroll
        for (int f = 0; f < 8; ++f)
#pragma unroll
            for (int j = 0; j < 4; ++j) { const float o = O[0][f][j] * r0 - O[1][f][j] * r1; O[0][f][j] = o; ss += o * o; }
        ss += __shfl_xor(ss, 16, 64); ss += __shfl_xor(ss, 32, 64);
        const float rs = rsqrtf(ss * (1.0f / 128.0f) + 1e-5f) * (1.0f - p.lam_init);
        bf16_t* op = p.br + (size_t)(b * SEQ_ + qrow) * DM_ + 1024 + h * 128 + fq * 4;
        f32x4 gv[8];
#pragma unroll
        for (int f = 0; f < 8; ++f) gv[f] = *(const f32x4*)(p.subg + f * 16 + fq * 4);
#pragma unroll
        for (int f = 0; f < 8; ++f) {
            uint2 o; o.x = cvt_pk_bf16(O[0][f][0] * rs * gv[f][0], O[0][f][1] * rs * gv[f][1]); o.y = cvt_pk_bf16(O[0][f][2] * rs * gv[f][2], O[0][f][3] * rs * gv[f][3]);
            *(uint2*)(op + f * 16) = o;
        }
    }
}

#define HY_PPW 2112
#define HY_PADL 1040
#define HY_VLEN 4112
#define HY_LDS (HY_PPW * 4 + 4 * HY_VLEN * 2)
struct HP { const bf16_t* proj; const float* fr; const float* nrm; unsigned* pp; bf16_t* vvt; float* yt; const float* cw; const float* cb; const float* hbias; bf16_t* br; };

__device__ __forceinline__ void phase_hy_pp(const HP& p) {
    for (int idx = bid_opaque() * 512 + tid_opaque(); idx < 512 * HY_PPW; idx += grid_n() * 512) {
        const int c = idx / HY_PPW, u = idx - c * HY_PPW;
        const float inv = 1.0f / p.nrm[c];
        const int s0 = 2080 - u, s1 = 2080 - (u + 1);
        const float f0 = (s0 >= 0 && s0 < SEQ_) ? p.fr[(size_t)s0 * 512 + c] * inv : 0.f;
        const float f1 = (s1 >= 0 && s1 < SEQ_) ? p.fr[(size_t)s1 * 512 + c] * inv : 0.f;
        p.pp[idx] = cvt_pk_bf16(f0, f1);
    }
}
__device__ __forceinline__ void unpack8(const uint4 v, float (&f)[8]) {
    f[0] = __uint_as_float(v.x << 16); f[1] = __uint_as_float(v.x & 0xffff0000u); f[2] = __uint_as_float(v.y << 16); f[3] = __uint_as_float(v.y & 0xffff0000u);
    f[4] = __uint_as_float(v.z << 16); f[5] = __uint_as_float(v.z & 0xffff0000u); f[6] = __uint_as_float(v.w << 16); f[7] = __uint_as_float(v.w & 0xffff0000u);
}
__device__ __forceinline__ void phase_hy_prep(char* shm, const HP& p) {
    bf16_t* tile = (bf16_t*)shm;
    for (int unit = bid_opaque(); unit < NB_ * 32 * 8; unit += grid_n()) {
        const int ct = unit & 7, tt = (unit >> 3) & 31, b = unit >> 8;
        const int tid = tid_opaque(), tl = tid >> 3, c8 = (tid & 7) * 8, c = ct * 64 + c8, t = tt * 64 + tl;
        float s1[8], s2[8];
#pragma unroll
        for (int e = 0; e < 8; ++e) { s1[e] = p.cb[512 + c + e]; s2[e] = p.cb[1024 + c + e]; }
#pragma unroll
        for (int k = 0; k < 3; ++k) {
            const int t2 = t + k - 1;
            if (t2 >= 0 && t2 < SEQ_) {
                const bf16_t* pr = p.proj + (size_t)(b * SEQ_ + t2) * PROJW + O_HY + c;
                float x1[8], xv[8]; unpack8(*(const uint4*)(pr + 512), x1); unpack8(*(const uint4*)(pr + 1024), xv);
                const f32x4 wa = *(const f32x4*)(p.cw + k * 1536 + 512 + c), wb = *(const f32x4*)(p.cw + k * 1536 + 512 + c + 4);
                const f32x4 va = *(const f32x4*)(p.cw + k * 1536 + 1024 + c), vb = *(const f32x4*)(p.cw + k * 1536 + 1024 + c + 4);
#pragma unroll
                for (int e = 0; e < 4; ++e) { s1[e] += wa[e] * x1[e]; s1[e + 4] += wb[e] * x1[e + 4]; s2[e] += va[e] * xv[e]; s2[e + 4] += vb[e] * xv[e + 4]; }
            }
        }
        __syncthreads();
#pragma unroll
        for (int e = 0; e < 8; ++e) tile[(c8 + e) * 72 + tl] = f2bf(s1[e] * s2[e]);
        __syncthreads();
        { const int cl = tid >> 3, t8 = (tid & 7) * 8;
          *(uint4*)(p.vvt + ((size_t)(ct * 64 + cl) * NB_ + b) * SEQ_ + tt * 64 + t8) = *(const uint4*)(tile + cl * 72 + t8); }
    }
}
__device__ __forceinline__ void phase_hy_conv(char* shm, const HP& p) {
    unsigned* pps = (unsigned*)shm;
    bf16_t* vs = (bf16_t*)(shm + HY_PPW * 4);
    for (int c = bid_opaque(); c < 512; c += grid_n()) {
        const int tid = tid_opaque(), wid = tid >> 6, lane = tid & 63, fr = lane & 15, h = lane >> 4;
        __syncthreads();
        for (int i = tid; i < HY_PPW; i += 512) pps[i] = p.pp[(size_t)c * HY_PPW + i];
        for (int i = tid; i < 4 * (HY_VLEN / 8); i += 512) {
            const int b = i / (HY_VLEN / 8), ch = i - b * (HY_VLEN / 8), e0 = ch * 8 - HY_PADL;
            uint4 v = make_uint4(0u, 0u, 0u, 0u);
            if (e0 >= 0 && e0 < SEQ_) v = *(const uint4*)(p.vvt + ((size_t)c * NB_ + b) * SEQ_ + e0);
            *(uint4*)(vs + b * HY_VLEN + ch * 8) = v;
        }
        __syncthreads();
        const int b = wid >> 1, ib = (wid & 1) * 64;
        f32x4 acc[4];
#pragma unroll
        for (int f = 0; f < 4; ++f) acc[f] = (f32x4){0.f, 0.f, 0.f, 0.f};
        const int ua = 1056 - 16 * (h >> 1) - fr + 8 * (h & 1);
        const bf16_t* vb = vs + b * HY_VLEN + HY_PADL + 16 * (ib + fr - (h >> 1)) + 8 * (h & 1);
#define HY_LOAD(d0_, af_, bf_) do { const unsigned* ap_ = pps + (ua - 16 * (d0_)); const i32x4 aw_ = (i32x4){(int)ap_[0], (int)ap_[2], (int)ap_[4], (int)ap_[6]}; af_ = __builtin_bit_cast(bf16x8, aw_); \
        _Pragma("unroll") for (int f = 0; f < 4; ++f) bf_[f] = *(const bf16x8*)(vb + 16 * (16 * f - (d0_))); } while (0)
        bf16x8 afA, afB, bfA[4], bfB[4];
        HY_LOAD(-64, afA, bfA);
        for (int d0 = -64; d0 < 64; d0 += 4) {
            HY_LOAD(d0 + 2, afB, bfB);
            __builtin_amdgcn_sched_barrier(0);
#pragma unroll
            for (int f = 0; f < 4; ++f) acc[f] = __builtin_amdgcn_mfma_f32_16x16x32_bf16(afA, bfA[f], acc[f], 0, 0, 0);
            __builtin_amdgcn_sched_barrier(0);
            HY_LOAD(d0 + 4, afA, bfA);
            __builtin_amdgcn_sched_barrier(0);
#pragma unroll
            for (int f = 0; f < 4; ++f) acc[f] = __builtin_amdgcn_mfma_f32_16x16x32_bf16(afB, bfB[f], acc[f], 0, 0, 0);
            __builtin_amdgcn_sched_barrier(0);
        }
#pragma unroll
        for (int f = 0; f < 4; ++f) acc[f] = __builtin_amdgcn_mfma_f32_16x16x32_bf16(afA, bfA[f], acc[f], 0, 0, 0);
#undef HY_LOAD
        const float hb = p.hbias[c];
#pragma unroll
        for (int f = 0; f < 4; ++f) {
            const int t = 16 * (ib + 16 * f + fr) + 4 * h;
            const bf16_t* vv = vs + b * HY_VLEN + HY_PADL + t;
            f32x4 o; o[0] = acc[f][0] + bf2f(vv[0]) * hb; o[1] = acc[f][1] + bf2f(vv[1]) * hb; o[2] = acc[f][2] + bf2f(vv[2]) * hb; o[3] = acc[f][3] + bf2f(vv[3]) * hb;
            *(f32x4*)(p.yt + ((size_t)c * NB_ + b) * SEQ_ + t) = o;
        }
    }
}
__device__ __forceinline__ void phase_hy_fin(char* shm, const HP& p, int bw0, int bwn) {
    float* tile = (float*)shm;
    const int bq = bid_opaque() - bw0; if (bq < 0 || bq >= bwn) return;
    for (int unit = bq; unit < NB_ * 32 * 8; unit += bwn) {
        const int ct = unit & 7, tt = (unit >> 3) & 31, b = unit >> 8, tid = tid_opaque();
        __syncthreads();
        { const int cl = tid >> 3, t8 = (tid & 7) * 8; const float* src = p.yt + ((size_t)(ct * 64 + cl) * NB_ + b) * SEQ_ + tt * 64 + t8;
          const f32x4 a = *(const f32x4*)src, bq = *(const f32x4*)(src + 4);
#pragma unroll
          for (int q = 0; q < 4; ++q) { tile[cl * 65 + t8 + q] = a[q]; tile[cl * 65 + t8 + 4 + q] = bq[q]; } }
        __syncthreads();
        const int cl = tid & 63, c = ct * 64 + cl, tq = tid >> 6;
        float w0[3];
#pragma unroll
        for (int k = 0; k < 3; ++k) w0[k] = p.cw[k * 1536 + c];
        const float b0 = p.cb[c];
        float xr[10];
#pragma unroll
        for (int r = 0; r < 10; ++r) { const int t2 = tt * 64 + tq * 8 + r - 1; xr[r] = (t2 >= 0 && t2 < SEQ_) ? bf2f(p.proj[(size_t)(b * SEQ_ + t2) * PROJW + O_HY + c]) : 0.f; }
#pragma unroll
        for (int q = 0; q < 8; ++q) {
            const int tl = tq * 8 + q, t = tt * 64 + tl;
            float s = b0;
#pragma unroll
            for (int k = 0; k < 3; ++k) s += w0[k] * xr[q + k];
            p.br[(size_t)(b * SEQ_ + t) * DM_ + c] = f2bf(tile[cl * 65 + tl] * s);
        }
    }
}
struct LP { const bf16_t* proj; const float* cw; const float* cb; const bf16_t* wt; const float* ba; const float* bx; const float* lam; float* sumP; float* sumE; bf16_t* br; };
#define LRU_LDS (32768 + 8192 + 64 * 65 * 4 + 2 * 64 * 65 * 4 + 2 * 2 * 16 * 64 * 4)
template <int PASS>
__device__ __forceinline__ void phase_lru(char* shm, const LP& p) {
    char* sW = shm;
    char* sXb = shm + 32768;
    float* X = (float*)(shm + 40960);
    float* H = X + 64 * 65;
    float* SP = H + 2 * 64 * 65;
    float* SE = SP + 2 * 16 * 64;
    for (int unit = bid_opaque(); unit < NB_ * 8 * 32; unit += grid_n()) {
        const int k = unit & 31, b = (unit >> 5) & 3, h = unit >> 7;
        const int tid = tid_opaque();
        __syncthreads();
        for (int i = tid; i < 256 * 8; i += 512) { const int row = i >> 3, ch = i & 7;
            *(uint4*)(sW + lds_rc(row, ch)) = *(const uint4*)(p.wt + ((size_t)h * 256 + row) * 64 + ch * 8); }
        { const int j = tid & 63, tq = tid >> 6, ch = h * 64 + j;
          float w4[4];
#pragma unroll
          for (int q = 0; q < 4; ++q) w4[q] = p.cw[q * 512 + ch];
          const float cbv = p.cb[ch];
#pragma unroll
          for (int q = 0; q < 8; ++q) {
              const int tl = tq * 8 + q, t = k * 64 + tl; float s = cbv;
#pragma unroll
              for (int kk = 0; kk < 4; ++kk) { const int t2 = t + kk - 2; if (t2 >= 0 && t2 < SEQ_) s += w4[kk] * bf2f(p.proj[(size_t)(b * SEQ_ + t2) * PROJW + O_LRU + ch]); }
              X[tl * 65 + j] = s;
              *(bf16_t*)(sXb + lds_rc(tl, j >> 3) + (j & 7) * 2) = f2bf(s);
          } }
        __syncthreads();
        const int wid = tid >> 6, lane = tid & 63, fr = lane & 15, fq = lane >> 4, dir = wid & 1, jf = wid >> 1, j = jf * 16 + fr, ch = h * 64 + j;
        f32x4 G[4][2];
        { const float bav = p.ba[dir * 512 + ch], bxv = p.bx[dir * 512 + ch];
#pragma unroll
          for (int tf = 0; tf < 4; ++tf) { G[tf][0] = (f32x4){bav, bav, bav, bav}; G[tf][1] = (f32x4){bxv, bxv, bxv, bxv}; } }
#pragma unroll
        for (int ks = 0; ks < 2; ++ks) {
            const bf16x8 wA = *(const bf16x8*)(sW + lds_rc((dir * 2 + 0) * 64 + j, ks * 4 + fq));
            const bf16x8 wX = *(const bf16x8*)(sW + lds_rc((dir * 2 + 1) * 64 + j, ks * 4 + fq));
#pragma unroll
            for (int tf = 0; tf < 4; ++tf) {
                const bf16x8 xa = *(const bf16x8*)(sXb + lds_rc(tf * 16 + fr, ks * 4 + fq));
                G[tf][0] = __builtin_amdgcn_mfma_f32_16x16x32_bf16(xa, wA, G[tf][0], 0, 0, 0);
                G[tf][1] = __builtin_amdgcn_mfma_f32_16x16x32_bf16(xa, wX, G[tf][1], 0, 0, 0);
            }
        }
        const float spl = softplus_fast_(-p.lam[dir * 512 + ch]);
        const int tfirst = dir ? (SEQ_ - 1) : 0;
#pragma unroll
        for (int tf = 0; tf < 4; ++tf) {
            float P = 1.f, E = 0.f;
#pragma unroll
            for (int qq = 0; qq < 4; ++qq) {
                const int q = dir ? 3 - qq : qq, tl = tf * 16 + fq * 4 + q, t = k * 64 + tl;
                const float r = sigmoid_fast_(G[tf][0][q]), ig = sigmoid_fast_(G[tf][1][q]);
                const float log_a = -8.0f * r * spl;
                const float x2 = 2.0f * log_a;
                const float om = x2 > -0.02f ? -x2 * (1.0f + x2 * (0.5f + x2 * (1.0f / 6.0f))) : 1.0f - __expf(x2);
                float mult = __builtin_amdgcn_sqrtf(om); if (t == tfirst) mult = 1.0f;
                const float av = __expf(log_a), bv = mult * ig * X[tl * 65 + j];
                G[tf][0][q] = av; G[tf][1][q] = bv;
                E = av * E + bv; P *= av;
            }
            SP[(dir * 16 + tf * 4 + fq) * 64 + j] = P; SE[(dir * 16 + tf * 4 + fq) * 64 + j] = E;
        }
        __syncthreads();
        const size_t sbase = ((size_t)(dir * NB_ + b) * 32) * 512 + ch;
        if (PASS == 0) {
            if (fq == 0) {
                float cP = 1.f, cE = 0.f;
                if (dir == 0) { for (int s = 0; s < 16; ++s) { cE = SP[s * 64 + j] * cE + SE[s * 64 + j]; cP *= SP[s * 64 + j]; } }
                else { for (int s = 15; s >= 0; --s) { cE = SP[(16 + s) * 64 + j] * cE + SE[(16 + s) * 64 + j]; cP *= SP[(16 + s) * 64 + j]; } }
                p.sumP[sbase + (size_t)k * 512] = cP; p.sumE[sbase + (size_t)k * 512] = cE;
            }
        } else {
            float c = 0.f;
            if (dir == 0) { for (int q = 0; q < k; ++q) c = p.sumP[sbase + (size_t)q * 512] * c + p.sumE[sbase + (size_t)q * 512]; }
            else { for (int q = 31; q > k; --q) c = p.sumP[sbase + (size_t)q * 512] * c + p.sumE[sbase + (size_t)q * 512]; }
            float cin[4];
            if (dir == 0) {
#pragma unroll
                for (int s = 0; s < 16; ++s) { if ((s & 3) == fq) cin[s >> 2] = c; c = SP[s * 64 + j] * c + SE[s * 64 + j]; }
            } else {
#pragma unroll
                for (int s = 15; s >= 0; --s) { if ((s & 3) == fq) cin[s >> 2] = c; c = SP[(16 + s) * 64 + j] * c + SE[(16 + s) * 64 + j]; }
            }
            float* Hd = H + dir * 64 * 65;
#pragma unroll
            for (int tf = 0; tf < 4; ++tf) {
                float cc = cin[tf];
#pragma unroll
                for (int qq = 0; qq < 4; ++qq) { const int q = dir ? 3 - qq : qq; cc = G[tf][0][q] * cc + G[tf][1][q]; Hd[(tf * 16 + fq * 4 + q) * 65 + j] = cc; }
            }
            __syncthreads();
            const int j2 = tid & 63, tq = tid >> 6, ch2 = h * 64 + j2;
            bf16_t gq[8];
#pragma unroll
            for (int q = 0; q < 8; ++q) gq[q] = p.proj[(size_t)(b * SEQ_ + k * 64 + tq * 8 + q) * PROJW + O_LRU + 512 + ch2];
#pragma unroll
            for (int q = 0; q < 8; ++q) {
                const int tl = tq * 8 + q; const size_t tok = (size_t)(b * SEQ_ + k * 64 + tl);
                const float g = bf2f(gq[q]);
                p.br[tok * DM_ + 512 + ch2] = f2bf((H[tl * 65 + j2] + H[64 * 65 + tl * 65 + j2]) * gelu_tanh_(g));
            }
        }
    }
}
struct SP_ { const bf16_t* proj; const float* dtraw; const float* cw; const float* cb; const float* dtb; const float* a_log; const float* dsk; const float* ng;
             bf16_t* xa; bf16_t* xT; float* states; float* decay; bf16_t* prev; bf16_t* br; };
#define SSD_Q 128
#define SSD_NC 16

__device__ __forceinline__ void phase_ssd_prep(char* shm, const SP_& p) {
    bf16_t* tile = (bf16_t*)shm;
    for (int unit = bid_opaque(); unit < NB_ * 32 * 16; unit += grid_n()) {
        const int ct = unit & 15, tt = (unit >> 4) & 31, b = unit >> 9;
        const int tid = tid_opaque(), tl = tid >> 3, c8 = (tid & 7) * 8, c = ct * 64 + c8, t = tt * 64 + tl;
        float s[8];
#pragma unroll
        for (int e = 0; e < 8; ++e) s[e] = p.cb[c + e];
#pragma unroll
        for (int k = 0; k < 4; ++k) {
            const int t2 = t + k - 2;
            if (t2 >= 0 && t2 < SEQ_) {
                float x[8]; unpack8(*(const uint4*)(p.proj + (size_t)(b * SEQ_ + t2) * PROJW + O_SSD + 512 + c), x);
                const f32x4 wa = *(const f32x4*)(p.cw + k * 1024 + c), wb = *(const f32x4*)(p.cw + k * 1024 + c + 4);
#pragma unroll
                for (int e = 0; e < 4; ++e) { s[e] += wa[e] * x[e]; s[e + 4] += wb[e] * x[e + 4]; }
            }
        }
        uint4 o; o.x = cvt_pk_bf16(silu_fast_(s[0]), silu_fast_(s[1])); o.y = cvt_pk_bf16(silu_fast_(s[2]), silu_fast_(s[3]));
        o.z = cvt_pk_bf16(silu_fast_(s[4]), silu_fast_(s[5])); o.w = cvt_pk_bf16(silu_fast_(s[6]), silu_fast_(s[7]));
        *(uint4*)(p.xa + (size_t)(b * SEQ_ + t) * 1024 + c) = o;
        __syncthreads();
        tile[(c8 + 0) * 72 + tl] = (bf16_t)(o.x & 0xffffu); tile[(c8 + 1) * 72 + tl] = (bf16_t)(o.x >> 16); tile[(c8 + 2) * 72 + tl] = (bf16_t)(o.y & 0xffffu); tile[(c8 + 3) * 72 + tl] = (bf16_t)(o.y >> 16);
        tile[(c8 + 4) * 72 + tl] = (bf16_t)(o.z & 0xffffu); tile[(c8 + 5) * 72 + tl] = (bf16_t)(o.z >> 16); tile[(c8 + 6) * 72 + tl] = (bf16_t)(o.w & 0xffffu); tile[(c8 + 7) * 72 + tl] = (bf16_t)(o.w >> 16);
        __syncthreads();
        { const int c2 = tid >> 3, t8 = (tid & 7) * 8;
          *(uint4*)(p.xT + ((size_t)b * 1024 + ct * 64 + c2) * SEQ_ + tt * 64 + t8) = *(const uint4*)(tile + c2 * 72 + t8); }
    }
}
__device__ __forceinline__ void ssd_tables(float* dtv, float* cum, const SP_& p, int b, int c, int g) {
    const int tid = tid_opaque();
    for (int i = tid; i < 8 * SSD_Q; i += 512) {
        const int l = i & 127, hd = i >> 7, dir = hd >> 2, j = hd & 3, h = g * 4 + j;
        dtv[i] = softplus_fast_(p.dtraw[(size_t)(b * SEQ_ + c * SSD_Q + l) * 16 + dir * 8 + h] + p.dtb[dir * 8 + h]);
    }
    __syncthreads();
    const int t8 = tid_opaque();
    if (t8 < 8) {
        const int dir = t8 >> 2, j = t8 & 3, h = g * 4 + j; const float a = -__expf(p.a_log[dir * 8 + h]);
        float s = 0.f;
        if (dir == 0) for (int l = 0; l < SSD_Q; ++l) { s += dtv[t8 * 128 + l] * a; cum[t8 * 128 + l] = s; }
        else for (int l = SSD_Q - 1; l >= 0; --l) { s += dtv[t8 * 128 + l] * a; cum[t8 * 128 + l] = s; }
    }
    __syncthreads();
}
#define SSD1_LDS (65536 + 32768 + 8192)
__device__ __forceinline__ void phase_ssd_states(char* shm, const SP_& p) {
    char* sX = shm;
    char* sB = shm + 65536;
    float* dtv = (float*)(shm + 98304); float* cum = dtv + 1024;
    for (int unit = bid_opaque(); unit < NB_ * SSD_NC * 2 * 2; unit += grid_n()) {
        const int hp = unit & 1, g = (unit >> 1) & 1, c = (unit >> 2) & 15, b = unit >> 6;
        const int tid = tid_opaque(), wid = tid >> 6, lane = tid & 63, fr = lane & 15, fq = lane >> 4;
        __syncthreads();
        for (int i = tid; i < 128 * 16; i += 512) { const int row = i >> 4, ch = i & 15;
            *(uint4*)(sX + row * 256 + ((ch ^ (row & 15)) * 16)) = *(const uint4*)(p.xT + ((size_t)b * 1024 + g * 256 + hp * 128 + row) * SEQ_ + c * SSD_Q + ch * 8); }
        for (int i = tid; i < 128 * 16; i += 512) { const int row = i >> 4, ch = i & 15;
            *(uint4*)(sB + row * 256 + ((ch ^ (row & 15)) * 16)) = *(const uint4*)(p.xT + ((size_t)b * 1024 + 512 + g * 128 + row) * SEQ_ + c * SSD_Q + ch * 8); }
        ssd_tables(dtv, cum, p, b, c, g);
        const int jj = wid >> 2, dir = (wid >> 1) & 1, nh = wid & 1, j = hp * 2 + jj, hd = dir * 4 + j, h = g * 4 + j;
        const float* dth = dtv + hd * 128; const float* cm = cum + hd * 128;
        const float cend = dir ? cm[0] : cm[SSD_Q - 1];
        f32x4 acc[4][4];
#pragma unroll
        for (int pf = 0; pf < 4; ++pf)
#pragma unroll
            for (int nf = 0; nf < 4; ++nf) acc[pf][nf] = (f32x4){0.f, 0.f, 0.f, 0.f};
#pragma unroll 1
        for (int ks = 0; ks < 4; ++ks) {
            float sc[8];
#pragma unroll
            for (int e = 0; e < 8; ++e) { const int l = ks * 32 + fq * 8 + e; sc[e] = dth[l] * __expf(cend - cm[l]); }
            bf16x8 af[4];
#pragma unroll
            for (int pf = 0; pf < 4; ++pf) {
                const int row = jj * 64 + pf * 16 + fr, ch = ks * 4 + fq;
                const i32x4 raw = *(const i32x4*)(sX + row * 256 + ((ch ^ (row & 15)) * 16));
                i32x4 o;
#pragma unroll
                for (int q = 0; q < 4; ++q) { const unsigned u = (unsigned)raw[q]; o[q] = (int)cvt_pk_bf16(__uint_as_float(u << 16) * sc[2 * q], __uint_as_float(u & 0xffff0000u) * sc[2 * q + 1]); }
                af[pf] = __builtin_bit_cast(bf16x8, o);
            }
#pragma unroll
            for (int nf = 0; nf < 4; ++nf) {
                const int row = nh * 64 + nf * 16 + fr, ch = ks * 4 + fq;
                const bf16x8 bfr = *(const bf16x8*)(sB + row * 256 + ((ch ^ (row & 15)) * 16));
#pragma unroll
                for (int pf = 0; pf < 4; ++pf) acc[pf][nf] = __builtin_amdgcn_mfma_f32_16x16x32_bf16(bfr, af[pf], acc[pf][nf], 0, 0, 0);
            }
        }
        float* st = p.states + ((((size_t)(b * SSD_NC + c) * 8 + h) * 2 + dir) * 64) * 128;
        float* rp = st + (size_t)fr * 128 + nh * 64 + fq * 4;
#pragma unroll
        for (int pf = 0; pf < 4; ++pf)
#pragma unroll
            for (int nf = 0; nf < 4; ++nf) *(f32x4*)(rp + pf * 16 * 128 + nf * 16) = acc[pf][nf];
        if (lane == 0 && nh == 0) p.decay[((b * SSD_NC + c) * 8 + h) * 2 + dir] = __expf(cend);
    }
}
__device__ __forceinline__ void phase_ssd_scan(const SP_& p) {
    for (int idx = bid_opaque() * 512 + tid_opaque(); idx < NB_ * 8 * 2 * 64 * 32; idx += grid_n() * 512) {
        const int n4 = idx & 31, pp = (idx >> 5) & 63, dir = (idx >> 11) & 1, h = (idx >> 12) & 7, b = idx >> 15;
        f32x4 s = (f32x4){0.f, 0.f, 0.f, 0.f};
#pragma unroll 1
        for (int half = 0; half < 2; ++half) {
            f32x4 st[8]; float dc[8];
#pragma unroll
            for (int q = 0; q < 8; ++q) {
                const int cc = half * 8 + q, c = dir ? (SSD_NC - 1 - cc) : cc;
                st[q] = *(const f32x4*)(p.states + ((((size_t)(b * SSD_NC + c) * 8 + h) * 2 + dir) * 64 + pp) * 128 + n4 * 4);
                dc[q] = p.decay[((b * SSD_NC + c) * 8 + h) * 2 + dir];
            }
#pragma unroll
            for (int q = 0; q < 8; ++q) {
                const int cc = half * 8 + q, c = dir ? (SSD_NC - 1 - cc) : cc;
                const size_t o = ((((size_t)(b * SSD_NC + c) * 8 + h) * 2 + dir) * 64 + pp) * 128 + n4 * 4;
                uint2 w; w.x = cvt_pk_bf16(s[0], s[1]); w.y = cvt_pk_bf16(s[2], s[3]);
                *(uint2*)(p.prev + o) = w;
                s = s * dc[q] + st[q];
            }
        }
    }
}
#define SSD3_LDS (32768 + 65536 + 32768 + 8192 + 512)
__device__ __forceinline__ void phase_ssd_out(char* shm, const SP_& p) {
    char* sB = shm;
    char* sX = shm + 32768;
    char* sC = shm + 98304;
    float* dtv = (float*)(shm + 131072); float* cum = dtv + 1024; float* ssx = cum + 1024;
    for (int unit = bid_opaque(); unit < NB_ * SSD_NC * 2 * 2; unit += grid_n()) {
        const int half_ = unit & 1, g = (unit >> 1) & 1, c = (unit >> 2) & 15, b = unit >> 6;
        const int tid = tid_opaque(), wid = tid >> 6, lane = tid & 63, fr = lane & 15, fq = lane >> 4;
        __syncthreads();
        for (int i = tid; i < 128 * 16; i += 512) { const int row = i >> 4, ch = i & 15; const bf16_t* src_ = p.xa + (size_t)(b * SEQ_ + c * SSD_Q + row) * 1024 + 512 + g * 128 + ch * 8;
            *(uint4*)(sB + row * 256 + ((ch ^ (row & 15)) * 16)) = *(const uint4*)src_;
            *(uint4*)(sC + row * 256 + ((ch ^ (row & 15)) * 16)) = *(const uint4*)(src_ + 256); }
        for (int i = tid; i < 256 * 16; i += 512) { const int row = i >> 4, ch = i & 15, x = row & 15;
            uint4 v = *(const uint4*)(p.xT + ((size_t)b * 1024 + g * 256 + row) * SEQ_ + c * SSD_Q + ch * 8);
            if (x & 1) v = make_uint4(v.z, v.w, v.x, v.y);
            *(uint4*)(sX + row * 256 + ((ch ^ (x >> 1)) * 16)) = v; }
        ssd_tables(dtv, cum, p, b, c, g);
        const int hp = wid >> 2, lrow = half_ * 64 + (wid & 3) * 16 + fr;
        const size_t tok = (size_t)(b * SEQ_ + c * SSD_Q + lrow);
#define SSD_CF(ks_) (*(const bf16x8*)(sC + lrow * 256 + ((((ks_) * 4 + fq) ^ (lrow & 15)) * 16)))
        f32x4 G[8];
#pragma unroll
        for (int sf = 0; sf < 8; ++sf) {
            f32x4 a = (f32x4){0.f, 0.f, 0.f, 0.f};
#pragma unroll
            for (int ks = 0; ks < 4; ++ks) {
                const int row = sf * 16 + fr, ch = ks * 4 + fq;
                const bf16x8 bfr = *(const bf16x8*)(sB + row * 256 + ((ch ^ (row & 15)) * 16));
                a = __builtin_amdgcn_mfma_f32_16x16x32_bf16(bfr, SSD_CF(ks), a, 0, 0, 0);
            }
            G[sf] = a;
        }
        f32x4 Y[2][4];
#pragma unroll
        for (int jj = 0; jj < 2; ++jj)
#pragma unroll
            for (int pf = 0; pf < 4; ++pf) Y[jj][pf] = (f32x4){0.f, 0.f, 0.f, 0.f};
#pragma unroll
        for (int jj = 0; jj < 2; ++jj) {
            const int j = hp * 2 + jj;
#pragma unroll 1
            for (int dir = 0; dir < 2; ++dir) {
                const int hd = dir * 4 + j, h = g * 4 + j;
                const float* dth = dtv + hd * 128; const float* cm = cum + hd * 128;
                const float cl = cm[lrow];
#pragma unroll
                for (int g2 = 0; g2 < 4; ++g2) {
                    float e[8];
#pragma unroll
                    for (int half = 0; half < 2; ++half)
#pragma unroll
                        for (int q = 0; q < 4; ++q) {
                            const int sf = 2 * g2 + half, s = sf * 16 + fq * 4 + q;
                            const bool keep = dir ? (s >= lrow) : (s <= lrow);
                            const float v = G[sf][q] * __expf(keep ? (cl - cm[s]) : 0.f) * dth[s];
                            e[half * 4 + q] = keep ? v : 0.f;
                        }
                    i32x4 w; w[0] = (int)cvt_pk_bf16(e[0], e[1]); w[1] = (int)cvt_pk_bf16(e[2], e[3]); w[2] = (int)cvt_pk_bf16(e[4], e[5]); w[3] = (int)cvt_pk_bf16(e[6], e[7]);
                    const bf16x8 Pf = __builtin_bit_cast(bf16x8, w);
#pragma unroll
                    for (int pf = 0; pf < 4; ++pf) {
                        const int row = j * 64 + pf * 16 + fr, x = row & 15;
                        const uint2 v0 = *(const uint2*)(sX + row * 256 + (((8 * g2 + fq) ^ x) * 8));
                        const uint2 v1 = *(const uint2*)(sX + row * 256 + (((8 * g2 + 4 + fq) ^ x) * 8));
                        const i32x4 wv = (i32x4){(int)v0.x, (int)v0.y, (int)v1.x, (int)v1.y};
                        Y[jj][pf] = __builtin_amdgcn_mfma_f32_16x16x32_bf16(__builtin_bit_cast(bf16x8, wv), Pf, Y[jj][pf], 0, 0, 0);
                    }
                    __builtin_amdgcn_sched_barrier(0);
                }
                const bf16_t* pv = p.prev + ((((size_t)(b * SSD_NC + c) * 8 + h) * 2 + dir) * 64) * 128;
                const float el = __expf(cl);
#pragma unroll
                for (int pf = 0; pf < 4; ++pf) {
                    f32x4 t = (f32x4){0.f, 0.f, 0.f, 0.f};
#pragma unroll
                    for (int ks = 0; ks < 4; ++ks) {
                        const bf16x8 pa = *(const bf16x8*)(pv + (size_t)(pf * 16 + fr) * 128 + ks * 32 + fq * 8);
                        t = __builtin_amdgcn_mfma_f32_16x16x32_bf16(pa, SSD_CF(ks), t, 0, 0, 0);
                    }
                    Y[jj][pf] += t * el;
                    __builtin_amdgcn_sched_barrier(0);
                }
            }
        }
        const int te = tid_opaque(); const int fqe = (te & 63) >> 4, wde = te >> 6, hpe = wde >> 2; const size_t toke = (size_t)(b * SEQ_ + c * SSD_Q + half_ * 64 + (wde & 3) * 16 + (te & 15));
        float ss = 0.f;
        uint2 xva[2][4], zva[2][4]; f32x4 gva[2][4];
#pragma unroll
        for (int jj = 0; jj < 2; ++jj)
#pragma unroll
            for (int pf = 0; pf < 4; ++pf) { const int cch = g * 256 + (hpe * 2 + jj) * 64 + pf * 16 + fqe * 4;
                xva[jj][pf] = *(const uint2*)(p.xa + toke * 1024 + cch); zva[jj][pf] = *(const uint2*)(p.proj + toke * PROJW + O_SSD + cch); gva[jj][pf] = *(const f32x4*)(p.ng + cch); }
#pragma unroll
        for (int jj = 0; jj < 2; ++jj) {
            const float dk = p.dsk[g * 4 + hpe * 2 + jj];
#pragma unroll
            for (int pf = 0; pf < 4; ++pf) {
                const uint2 xv = xva[jj][pf];
                const uint2 zv = zva[jj][pf];
                const float xs[4] = {__uint_as_float(xv.x << 16), __uint_as_float(xv.x & 0xffff0000u), __uint_as_float(xv.y << 16), __uint_as_float(xv.y & 0xffff0000u)};
                const float zs[4] = {__uint_as_float(zv.x << 16), __uint_as_float(zv.x & 0xffff0000u), __uint_as_float(zv.y << 16), __uint_as_float(zv.y & 0xffff0000u)};
#pragma unroll
                for (int q = 0; q < 4; ++q) { const float y = (Y[jj][pf][q] + dk * xs[q]) * silu_fast_(zs[q]); Y[jj][pf][q] = y; ss += y * y; }
                __builtin_amdgcn_sched_barrier(0);
            }
        }
        ss += __shfl_xor(ss, 16, 64); ss += __shfl_xor(ss, 32, 64);
        if (fqe == 0) ssx[wde * 16 + (te & 15)] = ss;
        __syncthreads();
        ss += ssx[(wde ^ 4) * 16 + (te & 15)];
        const float rs = rsqrtf(ss * (1.0f / 256.0f) + 1e-6f);
#pragma unroll
        for (int jj = 0; jj < 2; ++jj)
#pragma unroll
            for (int pf = 0; pf < 4; ++pf) {
                const int cch = g * 256 + (hpe * 2 + jj) * 64 + pf * 16 + fqe * 4;
                const f32x4 gv = gva[jj][pf];
                uint2 o; o.x = cvt_pk_bf16(Y[jj][pf][0] * rs * gv[0], Y[jj][pf][1] * rs * gv[1]); o.y = cvt_pk_bf16(Y[jj][pf][2] * rs * gv[2], Y[jj][pf][3] * rs * gv[3]);
                *(uint2*)(p.br + toke * DM_ + 1536 + cch) = o;
                __builtin_amdgcn_sched_barrier(0);
            }
    }
}
struct GP {
    const bf16_t* A; const bf16_t* Bt; const float* B; const float* B2; const float* bias; const float* R; float* Cf; bf16_t* Cb; bf16_t* Cb2; bf16_t* Vt; const bf16_t* G;
    const int* idx; const float* gate;
};
#ifndef GS_ROWS
#define GS_ROWS 8
#endif
__device__ __forceinline__ void static_order(int L, int nM, int nN, int& pm, int& pn) {
    const int nwg = nM * nN; int wgid = L;
    { const int q = nwg / 8, r = nwg % 8, xcd = wgid % 8, off = wgid / 8; wgid = (xcd < r ? xcd * (q + 1) : r * (q + 1) + (xcd - r) * q) + off; }
    const int nig = GS_ROWS * nN, gid = wgid / nig, fm = gid * GS_ROWS, gsz = (nM - fm) < GS_ROWS ? (nM - fm) : GS_ROWS;
    pm = fm + ((wgid % nig) % gsz); pn = (wgid % nig) / gsz;
}
#define LANE_IDS(t_) const int wid = (t_) >> 6, lane = (t_) & 63, wr = wid >> 2, wc = wid & 3, fr = lane & 15, fq = lane >> 4; (void)wr; (void)wc; (void)fr; (void)fq;
#define ZERO_ACC(acc, FM_) _Pragma("unroll") for (int m = 0; m < FM_; ++m) _Pragma("unroll") for (int n = 0; n < 4; ++n) acc[m][n] = (f32x4){0.f, 0.f, 0.f, 0.f}

__device__ __forceinline__ void phase_inproj(char* shm, const GP& p) {
    typedef GemmCore<256, false> G;
    for (int L = bid_opaque(); L < 32 * 54; L += grid_n()) {
        int pm, pn; static_order(L, 32, 54, pm, pn);
        const int col0 = pn < 22 ? pn * 256 : O_GATE + (pn - 22) * 256;
        f32x4 acc[8][4]; ZERO_ACC(acc, 8);
        {
            const int t0 = tid_opaque();
            unsigned aoff[G::GLA], boff[4];
#pragma unroll
            for (int i = 0; i < G::GLA; ++i) { int R, C; G::a_coord(t0, i, R, C); aoff[i] = (unsigned)((R * DM_ + C) * 2); }
#pragma unroll
            for (int i = 0; i < 4; ++i) { int cc, C; G::bt_coord(t0, i, cc, C); boff[i] = (unsigned)((cc * DM_ + C) * 2); }
            const char* pf = t0 < 256 ? (const char*)(p.A + (size_t)(pm * 256 + t0) * DM_) : (const char*)(p.Bt + (size_t)(pn * 256 + t0 - 256) * DM_);
            G::run_bt(shm, (const char*)(p.A + (size_t)pm * 256 * DM_), aoff, (const char*)(p.Bt + (size_t)pn * 256 * DM_), boff, DM_ * 2, pf, DM_ / 64, acc);
        }
        const int t1 = tid_opaque(); LANE_IDS(t1)
        const int cl = wc * 64 + 4 * fr;
        if (pn == 14 || pn == 15) {
            const int t0_ = pm * 256 + wr * 128 + fq * 4, bb = t0_ >> 11, tl = t0_ & (SEQ_ - 1);
            bf16_t* vp = p.Vt + (size_t)(bb * 512 + (pn - 14) * 256 + cl) * SEQ_ + tl;
#pragma unroll
            for (int m = 0; m < 8; ++m)
#pragma unroll
                for (int n = 0; n < 4; ++n) {
                    uint2 o; o.x = cvt_pk_bf16(acc[m][n][0], acc[m][n][1]); o.y = cvt_pk_bf16(acc[m][n][2], acc[m][n][3]);
                    *(uint2*)(vp + (size_t)n * SEQ_ + m * 16) = o;
                }
        } else if (pn < 22) {
#pragma unroll
            for (int m = 0; m < 8; ++m)
#pragma unroll
                for (int j = 0; j < 4; ++j) {
                    const int row = pm * 256 + wr * 128 + m * 16 + fq * 4 + j;
                    uint2 o; o.x = cvt_pk_bf16(acc[m][0][j], acc[m][1][j]); o.y = cvt_pk_bf16(acc[m][2][j], acc[m][3][j]);
                    *(uint2*)(p.Cb + (size_t)row * PROJW + pn * 256 + cl) = o;
                }
        } else {
            const int gc = (pn - 22) * 256 + cl;
            const f32x4 bg = *(const f32x4*)(p.bias + gc);
#pragma unroll
            for (int m = 0; m < 8; ++m)
#pragma unroll
                for (int j = 0; j < 4; ++j) {
                    const int row = pm * 256 + wr * 128 + m * 16 + fq * 4 + j;
                    uint2 o; o.x = cvt_pk_bf16(sigmoid_fast_(acc[m][0][j] + bg[0]), sigmoid_fast_(acc[m][1][j] + bg[1])); o.y = cvt_pk_bf16(sigmoid_fast_(acc[m][2][j] + bg[2]), sigmoid_fast_(acc[m][3][j] + bg[3]));
                    *(uint2*)(p.Cb2 + (size_t)row * 8192 + gc) = o;
                }
        }
    }
}
__device__ __forceinline__ void phase_merge(char* shm, const GP& p) {
    typedef GemmCore<128, false> G;
    for (int L = bid_opaque(); L < 64 * 8; L += grid_n()) {
        int pm, pn; static_order(L, 64, 8, pm, pn);
        f32x4 mg[4][4]; ZERO_ACC(mg, 4);
        f32x4 acc[4][4]; ZERO_ACC(acc, 4);
        {
            const int t0 = tid_opaque();
            unsigned aoff[G::GLA], boff[4];
#pragma unroll
            for (int i = 0; i < G::GLA; ++i) { int R, C; G::a_coord(t0, i, R, C); aoff[i] = (unsigned)((R * DM_ + C) * 2); }
#pragma unroll
            for (int i = 0; i < 4; ++i) { int cc, C; G::bt_coord(t0, i, cc, C); boff[i] = (unsigned)((cc * 512 + C) * 2); }
            const bf16_t* gates = p.G;
            auto seg_epi = [&acc, &mg, gates, pm, pn](int k) __attribute__((always_inline)) {
                const int t1 = tid_opaque(); LANE_IDS(t1)
                const bf16_t* gp = gates + (size_t)(pm * 128 + wr * 64 + fq * 4) * 8192 + k * DM_ + pn * 256 + wc * 64 + 4 * fr;
#pragma unroll
                for (int m = 0; m < 4; ++m) {
#pragma unroll
                    for (int j = 0; j < 4; ++j) {
                        const uint2 gv = *(const uint2*)(gp + (size_t)(m * 16 + j) * 8192);
                        mg[m][0][j] += __uint_as_float(gv.x << 16) * acc[m][0][j]; mg[m][1][j] += __uint_as_float(gv.x & 0xffff0000u) * acc[m][1][j];
                        mg[m][2][j] += __uint_as_float(gv.y << 16) * acc[m][2][j]; mg[m][3][j] += __uint_as_float(gv.y & 0xffff0000u) * acc[m][3][j];
                    }
#pragma unroll
                    for (int n = 0; n < 4; ++n) acc[m][n] = (f32x4){0.f, 0.f, 0.f, 0.f};
                    __builtin_amdgcn_sched_barrier(0);
                }
            };
            G::template run_bt_seg<8>(shm, (const char*)(p.A + (size_t)pm * 128 * DM_), aoff, (const char*)(p.Bt + (size_t)pn * 256 * 512), boff, 512 * 2, (size_t)DM_ * 512 * 2,
                                      (const char*)(p.A + (size_t)pm * 128 * DM_), 32, acc, seg_epi);
        }
        const int t2 = tid_opaque(); LANE_IDS(t2)
        bf16_t* op = p.Cb + (size_t)(pm * 128 + wr * 64 + fq * 4) * DM_ + pn * 256 + wc * 64 + 4 * fr;
#pragma unroll
        for (int m = 0; m < 4; ++m)
#pragma unroll
            for (int j = 0; j < 4; ++j) {
                uint2 o; o.x = cvt_pk_bf16(mg[m][0][j], mg[m][1][j]); o.y = cvt_pk_bf16(mg[m][2][j], mg[m][3][j]);
                *(uint2*)(op + (size_t)(m * 16 + j) * DM_) = o;
            }
    }
}
__device__ __forceinline__ void phase_outproj(char* shm, const GP& p) {
    typedef GemmCore<256, false> G;
    for (int L = bid_opaque(); L < 32 * 8; L += grid_n()) {
        int pm, pn; static_order(L, 32, 8, pm, pn);
        f32x4 acc[8][4]; ZERO_ACC(acc, 8);
        {
            const int t0 = tid_opaque();
            unsigned aoff[G::GLA], boff[4];
#pragma unroll
            for (int i = 0; i < G::GLA; ++i) { int R, C; G::a_coord(t0, i, R, C); aoff[i] = (unsigned)((R * DM_ + C) * 2); }
#pragma unroll
            for (int i = 0; i < 4; ++i) { int cc, C; G::bt_coord(t0, i, cc, C); boff[i] = (unsigned)((cc * DM_ + C) * 2); }
            const char* pf = t0 < 256 ? (const char*)(p.A + (size_t)(pm * 256 + t0) * DM_) : (const char*)(p.Bt + (size_t)(pn * 256 + t0 - 256) * DM_);
            G::run_bt(shm, (const char*)(p.A + (size_t)pm * 256 * DM_), aoff, (const char*)(p.Bt + (size_t)pn * 256 * DM_), boff, DM_ * 2, pf, DM_ / 64, acc);
        }
        const int t1 = tid_opaque(); LANE_IDS(t1)
        const size_t o0 = (size_t)(pm * 256 + wr * 128 + fq * 4) * DM_ + pn * 256 + wc * 64 + 4 * fr;
#pragma unroll
        for (int m = 0; m < 8; ++m)
#pragma unroll
            for (int j = 0; j < 4; ++j) {
                const size_t o = o0 + (size_t)(m * 16 + j) * DM_;
                const f32x4 r = *(const f32x4*)(p.R + o);
                *(f32x4*)(p.Cf + o) = (f32x4){r[0] + acc[m][0][j], r[1] + acc[m][1][j], r[2] + acc[m][2][j], r[3] + acc[m][3][j]};
            }
    }
}
__device__ __forceinline__ void phase_moe_up(char* shm, const GP& p) {
    typedef GemmCore<256, true> G;
    for (int L = bid_opaque(); L < 64 * 16; L += grid_n()) {
        const int xcd = L & 7, wg = xcd * 128 + (L >> 3), b = wg & 3, pair = wg >> 2, e = pair >> 4, nt = pair & 15, z = b * 16 + e;
        f32x4 acc[8][4]; ZERO_ACC(acc, 8);
        {
            const int t0 = tid_opaque(); int bk, bc, bw; G::b_coord(t0, bk, bc, bw);
            unsigned aoff[G::GLA];
#pragma unroll
            for (int i = 0; i < G::GLA; ++i) { int R, C; G::a_coord(t0, i, R, C); aoff[i] = (unsigned)(((b * SEQ_ + p.idx[z * 256 + R]) * DM_ + C) * 2); }
            const float* wsel = bw ? p.B2 : p.B;
            G::run(shm, (const char*)p.A, aoff, (const char*)(wsel + (size_t)e * DM_ * DM_ + (size_t)bk * DM_ + nt * 128 + bc), DM_ * 4, DM_ / 64, acc);
        }
        const int t1 = tid_opaque(); LANE_IDS(t1)
        const int hi = (fr >> 3) & 1;
        bf16_t* op = p.Cb + (size_t)(z * 256 + wr * 128 + fq * 4) * DM_ + nt * 128 + wc * 32 + 4 * (fr & 7);
#pragma unroll
        for (int mm = 0; mm < 4; ++mm)
#pragma unroll
            for (int j = 0; j < 4; ++j) {
                float a[4], g[4];
#pragma unroll
                for (int n = 0; n < 4; ++n) {
                    const float lo = acc[mm][n][j], hv = acc[mm + 4][n][j];
                    const float send = hi ? lo : hv;
                    const float recv = __shfl_xor(send, 8, 64);
                    a[n] = hi ? recv : lo;
                    g[n] = hi ? hv : recv;
                }
                uint2 o; o.x = cvt_pk_bf16(silu_fast_(a[0]) * g[0], silu_fast_(a[1]) * g[1]); o.y = cvt_pk_bf16(silu_fast_(a[2]) * g[2], silu_fast_(a[3]) * g[3]);
                *(uint2*)(op + (size_t)((mm + 4 * hi) * 16 + j) * DM_) = o;
            }
    }
}
__device__ __forceinline__ void phase_moe_down(char* shm, const GP& p) {
    typedef GemmCore<256, false> G;
    for (int L = bid_opaque(); L < 64 * 8; L += grid_n()) {
        const int xcd = L & 7, wg = xcd * 64 + (L >> 3), b = wg & 3, pair = wg >> 2, e = pair >> 3, nt = pair & 7, z = b * 16 + e;
        f32x4 acc[8][4]; ZERO_ACC(acc, 8);
        {
            const int t0 = tid_opaque(); int bk, bc, bw; G::b_coord(t0, bk, bc, bw);
            unsigned aoff[G::GLA];
#pragma unroll
            for (int i = 0; i < G::GLA; ++i) { int R, C; G::a_coord(t0, i, R, C); aoff[i] = (unsigned)((R * DM_ + C) * 2); }
            G::run(shm, (const char*)(p.A + (size_t)z * 256 * DM_), aoff, (const char*)(p.B + (size_t)e * DM_ * DM_ + (size_t)bk * DM_ + nt * 256 + bc), DM_ * 4, DM_ / 64, acc);
        }
        const int t1 = tid_opaque(); LANE_IDS(t1)
        const int row0 = z * 256 + wr * 128 + fq * 4;
        bf16_t* op = p.Cb + (size_t)row0 * DM_ + nt * 256 + wc * 64 + 4 * fr;
        f32x4 gtv[8];
#pragma unroll
        for (int m = 0; m < 8; ++m) gtv[m] = *(const f32x4*)(p.gate + row0 + m * 16);
#pragma unroll
        for (int m = 0; m < 8; ++m)
#pragma unroll
            for (int j = 0; j < 4; ++j) {
                const float gt = gtv[m][j];
                uint2 o; o.x = cvt_pk_bf16(gt * acc[m][0][j], gt * acc[m][1][j]); o.y = cvt_pk_bf16(gt * acc[m][2][j], gt * acc[m][3][j]);
                *(uint2*)(op + (size_t)(m * 16 + j) * DM_) = o;
            }
    }
}

namespace pg8 {
#define PG8_LAS __attribute__((address_space(3)))
constexpr int BM = 256, BK = 64, HALF = 128, HTB = HALF * BK * 2  , STAGE_BYTES = 8 * HTB;
__device__ __forceinline__ int lds_byte(int r, int c) { const int st = (r >> 4) * 2 + (c >> 5), rr = r & 15, cc = c & 31, ob = rr * 64 + cc * 2; return st * 1024 + (ob ^ (((ob >> 9) & 1) << 5)); }
__device__ __forceinline__ void stage_rc(int b, int& R, int& C) { const int st = b / 1024, sb = b % 1024, swz = sb ^ (((sb >> 9) & 1) << 5); R = (st >> 1) * 16 + swz / 64; C = (st & 1) * 32 + (swz % 64) / 2; }
__device__ __forceinline__ int perm32(int rho) { const int n = rho >> 4, i = rho & 15; return 8 * (i >> 2) + 4 * n + (i & 3); }
struct Unit { int pm, pn, kz; };
struct Gemm { const bf16_t* A; const bf16_t* Bt; int M, N, K, lda, ldb; };
struct MegaOrder {
    static constexpr bool GATHER = false;
    int nM, nN, G, c;
    __device__ __forceinline__ unsigned a_off(const Gemm& g, int R, int C) const { return (unsigned)(R * g.lda + C) * 2u; }
    __device__ __forceinline__ bool next(int i, Unit& u) const { const int L = i * G + c; if (L >= nM * nN) return false; int pm, pn; static_order(L, nM, nN, pm, pn); u.pm = pm; u.pn = pn; u.kz = 0; return true; }
    __device__ __forceinline__ void base(const Gemm& g, const Unit& u, const char*& a, const char*& b) const { a = (const char*)g.A + (size_t)u.pm * BM * g.lda * 2; b = (const char*)g.Bt + (size_t)u.pn * BM * g.ldb * 2; }
    __device__ __forceinline__ void a_ready(const Unit&) const {}
    __device__ __forceinline__ void done(const Unit&) const {}
};
__device__ __forceinline__ uint4 pack8_bf16(const f32x4& a, const f32x4& b) { return make_uint4(cvt_pk_bf16(a[0], a[1]), cvt_pk_bf16(a[2], a[3]), cvt_pk_bf16(b[0], b[1]), cvt_pk_bf16(b[2], b[3])); }
struct EpiInproj {
    static constexpr bool PERM = true, AFTER_DRAIN = false;
    bf16_t* proj; bf16_t* gates; bf16_t* vt; const float* bgate;
    __device__ __forceinline__ void operator()(const f32x4 (&acc)[2][2][4][2], const Unit& u, int wr, int wc, int fr, int fq) const {
        const int row0 = u.pm * BM + wr * 64 + fr, cb = wc * 32 + 8 * fq;
        if (u.pn == 14 || u.pn == 15) {
            const int bb = row0 >> 11;
#pragma unroll
            for (int ai = 0; ai < 2; ++ai)
#pragma unroll
                for (int m = 0; m < 4; ++m) { const int t = (row0 + ai * HALF + m * 16) & (SEQ_ - 1);
#pragma unroll
                    for (int bj = 0; bj < 2; ++bj)
#pragma unroll
                        for (int n = 0; n < 2; ++n)
#pragma unroll
                            for (int e = 0; e < 4; ++e) vt[(size_t)(bb * 512 + (u.pn - 14) * 256 + bj * HALF + cb + 4 * n + e) * SEQ_ + t] = f2bf(acc[ai][bj][m][n][e]); }
        } else if (u.pn < 22) {
#pragma unroll
            for (int ai = 0; ai < 2; ++ai)
#pragma unroll
                for (int m = 0; m < 4; ++m) { bf16_t* rowp = proj + (size_t)(row0 + ai * HALF + m * 16) * PROJW + u.pn * BM + cb;
#pragma unroll
                    for (int bj = 0; bj < 2; ++bj) *(uint4*)(rowp + bj * HALF) = pack8_bf16(acc[ai][bj][m][0], acc[ai][bj][m][1]); }
        } else {
            const int gc = (u.pn - 22) * BM + cb;
            f32x4 bv[2][2];
#pragma unroll
            for (int bj = 0; bj < 2; ++bj) { bv[bj][0] = *(const f32x4*)(bgate + gc + bj * HALF); bv[bj][1] = *(const f32x4*)(bgate + gc + bj * HALF + 4); }
#pragma unroll
            for (int ai = 0; ai < 2; ++ai)
#pragma unroll
                for (int m = 0; m < 4; ++m) { bf16_t* rowp = gates + (size_t)(row0 + ai * HALF + m * 16) * 8192 + gc;
#pragma unroll
                    for (int bj = 0; bj < 2; ++bj) { f32x4 v0 = acc[ai][bj][m][0] + bv[bj][0], v1 = acc[ai][bj][m][1] + bv[bj][1];
#pragma unroll
                        for (int e = 0; e < 4; ++e) { v0[e] = sigmoid_fast_(v0[e]); v1[e] = sigmoid_fast_(v1[e]); }
                        *(uint4*)(rowp + bj * HALF) = pack8_bf16(v0, v1); } }
        }
    }
};
struct EpiOutproj {
    static constexpr bool PERM = false, AFTER_DRAIN = false;
    const float* R; float* C;
    __device__ __forceinline__ void operator()(const f32x4 (&acc)[2][2][4][2], const Unit& u, int wr, int wc, int fr, int fq) const {
        const int row0 = u.pm * BM + wr * 64 + fr, col0 = u.pn * BM + wc * 32 + 4 * fq;
#pragma unroll
        for (int ai = 0; ai < 2; ++ai) {
            f32x4 rv[4][2][2];
#pragma unroll
            for (int m = 0; m < 4; ++m) { const size_t ro = (size_t)(row0 + ai * HALF + m * 16) * DM_ + col0;
#pragma unroll
                for (int bj = 0; bj < 2; ++bj)
#pragma unroll
                    for (int n = 0; n < 2; ++n) rv[m][bj][n] = *(const f32x4*)(R + ro + bj * HALF + n * 16); }
            __builtin_amdgcn_sched_barrier(0);
#pragma unroll
            for (int m = 0; m < 4; ++m) { const size_t ro = (size_t)(row0 + ai * HALF + m * 16) * DM_ + col0;
#pragma unroll
                for (int bj = 0; bj < 2; ++bj)
#pragma unroll
                    for (int n = 0; n < 2; ++n) *(f32x4*)(C + ro + bj * HALF + n * 16) = rv[m][bj][n] + acc[ai][bj][m][n]; }
            __builtin_amdgcn_sched_barrier(0);
        }
    }
};
struct OneUnit {
    static constexpr bool GATHER = false;
    __device__ __forceinline__ bool next(int i, Unit& u) const { if (i) return false; u.pm = 0; u.pn = 0; u.kz = 0; return true; }
    __device__ __forceinline__ void base(const Gemm& g, const Unit&, const char*& a, const char*& b) const { a = (const char*)g.A; b = (const char*)g.Bt; }
    __device__ __forceinline__ unsigned a_off(const Gemm& g, int R, int C) const { return (unsigned)(R * g.lda + C) * 2u; }
    __device__ __forceinline__ void a_ready(const Unit&) const {}
    __device__ __forceinline__ void done(const Unit&) const {}
};
struct OneUnitGather {
    static constexpr bool GATHER = true;
    const int* idx; int tok0;
    __device__ __forceinline__ bool next(int i, Unit& u) const { if (i) return false; u.pm = 0; u.pn = 0; u.kz = 0; return true; }
    __device__ __forceinline__ void base(const Gemm& g, const Unit&, const char*& a, const char*& b) const { a = (const char*)g.A; b = (const char*)g.Bt; }
    __device__ __forceinline__ unsigned a_off(const Gemm& g, int R, int C) const { return (unsigned)((tok0 + idx[R]) * g.lda + C) * 2u; }
    __device__ __forceinline__ void a_ready(const Unit&) const {}
    __device__ __forceinline__ void done(const Unit&) const {}
};
struct EpiMoeDown {
    static constexpr bool PERM = true, AFTER_DRAIN = false;
    bf16_t* out; const float* gate;
    __device__ __forceinline__ void operator()(const f32x4 (&acc)[2][2][4][2], const Unit&, int wr, int wc, int fr, int fq) const {
        const int row0 = wr * 64 + fr, cb = wc * 32 + 8 * fq;
        float gt[2][4];
#pragma unroll
        for (int ai = 0; ai < 2; ++ai)
#pragma unroll
            for (int m = 0; m < 4; ++m) gt[ai][m] = gate[row0 + ai * HALF + m * 16];
#pragma unroll
        for (int ai = 0; ai < 2; ++ai)
#pragma unroll
            for (int m = 0; m < 4; ++m) { const int r = row0 + ai * HALF + m * 16; bf16_t* rowp = out + (size_t)r * DM_ + cb;
#pragma unroll
                for (int bj = 0; bj < 2; ++bj) *(uint4*)(rowp + bj * HALF) = pack8_bf16(acc[ai][bj][m][0] * gt[ai][m], acc[ai][bj][m][1] * gt[ai][m]); }
    }
};
struct EpiMoeUp {
    static constexpr bool PERM = true, AFTER_DRAIN = false;
    bf16_t* out;
    __device__ __forceinline__ void operator()(const f32x4 (&acc)[2][2][4][2], const Unit&, int wr, int wc, int fr, int fq) const {
        const int row0 = wr * 64 + fr, cb = wc * 32 + 8 * fq;
#pragma unroll
        for (int ai = 0; ai < 2; ++ai)
#pragma unroll
            for (int m = 0; m < 4; ++m) { const int r = row0 + ai * HALF + m * 16;
                f32x4 v0, v1;
#pragma unroll
                for (int e = 0; e < 4; ++e) { v0[e] = silu_fast_(acc[ai][0][m][0][e]) * acc[ai][1][m][0][e]; v1[e] = silu_fast_(acc[ai][0][m][1][e]) * acc[ai][1][m][1][e]; }
                *(uint4*)(out + (size_t)r * DM_ + cb) = pack8_bf16(v0, v1); }
    }
};
struct MergeOrder {
    static constexpr bool GATHER = false;
    int G, c;
    __device__ __forceinline__ unsigned a_off(const Gemm& g, int R, int C) const { return (unsigned)(R * g.lda + C) * 2u; }
    __device__ __forceinline__ bool next(int i, Unit& u) const { const int L = (i >> 2) * G + c; if (L >= 32 * 8) return false; int pm, pn; static_order(L, 32, 8, pm, pn); u.pm = pm; u.pn = pn; u.kz = i & 3; return true; }
    __device__ __forceinline__ void base(const Gemm& g, const Unit& u, const char*& a, const char*& b) const {
        a = (const char*)g.A + ((size_t)u.pm * BM * DM_ + u.kz * 512) * 2; b = (const char*)g.Bt + ((size_t)u.kz * DM_ + u.pn * BM) * 512 * 2; }
    __device__ __forceinline__ void a_ready(const Unit&) const {}
    __device__ __forceinline__ void done(const Unit&) const {}
};
struct EpiMerge {
    static constexpr bool PERM = true, AFTER_DRAIN = false;
    const bf16_t* gates; float* m32; bf16_t* out;
    __device__ __forceinline__ void operator()(const f32x4 (&acc)[2][2][4][2], const Unit& u, int wr, int wc, int fr, int fq) const {
        const int row0 = u.pm * BM + wr * 64 + fr, col0 = u.pn * BM + wc * 32 + 8 * fq;
#pragma unroll
        for (int ai = 0; ai < 2; ++ai)
#pragma unroll
            for (int m = 0; m < 4; ++m) {
                const size_t row = (size_t)(row0 + ai * HALF + m * 16);
#pragma unroll
                for (int bj = 0; bj < 2; ++bj) {
                    const int col = col0 + bj * HALF;
                    const uint4 gv = *(const uint4*)(gates + row * 8192 + u.kz * DM_ + col);
                    f32x4 v0 = acc[ai][bj][m][0], v1 = acc[ai][bj][m][1];
                    v0[0] *= __uint_as_float(gv.x << 16); v0[1] *= __uint_as_float(gv.x & 0xffff0000u); v0[2] *= __uint_as_float(gv.y << 16); v0[3] *= __uint_as_float(gv.y & 0xffff0000u);
                    v1[0] *= __uint_as_float(gv.z << 16); v1[1] *= __uint_as_float(gv.z & 0xffff0000u); v1[2] *= __uint_as_float(gv.w << 16); v1[3] *= __uint_as_float(gv.w & 0xffff0000u);
                    float* mp = m32 + row * DM_ + col;
                    if (u.kz > 0) { v0 += *(const f32x4*)mp; v1 += *(const f32x4*)(mp + 4); }
                    if (u.kz < 3) { *(f32x4*)mp = v0; *(f32x4*)(mp + 4) = v1; }
                    else *(uint4*)(out + row * DM_ + col) = pack8_bf16(v0, v1);
                }
            }
    }
};
struct NoConv { static constexpr bool ON = false;
    __device__ __forceinline__ void load(int, f32x4 (&)[4]) const {}
    __device__ __forceinline__ void store(int, const f32x4 (&)[4]) const {} };
struct PanelConv { static constexpr bool ON = true;
    const float* src; bf16_t* dst;
    __device__ __forceinline__ void load(int it, f32x4 (&v)[4]) const {
#pragma unroll
        for (int r = 0; r < 4; ++r) v[r] = *(const f32x4*)(src + (size_t)(it * 32 + r) * DM_); }
    __device__ __forceinline__ void store(int it, const f32x4 (&v)[4]) const {
#pragma unroll
        for (int i = 0; i < 4; ++i) { uint2 o; o.x = cvt_pk_bf16(v[0][i], v[1][i]); o.y = cvt_pk_bf16(v[2][i], v[3][i]); *(uint2*)(dst + (size_t)i * DM_ + it * 32) = o; } }
};
template <bool DUAL>
__device__ __forceinline__ PanelConv make_panel_conv(const float* w, const float* w3, int col0, int q, bf16_t* panel) {
    const int tid = tid_opaque(), wid = __builtin_amdgcn_readfirstlane(tid >> 6), lane = tid & 63, kq = lane & 7, nl = lane >> 3;
    PanelConv c;
    c.src = (DUAL ? ((wid >> 2) ? w3 : w) + col0 + (wid & 3) * 32 : w + col0 + wid * 32) + nl * 4 + (size_t)(q * 512 + kq * 4) * DM_;
    c.dst = panel + (size_t)(wid * 32 + nl * 4) * DM_ + q * 512 + kq * 4;
    return c;
}
template <class Epi, class Sched, bool STAMP = false, class Conv = NoConv>
__device__ __forceinline__ void gemm_phase(PG8_LAS unsigned char* lds, const Gemm g, const Sched& S, const Epi& E, unsigned long long* stamps, const Conv cv = Conv{}) {
    const int tid = tid_opaque(), wid = __builtin_amdgcn_readfirstlane(tid >> 6), lane = tid & 63, wr = wid >> 2, wc = wid & 3, fr = lane & 15, fq = lane >> 4;
    const int K = g.K, nt = K / BK;
    int ts_lo = 0, ts_hi = 0, nts = 0; const unsigned long long rt_entry = STAMP ? (unsigned long long)wall_clock64() : 0ull;
#define PG8_STAMP() do { if (STAMP && wid == 0 && nts < 64) { const unsigned long long _c = (unsigned long long)clock64(); \
        ts_lo = (lane == nts) ? (int)(unsigned)_c : ts_lo; ts_hi = (lane == nts) ? (int)(unsigned)(_c >> 32) : ts_hi; ++nts; } } while (0)
    PG8_STAMP();
    unsigned voffA[2], voffA1[2], voffB[2];
#pragma unroll
    for (int i = 0; i < 2; ++i) { int R, C; stage_rc(tid * 16 + i * 8192, R, C); const int Rb = Epi::PERM ? ((R & ~31) + perm32(R & 31)) : R;
        voffA[i] = S.a_off(g, R, C); voffA1[i] = Sched::GATHER ? S.a_off(g, R + HALF, C) : voffA[i]; voffB[i] = (unsigned)(Rb * g.ldb + C) * 2u; }
    const size_t kstep = (size_t)(BK * 2);
    const size_t hstepA = Sched::GATHER ? (size_t)0 : (size_t)HALF * g.lda * 2, hstepB = (size_t)HALF * g.ldb * 2;
    const unsigned ldsw = (unsigned)wid * 1024u;
    const int aoff = lds_byte(wr * 64 + fr, fq * 8), boff = lds_byte(wc * 32 + fr, fq * 8);
#define PG8_SA(b, h) (((b) * 2 + (h)) * HTB)
#define PG8_SB(b, h) ((4 + (b) * 2 + (h)) * HTB)
#define PG8_STAGE(bufoff, gbase, voff) do { _Pragma("unroll") for (int _i = 0; _i < 2; ++_i) \
        __builtin_amdgcn_global_load_lds((const unsigned*)((const char*)(gbase) + (voff)[_i]), (PG8_LAS unsigned*)(lds + (bufoff) + ldsw + _i * 8192), 16, 0, 0); } while (0)
#define PG8_LDA(dst, b, h) do { _Pragma("unroll") for (int m = 0; m < 4; ++m) _Pragma("unroll") for (int k = 0; k < 2; ++k) dst[m][k] = *(const PG8_LAS bf16x8*)(lds + PG8_SA(b, h) + aoff + m * 2048 + k * 1024); } while (0)
#define PG8_LDB(dst, b, h) do { _Pragma("unroll") for (int n = 0; n < 2; ++n) _Pragma("unroll") for (int k = 0; k < 2; ++k) dst[n][k] = *(const PG8_LAS bf16x8*)(lds + PG8_SB(b, h) + boff + n * 2048 + k * 1024); } while (0)
#define PG8_MMA(ai, bj, At, Bt) do { __builtin_amdgcn_s_setprio(1); _Pragma("unroll") for (int m = 0; m < 4; ++m) _Pragma("unroll") for (int n = 0; n < 2; ++n) _Pragma("unroll") for (int k = 0; k < 2; ++k) \
        acc[ai][bj][m][n] = __builtin_amdgcn_mfma_f32_16x16x32_bf16(Bt[n][k], At[m][k], acc[ai][bj][m][n], 0, 0, 0); __builtin_amdgcn_s_setprio(0); } while (0)
#define PG8_WAIT_V(n) asm volatile("s_waitcnt vmcnt(" #n ")" ::: "memory")
#define PG8_WAIT_L(n) asm volatile("s_waitcnt lgkmcnt(" #n ")" ::: "memory")
#define PG8_BAR __builtin_amdgcn_s_barrier()
#define PG8_SCHED __builtin_amdgcn_sched_barrier(0)
    Unit cur, nxt; int ui = 0;
    if (!S.next(0, cur)) return;
    f32x4 acc[2][2][4][2];
#pragma unroll
    for (int a = 0; a < 2; ++a)
#pragma unroll
        for (int b = 0; b < 2; ++b)
#pragma unroll
            for (int m = 0; m < 4; ++m)
#pragma unroll
                for (int n = 0; n < 2; ++n) acc[a][b][m][n] = (f32x4){0.f, 0.f, 0.f, 0.f};
    bf16x8 At[4][2], B0[2][2], B1[2][2];
    const char* cA; const char* cB; S.base(g, cur, cA, cB);
    S.a_ready(cur);
    PG8_STAGE(PG8_SB(0, 0), cB, voffB); PG8_STAGE(PG8_SA(0, 0), cA, voffA); PG8_STAGE(PG8_SB(0, 1), cB + hstepB, voffB); PG8_STAGE(PG8_SA(0, 1), cA + hstepA, voffA1);
    if (wr == 1) PG8_BAR;
    PG8_WAIT_V(4); PG8_BAR;
    PG8_STAGE(PG8_SB(1, 0), cB + kstep, voffB); PG8_STAGE(PG8_SA(1, 0), cA + kstep, voffA); PG8_STAGE(PG8_SB(1, 1), cB + hstepB + kstep, voffB);
    PG8_WAIT_V(6); PG8_BAR;
    PG8_STAMP();
    for (;;) {
        const bool has_next = S.next(ui + 1, nxt);
        const char* nA = cA; const char* nB = cB; if (has_next) S.base(g, nxt, nA, nB);
        for (int t = 0; t < nt; t += 2) {
            const bool last = (t == nt - 2);
            const char* a1 = cA + (size_t)(t + 1) * kstep;
            const char* a2 = last ? nA : cA + (size_t)(t + 2) * kstep; const char* b2 = last ? nB : cB + (size_t)(t + 2) * kstep;
            const char* a3 = a2 + kstep; const char* b3 = b2 + kstep;
            if (last && has_next) S.a_ready(nxt);
            f32x4 cvv[4]; if constexpr (Conv::ON) { cv.load(t >> 1, cvv); PG8_SCHED; }
            PG8_LDB(B0, 0, 0); PG8_SCHED; PG8_LDA(At, 0, 0); PG8_STAGE(PG8_SA(1, 1), a1 + hstepA, voffA1);
            PG8_WAIT_L(8); PG8_BAR; PG8_WAIT_L(0); PG8_MMA(0, 0, At, B0); PG8_BAR; PG8_SCHED;
            PG8_LDB(B1, 0, 1); PG8_STAGE(PG8_SB(0, 0), b2, voffB);
            PG8_BAR; PG8_WAIT_L(0); PG8_MMA(0, 1, At, B1); PG8_BAR;
            PG8_LDA(At, 0, 1); PG8_STAGE(PG8_SA(0, 0), a2, voffA);
            PG8_BAR; PG8_WAIT_L(0); PG8_MMA(1, 0, At, B0); PG8_BAR; PG8_SCHED;
            PG8_STAGE(PG8_SB(0, 1), b2 + hstepB, voffB);
            PG8_WAIT_V(6); PG8_BAR; PG8_MMA(1, 1, At, B1); PG8_BAR;
            if constexpr (Conv::ON) { cv.store(t >> 1, cvv); PG8_SCHED; }
            PG8_LDB(B0, 1, 0); PG8_SCHED; PG8_LDA(At, 1, 0); PG8_STAGE(PG8_SA(0, 1), a2 + hstepA, voffA1);
            PG8_WAIT_L(8); PG8_BAR; PG8_WAIT_L(0); PG8_MMA(0, 0, At, B0); PG8_BAR; PG8_SCHED;
            PG8_LDB(B1, 1, 1); PG8_STAGE(PG8_SB(1, 0), b3, voffB);
            PG8_BAR; PG8_WAIT_L(0); PG8_MMA(0, 1, At, B1); PG8_BAR;
            PG8_LDA(At, 1, 1); PG8_STAGE(PG8_SA(1, 0), a3, voffA);
            PG8_BAR; PG8_WAIT_L(0); PG8_MMA(1, 0, At, B0); PG8_BAR; PG8_SCHED;
            PG8_STAGE(PG8_SB(1, 1), b3 + hstepB, voffB);
            PG8_WAIT_V(6); PG8_BAR; PG8_MMA(1, 1, At, B1); PG8_BAR;
        }
        PG8_STAMP();
        if constexpr (!Epi::AFTER_DRAIN) { E(acc, cur, wr, wc, fr, fq); S.done(cur); }
        PG8_STAMP();
        if (!has_next) break;
#pragma unroll
        for (int a = 0; a < 2; ++a)
#pragma unroll
            for (int b = 0; b < 2; ++b)
#pragma unroll
                for (int m = 0; m < 4; ++m)
#pragma unroll
                    for (int n = 0; n < 2; ++n) acc[a][b][m][n] = (f32x4){0.f, 0.f, 0.f, 0.f};
        cur = nxt; cA = nA; cB = nB; ++ui;
    }
    PG8_WAIT_V(0);
    if (wr == 0) PG8_BAR;
    PG8_BAR;
    if constexpr (Epi::AFTER_DRAIN) { E.fused(acc, cur, wr, wc, fr, fq, lds, wid, lane); S.done(cur); }
    PG8_STAMP();
    if (STAMP && wid == 0) { stamps[lane] = lane < nts ? (((unsigned long long)(unsigned)ts_hi << 32) | (unsigned)ts_lo) : 0ull;
        if (lane == 62) stamps[62] = rt_entry; if (lane == 63) stamps[63] = (unsigned long long)wall_clock64(); }
#undef PG8_STAMP
#undef PG8_SA
#undef PG8_SB
#undef PG8_STAGE
#undef PG8_LDA
#undef PG8_LDB
#undef PG8_MMA
#undef PG8_WAIT_V
#undef PG8_WAIT_L
#undef PG8_BAR
#undef PG8_SCHED
}
}
#define XB_TMO      128
#define XB_XCNT(j)  (256  + 64 * (j))
#define XB_XSUB(j)  (1280 + 64 * (j))
#define XB_XGEN(j)  (2304 + 64 * (j))
#define XB_TOP      3328
#define XB_TOPGEN   3392
#define XCD_BAR_WORDS 3456
#define XB_SPIN_CAP (1u << 18)
#define LAS __attribute__((address_space(3)))

__device__ __forceinline__ unsigned xb_ld(unsigned* p)              { return __hip_atomic_load(p, __ATOMIC_RELAXED, __HIP_MEMORY_SCOPE_AGENT); }
__device__ __forceinline__ unsigned xb_add(unsigned* p, unsigned v) { return __hip_atomic_fetch_add(p, v, __ATOMIC_RELAXED, __HIP_MEMORY_SCOPE_AGENT); }
__device__ __forceinline__ unsigned xb_xcc_id() { return (unsigned)__builtin_amdgcn_s_getreg((3 << 11) | 20) & 0xFu; }
#define XB_SPIN(cond, bar) do { unsigned _sp = 0; while (cond) { __builtin_amdgcn_s_sleep(1); \
    if ((++_sp & 255u) == 0u) { if (xb_ld(&(bar)[XB_TMO])) break; if (_sp > XB_SPIN_CAP) { atomicAdd(&(bar)[XB_TMO], 1u); break; } } } } while (0)

struct XcdBarrier {
    unsigned* bar; unsigned x;
    volatile LAS unsigned* st;
};

__device__ __forceinline__ XcdBarrier xcd_barrier_post(unsigned* bar, volatile LAS unsigned* st) {
    XcdBarrier b; b.bar = bar; b.x = xb_xcc_id(); b.st = st;
    if (threadIdx.x == 0) (void)xb_add(&bar[XB_XCNT(b.x)], 1u);
    return b;
}
__device__ __forceinline__ void xcd_barrier_complete(unsigned* bar, unsigned x, unsigned& nloc, unsigned& nx) {
    const unsigned G = gridDim.x * gridDim.y * gridDim.z;
    unsigned sum, cnt, mine, sp = 0u;
    for (;;) {
        sum = 0u; cnt = 0u; mine = 0u;
#pragma unroll
        for (unsigned j = 0; j < 16; ++j) { const unsigned c = xb_ld(&bar[XB_XCNT(j)]); sum += c; cnt += (c > 0u) ? 1u : 0u; mine = (j == x) ? c : mine; }
        if (sum == G) break;
        __builtin_amdgcn_s_sleep(1);
        if ((++sp & 255u) == 0u) { if (xb_ld(&bar[XB_TMO])) break; if (sp > XB_SPIN_CAP) { atomicAdd(&bar[XB_TMO], 1u); break; } }
    }
    nloc = mine > 0u ? mine : 1u; nx = cnt > 0u ? cnt : 1u;
}

__device__ __forceinline__ void xcd_barrier(const XcdBarrier& b) {
    asm volatile("s_waitcnt vmcnt(0)" ::: "memory");
    __syncthreads();
    if (threadIdx.x == 0) {
        unsigned* bar = b.bar; unsigned bx_ = b.x;
        asm volatile("" : "+s"(bar), "+s"(bx_));
        __builtin_amdgcn_s_waitcnt(0);
        unsigned nloc = b.st[0], nx = b.st[1];
        const unsigned old = xb_add(&bar[XB_XSUB(bx_)], 1u);
        const unsigned gen = old / nloc;
        if (old + 1u == (gen + 1u) * nloc) {
            __builtin_amdgcn_fence(__ATOMIC_RELEASE, "agent");
            asm volatile("s_waitcnt vmcnt(0)" ::: "memory");
            const unsigned og = xb_add(&bar[XB_TOP], 1u);
            const unsigned tg = og / nx;
            if (og + 1u == (tg + 1u) * nx) xb_add(&bar[XB_TOPGEN], 1u);
            else XB_SPIN(xb_ld(&bar[XB_TOPGEN]) == tg, bar);
            __builtin_amdgcn_fence(__ATOMIC_ACQUIRE, "agent");
            xb_add(&bar[XB_XGEN(bx_)], 1u);
            asm volatile("s_waitcnt vmcnt(0)" ::: "memory");
        } else {
            XB_SPIN(xb_ld(&bar[XB_XGEN(bx_)]) == gen, bar);
            __builtin_amdgcn_fence(__ATOMIC_ACQUIRE, "agent");
            asm volatile("s_waitcnt vmcnt(0)" ::: "memory");
        }
    }
    __syncthreads();
}

enum { X = 0, N1G, WIN, HCW, HCB, FW1, FB1, FW2, FB2, FW3, FB3, FW4, FREQ, HBIAS, LCW, LCB, LWA, LBA, LWX, LBX, LLAM, DLAM, DSUB, SCW, SCB, SDTB, SALOG, SD, SNG, WBR, BG, WOUT,
       N2G, WR, W1, W3, W2, RELB, FING };
struct MP {
    const float* in[39]; float* out; unsigned* bar;
    float* xres; bf16_t* hb; bf16_t* proj; bf16_t* gates; float* dtraw; bf16_t* br; bf16_t* mrg;
    float* fr; float* nrm; unsigned* hpp; bf16_t* vvt; float* hyt; bf16_t* vt;
    float* sumP; float* sumE; bf16_t* sxa; bf16_t* sxT; float* states; float* sdec; bf16_t* sprev;
    float* aff; int* tidx; float* tgat; int* tinv; bf16_t* hid; bf16_t* ybuf;
    bf16_t* wtin; bf16_t* wtbr; bf16_t* wtout; bf16_t* lruwt; float* m32;
    bf16_t* panel; unsigned* grp;
    int ngrid, pad1;
};
typedef const MP __attribute__((address_space(4)))* MPc;
__device__ __forceinline__ MPc params() { MPc q = (MPc)__builtin_amdgcn_kernarg_segment_ptr(); asm volatile("" : "+s"(q)); return q; }
__device__ __forceinline__ int bid_opaque() { int b = (int)__builtin_amdgcn_workgroup_id_x(); asm volatile("" : "+s"(b)); return b; }
__device__ __forceinline__ int grid_n() { return params()->ngrid; }

#define GRP_WORDS 16
#define GRP_COUNT (2 * 384)
template <bool DUAL>
__device__ __forceinline__ void moe_convert(const float* w, const float* w3, int col0, int q, bf16_t* panel) {
    const int tid = tid_opaque(), wid = __builtin_amdgcn_readfirstlane(tid >> 6), lane = tid & 63, kq = lane & 3, ngl = lane >> 2, ksub = wid & 1, grp = wid >> 1;
    const float* src = (DUAL ? ((grp >> 1) ? w3 : w) + col0 + (grp & 1) * 64 : w + col0 + grp * 64) + 4 * ngl + (size_t)(q * 512 + ksub * 32 + kq * 8) * DM_;
    bf16_t* dst = panel + (size_t)(grp * 64 + 4 * ngl) * DM_ + q * 512 + ksub * 32 + kq * 8;
#pragma unroll 1
    for (int ks = 0; ks < 8; ks += 2) {
        f32x4 v[2][8];
#pragma unroll
        for (int u = 0; u < 2; ++u)
#pragma unroll
            for (int r = 0; r < 8; ++r) v[u][r] = *(const f32x4*)(src + (size_t)((ks + u) * 64 + r) * DM_);
#pragma unroll
        for (int u = 0; u < 2; ++u)
#pragma unroll
            for (int i = 0; i < 4; ++i) { uint4 o; o.x = cvt_pk_bf16(v[u][0][i], v[u][1][i]); o.y = cvt_pk_bf16(v[u][2][i], v[u][3][i]); o.z = cvt_pk_bf16(v[u][4][i], v[u][5][i]); o.w = cvt_pk_bf16(v[u][6][i], v[u][7][i]);
                *(uint4*)(dst + (size_t)i * DM_ + (ks + u) * 64) = o; }
    }
}
__device__ __forceinline__ void group_sync(unsigned* cnt, unsigned* bar) {
    asm volatile("s_waitcnt vmcnt(0)" ::: "memory");
    __syncthreads();
    if (threadIdx.x == 0) {
        asm volatile("" : "+s"(cnt), "+s"(bar));
        __builtin_amdgcn_fence(__ATOMIC_RELEASE, "agent");
        asm volatile("s_waitcnt vmcnt(0)" ::: "memory");
        (void)xb_add(cnt, 1u);
        XB_SPIN(xb_ld(cnt) < 4u, bar);
        __builtin_amdgcn_fence(__ATOMIC_ACQUIRE, "agent");
        asm volatile("s_waitcnt vmcnt(0)" ::: "memory");
    }
    __syncthreads();
}
__device__ __forceinline__ void phase_moe_down2(char* shm, MPc p, int l) {
    const int bid = bid_opaque(), x = bid & 7, q = bid >> 3, b = q & 3, gi = q >> 2, ngx = grid_n() >> 5;
    if (q < ngx * 4) {
        if (gi < 16) { const int pair = x * 16 + gi, e = pair >> 3, nt = pair & 7;
            moe_convert<false>(p->in[W2] + ((size_t)l * 16 + e) * DM_ * DM_, nullptr, nt * 256, b, p->panel + (size_t)pair * 256 * DM_); }
        for (int j = gi; j < 16; j += ngx) {
            const int pair = x * 16 + j, e = pair >> 3, nt = pair & 7, z = b * 16 + e;
            bf16_t* panel = p->panel + (size_t)pair * 256 * DM_;
            group_sync(p->grp + (size_t)(l * 384 + 256 + pair) * GRP_WORDS, p->bar);
            const pg8::Gemm gg{p->hid + (size_t)z * 256 * DM_, panel, 256, 256, DM_, DM_, DM_}; const pg8::OneUnit so{}; const pg8::EpiMoeDown ep{p->ybuf + (size_t)z * 256 * DM_ + nt * 256, p->tgat + z * 256};
            if (j + ngx < 16) {
                const int pair2 = pair + ngx, e2 = pair2 >> 3, nt2 = pair2 & 7;
                const pg8::PanelConv cv = pg8::make_panel_conv<false>(p->in[W2] + ((size_t)l * 16 + e2) * DM_ * DM_, nullptr, nt2 * 256, b, p->panel + (size_t)pair2 * 256 * DM_);
                pg8::gemm_phase<pg8::EpiMoeDown, pg8::OneUnit, false, pg8::PanelConv>((PG8_LAS unsigned char*)shm, gg, so, ep, nullptr, cv);
            } else pg8::gemm_phase<pg8::EpiMoeDown, pg8::OneUnit, false>((PG8_LAS unsigned char*)shm, gg, so, ep, nullptr);
        }
    }
}
__device__ __forceinline__ void phase_moe_up2(char* shm, MPc p, int l) {
    const int bid = bid_opaque(), x = bid & 7, q = bid >> 3, b = q & 3, gi = q >> 2, ngx = grid_n() >> 5;
    if (q < ngx * 4)
    for (int j = gi; j < 32; j += ngx) {
        const int pair = x * 32 + j, e = pair >> 4, nt = pair & 15, z = b * 16 + e;
        bf16_t* panel = p->panel + (size_t)pair * 256 * DM_;
        moe_convert<true>(p->in[W1] + ((size_t)l * 16 + e) * DM_ * DM_, p->in[W3] + ((size_t)l * 16 + e) * DM_ * DM_, nt * 128, b, panel);
        group_sync(p->grp + (size_t)(l * 384 + pair) * GRP_WORDS, p->bar);
        const pg8::Gemm gg{p->hb, panel, 256, 256, DM_, DM_, DM_}; const pg8::OneUnitGather so{p->tidx + z * 256, b * SEQ_}; const pg8::EpiMoeUp ep{p->hid + (size_t)z * 256 * DM_ + nt * 128};
        pg8::gemm_phase<pg8::EpiMoeUp, pg8::OneUnitGather, false>((PG8_LAS unsigned char*)shm, gg, so, ep, nullptr);
    }
}
#ifndef MOE_DOWN2
#define MOE_DOWN2 0
#endif
#define MEGA_LDS (139264 + 1024)
#define NPH 12

template <int MODE>
__device__ __forceinline__ void phase_norm(char* shm, MPc p, int l) {
    float* hrow = (float*)shm;
    float* red = (float*)(shm + 65536);
    for (int it = bid_opaque(); it < TT_ / 8; it += grid_n()) {
        const int tid = tid_opaque(), wid = tid >> 6, lane = tid & 63;
        const int tok = it * 8 + wid, b = tok >> 11;
        const float* xin = (MODE == 0 && l == 0) ? p->in[X] : p->xres;
        f32x4 v[8];
#pragma unroll
        for (int i = 0; i < 8; ++i) v[i] = *(const f32x4*)(xin + (size_t)tok * DM_ + (i * 64 + lane) * 4);
        const float* g = MODE == 0 ? p->in[N1G] + l * DM_ : (MODE == 1 ? p->in[N2G] + l * DM_ : p->in[FING]);
        f32x4 gv[8];
#pragma unroll
        for (int i = 0; i < 8; ++i) gv[i] = *(const f32x4*)(g + (i * 64 + lane) * 4);
        if (MODE == 2 || (MODE == 0 && l > 0)) {
            const int myslot = lane < 16 ? p->tinv[tok * 16 + lane] : -1;
            unsigned long long em = __ballot(myslot >= 0);
            while (em) {
                const int e = __builtin_ctzll(em); em &= em - 1;
                const int slot = __shfl(myslot, e, 64);
                const bf16_t* yr = p->ybuf + ((size_t)(b * 16 + e) * 256 + slot) * DM_;
                uint2 y[8];
#pragma unroll
                for (int i = 0; i < 8; ++i) y[i] = *(const uint2*)(yr + (i * 64 + lane) * 4);
#pragma unroll
                for (int i = 0; i < 8; ++i) { v[i][0] += __uint_as_float(y[i].x << 16); v[i][1] += __uint_as_float(y[i].x & 0xffff0000u); v[i][2] += __uint_as_float(y[i].y << 16); v[i][3] += __uint_as_float(y[i].y & 0xffff0000u); }
            }
        }
        float ss = 0.f;
#pragma unroll
        for (int i = 0; i < 8; ++i) ss += v[i][0] * v[i][0] + v[i][1] * v[i][1] + v[i][2] * v[i][2] + v[i][3] * v[i][3];
#pragma unroll
        for (int o = 32; o > 0; o >>= 1) ss += __shfl_xor(ss, o, 64);
        const float rs = rsqrtf(ss * (1.0f / DM_) + 1e-6f);
        if (MODE != 2) __syncthreads();
#pragma unroll
        for (int i = 0; i < 8; ++i) {
            const int c = (i * 64 + lane) * 4;
            const f32x4 y = (f32x4){v[i][0] * rs * gv[i][0], v[i][1] * rs * gv[i][1], v[i][2] * rs * gv[i][2], v[i][3] * rs * gv[i][3]};
            if (MODE == 0 && l > 0) *(f32x4*)(p->xres + (size_t)tok * DM_ + c) = v[i];
            if (MODE == 2) *(f32x4*)(p->out + (size_t)tok * DM_ + c) = y;
            else {
                uint2 o; o.x = cvt_pk_bf16(y[0], y[1]); o.y = cvt_pk_bf16(y[2], y[3]);
                *(uint2*)(p->hb + (size_t)tok * DM_ + c) = o;
                *(f32x4*)(hrow + wid * DM_ + c) = y;
            }
        }
        if (MODE != 2) {
            __syncthreads();
            const float* W = MODE == 0 ? p->in[WIN] + (size_t)l * DM_ * INC_ + PROJW : p->in[WR] + (size_t)l * DM_ * 16;
            const int ldw = MODE == 0 ? INC_ : 16;
            const int e = tid & 15, part = tid >> 4;
            float acc[8] = {0.f, 0.f, 0.f, 0.f, 0.f, 0.f, 0.f, 0.f};
#pragma unroll 4
            for (int k = part * 64; k < part * 64 + 64; ++k) {
                const float w = W[(size_t)k * ldw + e];
#pragma unroll
                for (int t = 0; t < 8; ++t) acc[t] += hrow[t * DM_ + k] * w;
            }
#pragma unroll
            for (int t = 0; t < 8; ++t) red[(t * 32 + part) * 16 + e] = acc[t];
            __syncthreads();
            if (tid < 128) {
                const int tl = tid >> 4, e2 = tid & 15; float s = 0.f;
                for (int q = 0; q < 32; ++q) s += red[(tl * 32 + q) * 16 + e2];
                const int tk = it * 8 + tl;
                if (MODE == 0) p->dtraw[(size_t)tk * 16 + e2] = s;
                else {
                    float m = s;
#pragma unroll
                    for (int o = 8; o > 0; o >>= 1) m = fmaxf(m, __shfl_xor(m, o, 64));
                    const float ex = expf(s - m); float z = ex;
#pragma unroll
                    for (int o = 8; o > 0; o >>= 1) z += __shfl_xor(z, o, 64);
                    p->aff[(size_t)tk * 16 + e2] = ex / z;
                }
            }
        }
    }
}
__device__ __forceinline__ int block_sum_512(int v, volatile int* red  , int par, int tid) {
#pragma unroll
    for (int o = 32; o > 0; o >>= 1) v += __shfl_xor(v, o, 64);
    if ((tid & 63) == 0) red[par * 8 + (tid >> 6)] = v;
    __syncthreads();
    int s = 0;
#pragma unroll
    for (int w = 0; w < 8; ++w) s += red[par * 8 + w];
    return s;
}
__device__ __forceinline__ int block_exscan_512(int v, volatile int* wsum  , int tid) {
    int inc = v;
#pragma unroll
    for (int o = 1; o < 64; o <<= 1) { const int n = __shfl_up(inc, o, 64); if ((tid & 63) >= o) inc += n; }
    if ((tid & 63) == 63) wsum[tid >> 6] = inc;
    __syncthreads();
    int base = 0;
#pragma unroll
    for (int w = 0; w < 8; ++w) base += (w < (tid >> 6)) ? wsum[w] : 0;
    __syncthreads();
    return base + inc - v;
}
__device__ __forceinline__ void phase_topk(char* shm, MPc p) {
    volatile int* red = (volatile int*)shm;
    volatile int* wsum = red + 16;
    for (int z = bid_opaque(); z < 64; z += grid_n()) {
        const int b = z >> 4, e = z & 15, tid = tid_opaque();
        __syncthreads();
        float v[4]; unsigned u[4];
#pragma unroll
        for (int i = 0; i < 4; ++i) { v[i] = p->aff[(size_t)(b * SEQ_ + tid * 4 + i) * 16 + e]; u[i] = __float_as_uint(v[i]); }
        unsigned T = 0u;
        for (int bit = 30; bit >= 0; --bit) {
            const unsigned cand = T | (1u << bit);
            const int c = block_sum_512((u[0] >= cand) + (u[1] >= cand) + (u[2] >= cand) + (u[3] >= cand), red, bit & 1, tid);
            if (c >= 256) T = cand;
        }
        __syncthreads();
        const int ngt = block_sum_512((u[0] > T) + (u[1] > T) + (u[2] > T) + (u[3] > T), red, 0, tid);
        const int need = 256 - ngt;
        __syncthreads();
        const int eq_l = (u[0] == T) + (u[1] == T) + (u[2] == T) + (u[3] == T);
        int eqr = block_exscan_512(eq_l, wsum, tid);
        int sel[4], nsel = 0;
#pragma unroll
        for (int i = 0; i < 4; ++i) { const bool isq = u[i] == T; sel[i] = (u[i] > T) || (isq && eqr < need); eqr += isq ? 1 : 0; nsel += sel[i]; }
        int slot = block_exscan_512(nsel, wsum, tid);
#pragma unroll
        for (int i = 0; i < 4; ++i) {
            const int t = tid * 4 + i;
            if (sel[i]) { p->tidx[z * 256 + slot] = t; p->tgat[z * 256 + slot] = v[i]; }
            p->tinv[(b * SEQ_ + t) * 16 + e] = sel[i] ? slot : -1;
            slot += sel[i];
        }
    }
}
__device__ __forceinline__ void phase_hy_filter(char* shm, MPc p) {
    float* zz = (float*)shm; float* ha = zz + 8 * 64; float* hbq = ha + 8 * 64;
    for (int u = bid_opaque(); u < 512; u += grid_n()) {
        const int lf = u >> 8, tid = tid_opaque(), wid = tid >> 6, o = tid & 63, i = (u & 255) * 8 + wid;
        const float* fw1 = p->in[FW1] + lf * 33 * 64; const float* fw2 = p->in[FW2] + lf * 4096; const float* fw3 = p->in[FW3] + lf * 4096; const float* fw4 = p->in[FW4] + lf * 64 * 512;
        const float t = (float)i / (float)(SEQ_ - 1);
        const float w = (2.0f * 3.14159265358979323846f / (float)SEQ_) * (float)i;
        __syncthreads();
        if (o == 0) zz[wid * 64] = t;
        if (o < 16) { const float band = 1e-4f + (float)o * ((15.0f - 1e-4f) / 15.0f); zz[wid * 64 + 1 + o] = __cosf(band * w); zz[wid * 64 + 17 + o] = -__sinf(band * w); }
        __syncthreads();
        const float fq = p->in[FREQ][lf * 64 + o];
        float s = p->in[FB1][lf * 64 + o];
        for (int k = 0; k < 33; ++k) s += zz[wid * 64 + k] * fw1[k * 64 + o];
        ha[wid * 64 + o] = __sinf(fq * s);
        __syncthreads();
        s = p->in[FB2][lf * 64 + o];
        for (int k = 0; k < 64; ++k) s += ha[wid * 64 + k] * fw2[k * 64 + o];
        hbq[wid * 64 + o] = __sinf(fq * s);
        __syncthreads();
        s = p->in[FB3][lf * 64 + o];
        for (int k = 0; k < 64; ++k) s += hbq[wid * 64 + k] * fw3[k * 64 + o];
        __syncthreads();
        ha[wid * 64 + o] = __sinf(fq * s);
        __syncthreads();
        { const float d0 = logf(1e-2f) / 1.5f, d1 = logf(1e-2f) / 0.3f;
          const int c = tid;
          float a8[8] = {0.f, 0.f, 0.f, 0.f, 0.f, 0.f, 0.f, 0.f};
          for (int k = 0; k < 64; ++k) { const float wv = fw4[k * 512 + c];
#pragma unroll
              for (int q = 0; q < 8; ++q) a8[q] += ha[q * 64 + k] * wv; }
          const float delta = fabsf(d0 + (float)c * ((d1 - d0) / 511.0f));
#pragma unroll
          for (int q = 0; q < 8; ++q) { const int iq = (u & 255) * 8 + q; const float tq = (float)iq / (float)(SEQ_ - 1);
              p->fr[((size_t)lf * SEQ_ + iq) * 512 + c] = a8[q] * __expf(-2.0f * fabsf(tq - 0.5f) * delta); } }
    }
}
__device__ __forceinline__ void phase_hy_norm(MPc p) {
    for (int u = bid_opaque(); u < 128; u += grid_n()) {
        const int tid = tid_opaque(), pr = u * 8 + (tid >> 6), lane = tid & 63, lf = pr >> 9, c = pr & 511;
        float s = 0.f;
        for (int q = 0; q < 32; ++q) s += fabsf(p->fr[((size_t)lf * SEQ_ + lane + 64 * q) * 512 + c]);
#pragma unroll
        for (int o = 32; o > 0; o >>= 1) s += __shfl_xor(s, o, 64);
        if (lane == 0) p->nrm[pr] = s;
    }
}

__device__ __forceinline__ GP mk_gp(MPc p, int l, int which) {
    GP g{};
    if (which == 0) { g.A = p->hb; g.Bt = p->wtin + (size_t)l * 13824 * DM_; g.bias = p->in[BG] + (size_t)l * 4 * DM_; g.Cb = p->proj; g.Cb2 = p->gates; g.Vt = p->vt; }
    if (which == 1) { g.A = p->br; g.Bt = p->wtbr + (size_t)l * 4 * DM_ * 512; g.G = p->gates; g.Cb = p->mrg; }
    if (which == 2) { g.A = p->mrg; g.Bt = p->wtout + (size_t)l * DM_ * DM_; g.R = l == 0 ? p->in[X] : p->xres; g.Cf = p->xres; }
    if (which == 3) { g.A = p->hb; g.B = p->in[W1] + (size_t)l * 16 * DM_ * DM_; g.B2 = p->in[W3] + (size_t)l * 16 * DM_ * DM_; g.idx = p->tidx; g.Cb = p->hid; }
    if (which == 4) { g.A = p->hid; g.B = p->in[W2] + (size_t)l * 16 * DM_ * DM_; g.gate = p->tgat; g.Cb = p->ybuf; }
    return g;
}
__device__ __forceinline__ HP mk_hp(MPc p, int l) {
    HP h{}; h.proj = p->proj; h.fr = p->fr + (size_t)l * SEQ_ * 512; h.nrm = p->nrm + l * 512; h.pp = p->hpp + (size_t)l * 512 * HY_PPW; h.vvt = p->vvt; h.yt = p->hyt;
    h.cw = p->in[HCW] + l * 3 * 1536; h.cb = p->in[HCB] + l * 1536; h.hbias = p->in[HBIAS] + l * 512; h.br = p->br; return h;
}
__device__ __forceinline__ LP mk_lp(MPc p, int l) {
    LP q{}; q.proj = p->proj; q.cw = p->in[LCW] + l * 4 * 512; q.cb = p->in[LCB] + l * 512; q.wt = p->lruwt + (size_t)l * 8 * 256 * 64; q.ba = p->in[LBA] + l * 1024;
    q.bx = p->in[LBX] + l * 1024; q.lam = p->in[LLAM] + l * 1024; q.sumP = p->sumP; q.sumE = p->sumE; q.br = p->br; return q;
}
__device__ __forceinline__ SP_ mk_sp(MPc p, int l) {
    SP_ s{}; s.proj = p->proj; s.dtraw = p->dtraw; s.cw = p->in[SCW] + l * 4 * 1024; s.cb = p->in[SCB] + l * 1024; s.dtb = p->in[SDTB] + l * 16; s.a_log = p->in[SALOG] + l * 16; s.dsk = p->in[SD] + l * 8; s.ng = p->in[SNG] + l * 512;
    s.xa = p->sxa; s.xT = p->sxT; s.states = p->states; s.decay = p->sdec; s.prev = p->sprev; s.br = p->br; return s;
}
__device__ __forceinline__ AP mk_ap(MPc p, int l) {
    AP a{}; a.proj = p->proj; a.vt = p->vt; a.rel_bias = p->in[RELB]; a.dlam = p->in[DLAM] + l * 256; a.subg = p->in[DSUB] + l * 128; a.br = p->br; a.lam_init = l == 0 ? 0.2f : 0.35550906759096926f; return a;
}
__device__ __forceinline__ void wconv_tile(float* tile, const float* src, size_t ld_src, bf16_t* dst, size_t ld_dst, int tid) {
    __syncthreads();
    { const int kr = tid >> 4, n4 = (tid & 15) * 4;
#pragma unroll
      for (int h = 0; h < 2; ++h) { const f32x4 v = *(const f32x4*)(src + (size_t)(kr + 32 * h) * ld_src + n4); float* t = tile + (kr + 32 * h) * 65 + n4; t[0] = v[0]; t[1] = v[1]; t[2] = v[2]; t[3] = v[3]; } }
    __syncthreads();
    { const int n = tid >> 3, k8 = (tid & 7) * 8; const float* t = tile + k8 * 65 + n;
      uint4 o; o.x = cvt_pk_bf16(t[0], t[65]); o.y = cvt_pk_bf16(t[130], t[195]); o.z = cvt_pk_bf16(t[260], t[325]); o.w = cvt_pk_bf16(t[390], t[455]);
      *(uint4*)(dst + (size_t)n * ld_dst + k8) = o; }
}
__device__ __forceinline__ void phase_wconv(char* shm, MPc p, int l, int bw0, int bwn) {
    const int bq = bid_opaque() - bw0; if (bq < 0 || bq >= bwn) return;
    for (int e0 = bq * 512 + tid_opaque(); e0 < 8 * 256 * 64; e0 += bwn * 512) {
        const int e = l * 8 * 256 * 64 + e0; const int i = e & 63, n = (e >> 6) & 255, h = (e >> 14) & 7, j = n & 63, g = (n >> 6) & 1, dir = n >> 7;
        const float* w = (g ? p->in[LWX] : p->in[LWA]) + ((size_t)((l * 2 + dir) * 8 + h) * 64 + i) * 64 + j;
        p->lruwt[e] = f2bf(*w);
    }
    float* tile = (float*)shm;
    const int NJ_IN = 32 * 216, NJ_BR = 4 * 8 * 32, NJ_OUT = 32 * 32, NJ = NJ_IN + NJ_BR + NJ_OUT;
    for (int u = bq; u < NJ; u += bwn) {
        int j = u; const int tid = tid_opaque();
        if (j < NJ_IN) { const int nt = j % 216, kt = j / 216, n0 = nt * 64, ns = n0 < PROJW ? n0 : n0 + 16;
            wconv_tile(tile, p->in[WIN] + (size_t)l * DM_ * INC_ + (size_t)kt * 64 * INC_ + ns, INC_, p->wtin + ((size_t)l * 13824 + n0) * DM_ + kt * 64, DM_, tid); }
        else if (j < NJ_IN + NJ_BR) { j -= NJ_IN; const int nt = j & 31, kt = (j >> 5) & 7, k = j >> 8;
            wconv_tile(tile, p->in[WBR] + ((size_t)(l * 4 + k) * 512 + kt * 64) * DM_ + nt * 64, DM_, p->wtbr + (((size_t)(l * 4 + k) * DM_) + nt * 64) * 512 + kt * 64, 512, tid); }
        else { j -= NJ_IN + NJ_BR; const int nt = j & 31, kt = j >> 5;
            wconv_tile(tile, p->in[WOUT] + ((size_t)l * DM_ + kt * 64) * DM_ + nt * 64, DM_, p->wtout + ((size_t)l * DM_ + nt * 64) * DM_ + kt * 64, DM_, tid); }
    }
}
#define PH_ON(id) (ONLY < 0 || ONLY == (id))
#define PH_SYNC(id) do { if (ONLY < 0) xcd_barrier(bar); } while (0)
template <int ONLY>
__global__ void __launch_bounds__(512, 2) k_mega(MP p_unused) {
    extern __shared__ __attribute__((aligned(1024))) char shm[];
    XcdBarrier bar{};
    if (ONLY < 0) {
        volatile LAS unsigned* xbw = (volatile LAS unsigned*)(shm + MEGA_LDS - 16);
        if (threadIdx.x == 0) { xbw[0] = 0u; xbw[1] = 0u; }
        __syncthreads();
        bar = xcd_barrier_post(params()->bar, xbw);
        if (threadIdx.x == 0) { unsigned nloc, nx; xcd_barrier_complete(bar.bar, bar.x, nloc, nx); xbw[0] = nloc; xbw[1] = nx; }
        __syncthreads();
    }
    constexpr int L0 = ONLY < 0 ? 0 : (ONLY >= 2 * NPH ? 2 : ONLY / NPH), L1 = ONLY < 0 ? 2 : (ONLY >= 2 * NPH ? 2 : ONLY / NPH + 1);
#pragma unroll 1
    for (int l = L0; l < L1; ++l) {
        const int id0 = l * NPH;
        if (PH_ON(id0 + 0)) { phase_norm<0>(shm, params(), l); if (l == 0) { phase_hy_filter(shm, params()); phase_wconv(shm, params(), 0, 0, grid_n()); } }
        PH_SYNC(id0 + 0);
        if (PH_ON(id0 + 1)) { if (l == 0) phase_hy_norm(params()); const GP g = mk_gp(params(), l, 0);
            const pg8::Gemm gg{g.A, g.Bt, TT_, 13824, DM_, DM_, DM_}; const pg8::MegaOrder so{32, 54, grid_n(), bid_opaque()}; const pg8::EpiInproj ep{g.Cb, g.Cb2, g.Vt, g.bias};
            pg8::gemm_phase<pg8::EpiInproj, pg8::MegaOrder, false>((PG8_LAS unsigned char*)shm, gg, so, ep, nullptr); }
        PH_SYNC(id0 + 1);
        if (PH_ON(id0 + 2)) {
            { const AP a = mk_ap(params(), l); phase_attn(shm, a); }
            if (l == 0) { const HP h0 = mk_hp(params(), 0); phase_hy_pp(h0); const HP h1 = mk_hp(params(), 1); phase_hy_pp(h1); }
            { const HP h = mk_hp(params(), l); phase_hy_prep(shm, h); }
            { const SP_ s = mk_sp(params(), l); phase_ssd_prep(shm, s); }
            { const LP q = mk_lp(params(), l); phase_lru<0>(shm, q); }
        }
        PH_SYNC(id0 + 2);
        if (PH_ON(id0 + 3)) {
            { const HP h = mk_hp(params(), l); phase_hy_conv(shm, h); }
            { const SP_ s = mk_sp(params(), l); phase_ssd_states(shm, s); }
            { const LP q = mk_lp(params(), l); phase_lru<1>(shm, q); }
        }
        PH_SYNC(id0 + 3);
        if (PH_ON(id0 + 4)) { const SP_ s = mk_sp(params(), l); phase_ssd_scan(s); }
        PH_SYNC(id0 + 4);
        if (PH_ON(id0 + 5)) { { const SP_ s = mk_sp(params(), l); phase_ssd_out(shm, s); }
            { const HP h = mk_hp(params(), l); phase_hy_fin(shm, h, 0, grid_n()); }
            if (l == 0) phase_wconv(shm, params(), 1, 0, grid_n()); }
        PH_SYNC(id0 + 5);
        if (PH_ON(id0 + 6)) { const GP g = mk_gp(params(), l, 1); phase_merge(shm, g); }
        PH_SYNC(id0 + 6);
        if (PH_ON(id0 + 7)) { const GP g = mk_gp(params(), l, 2);
            const pg8::Gemm gg{g.A, g.Bt, TT_, DM_, DM_, DM_, DM_}; const pg8::MegaOrder so{32, 8, grid_n(), bid_opaque()}; const pg8::EpiOutproj ep{g.R, g.Cf};
            pg8::gemm_phase<pg8::EpiOutproj, pg8::MegaOrder, false>((PG8_LAS unsigned char*)shm, gg, so, ep, nullptr); }
        PH_SYNC(id0 + 7);
        if (PH_ON(id0 + 8)) phase_norm<1>(shm, params(), l);
        PH_SYNC(id0 + 8);
        if (PH_ON(id0 + 9)) phase_topk(shm, params());
        PH_SYNC(id0 + 9);
        if (PH_ON(id0 + 10)) { const GP g = mk_gp(params(), l, 3); phase_moe_up(shm, g); }
        PH_SYNC(id0 + 10);
        #if MOE_DOWN2
        if (PH_ON(id0 + 11)) phase_moe_down2(shm, params(), l);
#else
        if (PH_ON(id0 + 11)) { const GP g = mk_gp(params(), l, 4); phase_moe_down(shm, g); }
#endif
        PH_SYNC(id0 + 11);
    }
    if (PH_ON(2 * NPH)) phase_norm<2>(shm, params(), 0);
}
template <int I> struct PhaseLauncher { static void go(int grid, hipStream_t st, const MP& p) { (void)hipFuncSetAttribute((const void*)k_mega<I>, hipFuncAttributeMaxDynamicSharedMemorySize, MEGA_LDS); hipLaunchKernelGGL(k_mega<I>, dim3(grid), dim3(512), MEGA_LDS, st, p); PhaseLauncher<I + 1>::go(grid, st, p); } };
template <> struct PhaseLauncher<2 * NPH + 1> { static void go(int, hipStream_t, const MP&) {} };

#ifndef MK_N_LAUNCHES
#define MK_N_LAUNCHES 1
#endif
extern "C" void kernel_launch(void* const* d_in, const int* in_sizes, int n_in, void* d_out, int out_size, void* d_ws, size_t ws_size, hipStream_t stream) {
    static int grid = 0;
    if (grid == 0) {
        int dev = 0, cus = 0;
        if (hipGetDevice(&dev) != hipSuccess || hipDeviceGetAttribute(&cus, hipDeviceAttributeMultiprocessorCount, dev) != hipSuccess) { fprintf(stderr, "kernel_launch: device query failed\n"); grid = -1; return; }
        if (hipFuncSetAttribute((const void*)k_mega<-1>, hipFuncAttributeMaxDynamicSharedMemorySize, MEGA_LDS) != hipSuccess) { fprintf(stderr, "kernel_launch: hipFuncSetAttribute failed\n"); grid = -1; return; }
        (void)hipGetLastError();
        grid = cus;
    }
    if (grid < 0) return;
    char* w = (char*)d_ws; size_t off = 0;
    auto alloc = [&](size_t bytes) { void* q = w + off; off += (bytes + 255) & ~(size_t)255; return q; };
    MP p{};
    for (int i = 0; i < 39; ++i) p.in[i] = (const float*)d_in[i];
    p.out = (float*)d_out; p.ngrid = grid;
    p.bar = (unsigned*)alloc(XCD_BAR_WORDS * 4 + GRP_COUNT * GRP_WORDS * 4); p.grp = p.bar + XCD_BAR_WORDS;
    p.panel = (bf16_t*)alloc((size_t)256 * 256 * DM_ * 2);
    p.xres = (float*)alloc((size_t)TT_ * DM_ * 4);
    p.hb = (bf16_t*)alloc((size_t)TT_ * DM_ * 2);
    p.proj = (bf16_t*)alloc((size_t)TT_ * PROJW * 2);
    p.gates = (bf16_t*)alloc((size_t)TT_ * 8192 * 2);
    p.dtraw = (float*)alloc((size_t)TT_ * 16 * 4);
    p.br = (bf16_t*)alloc((size_t)TT_ * DM_ * 2);
    p.mrg = (bf16_t*)alloc((size_t)TT_ * DM_ * 2);
    p.fr = (float*)alloc((size_t)2 * SEQ_ * 512 * 4);
    p.nrm = (float*)alloc(2 * 512 * 4);
    p.hpp = (unsigned*)alloc((size_t)2 * 512 * HY_PPW * 4);
    p.vvt = (bf16_t*)alloc((size_t)512 * NB_ * SEQ_ * 2);
    p.hyt = (float*)alloc((size_t)512 * NB_ * SEQ_ * 4);
    p.vt = (bf16_t*)alloc((size_t)NB_ * 512 * SEQ_ * 2);
    p.sumP = (float*)alloc((size_t)2 * NB_ * 32 * 512 * 4);
    p.sumE = (float*)alloc((size_t)2 * NB_ * 32 * 512 * 4);
    p.sxa = (bf16_t*)alloc((size_t)TT_ * 1024 * 2);
    p.sxT = (bf16_t*)alloc((size_t)TT_ * 1024 * 2);
    p.states = (float*)alloc((size_t)NB_ * SSD_NC * 16 * 64 * 128 * 4);
    p.sdec = (float*)alloc(NB_ * SSD_NC * 16 * 4);
    p.sprev = (bf16_t*)alloc((size_t)NB_ * SSD_NC * 16 * 64 * 128 * 2);
    p.aff = (float*)alloc((size_t)TT_ * 16 * 4);
    p.tidx = (int*)alloc(64 * 256 * 4);
    p.tgat = (float*)alloc(64 * 256 * 4);
    p.tinv = (int*)alloc((size_t)TT_ * 16 * 4);
    p.hid = (bf16_t*)alloc((size_t)64 * 256 * DM_ * 2);
    p.ybuf = (bf16_t*)alloc((size_t)64 * 256 * DM_ * 2);
    p.wtin = (bf16_t*)alloc((size_t)2 * 13824 * DM_ * 2);
    p.wtbr = (bf16_t*)alloc((size_t)2 * 4 * DM_ * 512 * 2);
    p.wtout = (bf16_t*)alloc((size_t)2 * DM_ * DM_ * 2);
    p.lruwt = (bf16_t*)alloc((size_t)2 * 8 * 256 * 64 * 2);
    p.m32 = (float*)alloc((size_t)TT_ * DM_ * 4);
    if (off > ws_size) { fprintf(stderr, "kernel_launch: workspace too small (%zu > %zu)\n", off, ws_size); return; }
    (void)hipMemsetAsync(p.bar, 0, XCD_BAR_WORDS * 4 + GRP_COUNT * GRP_WORDS * 4, stream);
#if MK_N_LAUNCHES == 1
    hipLaunchKernelGGL(k_mega<-1>, dim3(grid), dim3(512), MEGA_LDS, stream, p);
#else
    PhaseLauncher<0>::go(grid, stream, p);
#endif
}
```

```cpp
#include <hip/hip_runtime.h>
#include <math.h>
#include <stdint.h>
#include <stdio.h>

#define NB_ 4
#define SEQ_ 2048
#define DM_ 2048
#define TT_ 8192
#define INC_ 13840
#define O_HY 0
#define O_LRU 1536
#define O_DA 2560
#define O_SSD 4096
#define O_GATE 5648
typedef short bf16x8 __attribute__((ext_vector_type(8)));
typedef float f32x4 __attribute__((ext_vector_type(4)));
typedef float f32x2 __attribute__((ext_vector_type(2)));
typedef int i32x4 __attribute__((ext_vector_type(4)));
typedef unsigned short bf16_t;
__device__ __forceinline__ int bid_opaque();
__device__ __forceinline__ int grid_n();

typedef __bf16 bf16x2_t __attribute__((ext_vector_type(2)));
__device__ __forceinline__ unsigned cvt_pk_bf16(float lo, float hi) { const f32x2 v = {lo, hi}; return __builtin_bit_cast(unsigned, __builtin_convertvector(v, bf16x2_t)); }
__device__ __forceinline__ int tid_opaque() { int t = (int)__builtin_amdgcn_workitem_id_x(); asm volatile("" : "+v"(t)); return t; }
__device__ __forceinline__ float bf2f(bf16_t v) { return __uint_as_float((unsigned)v << 16); }
__device__ __forceinline__ bf16_t f2bf(float f) { return (bf16_t)(cvt_pk_bf16(f, 0.f) & 0xffffu); }

__device__ __forceinline__ int lds_rc(int r, int chunk) { return r * 128 + ((chunk ^ ((r >> 1) & 7)) << 4); }
#define GEMM_LDS_BYTES(BM) (2 * ((BM) * 128 + 256 * 128))
#ifndef GEMM_L2PF
#define GEMM_L2PF 0
#endif
#ifndef GEMM_BT_AH
#define GEMM_BT_AH 8
#endif

#define GEMM_KTILE(buf, HOOK) do { const char* sS = shm + (buf) * STAGE; bf16x8 Bc[4], Bn[4], Ar[4]; \
        _Pragma("unroll") for (int n = 0; n < 4; ++n) Bc[n] = *(const bf16x8*)(sS + broff0 + n * 2048); \
        _Pragma("unroll") for (int q = 0; q < 3; ++q) Ar[q] = *(const bf16x8*)(sS + aroff0 + q * 2048); \
        __builtin_amdgcn_sched_barrier(0); \
        _Pragma("unroll") for (int g = 0; g < 2 * FM; ++g) { \
            if (g + 3 < 2 * FM) Ar[(g + 3) & 3] = *(const bf16x8*)(sS + ((g + 3) / FM ? aroff1 : aroff0) + ((g + 3) % FM) * 2048); \
            if (g == FM - 4) { _Pragma("unroll") for (int n = 0; n < 4; ++n) Bn[n] = *(const bf16x8*)(sS + broff1 + n * 2048); } \
            __builtin_amdgcn_sched_barrier(0); \
            _Pragma("unroll") for (int n = 0; n < 4; ++n) acc[g % FM][n] = __builtin_amdgcn_mfma_f32_16x16x32_bf16(Ar[g & 3], (g < FM ? Bc[n] : Bn[n]), acc[g % FM][n], 0, 0, 0); \
            HOOK(g); \
            __builtin_amdgcn_sched_barrier(0); } } while (0)
template <int BM, bool DUAL>
struct GemmCore {
    static constexpr int FM = BM / 32;
    static constexpr int GLA = BM * 128 / 8192;
    static constexpr int TILE_A = BM * 128, TILE_B = 256 * 128, STAGE = TILE_A + TILE_B;

    template <class AccT>
    static __device__ __forceinline__ void run(char* shm, const char* abase, const unsigned (&aoff)[GLA], const char* bl, unsigned ldb, int nt, AccT& acc) {
        const int tid = tid_opaque(), wid = tid >> 6, lane = tid & 63, wr = wid >> 2, wc = wid & 3, fr = lane & 15, fq = lane >> 4;
        const int kq = lane & 3, ngl = lane >> 2, ksub = wid & 1, grp = wid >> 1;
        i32x4 sa[GLA];
        f32x4 sb[8];
        const int awoff = lds_rc(tid >> 3, tid & 7);
        const int bwoff = TILE_A + lds_rc(grp * 64 + ngl, ksub * 4 + kq);
        const int aroff0 = lds_rc(wr * (BM / 2) + fr, fq), aroff1 = lds_rc(wr * (BM / 2) + fr, 4 + fq);
        const int broff0 = TILE_A + lds_rc(wc * 64 + fr, fq), broff1 = TILE_A + lds_rc(wc * 64 + fr, 4 + fq);
#define G_ISSUE(kt) do { const char* ab_ = abase + (size_t)(kt) * 128; _Pragma("unroll") for (int i = 0; i < GLA; ++i) sa[i] = *(const i32x4*)(ab_ + aoff[i]); \
        _Pragma("unroll") for (int r = 0; r < 8; ++r) sb[r] = *(const f32x4*)(bl + (size_t)((kt) * 64 + r) * ldb); \
        __builtin_amdgcn_sched_barrier(0); } while (0)
#define G_WRITE(buf) do { char* sbase = shm + (buf) * STAGE; _Pragma("unroll") for (int i = 0; i < GLA; ++i) *(i32x4*)(sbase + awoff + i * 8192) = sa[i]; \
        _Pragma("unroll") for (int i = 0; i < 4; ++i) { i32x4 w; w[0] = (int)cvt_pk_bf16(sb[0][i], sb[1][i]); w[1] = (int)cvt_pk_bf16(sb[2][i], sb[3][i]); \
              w[2] = (int)cvt_pk_bf16(sb[4][i], sb[5][i]); w[3] = (int)cvt_pk_bf16(sb[6][i], sb[7][i]); *(i32x4*)(sbase + bwoff + i * 2048) = w; } } while (0)
        G_ISSUE(0); G_WRITE(0); if (nt > 1) G_ISSUE(1); __syncthreads();
        for (int t = 0; t < nt; ++t) {
            const int cur = t & 1; const bool w_ok = t + 1 < nt, i_ok = t + 2 < nt;
            char* wb_ = shm + (cur ^ 1) * STAGE; const char* ab2_ = abase + (size_t)(t + 2) * 128; const char* bl2_ = bl + (size_t)(t + 2) * 64 * ldb;
#define G_HOOK(g) do { if ((g) < GLA) { if (w_ok) *(i32x4*)(wb_ + awoff + (g) * 8192) = sa[(g)]; if (i_ok) sa[(g)] = *(const i32x4*)(ab2_ + aoff[(g)]); } \
            else if ((g) >= 8 && (g) < 12) { if (w_ok) { const int i = (g) - 8; i32x4 w; w[0] = (int)cvt_pk_bf16(sb[0][i], sb[1][i]); w[1] = (int)cvt_pk_bf16(sb[2][i], sb[3][i]); \
                  w[2] = (int)cvt_pk_bf16(sb[4][i], sb[5][i]); w[3] = (int)cvt_pk_bf16(sb[6][i], sb[7][i]); *(i32x4*)(wb_ + bwoff + i * 2048) = w; } } \
            else if ((g) >= 12) { if (i_ok) { const int r = ((g) - 12) * 2; sb[r] = *(const f32x4*)(bl2_ + (size_t)r * ldb); sb[r + 1] = *(const f32x4*)(bl2_ + (size_t)(r + 1) * ldb); } } } while (0)
            GEMM_KTILE(cur, G_HOOK);
#undef G_HOOK
            __syncthreads();
        }
#undef G_ISSUE
#undef G_WRITE
    }
    struct NoEpi { __device__ __forceinline__ void operator()(int) const {} };
    template <class AccT>
    static __device__ __forceinline__ void run_bt(char* shm, const char* abase, const unsigned (&aoff)[GLA], const char* bbase, const unsigned (&boff)[4], unsigned ldbt, const char* pf_in, int nt, AccT& acc) {
        run_bt_seg<1 << 20>(shm, abase, aoff, bbase, boff, ldbt, 0, pf_in, nt, acc, NoEpi());
    }
    template <int SEG, class AccT, class Epi>
    static __device__ __forceinline__ void run_bt_seg(char* shm, const char* abase, const unsigned (&aoff)[GLA], const char* bbase, const unsigned (&boff)[4], unsigned ldbt, size_t segstride, const char* pf_in, int nt, AccT& acc, Epi seg_epi) {
        const int tid = tid_opaque(), wid = tid >> 6, lane = tid & 63, wr = wid >> 2, wc = wid & 3, fr = lane & 15, fq = lane >> 4;
        i32x4 sa[GLA], sbt[4];
        const unsigned astr = 64u * DM_ * 2u, bstr = 64u * ldbt;
        const int awoff = lds_rc(tid >> 3, tid & 7);
        const int aroff0 = lds_rc(wr * (BM / 2) + fr, fq), aroff1 = lds_rc(wr * (BM / 2) + fr, 4 + fq);
        const int broff0 = TILE_A + lds_rc(wc * 64 + fr, fq), broff1 = TILE_A + lds_rc(wc * 64 + fr, 4 + fq);
#define T_ISSUE(kt) do { const char* ab_ = abase + (size_t)(kt) * 128 + aoff[0]; const char* bb_ = bbase + (size_t)((kt) / SEG) * segstride + (size_t)((kt) % SEG) * 128 + boff[0]; \
        _Pragma("unroll") for (int i = 0; i < GLA; ++i) sa[i] = *(const i32x4*)(ab_ + (size_t)i * astr); \
        _Pragma("unroll") for (int i = 0; i < 4; ++i) sbt[i] = *(const i32x4*)(bb_ + (size_t)i * bstr); \
        __builtin_amdgcn_sched_barrier(0); } while (0)
#define T_WRITE(buf) do { char* sbase = shm + (buf) * STAGE; _Pragma("unroll") for (int i = 0; i < GLA; ++i) *(i32x4*)(sbase + awoff + i * 8192) = sa[i]; \
        _Pragma("unroll") for (int i = 0; i < 4; ++i) *(i32x4*)(sbase + TILE_A + awoff + i * 8192) = sbt[i]; } while (0)
        const unsigned long long pf0 = (unsigned long long)pf_in;
        const unsigned long long pfu = ((unsigned long long)(unsigned)__builtin_amdgcn_readfirstlane((int)(pf0 >> 32)) << 32) | (unsigned)__builtin_amdgcn_readfirstlane((int)(unsigned)pf0);
        const char* pf = (const char*)pfu; const unsigned pfo = (unsigned)(pf0 - pfu);
        unsigned pfa = 0u, pfb = 0u;
        T_ISSUE(0); T_WRITE(0); if (nt > 1) T_ISSUE(1);
#if GEMM_L2PF
        if (nt > 2) pfa = *(const unsigned*)(pf + 2 * 128 + pfo);
#endif
        __syncthreads();
        for (int t = 0; t < nt; ++t) {
            const int cur = t & 1;
            const bool w_ok = t + 1 < nt, i_ok = t + 2 < nt;
            char* wb_ = shm + (cur ^ 1) * STAGE; const char* ab2_ = abase + (size_t)(t + 2) * 128 + aoff[0];
            const char* bb2_ = bbase + (size_t)((t + 2) / SEG) * segstride + (size_t)((t + 2) % SEG) * 128 + boff[0];
#define T_HOOK(g) do { if ((g) < GLA) { if (w_ok) *(i32x4*)(wb_ + awoff + (g) * 8192) = sa[(g)]; if (i_ok) sa[(g)] = *(const i32x4*)(ab2_ + (size_t)(g) * astr); } \
            else if ((g) < GLA + 4) { const int i = (g) - GLA; if (w_ok) *(i32x4*)(wb_ + TILE_A + awoff + i * 8192) = sbt[i]; if (i_ok) sbt[i] = *(const i32x4*)(bb2_ + (size_t)i * bstr); } } while (0)
#if GEMM_L2PF
            if (t + 3 < nt) pfb = *(const unsigned*)(pf + (size_t)(t + 3) * 128 + pfo);
            asm volatile("" :: "v"(pfa));
            pfa = pfb;
#endif
            GEMM_KTILE(cur, T_HOOK);
#undef T_HOOK
            __syncthreads();
            if ((t % SEG) == SEG - 1) seg_epi(t / SEG);
        }
#undef T_ISSUE
#undef T_WRITE
    }
    static __device__ __forceinline__ void bt_coord(int tid, int i, int& col, int& C) { const int R = (tid >> 3) + 64 * i; C = (tid & 7) * 8;
        col = (R & ~63) + 4 * (R & 15) + ((R >> 4) & 3); }
    static __device__ __forceinline__ void a_coord(int tid, int i, int& R, int& C) { R = (tid >> 3) + 64 * i; C = (tid & 7) * 8; }
    static __device__ __forceinline__ void b_coord(int tid, int& k, int& col, int& which) { const int wid = tid >> 6, lane = tid & 63; const int kq = lane & 3, ngl = lane >> 2, ksub = wid & 1, grp = wid >> 1;
        k = ksub * 32 + kq * 8; if (DUAL) { which = ngl >> 3; col = grp * 32 + 4 * (ngl & 7); } else { which = 0; col = grp * 64 + 4 * ngl; } }
};
#define PROJW 5632
__device__ __forceinline__ float sigmoidf_(float x) { return 1.0f / (1.0f + expf(-x)); }
__device__ __forceinline__ float siluf_(float x) { return x / (1.0f + expf(-x)); }
__device__ __forceinline__ float softplusf_(float x) { return x > 20.f ? x : log1pf(expf(x)); }
__device__ __forceinline__ float sigmoid_fast_(float x) { return __builtin_amdgcn_rcpf(1.0f + __expf(-x)); }
__device__ __forceinline__ float silu_fast_(float x) { return x * __builtin_amdgcn_rcpf(1.0f + __expf(-x)); }
__device__ __forceinline__ float softplus_fast_(float x) { const float e = __expf(x); const float sm = e * (1.0f - e * (0.5f - e * (1.0f / 3.0f))); return x > 15.f ? x : (e < 0.01f ? sm : __logf(1.0f + e)); }
__device__ __forceinline__ float gelu_tanh_(float x) { const float u2 = 1.5957691216057308f * (x + 0.044715f * x * x * x); return x * __builtin_amdgcn_rcpf(1.0f + __expf(-u2)); }

__device__ __forceinline__ float block_sum_256(float v, float* red) {
    for (int o = 32; o > 0; o >>= 1) v += __shfl_down(v, o, 64);
    __syncthreads();
    if ((tid_opaque() & 63) == 0) red[tid_opaque() >> 6] = v;
    __syncthreads();
    float r = red[0] + red[1] + red[2] + red[3];
    __syncthreads();
    return r;
}
__device__ __forceinline__ float block_max_256(float v, float* red) {
    for (int o = 32; o > 0; o >>= 1) v = fmaxf(v, __shfl_down(v, o, 64));
    __syncthreads();
    if ((tid_opaque() & 63) == 0) red[tid_opaque() >> 6] = v;
    __syncthreads();
    float r = fmaxf(fmaxf(red[0], red[1]), fmaxf(red[2], red[3]));
    __syncthreads();
    return r;
}

__device__ __forceinline__ int t5_bucket(int rel) {
    const int ret = rel > 0 ? 16 : 0; const int n = rel < 0 ? -rel : rel;
    if (n < 8) return ret + n;
    const float v = logf((float)n / 8.0f) / 2.772588722239781f * 8.0f;
    int large = 8 + (int)v; if (large > 15) large = 15;
    return ret + large;
}
struct AP { const bf16_t* proj; const bf16_t* vt; const float* rel_bias; const float* dlam; const float* subg; bf16_t* br; float lam_init; };
#define ATT_LDS (2 * 32768 + 2048)
__device__ __forceinline__ void phase_attn(char* shm, const AP& p) {
    float* btab = (float*)(shm + 65536);
    const float LOG2E = 1.4426950408889634f;
    for (int unit = bid_opaque(); unit < NB_ * 4 * 16; unit += grid_n()) {
        const int xq = unit & 7, sq = unit >> 3, bh = (xq * 2 + (sq >> 4)) & 15, qt = sq & 15, h = bh & 3, b = bh >> 2;
        const int tid = tid_opaque(), wid = tid >> 6, lane = tid & 63, fr = lane & 15, fq = lane >> 4;
        __syncthreads();
        if (tid < 257) btab[tid] = p.rel_bias[t5_bucket(tid - 128) * 4 + h] * LOG2E;
        float l0 = 0.f, l1 = 0.f;
        for (int d = 0; d < 64; ++d) { l0 += p.dlam[d] * p.dlam[64 + d]; l1 += p.dlam[128 + d] * p.dlam[192 + d]; }
        const float lam = expf(l0) - expf(l1) + p.lam_init;
        const int q0 = qt * 128, qrow = q0 + wid * 16 + fr;
        bf16x8 qf[2][2];
        { const bf16_t* qp = p.proj + (size_t)(b * SEQ_ + qrow) * PROJW + O_DA + h * 128 + fq * 8;
#pragma unroll
          for (int i = 0; i < 2; ++i)
#pragma unroll
            for (int s = 0; s < 2; ++s) qf[i][s] = *(const bf16x8*)(qp + i * 64 + s * 32); }
        const bf16_t* kg[2]; const bf16_t* vg[2]; int kl[2], vl[2]; bool vswap[2];
#pragma unroll
        for (int u = 0; u < 2; ++u) {
            const int c = tid + u * 512;
            const int krow = c >> 4, kch = c & 15;
            kg[u] = p.proj + (size_t)(b * SEQ_ + krow) * PROJW + O_DA + 512 + h * 128 + kch * 8;
            kl[u] = krow * 256 + ((kch ^ (krow & 15)) * 16);
            const int dv = c >> 3, ch16 = c & 7;
            vg[u] = p.vt + (size_t)(b * 512 + h * 128 + dv) * SEQ_ + ch16 * 8;
            vl[u] = 16384 + dv * 128 + ((ch16 ^ ((dv & 15) >> 1)) * 16); vswap[u] = dv & 1;
        }
        i32x4 sk[2], sv[2];
#define A_ISSUE(kt) do { _Pragma("unroll") for (int u = 0; u < 2; ++u) { sk[u] = *(const i32x4*)(kg[u] + (size_t)(kt) * 64 * PROJW); sv[u] = *(const i32x4*)(vg[u] + (kt) * 64); } } while (0)
#define A_WRITE(buf) do { char* sb_ = shm + (buf) * 32768; _Pragma("unroll") for (int u = 0; u < 2; ++u) { *(i32x4*)(sb_ + kl[u]) = sk[u]; \
            i32x4 w_ = sv[u]; if (vswap[u]) w_ = (i32x4){sv[u][2], sv[u][3], sv[u][0], sv[u][1]}; *(i32x4*)(sb_ + vl[u]) = w_; } } while (0)
        f32x4 O[2][8];
#pragma unroll
        for (int i = 0; i < 2; ++i)
#pragma unroll
            for (int f = 0; f < 8; ++f) O[i][f] = (f32x4){0.f, 0.f, 0.f, 0.f};
        float mrun[2] = {-1e30f, -1e30f}, lrun[2] = {0.f, 0.f};
        A_ISSUE(0); A_WRITE(0); A_ISSUE(1); __syncthreads();
        const int NT = SEQ_ / 64;
        for (int kt = 0; kt < NT; ++kt) {
            const int cur = kt & 1;
            if (kt + 1 < NT) A_WRITE(cur ^ 1);
            if (kt + 2 < NT) A_ISSUE(kt + 2);
            const char* sK = shm + cur * 32768; const char* sV = sK + 16384;
            f32x4 S[2][4];
#pragma unroll
            for (int i = 0; i < 2; ++i)
#pragma unroll
                for (int kf = 0; kf < 4; ++kf) {
                    f32x4 a = (f32x4){0.f, 0.f, 0.f, 0.f};
#pragma unroll
                    for (int s = 0; s < 2; ++s) {
                        const int row = kf * 16 + fr, ch = i * 8 + s * 4 + fq;
                        const bf16x8 kfA = *(const bf16x8*)(sK + row * 256 + ((ch ^ (row & 15)) * 16));
                        a = __builtin_amdgcn_mfma_f32_16x16x32_bf16(kfA, qf[i][s], a, 0, 0, 0);
                    }
                    S[i][kf] = a;
                }
            const int k0 = kt * 64;
            const bool far_hi = (k0 >= q0 + 127 + 128), far_lo = (k0 + 63 <= q0 - 128);
            const float c1 = 0.125f * LOG2E;
            if (far_hi || far_lo) {
                const float bc_ = far_hi ? btab[256] : btab[0];
#pragma unroll
                for (int i = 0; i < 2; ++i)
#pragma unroll
                    for (int kf = 0; kf < 4; ++kf)
#pragma unroll
                        for (int j = 0; j < 4; ++j) S[i][kf][j] = S[i][kf][j] * c1 + bc_;
            } else {
#pragma unroll
                for (int kf = 0; kf < 4; ++kf)
#pragma unroll
                    for (int j = 0; j < 4; ++j) {
                        int rel = (k0 + kf * 16 + fq * 4 + j) - qrow; rel = rel < -128 ? -128 : (rel > 128 ? 128 : rel);
                        const float bv_ = btab[rel + 128];
                        S[0][kf][j] = S[0][kf][j] * c1 + bv_; S[1][kf][j] = S[1][kf][j] * c1 + bv_;
                    }
            }
            bf16x8 Pf[2][2];
#pragma unroll
            for (int i = 0; i < 2; ++i) {
                float mx = S[i][0][0];
#pragma unroll
                for (int kf = 0; kf < 4; ++kf)
#pragma unroll
                    for (int j = 0; j < 4; ++j) mx = fmaxf(mx, S[i][kf][j]);
                mx = fmaxf(mx, __shfl_xor(mx, 16, 64)); mx = fmaxf(mx, __shfl_xor(mx, 32, 64));
                const float mnew = fmaxf(mrun[i], mx);
                const float alpha = __builtin_amdgcn_exp2f(mrun[i] - mnew);
                mrun[i] = mnew;
                float ps = 0.f;
#pragma unroll
                for (int kf = 0; kf < 4; ++kf)
#pragma unroll
                    for (int j = 0; j < 4; ++j) { const float e = __builtin_amdgcn_exp2f(S[i][kf][j] - mnew); S[i][kf][j] = e; ps += e; }
                ps += __shfl_xor(ps, 16, 64); ps += __shfl_xor(ps, 32, 64);
                lrun[i] = lrun[i] * alpha + ps;
                if (__any(alpha != 1.0f)) {
#pragma unroll
                    for (int f = 0; f < 8; ++f) { O[i][f][0] *= alpha; O[i][f][1] *= alpha; O[i][f][2] *= alpha; O[i][f][3] *= alpha; }
                }
#pragma unroll
                for (int g = 0; g < 2; ++g) {
                    i32x4 w;
                    w[0] = (int)cvt_pk_bf16(S[i][2 * g][0], S[i][2 * g][1]); w[1] = (int)cvt_pk_bf16(S[i][2 * g][2], S[i][2 * g][3]);
                    w[2] = (int)cvt_pk_bf16(S[i][2 * g + 1][0], S[i][2 * g + 1][1]); w[3] = (int)cvt_pk_bf16(S[i][2 * g + 1][2], S[i][2 * g + 1][3]);
                    Pf[i][g] = __builtin_bit_cast(bf16x8, w);
                }
            }
#pragma unroll
            for (int f = 0; f < 8; ++f)
#pragma unroll
                for (int g = 0; g < 2; ++g) {
                    const int dv = f * 16 + fr, x = dv & 15;
                    const uint2 v0 = *(const uint2*)(sV + dv * 128 + (((8 * g + fq) ^ x) * 8));
                    const uint2 v1 = *(const uint2*)(sV + dv * 128 + (((8 * g + 4 + fq) ^ x) * 8));
                    const i32x4 w = (i32x4){(int)v0.x, (int)v0.y, (int)v1.x, (int)v1.y};
                    const bf16x8 vA = __builtin_bit_cast(bf16x8, w);
                    O[0][f] = __builtin_amdgcn_mfma_f32_16x16x32_bf16(vA, Pf[0][g], O[0][f], 0, 0, 0);
                    O[1][f] = __builtin_amdgcn_mfma_f32_16x16x32_bf16(vA, Pf[1][g], O[1][f], 0, 0, 0);
                }
            __syncthreads();
        }
#undef A_ISSUE
#undef A_WRITE
        const float r0 = 1.0f / lrun[0], r1 = lam / lrun[1];
        float ss = 0.f;
#pragma unroll
        for (int f = 0; f < 8; ++f)
#pragma unroll
            for (int j = 0; j < 4; ++j) { const float o = O[0][f][j] * r0 - O[1][f][j] * r1; O[0][f][j] = o; ss += o * o; }
        ss += __shfl_xor(ss, 16, 64); ss += __shfl_xor(ss, 32, 64);
        const float rs = rsqrtf(ss * (1.0f / 128.0f) + 1e-5f) * (1.0f - p.lam_init);
        bf16_t* op = p.br + (size_t)(b * SEQ_ + qrow) * DM_ + 1024 + h * 128 + fq * 4;
        f32x4 gv[8];
#pragma unroll
        for (int f = 0; f < 8; ++f) gv[f] = *(const f32x4*)(p.subg + f * 16 + fq * 4);
#pragma unroll
        for (int f = 0; f < 8; ++f) {
            uint2 o; o.x = cvt_pk_bf16(O[0][f][0] * rs * gv[f][0], O[0][f][1] * rs * gv[f][1]); o.y = cvt_pk_bf16(O[0][f][2] * rs * gv[f][2], O[0][f][3] * rs * gv[f][3]);
            *(uint2*)(op + f * 16) = o;
        }
    }
}

#define HY_PPW 2112
#define HY_PADL 1040
#define HY_VLEN 4112
#define HY_LDS (HY_PPW * 4 + 4 * HY_VLEN * 2)
struct HP { const bf16_t* proj; const float* fr; const float* nrm; unsigned* pp; bf16_t* vvt; float* yt; const float* cw; const float* cb; const float* hbias; bf16_t* br; };

__device__ __forceinline__ void phase_hy_pp(const HP& p) {
    for (int idx = bid_opaque() * 512 + tid_opaque(); idx < 512 * HY_PPW; idx += grid_n() * 512) {
        const int c = idx / HY_PPW, u = idx - c * HY_PPW;
        const float inv = 1.0f / p.nrm[c];
        const int s0 = 2080 - u, s1 = 2080 - (u + 1);
        const float f0 = (s0 >= 0 && s0 < SEQ_) ? p.fr[(size_t)s0 * 512 + c] * inv : 0.f;
        const float f1 = (s1 >= 0 && s1 < SEQ_) ? p.fr[(size_t)s1 * 512 + c] * inv : 0.f;
        p.pp[idx] = cvt_pk_bf16(f0, f1);
    }
}
__device__ __forceinline__ void unpack8(const uint4 v, float (&f)[8]) {
    f[0] = __uint_as_float(v.x << 16); f[1] = __uint_as_float(v.x & 0xffff0000u); f[2] = __uint_as_float(v.y << 16); f[3] = __uint_as_float(v.y & 0xffff0000u);
    f[4] = __uint_as_float(v.z << 16); f[5] = __uint_as_float(v.z & 0xffff0000u); f[6] = __uint_as_float(v.w << 16); f[7] = __uint_as_float(v.w & 0xffff0000u);
}
__device__ __forceinline__ void phase_hy_prep(char* shm, const HP& p) {
    bf16_t* tile = (bf16_t*)shm;
    for (int unit = bid_opaque(); unit < NB_ * 32 * 8; unit += grid_n()) {
        const int ct = unit & 7, tt = (unit >> 3) & 31, b = unit >> 8;
        const int tid = tid_opaque(), tl = tid >> 3, c8 = (tid & 7) * 8, c = ct * 64 + c8, t = tt * 64 + tl;
        float s1[8], s2[8];
#pragma unroll
        for (int e = 0; e < 8; ++e) { s1[e] = p.cb[512 + c + e]; s2[e] = p.cb[1024 + c + e]; }
        uint4 r1[3], r2[3];
#pragma unroll
        for (int k = 0; k < 3; ++k) { const int t2 = t + k - 1, t2c = t2 < 0 ? 0 : (t2 >= SEQ_ ? SEQ_ - 1 : t2);
            const bf16_t* pr = p.proj + (size_t)(b * SEQ_ + t2c) * PROJW + O_HY + c; r1[k] = *(const uint4*)(pr + 512); r2[k] = *(const uint4*)(pr + 1024);
            const unsigned mk = t2 == t2c ? 0xffffffffu : 0u; r1[k].x &= mk; r1[k].y &= mk; r1[k].z &= mk; r1[k].w &= mk; r2[k].x &= mk; r2[k].y &= mk; r2[k].z &= mk; r2[k].w &= mk; }
        f32x4 wq[3][4];
#pragma unroll
        for (int k = 0; k < 3; ++k) { wq[k][0] = *(const f32x4*)(p.cw + k * 1536 + 512 + c); wq[k][1] = *(const f32x4*)(p.cw + k * 1536 + 512 + c + 4);
            wq[k][2] = *(const f32x4*)(p.cw + k * 1536 + 1024 + c); wq[k][3] = *(const f32x4*)(p.cw + k * 1536 + 1024 + c + 4); }
        __builtin_amdgcn_sched_barrier(0);
#pragma unroll
        for (int k = 0; k < 3; ++k) {
            float x1[8], xv[8]; unpack8(r1[k], x1); unpack8(r2[k], xv);
            const f32x4 wa = wq[k][0], wb = wq[k][1], va = wq[k][2], vb = wq[k][3];
#pragma unroll
            for (int e = 0; e < 4; ++e) { s1[e] += wa[e] * x1[e]; s1[e + 4] += wb[e] * x1[e + 4]; s2[e] += va[e] * xv[e]; s2[e + 4] += vb[e] * xv[e + 4]; }
        }
        __syncthreads();
#pragma unroll
        for (int e = 0; e < 8; ++e) tile[(c8 + e) * 72 + tl] = f2bf(s1[e] * s2[e]);
        __syncthreads();
        { const int cl = tid >> 3, t8 = (tid & 7) * 8;
          *(uint4*)(p.vvt + ((size_t)(ct * 64 + cl) * NB_ + b) * SEQ_ + tt * 64 + t8) = *(const uint4*)(tile + cl * 72 + t8); }
    }
}
__device__ __forceinline__ void phase_hy_conv(char* shm, const HP& p) {
    unsigned* pps = (unsigned*)shm;
    bf16_t* vs = (bf16_t*)(shm + HY_PPW * 4);
    for (int c = bid_opaque(); c < 512; c += grid_n()) {
        const int tid = tid_opaque(), wid = tid >> 6, lane = tid & 63, fr = lane & 15, h = lane >> 4;
        __syncthreads();
        for (int i = tid; i < HY_PPW; i += 512) pps[i] = p.pp[(size_t)c * HY_PPW + i];
        for (int i = tid; i < 4 * (HY_VLEN / 8); i += 512) {
            const int b = i / (HY_VLEN / 8), ch = i - b * (HY_VLEN / 8), e0 = ch * 8 - HY_PADL;
            const int e0c = e0 < 0 ? 0 : (e0 >= SEQ_ ? SEQ_ - 8 : e0);
            uint4 v = *(const uint4*)(p.vvt + ((size_t)c * NB_ + b) * SEQ_ + e0c);
            if (e0 != e0c) v = make_uint4(0u, 0u, 0u, 0u);
            *(uint4*)(vs + b * HY_VLEN + ch * 8) = v;
        }
        __syncthreads();
        const int b = wid >> 1, ib = (wid & 1) * 64;
        f32x4 acc[4];
#pragma unroll
        for (int f = 0; f < 4; ++f) acc[f] = (f32x4){0.f, 0.f, 0.f, 0.f};
        const int ua = 1056 - 16 * (h >> 1) - fr + 8 * (h & 1);
        const bf16_t* vb = vs + b * HY_VLEN + HY_PADL + 16 * (ib + fr - (h >> 1)) + 8 * (h & 1);
#define HY_LOAD(d0_, af_, bf_) do { const unsigned* ap_ = pps + (ua - 16 * (d0_)); const i32x4 aw_ = (i32x4){(int)ap_[0], (int)ap_[2], (int)ap_[4], (int)ap_[6]}; af_ = __builtin_bit_cast(bf16x8, aw_); \
        _Pragma("unroll") for (int f = 0; f < 4; ++f) bf_[f] = *(const bf16x8*)(vb + 16 * (16 * f - (d0_))); } while (0)
        bf16x8 afA, afB, bfA[4], bfB[4];
        HY_LOAD(-64, afA, bfA);
        for (int d0 = -64; d0 < 64; d0 += 4) {
            HY_LOAD(d0 + 2, afB, bfB);
            __builtin_amdgcn_sched_barrier(0);
#pragma unroll
            for (int f = 0; f < 4; ++f) acc[f] = __builtin_amdgcn_mfma_f32_16x16x32_bf16(afA, bfA[f], acc[f], 0, 0, 0);
            __builtin_amdgcn_sched_barrier(0);
            HY_LOAD(d0 + 4, afA, bfA);
            __builtin_amdgcn_sched_barrier(0);
#pragma unroll
            for (int f = 0; f < 4; ++f) acc[f] = __builtin_amdgcn_mfma_f32_16x16x32_bf16(afB, bfB[f], acc[f], 0, 0, 0);
            __builtin_amdgcn_sched_barrier(0);
        }
#pragma unroll
        for (int f = 0; f < 4; ++f) acc[f] = __builtin_amdgcn_mfma_f32_16x16x32_bf16(afA, bfA[f], acc[f], 0, 0, 0);
#undef HY_LOAD
        const float hb = p.hbias[c];
#pragma unroll
        for (int f = 0; f < 4; ++f) {
            const int t = 16 * (ib + 16 * f + fr) + 4 * h;
            const bf16_t* vv = vs + b * HY_VLEN + HY_PADL + t;
            f32x4 o; o[0] = acc[f][0] + bf2f(vv[0]) * hb; o[1] = acc[f][1] + bf2f(vv[1]) * hb; o[2] = acc[f][2] + bf2f(vv[2]) * hb; o[3] = acc[f][3] + bf2f(vv[3]) * hb;
            *(f32x4*)(p.yt + ((size_t)c * NB_ + b) * SEQ_ + t) = o;
        }
    }
}
__device__ __forceinline__ void phase_hy_fin(char* shm, const HP& p, int bw0, int bwn) {
    float* tile = (float*)shm;
    const int bq = bid_opaque() - bw0; if (bq < 0 || bq >= bwn) return;
    for (int unit = bq; unit < NB_ * 32 * 8; unit += bwn) {
        const int ct = unit & 7, tt = (unit >> 3) & 31, b = unit >> 8, tid = tid_opaque();
        __syncthreads();
        { const int cl = tid >> 3, t8 = (tid & 7) * 8; const float* src = p.yt + ((size_t)(ct * 64 + cl) * NB_ + b) * SEQ_ + tt * 64 + t8;
          const f32x4 a = *(const f32x4*)src, bq = *(const f32x4*)(src + 4);
#pragma unroll
          for (int q = 0; q < 4; ++q) { tile[cl * 65 + t8 + q] = a[q]; tile[cl * 65 + t8 + 4 + q] = bq[q]; } }
        __syncthreads();
        const int cl = tid & 63, c = ct * 64 + cl, tq = tid >> 6;
        float w0[3];
#pragma unroll
        for (int k = 0; k < 3; ++k) w0[k] = p.cw[k * 1536 + c];
        const float b0 = p.cb[c];
        float xr[10];
#pragma unroll
        for (int r = 0; r < 10; ++r) { const int t2 = tt * 64 + tq * 8 + r - 1, t2c = t2 < 0 ? 0 : (t2 >= SEQ_ ? SEQ_ - 1 : t2);
            xr[r] = __uint_as_float((unsigned)p.proj[(size_t)(b * SEQ_ + t2c) * PROJW + O_HY + c]); }
        __builtin_amdgcn_sched_barrier(0);
#pragma unroll
        for (int r = 0; r < 10; ++r) { const int t2 = tt * 64 + tq * 8 + r - 1; xr[r] = (t2 >= 0 && t2 < SEQ_) ? __uint_as_float(__float_as_uint(xr[r]) << 16) : 0.f; }
#pragma unroll
        for (int q = 0; q < 8; ++q) {
            const int tl = tq * 8 + q, t = tt * 64 + tl;
            float s = b0;
#pragma unroll
            for (int k = 0; k < 3; ++k) s += w0[k] * xr[q + k];
            p.br[(size_t)(b * SEQ_ + t) * DM_ + c] = f2bf(tile[cl * 65 + tl] * s);
        }
    }
}
struct LP { const bf16_t* proj; const float* cw; const float* cb; const bf16_t* wt; const float* ba; const float* bx; const float* lam; float* sumP; float* sumE; bf16_t* br; };
#define LRU_LDS (32768 + 8192 + 64 * 65 * 4 + 2 * 64 * 65 * 4 + 2 * 2 * 16 * 64 * 4)
template <int PASS>
__device__ __forceinline__ void phase_lru(char* shm, const LP& p) {
    char* sW = shm;
    char* sXb = shm + 32768;
    float* X = (float*)(shm + 40960);
    float* H = X + 64 * 65;
    float* SP = H + 2 * 64 * 65;
    float* SE = SP + 2 * 16 * 64;
    for (int unit = bid_opaque(); unit < NB_ * 8 * 32; unit += grid_n()) {
        const int k = unit & 31, b = (unit >> 5) & 3, h = unit >> 7;
        const int tid = tid_opaque();
        __syncthreads();
        for (int i = tid; i < 256 * 8; i += 512) { const int row = i >> 3, ch = i & 7;
            *(uint4*)(sW + lds_rc(row, ch)) = *(const uint4*)(p.wt + ((size_t)h * 256 + row) * 64 + ch * 8); }
        { const int j = tid & 63, tq = tid >> 6, ch = h * 64 + j;
          float w4[4];
#pragma unroll
          for (int q = 0; q < 4; ++q) w4[q] = p.cw[q * 512 + ch];
          const float cbv = p.cb[ch];
          float xr[11];
#pragma unroll
          for (int r = 0; r < 11; ++r) { const int t2 = k * 64 + tq * 8 + r - 2, t2c = t2 < 0 ? 0 : (t2 >= SEQ_ ? SEQ_ - 1 : t2);
              xr[r] = __uint_as_float((unsigned)p.proj[(size_t)(b * SEQ_ + t2c) * PROJW + O_LRU + ch]); }
          __builtin_amdgcn_sched_barrier(0);
#pragma unroll
          for (int r = 0; r < 11; ++r) { const int t2 = k * 64 + tq * 8 + r - 2; xr[r] = (t2 >= 0 && t2 < SEQ_) ? __uint_as_float(__float_as_uint(xr[r]) << 16) : 0.f; }
#pragma unroll
          for (int q = 0; q < 8; ++q) {
              const int tl = tq * 8 + q; float s = cbv;
#pragma unroll
              for (int kk = 0; kk < 4; ++kk) s += w4[kk] * xr[q + kk];
              X[tl * 65 + j] = s;
              *(bf16_t*)(sXb + lds_rc(tl, j >> 3) + (j & 7) * 2) = f2bf(s);
          } }
        __syncthreads();
        const int wid = tid >> 6, lane = tid & 63, fr = lane & 15, fq = lane >> 4, dir = wid & 1, jf = wid >> 1, j = jf * 16 + fr, ch = h * 64 + j;
        f32x4 G[4][2];
        { const float bav = p.ba[dir * 512 + ch], bxv = p.bx[dir * 512 + ch];
#pragma unroll
          for (int tf = 0; tf < 4; ++tf) { G[tf][0] = (f32x4){bav, bav, bav, bav}; G[tf][1] = (f32x4){bxv, bxv, bxv, bxv}; } }
#pragma unroll
        for (int ks = 0; ks < 2; ++ks) {
            const bf16x8 wA = *(const bf16x8*)(sW + lds_rc((dir * 2 + 0) * 64 + j, ks * 4 + fq));
            const bf16x8 wX = *(const bf16x8*)(sW + lds_rc((dir * 2 + 1) * 64 + j, ks * 4 + fq));
#pragma unroll
            for (int tf = 0; tf < 4; ++tf) {
                const bf16x8 xa = *(const bf16x8*)(sXb + lds_rc(tf * 16 + fr, ks * 4 + fq));
                G[tf][0] = __builtin_amdgcn_mfma_f32_16x16x32_bf16(xa, wA, G[tf][0], 0, 0, 0);
                G[tf][1] = __builtin_amdgcn_mfma_f32_16x16x32_bf16(xa, wX, G[tf][1], 0, 0, 0);
            }
        }
        const float spl = softplus_fast_(-p.lam[dir * 512 + ch]);
        const int tfirst = dir ? (SEQ_ - 1) : 0;
#pragma unroll
        for (int tf = 0; tf < 4; ++tf) {
            float P = 1.f, E = 0.f;
#pragma unroll
            for (int qq = 0; qq < 4; ++qq) {
                const int q = dir ? 3 - qq : qq, tl = tf * 16 + fq * 4 + q, t = k * 64 + tl;
                const float r = sigmoid_fast_(G[tf][0][q]), ig = sigmoid_fast_(G[tf][1][q]);
                const float log_a = -8.0f * r * spl;
                const float x2 = 2.0f * log_a;
                const float om = x2 > -0.02f ? -x2 * (1.0f + x2 * (0.5f + x2 * (1.0f / 6.0f))) : 1.0f - __expf(x2);
                float mult = __builtin_amdgcn_sqrtf(om); if (t == tfirst) mult = 1.0f;
                const float av = __expf(log_a), bv = mult * ig * X[tl * 65 + j];
                G[tf][0][q] = av; G[tf][1][q] = bv;
                E = av * E + bv; P *= av;
            }
            SP[(dir * 16 + tf * 4 + fq) * 64 + j] = P; SE[(dir * 16 + tf * 4 + fq) * 64 + j] = E;
        }
        __syncthreads();
        const size_t sbase = ((size_t)(dir * NB_ + b) * 32) * 512 + ch;
        if (PASS == 0) {
            if (fq == 0) {
                float cP = 1.f, cE = 0.f;
                if (dir == 0) { for (int s = 0; s < 16; ++s) { cE = SP[s * 64 + j] * cE + SE[s * 64 + j]; cP *= SP[s * 64 + j]; } }
                else { for (int s = 15; s >= 0; --s) { cE = SP[(16 + s) * 64 + j] * cE + SE[(16 + s) * 64 + j]; cP *= SP[(16 + s) * 64 + j]; } }
                p.sumP[sbase + (size_t)k * 512] = cP; p.sumE[sbase + (size_t)k * 512] = cE;
            }
        } else {
            float c = 0.f;
            if (dir == 0) { for (int q = 0; q < k; ++q) c = p.sumP[sbase + (size_t)q * 512] * c + p.sumE[sbase + (size_t)q * 512]; }
            else { for (int q = 31; q > k; --q) c = p.sumP[sbase + (size_t)q * 512] * c + p.sumE[sbase + (size_t)q * 512]; }
            float cin[4];
            if (dir == 0) {
#pragma unroll
                for (int s = 0; s < 16; ++s) { if ((s & 3) == fq) cin[s >> 2] = c; c = SP[s * 64 + j] * c + SE[s * 64 + j]; }
            } else {
#pragma unroll
                for (int s = 15; s >= 0; --s) { if ((s & 3) == fq) cin[s >> 2] = c; c = SP[(16 + s) * 64 + j] * c + SE[(16 + s) * 64 + j]; }
            }
            float* Hd = H + dir * 64 * 65;
#pragma unroll
            for (int tf = 0; tf < 4; ++tf) {
                float cc = cin[tf];
#pragma unroll
                for (int qq = 0; qq < 4; ++qq) { const int q = dir ? 3 - qq : qq; cc = G[tf][0][q] * cc + G[tf][1][q]; Hd[(tf * 16 + fq * 4 + q) * 65 + j] = cc; }
            }
            __syncthreads();
            const int j2 = tid & 63, tq = tid >> 6, ch2 = h * 64 + j2;
            bf16_t gq[8];
#pragma unroll
            for (int q = 0; q < 8; ++q) gq[q] = p.proj[(size_t)(b * SEQ_ + k * 64 + tq * 8 + q) * PROJW + O_LRU + 512 + ch2];
            __builtin_amdgcn_sched_barrier(0);
#pragma unroll
            for (int q = 0; q < 8; ++q) {
                const int tl = tq * 8 + q; const size_t tok = (size_t)(b * SEQ_ + k * 64 + tl);
                const float g = bf2f(gq[q]);
                p.br[tok * DM_ + 512 + ch2] = f2bf((H[tl * 65 + j2] + H[64 * 65 + tl * 65 + j2]) * gelu_tanh_(g));
            }
        }
    }
}
struct SP_ { const bf16_t* proj; const float* dtraw; const float* cw; const float* cb; const float* dtb; const float* a_log; const float* dsk; const float* ng;
             bf16_t* xa; bf16_t* xT; float* states; float* decay; bf16_t* prev; bf16_t* br; };
#define SSD_Q 128
#define SSD_NC 16

__device__ __forceinline__ void phase_ssd_prep(char* shm, const SP_& p) {
    bf16_t* tile = (bf16_t*)shm;
    for (int unit = bid_opaque(); unit < NB_ * 32 * 16; unit += grid_n()) {
        const int ct = unit & 15, tt = (unit >> 4) & 31, b = unit >> 9;
        const int tid = tid_opaque(), tl = tid >> 3, c8 = (tid & 7) * 8, c = ct * 64 + c8, t = tt * 64 + tl;
        float s[8];
#pragma unroll
        for (int e = 0; e < 8; ++e) s[e] = p.cb[c + e];
        uint4 rr[4];
#pragma unroll
        for (int k = 0; k < 4; ++k) { const int t2 = t + k - 2, t2c = t2 < 0 ? 0 : (t2 >= SEQ_ ? SEQ_ - 1 : t2);
            rr[k] = *(const uint4*)(p.proj + (size_t)(b * SEQ_ + t2c) * PROJW + O_SSD + 512 + c); const unsigned mk = t2 == t2c ? 0xffffffffu : 0u; rr[k].x &= mk; rr[k].y &= mk; rr[k].z &= mk; rr[k].w &= mk; }
        f32x4 wq[4][2];
#pragma unroll
        for (int k = 0; k < 4; ++k) { wq[k][0] = *(const f32x4*)(p.cw + k * 1024 + c); wq[k][1] = *(const f32x4*)(p.cw + k * 1024 + c + 4); }
        __builtin_amdgcn_sched_barrier(0);
#pragma unroll
        for (int k = 0; k < 4; ++k) {
            float x[8]; unpack8(rr[k], x);
            const f32x4 wa = wq[k][0], wb = wq[k][1];
#pragma unroll
            for (int e = 0; e < 4; ++e) { s[e] += wa[e] * x[e]; s[e + 4] += wb[e] * x[e + 4]; }
        }
        uint4 o; o.x = cvt_pk_bf16(silu_fast_(s[0]), silu_fast_(s[1])); o.y = cvt_pk_bf16(silu_fast_(s[2]), silu_fast_(s[3]));
        o.z = cvt_pk_bf16(silu_fast_(s[4]), silu_fast_(s[5])); o.w = cvt_pk_bf16(silu_fast_(s[6]), silu_fast_(s[7]));
        *(uint4*)(p.xa + (size_t)(b * SEQ_ + t) * 1024 + c) = o;
        __syncthreads();
        tile[(c8 + 0) * 72 + tl] = (bf16_t)(o.x & 0xffffu); tile[(c8 + 1) * 72 + tl] = (bf16_t)(o.x >> 16); tile[(c8 + 2) * 72 + tl] = (bf16_t)(o.y & 0xffffu); tile[(c8 + 3) * 72 + tl] = (bf16_t)(o.y >> 16);
        tile[(c8 + 4) * 72 + tl] = (bf16_t)(o.z & 0xffffu); tile[(c8 + 5) * 72 + tl] = (bf16_t)(o.z >> 16); tile[(c8 + 6) * 72 + tl] = (bf16_t)(o.w & 0xffffu); tile[(c8 + 7) * 72 + tl] = (bf16_t)(o.w >> 16);
        __syncthreads();
        { const int c2 = tid >> 3, t8 = (tid & 7) * 8;
          *(uint4*)(p.xT + ((size_t)b * 1024 + ct * 64 + c2) * SEQ_ + tt * 64 + t8) = *(const uint4*)(tile + c2 * 72 + t8); }
    }
}
__device__ __forceinline__ void ssd_tables(float* dtv, float* cum, const SP_& p, int b, int c, int g) {
    const int tid = tid_opaque();
    for (int i = tid; i < 8 * SSD_Q; i += 512) {
        const int l = i & 127, hd = i >> 7, dir = hd >> 2, j = hd & 3, h = g * 4 + j;
        dtv[i] = softplus_fast_(p.dtraw[(size_t)(b * SEQ_ + c * SSD_Q + l) * 16 + dir * 8 + h] + p.dtb[dir * 8 + h]);
    }
    __syncthreads();
    const int t8 = tid_opaque();
    if (t8 < 8) {
        const int dir = t8 >> 2, j = t8 & 3, h = g * 4 + j; const float a = -__expf(p.a_log[dir * 8 + h]);
        float s = 0.f;
        if (dir == 0) for (int l = 0; l < SSD_Q; ++l) { s += dtv[t8 * 128 + l] * a; cum[t8 * 128 + l] = s; }
        else for (int l = SSD_Q - 1; l >= 0; --l) { s += dtv[t8 * 128 + l] * a; cum[t8 * 128 + l] = s; }
    }
    __syncthreads();
}
#define SSD1_LDS (65536 + 32768 + 8192)
__device__ __forceinline__ void phase_ssd_states(char* shm, const SP_& p) {
    char* sX = shm;
    char* sB = shm + 65536;
    float* dtv = (float*)(shm + 98304); float* cum = dtv + 1024;
    for (int unit = bid_opaque(); unit < NB_ * SSD_NC * 2 * 2; unit += grid_n()) {
        const int hp = unit & 1, g = (unit >> 1) & 1, c = (unit >> 2) & 15, b = unit >> 6;
        const int tid = tid_opaque(), wid = tid >> 6, lane = tid & 63, fr = lane & 15, fq = lane >> 4;
        __syncthreads();
        for (int i = tid; i < 128 * 16; i += 512) { const int row = i >> 4, ch = i & 15;
            *(uint4*)(sX + row * 256 + ((ch ^ (row & 15)) * 16)) = *(const uint4*)(p.xT + ((size_t)b * 1024 + g * 256 + hp * 128 + row) * SEQ_ + c * SSD_Q + ch * 8); }
        for (int i = tid; i < 128 * 16; i += 512) { const int row = i >> 4, ch = i & 15;
            *(uint4*)(sB + row * 256 + ((ch ^ (row & 15)) * 16)) = *(const uint4*)(p.xT + ((size_t)b * 1024 + 512 + g * 128 + row) * SEQ_ + c * SSD_Q + ch * 8); }
        ssd_tables(dtv, cum, p, b, c, g);
        const int jj = wid >> 2, dir = (wid >> 1) & 1, nh = wid & 1, j = hp * 2 + jj, hd = dir * 4 + j, h = g * 4 + j;
        const float* dth = dtv + hd * 128; const float* cm = cum + hd * 128;
        const float cend = dir ? cm[0] : cm[SSD_Q - 1];
        f32x4 acc[4][4];
#pragma unroll
        for (int pf = 0; pf < 4; ++pf)
#pragma unroll
            for (int nf = 0; nf < 4; ++nf) acc[pf][nf] = (f32x4){0.f, 0.f, 0.f, 0.f};
#pragma unroll 1
        for (int ks = 0; ks < 4; ++ks) {
            float sc[8];
#pragma unroll
            for (int e = 0; e < 8; ++e) { const int l = ks * 32 + fq * 8 + e; sc[e] = dth[l] * __expf(cend - cm[l]); }
            bf16x8 af[4];
#pragma unroll
            for (int pf = 0; pf < 4; ++pf) {
                const int row = jj * 64 + pf * 16 + fr, ch = ks * 4 + fq;
                const i32x4 raw = *(const i32x4*)(sX + row * 256 + ((ch ^ (row & 15)) * 16));
                i32x4 o;
#pragma unroll
                for (int q = 0; q < 4; ++q) { const unsigned u = (unsigned)raw[q]; o[q] = (int)cvt_pk_bf16(__uint_as_float(u << 16) * sc[2 * q], __uint_as_float(u & 0xffff0000u) * sc[2 * q + 1]); }
                af[pf] = __builtin_bit_cast(bf16x8, o);
            }
#pragma unroll
            for (int nf = 0; nf < 4; ++nf) {
                const int row = nh * 64 + nf * 16 + fr, ch = ks * 4 + fq;
                const bf16x8 bfr = *(const bf16x8*)(sB + row * 256 + ((ch ^ (row & 15)) * 16));
#pragma unroll
                for (int pf = 0; pf < 4; ++pf) acc[pf][nf] = __builtin_amdgcn_mfma_f32_16x16x32_bf16(bfr, af[pf], acc[pf][nf], 0, 0, 0);
            }
        }
        float* st = p.states + ((((size_t)(b * SSD_NC + c) * 8 + h) * 2 + dir) * 64) * 128;
        float* rp = st + (size_t)fr * 128 + nh * 64 + fq * 4;
#pragma unroll
        for (int pf = 0; pf < 4; ++pf)
#pragma unroll
            for (int nf = 0; nf < 4; ++nf) *(f32x4*)(rp + pf * 16 * 128 + nf * 16) = acc[pf][nf];
        if (lane == 0 && nh == 0) p.decay[((b * SSD_NC + c) * 8 + h) * 2 + dir] = __expf(cend);
    }
}
__device__ __forceinline__ void phase_ssd_scan(const SP_& p) {
    for (int idx = bid_opaque() * 512 + tid_opaque(); idx < NB_ * 8 * 2 * 64 * 32; idx += grid_n() * 512) {
        const int n4 = idx & 31, pp = (idx >> 5) & 63, dir = (idx >> 11) & 1, h = (idx >> 12) & 7, b = idx >> 15;
        f32x4 s = (f32x4){0.f, 0.f, 0.f, 0.f};
#pragma unroll 1
        for (int half = 0; half < 2; ++half) {
            f32x4 st[8]; float dc[8];
#pragma unroll
            for (int q = 0; q < 8; ++q) {
                const int cc = half * 8 + q, c = dir ? (SSD_NC - 1 - cc) : cc;
                st[q] = *(const f32x4*)(p.states + ((((size_t)(b * SSD_NC + c) * 8 + h) * 2 + dir) * 64 + pp) * 128 + n4 * 4);
                dc[q] = p.decay[((b * SSD_NC + c) * 8 + h) * 2 + dir];
            }
#pragma unroll
            for (int q = 0; q < 8; ++q) {
                const int cc = half * 8 + q, c = dir ? (SSD_NC - 1 - cc) : cc;
                const size_t o = ((((size_t)(b * SSD_NC + c) * 8 + h) * 2 + dir) * 64 + pp) * 128 + n4 * 4;
                uint2 w; w.x = cvt_pk_bf16(s[0], s[1]); w.y = cvt_pk_bf16(s[2], s[3]);
                *(uint2*)(p.prev + o) = w;
                s = s * dc[q] + st[q];
            }
        }
    }
}
#define SSD3_LDS (32768 + 65536 + 32768 + 8192 + 512)
__device__ __forceinline__ void phase_ssd_out(char* shm, const SP_& p) {
    char* sB = shm;
    char* sX = shm + 32768;
    char* sC = shm + 98304;
    float* dtv = (float*)(shm + 131072); float* cum = dtv + 1024; float* ssx = cum + 1024;
    for (int unit = bid_opaque(); unit < NB_ * SSD_NC * 2 * 2; unit += grid_n()) {
        const int half_ = unit & 1, g = (unit >> 1) & 1, c = (unit >> 2) & 15, b = unit >> 6;
        const int tid = tid_opaque(), wid = tid >> 6, lane = tid & 63, fr = lane & 15, fq = lane >> 4;
        __syncthreads();
        for (int i = tid; i < 128 * 16; i += 512) { const int row = i >> 4, ch = i & 15; const bf16_t* src_ = p.xa + (size_t)(b * SEQ_ + c * SSD_Q + row) * 1024 + 512 + g * 128 + ch * 8;
            *(uint4*)(sB + row * 256 + ((ch ^ (row & 15)) * 16)) = *(const uint4*)src_;
            *(uint4*)(sC + row * 256 + ((ch ^ (row & 15)) * 16)) = *(const uint4*)(src_ + 256); }
        for (int i = tid; i < 256 * 16; i += 512) { const int row = i >> 4, ch = i & 15, x = row & 15;
            uint4 v = *(const uint4*)(p.xT + ((size_t)b * 1024 + g * 256 + row) * SEQ_ + c * SSD_Q + ch * 8);
            if (x & 1) v = make_uint4(v.z, v.w, v.x, v.y);
            *(uint4*)(sX + row * 256 + ((ch ^ (x >> 1)) * 16)) = v; }
        ssd_tables(dtv, cum, p, b, c, g);
        const int hp = wid >> 2, lrow = half_ * 64 + (wid & 3) * 16 + fr;
        const size_t tok = (size_t)(b * SEQ_ + c * SSD_Q + lrow);
#define SSD_CF(ks_) (*(const bf16x8*)(sC + lrow * 256 + ((((ks_) * 4 + fq) ^ (lrow & 15)) * 16)))
        f32x4 G[8];
#pragma unroll
        for (int sf = 0; sf < 8; ++sf) {
            f32x4 a = (f32x4){0.f, 0.f, 0.f, 0.f};
#pragma unroll
            for (int ks = 0; ks < 4; ++ks) {
                const int row = sf * 16 + fr, ch = ks * 4 + fq;
                const bf16x8 bfr = *(const bf16x8*)(sB + row * 256 + ((ch ^ (row & 15)) * 16));
                a = __builtin_amdgcn_mfma_f32_16x16x32_bf16(bfr, SSD_CF(ks), a, 0, 0, 0);
            }
            G[sf] = a;
        }
        f32x4 Y[2][4];
#pragma unroll
        for (int jj = 0; jj < 2; ++jj)
#pragma unroll
            for (int pf = 0; pf < 4; ++pf) Y[jj][pf] = (f32x4){0.f, 0.f, 0.f, 0.f};
#pragma unroll
        for (int jj = 0; jj < 2; ++jj) {
            const int j = hp * 2 + jj;
#pragma unroll 1
            for (int dir = 0; dir < 2; ++dir) {
                const int hd = dir * 4 + j, h = g * 4 + j;
                const float* dth = dtv + hd * 128; const float* cm = cum + hd * 128;
                const float cl = cm[lrow];
                const bf16_t* pv = p.prev + ((((size_t)(b * SSD_NC + c) * 8 + h) * 2 + dir) * 64) * 128;
                bf16x8 pa[4][4];
#pragma unroll
                for (int pf = 0; pf < 4; ++pf)
#pragma unroll
                    for (int ks = 0; ks < 4; ++ks) pa[pf][ks] = *(const bf16x8*)(pv + (size_t)(pf * 16 + fr) * 128 + ks * 32 + fq * 8);
#pragma unroll
                for (int g2 = 0; g2 < 4; ++g2) {
                    float e[8];
#pragma unroll
                    for (int half = 0; half < 2; ++half)
#pragma unroll
                        for (int q = 0; q < 4; ++q) {
                            const int sf = 2 * g2 + half, s = sf * 16 + fq * 4 + q;
                            const bool keep = dir ? (s >= lrow) : (s <= lrow);
                            const float v = G[sf][q] * __expf(keep ? (cl - cm[s]) : 0.f) * dth[s];
                            e[half * 4 + q] = keep ? v : 0.f;
                        }
                    i32x4 w; w[0] = (int)cvt_pk_bf16(e[0], e[1]); w[1] = (int)cvt_pk_bf16(e[2], e[3]); w[2] = (int)cvt_pk_bf16(e[4], e[5]); w[3] = (int)cvt_pk_bf16(e[6], e[7]);
                    const bf16x8 Pf = __builtin_bit_cast(bf16x8, w);
#pragma unroll
                    for (int pf = 0; pf < 4; ++pf) {
                        const int row = j * 64 + pf * 16 + fr, x = row & 15;
                        const uint2 v0 = *(const uint2*)(sX + row * 256 + (((8 * g2 + fq) ^ x) * 8));
                        const uint2 v1 = *(const uint2*)(sX + row * 256 + (((8 * g2 + 4 + fq) ^ x) * 8));
                        const i32x4 wv = (i32x4){(int)v0.x, (int)v0.y, (int)v1.x, (int)v1.y};
                        Y[jj][pf] = __builtin_amdgcn_mfma_f32_16x16x32_bf16(__builtin_bit_cast(bf16x8, wv), Pf, Y[jj][pf], 0, 0, 0);
                    }
                    __builtin_amdgcn_sched_barrier(0);
                }
                const float el = __expf(cl);
#pragma unroll
                for (int pf = 0; pf < 4; ++pf) {
                    f32x4 t = (f32x4){0.f, 0.f, 0.f, 0.f};
#pragma unroll
                    for (int ks = 0; ks < 4; ++ks) {
                        t = __builtin_amdgcn_mfma_f32_16x16x32_bf16(pa[pf][ks], SSD_CF(ks), t, 0, 0, 0);
                    }
                    Y[jj][pf] += t * el;
                    __builtin_amdgcn_sched_barrier(0);
                }
            }
        }
        const int te = tid_opaque(); const int fqe = (te & 63) >> 4, wde = te >> 6, hpe = wde >> 2; const size_t toke = (size_t)(b * SEQ_ + c * SSD_Q + half_ * 64 + (wde & 3) * 16 + (te & 15));
        float ss = 0.f;
        uint2 xva[2][4], zva[2][4]; f32x4 gva[2][4];
#pragma unroll
        for (int jj = 0; jj < 2; ++jj)
#pragma unroll
            for (int pf = 0; pf < 4; ++pf) { const int cch = g * 256 + (hpe * 2 + jj) * 64 + pf * 16 + fqe * 4;
                xva[jj][pf] = *(const uint2*)(p.xa + toke * 1024 + cch); zva[jj][pf] = *(const uint2*)(p.proj + toke * PROJW + O_SSD + cch); gva[jj][pf] = *(const f32x4*)(p.ng + cch); }
#pragma unroll
        for (int jj = 0; jj < 2; ++jj) {
            const float dk = p.dsk[g * 4 + hpe * 2 + jj];
#pragma unroll
            for (int pf = 0; pf < 4; ++pf) {
                const uint2 xv = xva[jj][pf];
                const uint2 zv = zva[jj][pf];
                const float xs[4] = {__uint_as_float(xv.x << 16), __uint_as_float(xv.x & 0xffff0000u), __uint_as_float(xv.y << 16), __uint_as_float(xv.y & 0xffff0000u)};
                const float zs[4] = {__uint_as_float(zv.x << 16), __uint_as_float(zv.x & 0xffff0000u), __uint_as_float(zv.y << 16), __uint_as_float(zv.y & 0xffff0000u)};
#pragma unroll
                for (int q = 0; q < 4; ++q) { const float y = (Y[jj][pf][q] + dk * xs[q]) * silu_fast_(zs[q]); Y[jj][pf][q] = y; ss += y * y; }
                __builtin_amdgcn_sched_barrier(0);
            }
        }
        ss += __shfl_xor(ss, 16, 64); ss += __shfl_xor(ss, 32, 64);
        if (fqe == 0) ssx[wde * 16 + (te & 15)] = ss;
        __syncthreads();
        ss += ssx[(wde ^ 4) * 16 + (te & 15)];
        const float rs = rsqrtf(ss * (1.0f / 256.0f) + 1e-6f);
#pragma unroll
        for (int jj = 0; jj < 2; ++jj)
#pragma unroll
            for (int pf = 0; pf < 4; ++pf) {
                const int cch = g * 256 + (hpe * 2 + jj) * 64 + pf * 16 + fqe * 4;
                const f32x4 gv = gva[jj][pf];
                uint2 o; o.x = cvt_pk_bf16(Y[jj][pf][0] * rs * gv[0], Y[jj][pf][1] * rs * gv[1]); o.y = cvt_pk_bf16(Y[jj][pf][2] * rs * gv[2], Y[jj][pf][3] * rs * gv[3]);
                *(uint2*)(p.br + toke * DM_ + 1536 + cch) = o;
                __builtin_amdgcn_sched_barrier(0);
            }
    }
}
struct GP {
    const bf16_t* A; const bf16_t* Bt; const float* B; const float* B2; const float* bias; const float* R; float* Cf; bf16_t* Cb; bf16_t* Cb2; bf16_t* Vt; const bf16_t* G;
    const int* idx; const float* gate;
};
#ifndef GS_ROWS
#define GS_ROWS 8
#endif
__device__ __forceinline__ void static_order(int L, int nM, int nN, int& pm, int& pn) {
    const int nwg = nM * nN; int wgid = L;
    { const int q = nwg / 8, r = nwg % 8, xcd = wgid % 8, off = wgid / 8; wgid = (xcd < r ? xcd * (q + 1) : r * (q + 1) + (xcd - r) * q) + off; }
    const int nig = GS_ROWS * nN, gid = wgid / nig, fm = gid * GS_ROWS, gsz = (nM - fm) < GS_ROWS ? (nM - fm) : GS_ROWS;
    pm = fm + ((wgid % nig) % gsz); pn = (wgid % nig) / gsz;
}
#define LANE_IDS(t_) const int wid = (t_) >> 6, lane = (t_) & 63, wr = wid >> 2, wc = wid & 3, fr = lane & 15, fq = lane >> 4; (void)wr; (void)wc; (void)fr; (void)fq;
#define ZERO_ACC(acc, FM_) _Pragma("unroll") for (int m = 0; m < FM_; ++m) _Pragma("unroll") for (int n = 0; n < 4; ++n) acc[m][n] = (f32x4){0.f, 0.f, 0.f, 0.f}

__device__ __forceinline__ void phase_inproj(char* shm, const GP& p) {
    typedef GemmCore<256, false> G;
    for (int L = bid_opaque(); L < 32 * 54; L += grid_n()) {
        int pm, pn; static_order(L, 32, 54, pm, pn);
        const int col0 = pn < 22 ? pn * 256 : O_GATE + (pn - 22) * 256;
        f32x4 acc[8][4]; ZERO_ACC(acc, 8);
        {
            const int t0 = tid_opaque();
            unsigned aoff[G::GLA], boff[4];
#pragma unroll
            for (int i = 0; i < G::GLA; ++i) { int R, C; G::a_coord(t0, i, R, C); aoff[i] = (unsigned)((R * DM_ + C) * 2); }
#pragma unroll
            for (int i = 0; i < 4; ++i) { int cc, C; G::bt_coord(t0, i, cc, C); boff[i] = (unsigned)((cc * DM_ + C) * 2); }
            const char* pf = t0 < 256 ? (const char*)(p.A + (size_t)(pm * 256 + t0) * DM_) : (const char*)(p.Bt + (size_t)(pn * 256 + t0 - 256) * DM_);
            G::run_bt(shm, (const char*)(p.A + (size_t)pm * 256 * DM_), aoff, (const char*)(p.Bt + (size_t)pn * 256 * DM_), boff, DM_ * 2, pf, DM_ / 64, acc);
        }
        const int t1 = tid_opaque(); LANE_IDS(t1)
        const int cl = wc * 64 + 4 * fr;
        if (pn == 14 || pn == 15) {
            const int t0_ = pm * 256 + wr * 128 + fq * 4, bb = t0_ >> 11, tl = t0_ & (SEQ_ - 1);
            bf16_t* vp = p.Vt + (size_t)(bb * 512 + (pn - 14) * 256 + cl) * SEQ_ + tl;
#pragma unroll
            for (int m = 0; m < 8; ++m)
#pragma unroll
                for (int n = 0; n < 4; ++n) {
                    uint2 o; o.x = cvt_pk_bf16(acc[m][n][0], acc[m][n][1]); o.y = cvt_pk_bf16(acc[m][n][2], acc[m][n][3]);
                    *(uint2*)(vp + (size_t)n * SEQ_ + m * 16) = o;
                }
        } else if (pn < 22) {
#pragma unroll
            for (int m = 0; m < 8; ++m)
#pragma unroll
                for (int j = 0; j < 4; ++j) {
                    const int row = pm * 256 + wr * 128 + m * 16 + fq * 4 + j;
                    uint2 o; o.x = cvt_pk_bf16(acc[m][0][j], acc[m][1][j]); o.y = cvt_pk_bf16(acc[m][2][j], acc[m][3][j]);
                    *(uint2*)(p.Cb + (size_t)row * PROJW + pn * 256 + cl) = o;
                }
        } else {
            const int gc = (pn - 22) * 256 + cl;
            const f32x4 bg = *(const f32x4*)(p.bias + gc);
#pragma unroll
            for (int m = 0; m < 8; ++m)
#pragma unroll
                for (int j = 0; j < 4; ++j) {
                    const int row = pm * 256 + wr * 128 + m * 16 + fq * 4 + j;
                    uint2 o; o.x = cvt_pk_bf16(sigmoid_fast_(acc[m][0][j] + bg[0]), sigmoid_fast_(acc[m][1][j] + bg[1])); o.y = cvt_pk_bf16(sigmoid_fast_(acc[m][2][j] + bg[2]), sigmoid_fast_(acc[m][3][j] + bg[3]));
                    *(uint2*)(p.Cb2 + (size_t)row * 8192 + gc) = o;
                }
        }
    }
}
__device__ __forceinline__ void phase_merge(char* shm, const GP& p) {
    typedef GemmCore<128, false> G;
    for (int L = bid_opaque(); L < 64 * 8; L += grid_n()) {
        int pm, pn; static_order(L, 64, 8, pm, pn);
        f32x4 mg[4][4]; ZERO_ACC(mg, 4);
        f32x4 acc[4][4]; ZERO_ACC(acc, 4);
        {
            const int t0 = tid_opaque();
            unsigned aoff[G::GLA], boff[4];
#pragma unroll
            for (int i = 0; i < G::GLA; ++i) { int R, C; G::a_coord(t0, i, R, C); aoff[i] = (unsigned)((R * DM_ + C) * 2); }
#pragma unroll
            for (int i = 0; i < 4; ++i) { int cc, C; G::bt_coord(t0, i, cc, C); boff[i] = (unsigned)((cc * 512 + C) * 2); }
            const bf16_t* gates = p.G;
            auto seg_epi = [&acc, &mg, gates, pm, pn](int k) __attribute__((always_inline)) {
                const int t1 = tid_opaque(); LANE_IDS(t1)
                const bf16_t* gp = gates + (size_t)(pm * 128 + wr * 64 + fq * 4) * 8192 + k * DM_ + pn * 256 + wc * 64 + 4 * fr;
#pragma unroll
                for (int m = 0; m < 4; ++m) {
#pragma unroll
                    for (int j = 0; j < 4; ++j) {
                        const uint2 gv = *(const uint2*)(gp + (size_t)(m * 16 + j) * 8192);
                        mg[m][0][j] += __uint_as_float(gv.x << 16) * acc[m][0][j]; mg[m][1][j] += __uint_as_float(gv.x & 0xffff0000u) * acc[m][1][j];
                        mg[m][2][j] += __uint_as_float(gv.y << 16) * acc[m][2][j]; mg[m][3][j] += __uint_as_float(gv.y & 0xffff0000u) * acc[m][3][j];
                    }
#pragma unroll
                    for (int n = 0; n < 4; ++n) acc[m][n] = (f32x4){0.f, 0.f, 0.f, 0.f};
                    __builtin_amdgcn_sched_barrier(0);
                }
            };
            G::template run_bt_seg<8>(shm, (const char*)(p.A + (size_t)pm * 128 * DM_), aoff, (const char*)(p.Bt + (size_t)pn * 256 * 512), boff, 512 * 2, (size_t)DM_ * 512 * 2,
                                      (const char*)(p.A + (size_t)pm * 128 * DM_), 32, acc, seg_epi);
        }
        const int t2 = tid_opaque(); LANE_IDS(t2)
        bf16_t* op = p.Cb + (size_t)(pm * 128 + wr * 64 + fq * 4) * DM_ + pn * 256 + wc * 64 + 4 * fr;
#pragma unroll
        for (int m = 0; m < 4; ++m)
#pragma unroll
            for (int j = 0; j < 4; ++j) {
                uint2 o; o.x = cvt_pk_bf16(mg[m][0][j], mg[m][1][j]); o.y = cvt_pk_bf16(mg[m][2][j], mg[m][3][j]);
                *(uint2*)(op + (size_t)(m * 16 + j) * DM_) = o;
            }
    }
}
__device__ __forceinline__ void phase_outproj(char* shm, const GP& p) {
    typedef GemmCore<256, false> G;
    for (int L = bid_opaque(); L < 32 * 8; L += grid_n()) {
        int pm, pn; static_order(L, 32, 8, pm, pn);
        f32x4 acc[8][4]; ZERO_ACC(acc, 8);
        {
            const int t0 = tid_opaque();
            unsigned aoff[G::GLA], boff[4];
#pragma unroll
            for (int i = 0; i < G::GLA; ++i) { int R, C; G::a_coord(t0, i, R, C); aoff[i] = (unsigned)((R * DM_ + C) * 2); }
#pragma unroll
            for (int i = 0; i < 4; ++i) { int cc, C; G::bt_coord(t0, i, cc, C); boff[i] = (unsigned)((cc * DM_ + C) * 2); }
            const char* pf = t0 < 256 ? (const char*)(p.A + (size_t)(pm * 256 + t0) * DM_) : (const char*)(p.Bt + (size_t)(pn * 256 + t0 - 256) * DM_);
            G::run_bt(shm, (const char*)(p.A + (size_t)pm * 256 * DM_), aoff, (const char*)(p.Bt + (size_t)pn * 256 * DM_), boff, DM_ * 2, pf, DM_ / 64, acc);
        }
        const int t1 = tid_opaque(); LANE_IDS(t1)
        const size_t o0 = (size_t)(pm * 256 + wr * 128 + fq * 4) * DM_ + pn * 256 + wc * 64 + 4 * fr;
#pragma unroll
        for (int m = 0; m < 8; ++m)
#pragma unroll
            for (int j = 0; j < 4; ++j) {
                const size_t o = o0 + (size_t)(m * 16 + j) * DM_;
                const f32x4 r = *(const f32x4*)(p.R + o);
                *(f32x4*)(p.Cf + o) = (f32x4){r[0] + acc[m][0][j], r[1] + acc[m][1][j], r[2] + acc[m][2][j], r[3] + acc[m][3][j]};
            }
    }
}
__device__ __forceinline__ void phase_moe_up(char* shm, const GP& p) {
    typedef GemmCore<256, true> G;
    for (int L = bid_opaque(); L < 64 * 16; L += grid_n()) {
        const int xcd = L & 7, wg = xcd * 128 + (L >> 3), b = wg & 3, pair = wg >> 2, e = pair >> 4, nt = pair & 15, z = b * 16 + e;
        f32x4 acc[8][4]; ZERO_ACC(acc, 8);
        {
            const int t0 = tid_opaque(); int bk, bc, bw; G::b_coord(t0, bk, bc, bw);
            unsigned aoff[G::GLA];
#pragma unroll
            for (int i = 0; i < G::GLA; ++i) { int R, C; G::a_coord(t0, i, R, C); aoff[i] = (unsigned)(((b * SEQ_ + p.idx[z * 256 + R]) * DM_ + C) * 2); }
            const float* wsel = bw ? p.B2 : p.B;
            G::run(shm, (const char*)p.A, aoff, (const char*)(wsel + (size_t)e * DM_ * DM_ + (size_t)bk * DM_ + nt * 128 + bc), DM_ * 4, DM_ / 64, acc);
        }
        const int t1 = tid_opaque(); LANE_IDS(t1)
        const int hi = (fr >> 3) & 1;
        bf16_t* op = p.Cb + (size_t)(z * 256 + wr * 128 + fq * 4) * DM_ + nt * 128 + wc * 32 + 4 * (fr & 7);
#pragma unroll
        for (int mm = 0; mm < 4; ++mm)
#pragma unroll
            for (int j = 0; j < 4; ++j) {
                float a[4], g[4];
#pragma unroll
                for (int n = 0; n < 4; ++n) {
                    const float lo = acc[mm][n][j], hv = acc[mm + 4][n][j];
                    const float send = hi ? lo : hv;
                    const float recv = __shfl_xor(send, 8, 64);
                    a[n] = hi ? recv : lo;
                    g[n] = hi ? hv : recv;
                }
                uint2 o; o.x = cvt_pk_bf16(silu_fast_(a[0]) * g[0], silu_fast_(a[1]) * g[1]); o.y = cvt_pk_bf16(silu_fast_(a[2]) * g[2], silu_fast_(a[3]) * g[3]);
                *(uint2*)(op + (size_t)((mm + 4 * hi) * 16 + j) * DM_) = o;
            }
    }
}
__device__ __forceinline__ void phase_moe_down(char* shm, const GP& p) {
    typedef GemmCore<256, false> G;
    for (int L = bid_opaque(); L < 64 * 8; L += grid_n()) {
        const int xcd = L & 7, wg = xcd * 64 + (L >> 3), b = wg & 3, pair = wg >> 2, e = pair >> 3, nt = pair & 7, z = b * 16 + e;
        f32x4 acc[8][4]; ZERO_ACC(acc, 8);
        {
            const int t0 = tid_opaque(); int bk, bc, bw; G::b_coord(t0, bk, bc, bw);
            unsigned aoff[G::GLA];
#pragma unroll
            for (int i = 0; i < G::GLA; ++i) { int R, C; G::a_coord(t0, i, R, C); aoff[i] = (unsigned)((R * DM_ + C) * 2); }
            G::run(shm, (const char*)(p.A + (size_t)z * 256 * DM_), aoff, (const char*)(p.B + (size_t)e * DM_ * DM_ + (size_t)bk * DM_ + nt * 256 + bc), DM_ * 4, DM_ / 64, acc);
        }
        const int t1 = tid_opaque(); LANE_IDS(t1)
        const int row0 = z * 256 + wr * 128 + fq * 4;
        bf16_t* op = p.Cb + (size_t)row0 * DM_ + nt * 256 + wc * 64 + 4 * fr;
        f32x4 gtv[8];
#pragma unroll
        for (int m = 0; m < 8; ++m) gtv[m] = *(const f32x4*)(p.gate + row0 + m * 16);
#pragma unroll
        for (int m = 0; m < 8; ++m)
#pragma unroll
            for (int j = 0; j < 4; ++j) {
                const float gt = gtv[m][j];
                uint2 o; o.x = cvt_pk_bf16(gt * acc[m][0][j], gt * acc[m][1][j]); o.y = cvt_pk_bf16(gt * acc[m][2][j], gt * acc[m][3][j]);
                *(uint2*)(op + (size_t)(m * 16 + j) * DM_) = o;
            }
    }
}

namespace pg8 {
#define PG8_LAS __attribute__((address_space(3)))
constexpr int BM = 256, BK = 64, HALF = 128, HTB = HALF * BK * 2  , STAGE_BYTES = 8 * HTB;
__device__ __forceinline__ int lds_byte(int r, int c) { const int st = (r >> 4) * 2 + (c >> 5), rr = r & 15, cc = c & 31, ob = rr * 64 + cc * 2; return st * 1024 + (ob ^ (((ob >> 9) & 1) << 5)); }
__device__ __forceinline__ void stage_rc(int b, int& R, int& C) { const int st = b / 1024, sb = b % 1024, swz = sb ^ (((sb >> 9) & 1) << 5); R = (st >> 1) * 16 + swz / 64; C = (st & 1) * 32 + (swz % 64) / 2; }
__device__ __forceinline__ int perm32(int rho) { const int n = rho >> 4, i = rho & 15; return 8 * (i >> 2) + 4 * n + (i & 3); }
struct Unit { int pm, pn, kz; };
struct Gemm { const bf16_t* A; const bf16_t* Bt; int M, N, K, lda, ldb; };
struct MegaOrder {
    static constexpr bool GATHER = false;
    int nM, nN, G, c;
    __device__ __forceinline__ unsigned a_off(const Gemm& g, int R, int C) const { return (unsigned)(R * g.lda + C) * 2u; }
    __device__ __forceinline__ bool next(int i, Unit& u) const { const int L = i * G + c; if (L >= nM * nN) return false; int pm, pn; static_order(L, nM, nN, pm, pn); u.pm = pm; u.pn = pn; u.kz = 0; return true; }
    __device__ __forceinline__ void base(const Gemm& g, const Unit& u, const char*& a, const char*& b) const { a = (const char*)g.A + (size_t)u.pm * BM * g.lda * 2; b = (const char*)g.Bt + (size_t)u.pn * BM * g.ldb * 2; }
    __device__ __forceinline__ void a_ready(const Unit&) const {}
    __device__ __forceinline__ void done(const Unit&) const {}
};
__device__ __forceinline__ uint4 pack8_bf16(const f32x4& a, const f32x4& b) { return make_uint4(cvt_pk_bf16(a[0], a[1]), cvt_pk_bf16(a[2], a[3]), cvt_pk_bf16(b[0], b[1]), cvt_pk_bf16(b[2], b[3])); }
struct EpiInproj {
    static constexpr bool PERM = true, AFTER_DRAIN = false;
    bf16_t* proj; bf16_t* gates; bf16_t* vt; const float* bgate;
    __device__ __forceinline__ void operator()(const f32x4 (&acc)[2][2][4][2], const Unit& u, int wr, int wc, int fr, int fq) const {
        const int row0 = u.pm * BM + wr * 64 + fr, cb = wc * 32 + 8 * fq;
        if (u.pn == 14 || u.pn == 15) {
            const int bb = row0 >> 11;
#pragma unroll
            for (int ai = 0; ai < 2; ++ai)
#pragma unroll
                for (int m = 0; m < 4; ++m) { const int t = (row0 + ai * HALF + m * 16) & (SEQ_ - 1);
#pragma unroll
                    for (int bj = 0; bj < 2; ++bj)
#pragma unroll
                        for (int n = 0; n < 2; ++n)
#pragma unroll
                            for (int e = 0; e < 4; ++e) vt[(size_t)(bb * 512 + (u.pn - 14) * 256 + bj * HALF + cb + 4 * n + e) * SEQ_ + t] = f2bf(acc[ai][bj][m][n][e]); }
        } else if (u.pn < 22) {
#pragma unroll
            for (int ai = 0; ai < 2; ++ai)
#pragma unroll
                for (int m = 0; m < 4; ++m) { bf16_t* rowp = proj + (size_t)(row0 + ai * HALF + m * 16) * PROJW + u.pn * BM + cb;
#pragma unroll
                    for (int bj = 0; bj < 2; ++bj) *(uint4*)(rowp + bj * HALF) = pack8_bf16(acc[ai][bj][m][0], acc[ai][bj][m][1]); }
        } else {
            const int gc = (u.pn - 22) * BM + cb;
            f32x4 bv[2][2];
#pragma unroll
            for (int bj = 0; bj < 2; ++bj) { bv[bj][0] = *(const f32x4*)(bgate + gc + bj * HALF); bv[bj][1] = *(const f32x4*)(bgate + gc + bj * HALF + 4); }
#pragma unroll
            for (int ai = 0; ai < 2; ++ai)
#pragma unroll
                for (int m = 0; m < 4; ++m) { bf16_t* rowp = gates + (size_t)(row0 + ai * HALF + m * 16) * 8192 + gc;
#pragma unroll
                    for (int bj = 0; bj < 2; ++bj) { f32x4 v0 = acc[ai][bj][m][0] + bv[bj][0], v1 = acc[ai][bj][m][1] + bv[bj][1];
#pragma unroll
                        for (int e = 0; e < 4; ++e) { v0[e] = sigmoid_fast_(v0[e]); v1[e] = sigmoid_fast_(v1[e]); }
                        *(uint4*)(rowp + bj * HALF) = pack8_bf16(v0, v1); } }
        }
    }
};
struct EpiOutproj {
    static constexpr bool PERM = false, AFTER_DRAIN = false;
    const float* R; float* C;
    __device__ __forceinline__ void operator()(const f32x4 (&acc)[2][2][4][2], const Unit& u, int wr, int wc, int fr, int fq) const {
        const int row0 = u.pm * BM + wr * 64 + fr, col0 = u.pn * BM + wc * 32 + 4 * fq;
#pragma unroll
        for (int ai = 0; ai < 2; ++ai) {
            f32x4 rv[4][2][2];
#pragma unroll
            for (int m = 0; m < 4; ++m) { const size_t ro = (size_t)(row0 + ai * HALF + m * 16) * DM_ + col0;
#pragma unroll
                for (int bj = 0; bj < 2; ++bj)
#pragma unroll
                    for (int n = 0; n < 2; ++n) rv[m][bj][n] = *(const f32x4*)(R + ro + bj * HALF + n * 16); }
            __builtin_amdgcn_sched_barrier(0);
#pragma unroll
            for (int m = 0; m < 4; ++m) { const size_t ro = (size_t)(row0 + ai * HALF + m * 16) * DM_ + col0;
#pragma unroll
                for (int bj = 0; bj < 2; ++bj)
#pragma unroll
                    for (int n = 0; n < 2; ++n) *(f32x4*)(C + ro + bj * HALF + n * 16) = rv[m][bj][n] + acc[ai][bj][m][n]; }
            __builtin_amdgcn_sched_barrier(0);
        }
    }
};
struct OneUnit {
    static constexpr bool GATHER = false;
    __device__ __forceinline__ bool next(int i, Unit& u) const { if (i) return false; u.pm = 0; u.pn = 0; u.kz = 0; return true; }
    __device__ __forceinline__ void base(const Gemm& g, const Unit&, const char*& a, const char*& b) const { a = (const char*)g.A; b = (const char*)g.Bt; }
    __device__ __forceinline__ unsigned a_off(const Gemm& g, int R, int C) const { return (unsigned)(R * g.lda + C) * 2u; }
    __device__ __forceinline__ void a_ready(const Unit&) const {}
    __device__ __forceinline__ void done(const Unit&) const {}
};
struct OneUnitGather {
    static constexpr bool GATHER = true;
    const int* idx; int tok0;
    __device__ __forceinline__ bool next(int i, Unit& u) const { if (i) return false; u.pm = 0; u.pn = 0; u.kz = 0; return true; }
    __device__ __forceinline__ void base(const Gemm& g, const Unit&, const char*& a, const char*& b) const { a = (const char*)g.A; b = (const char*)g.Bt; }
    __device__ __forceinline__ unsigned a_off(const Gemm& g, int R, int C) const { return (unsigned)((tok0 + idx[R]) * g.lda + C) * 2u; }
    __device__ __forceinline__ void a_ready(const Unit&) const {}
    __device__ __forceinline__ void done(const Unit&) const {}
};
struct EpiMoeDown {
    static constexpr bool PERM = true, AFTER_DRAIN = false;
    bf16_t* out; const float* gate;
    __device__ __forceinline__ void operator()(const f32x4 (&acc)[2][2][4][2], const Unit&, int wr, int wc, int fr, int fq) const {
        const int row0 = wr * 64 + fr, cb = wc * 32 + 8 * fq;
        float gt[2][4];
#pragma unroll
        for (int ai = 0; ai < 2; ++ai)
#pragma unroll
            for (int m = 0; m < 4; ++m) gt[ai][m] = gate[row0 + ai * HALF + m * 16];
#pragma unroll
        for (int ai = 0; ai < 2; ++ai)
#pragma unroll
            for (int m = 0; m < 4; ++m) { const int r = row0 + ai * HALF + m * 16; bf16_t* rowp = out + (size_t)r * DM_ + cb;
#pragma unroll
                for (int bj = 0; bj < 2; ++bj) *(uint4*)(rowp + bj * HALF) = pack8_bf16(acc[ai][bj][m][0] * gt[ai][m], acc[ai][bj][m][1] * gt[ai][m]); }
    }
};
struct EpiMoeUp {
    static constexpr bool PERM = true, AFTER_DRAIN = false;
    bf16_t* out;
    __device__ __forceinline__ void operator()(const f32x4 (&acc)[2][2][4][2], const Unit&, int wr, int wc, int fr, int fq) const {
        const int row0 = wr * 64 + fr, cb = wc * 32 + 8 * fq;
#pragma unroll
        for (int ai = 0; ai < 2; ++ai)
#pragma unroll
            for (int m = 0; m < 4; ++m) { const int r = row0 + ai * HALF + m * 16;
                f32x4 v0, v1;
#pragma unroll
                for (int e = 0; e < 4; ++e) { v0[e] = silu_fast_(acc[ai][0][m][0][e]) * acc[ai][1][m][0][e]; v1[e] = silu_fast_(acc[ai][0][m][1][e]) * acc[ai][1][m][1][e]; }
                *(uint4*)(out + (size_t)r * DM_ + cb) = pack8_bf16(v0, v1); }
    }
};
struct MergeOrder {
    static constexpr bool GATHER = false;
    int G, c;
    __device__ __forceinline__ unsigned a_off(const Gemm& g, int R, int C) const { return (unsigned)(R * g.lda + C) * 2u; }
    __device__ __forceinline__ bool next(int i, Unit& u) const { const int L = (i >> 2) * G + c; if (L >= 32 * 8) return false; int pm, pn; static_order(L, 32, 8, pm, pn); u.pm = pm; u.pn = pn; u.kz = i & 3; return true; }
    __device__ __forceinline__ void base(const Gemm& g, const Unit& u, const char*& a, const char*& b) const {
        a = (const char*)g.A + ((size_t)u.pm * BM * DM_ + u.kz * 512) * 2; b = (const char*)g.Bt + ((size_t)u.kz * DM_ + u.pn * BM) * 512 * 2; }
    __device__ __forceinline__ void a_ready(const Unit&) const {}
    __device__ __forceinline__ void done(const Unit&) const {}
};
struct EpiMerge {
    static constexpr bool PERM = true, AFTER_DRAIN = false;
    const bf16_t* gates; float* m32; bf16_t* out;
    __device__ __forceinline__ void operator()(const f32x4 (&acc)[2][2][4][2], const Unit& u, int wr, int wc, int fr, int fq) const {
        const int row0 = u.pm * BM + wr * 64 + fr, col0 = u.pn * BM + wc * 32 + 8 * fq;
#pragma unroll
        for (int ai = 0; ai < 2; ++ai)
#pragma unroll
            for (int m = 0; m < 4; ++m) {
                const size_t row = (size_t)(row0 + ai * HALF + m * 16);
#pragma unroll
                for (int bj = 0; bj < 2; ++bj) {
                    const int col = col0 + bj * HALF;
                    const uint4 gv = *(const uint4*)(gates + row * 8192 + u.kz * DM_ + col);
                    f32x4 v0 = acc[ai][bj][m][0], v1 = acc[ai][bj][m][1];
                    v0[0] *= __uint_as_float(gv.x << 16); v0[1] *= __uint_as_float(gv.x & 0xffff0000u); v0[2] *= __uint_as_float(gv.y << 16); v0[3] *= __uint_as_float(gv.y & 0xffff0000u);
                    v1[0] *= __uint_as_float(gv.z << 16); v1[1] *= __uint_as_float(gv.z & 0xffff0000u); v1[2] *= __uint_as_float(gv.w << 16); v1[3] *= __uint_as_float(gv.w & 0xffff0000u);
                    float* mp = m32 + row * DM_ + col;
                    if (u.kz > 0) { v0 += *(const f32x4*)mp; v1 += *(const f32x4*)(mp + 4); }
                    if (u.kz < 3) { *(f32x4*)mp = v0; *(f32x4*)(mp + 4) = v1; }
                    else *(uint4*)(out + row * DM_ + col) = pack8_bf16(v0, v1);
                }
            }
    }
};
struct NoConv { static constexpr bool ON = false;
    __device__ __forceinline__ void load(int, f32x4 (&)[4]) const {}
    __device__ __forceinline__ void store(int, const f32x4 (&)[4]) const {} };
struct PanelConv { static constexpr bool ON = true;
    const float* src; bf16_t* dst;
    __device__ __forceinline__ void load(int it, f32x4 (&v)[4]) const {
#pragma unroll
        for (int r = 0; r < 4; ++r) v[r] = *(const f32x4*)(src + (size_t)(it * 32 + r) * DM_); }
    __device__ __forceinline__ void store(int it, const f32x4 (&v)[4]) const {
#pragma unroll
        for (int i = 0; i < 4; ++i) { uint2 o; o.x = cvt_pk_bf16(v[0][i], v[1][i]); o.y = cvt_pk_bf16(v[2][i], v[3][i]); *(uint2*)(dst + (size_t)i * DM_ + it * 32) = o; } }
};
template <bool DUAL>
__device__ __forceinline__ PanelConv make_panel_conv(const float* w, const float* w3, int col0, int q, bf16_t* panel) {
    const int tid = tid_opaque(), wid = __builtin_amdgcn_readfirstlane(tid >> 6), lane = tid & 63, kq = lane & 7, nl = lane >> 3;
    PanelConv c;
    c.src = (DUAL ? ((wid >> 2) ? w3 : w) + col0 + (wid & 3) * 32 : w + col0 + wid * 32) + nl * 4 + (size_t)(q * 512 + kq * 4) * DM_;
    c.dst = panel + (size_t)(wid * 32 + nl * 4) * DM_ + q * 512 + kq * 4;
    return c;
}
template <class Epi, class Sched, bool STAMP = false, class Conv = NoConv>
__device__ __forceinline__ void gemm_phase(PG8_LAS unsigned char* lds, const Gemm g, const Sched& S, const Epi& E, unsigned long long* stamps, const Conv cv = Conv{}) {
    const int tid = tid_opaque(), wid = __builtin_amdgcn_readfirstlane(tid >> 6), lane = tid & 63, wr = wid >> 2, wc = wid & 3, fr = lane & 15, fq = lane >> 4;
    const int K = g.K, nt = K / BK;
    int ts_lo = 0, ts_hi = 0, nts = 0; const unsigned long long rt_entry = STAMP ? (unsigned long long)wall_clock64() : 0ull;
#define PG8_STAMP() do { if (STAMP && wid == 0 && nts < 64) { const unsigned long long _c = (unsigned long long)clock64(); \
        ts_lo = (lane == nts) ? (int)(unsigned)_c : ts_lo; ts_hi = (lane == nts) ? (int)(unsigned)(_c >> 32) : ts_hi; ++nts; } } while (0)
    PG8_STAMP();
    unsigned voffA[2], voffA1[2], voffB[2];
#pragma unroll
    for (int i = 0; i < 2; ++i) { int R, C; stage_rc(tid * 16 + i * 8192, R, C); const int Rb = Epi::PERM ? ((R & ~31) + perm32(R & 31)) : R;
        voffA[i] = S.a_off(g, R, C); voffA1[i] = Sched::GATHER ? S.a_off(g, R + HALF, C) : voffA[i]; voffB[i] = (unsigned)(Rb * g.ldb + C) * 2u; }
    const size_t kstep = (size_t)(BK * 2);
    const size_t hstepA = Sched::GATHER ? (size_t)0 : (size_t)HALF * g.lda * 2, hstepB = (size_t)HALF * g.ldb * 2;
    const unsigned ldsw = (unsigned)wid * 1024u;
    const int aoff = lds_byte(wr * 64 + fr, fq * 8), boff = lds_byte(wc * 32 + fr, fq * 8);
#define PG8_SA(b, h) (((b) * 2 + (h)) * HTB)
#define PG8_SB(b, h) ((4 + (b) * 2 + (h)) * HTB)
#define PG8_STAGE(bufoff, gbase, voff) do { _Pragma("unroll") for (int _i = 0; _i < 2; ++_i) \
        __builtin_amdgcn_global_load_lds((const unsigned*)((const char*)(gbase) + (voff)[_i]), (PG8_LAS unsigned*)(lds + (bufoff) + ldsw + _i * 8192), 16, 0, 0); } while (0)
#define PG8_LDA(dst, b, h) do { _Pragma("unroll") for (int m = 0; m < 4; ++m) _Pragma("unroll") for (int k = 0; k < 2; ++k) dst[m][k] = *(const PG8_LAS bf16x8*)(lds + PG8_SA(b, h) + aoff + m * 2048 + k * 1024); } while (0)
#define PG8_LDB(dst, b, h) do { _Pragma("unroll") for (int n = 0; n < 2; ++n) _Pragma("unroll") for (int k = 0; k < 2; ++k) dst[n][k] = *(const PG8_LAS bf16x8*)(lds + PG8_SB(b, h) + boff + n * 2048 + k * 1024); } while (0)
#define PG8_MMA(ai, bj, At, Bt) do { __builtin_amdgcn_s_setprio(1); _Pragma("unroll") for (int m = 0; m < 4; ++m) _Pragma("unroll") for (int n = 0; n < 2; ++n) _Pragma("unroll") for (int k = 0; k < 2; ++k) \
        acc[ai][bj][m][n] = __builtin_amdgcn_mfma_f32_16x16x32_bf16(Bt[n][k], At[m][k], acc[ai][bj][m][n], 0, 0, 0); __builtin_amdgcn_s_setprio(0); } while (0)
#define PG8_WAIT_V(n) asm volatile("s_waitcnt vmcnt(" #n ")" ::: "memory")
#define PG8_WAIT_L(n) asm volatile("s_waitcnt lgkmcnt(" #n ")" ::: "memory")
#define PG8_BAR __builtin_amdgcn_s_barrier()
#define PG8_SCHED __builtin_amdgcn_sched_barrier(0)
    Unit cur, nxt; int ui = 0;
    if (!S.next(0, cur)) return;
    f32x4 acc[2][2][4][2];
#pragma unroll
    for (int a = 0; a < 2; ++a)
#pragma unroll
        for (int b = 0; b < 2; ++b)
#pragma unroll
            for (int m = 0; m < 4; ++m)
#pragma unroll
                for (int n = 0; n < 2; ++n) acc[a][b][m][n] = (f32x4){0.f, 0.f, 0.f, 0.f};
    bf16x8 At[4][2], B0[2][2], B1[2][2];
    const char* cA; const char* cB; S.base(g, cur, cA, cB);
    S.a_ready(cur);
    PG8_STAGE(PG8_SB(0, 0), cB, voffB); PG8_STAGE(PG8_SA(0, 0), cA, voffA); PG8_STAGE(PG8_SB(0, 1), cB + hstepB, voffB); PG8_STAGE(PG8_SA(0, 1), cA + hstepA, voffA1);
    if (wr == 1) PG8_BAR;
    PG8_WAIT_V(4); PG8_BAR;
    PG8_STAGE(PG8_SB(1, 0), cB + kstep, voffB); PG8_STAGE(PG8_SA(1, 0), cA + kstep, voffA); PG8_STAGE(PG8_SB(1, 1), cB + hstepB + kstep, voffB);
    PG8_WAIT_V(6); PG8_BAR;
    PG8_STAMP();
    for (;;) {
        const bool has_next = S.next(ui + 1, nxt);
        const char* nA = cA; const char* nB = cB; if (has_next) S.base(g, nxt, nA, nB);
        for (int t = 0; t < nt; t += 2) {
            const bool last = (t == nt - 2);
            const char* a1 = cA + (size_t)(t + 1) * kstep;
            const char* a2 = last ? nA : cA + (size_t)(t + 2) * kstep; const char* b2 = last ? nB : cB + (size_t)(t + 2) * kstep;
            const char* a3 = a2 + kstep; const char* b3 = b2 + kstep;
            if (last && has_next) S.a_ready(nxt);
            f32x4 cvv[4]; if constexpr (Conv::ON) { cv.load(t >> 1, cvv); PG8_SCHED; }
            PG8_LDB(B0, 0, 0); PG8_SCHED; PG8_LDA(At, 0, 0); PG8_STAGE(PG8_SA(1, 1), a1 + hstepA, voffA1);
            PG8_WAIT_L(8); PG8_BAR; PG8_WAIT_L(0); PG8_MMA(0, 0, At, B0); PG8_BAR; PG8_SCHED;
            PG8_LDB(B1, 0, 1); PG8_STAGE(PG8_SB(0, 0), b2, voffB);
            PG8_BAR; PG8_WAIT_L(0); PG8_MMA(0, 1, At, B1); PG8_BAR;
            PG8_LDA(At, 0, 1); PG8_STAGE(PG8_SA(0, 0), a2, voffA);
            PG8_BAR; PG8_WAIT_L(0); PG8_MMA(1, 0, At, B0); PG8_BAR; PG8_SCHED;
            PG8_STAGE(PG8_SB(0, 1), b2 + hstepB, voffB);
            PG8_WAIT_V(6); PG8_BAR; PG8_MMA(1, 1, At, B1); PG8_BAR;
            if constexpr (Conv::ON) { cv.store(t >> 1, cvv); PG8_SCHED; }
            PG8_LDB(B0, 1, 0); PG8_SCHED; PG8_LDA(At, 1, 0); PG8_STAGE(PG8_SA(0, 1), a2 + hstepA, voffA1);
            PG8_WAIT_L(8); PG8_BAR; PG8_WAIT_L(0); PG8_MMA(0, 0, At, B0); PG8_BAR; PG8_SCHED;
            PG8_LDB(B1, 1, 1); PG8_STAGE(PG8_SB(1, 0), b3, voffB);
            PG8_BAR; PG8_WAIT_L(0); PG8_MMA(0, 1, At, B1); PG8_BAR;
            PG8_LDA(At, 1, 1); PG8_STAGE(PG8_SA(1, 0), a3, voffA);
            PG8_BAR; PG8_WAIT_L(0); PG8_MMA(1, 0, At, B0); PG8_BAR; PG8_SCHED;
            PG8_STAGE(PG8_SB(1, 1), b3 + hstepB, voffB);
            PG8_WAIT_V(6); PG8_BAR; PG8_MMA(1, 1, At, B1); PG8_BAR;
        }
        PG8_STAMP();
        if constexpr (!Epi::AFTER_DRAIN) { E(acc, cur, wr, wc, fr, fq); S.done(cur); }
        PG8_STAMP();
        if (!has_next) break;
#pragma unroll
        for (int a = 0; a < 2; ++a)
#pragma unroll
            for (int b = 0; b < 2; ++b)
#pragma unroll
                for (int m = 0; m < 4; ++m)
#pragma unroll
                    for (int n = 0; n < 2; ++n) acc[a][b][m][n] = (f32x4){0.f, 0.f, 0.f, 0.f};
        cur = nxt; cA = nA; cB = nB; ++ui;
    }
    PG8_WAIT_V(0);
    if (wr == 0) PG8_BAR;
    PG8_BAR;
    if constexpr (Epi::AFTER_DRAIN) { E.fused(acc, cur, wr, wc, fr, fq, lds, wid, lane); S.done(cur); }
    PG8_STAMP();
    if (STAMP && wid == 0) { stamps[lane] = lane < nts ? (((unsigned long long)(unsigned)ts_hi << 32) | (unsigned)ts_lo) : 0ull;
        if (lane == 62) stamps[62] = rt_entry; if (lane == 63) stamps[63] = (unsigned long long)wall_clock64(); }
#undef PG8_STAMP
#undef PG8_SA
#undef PG8_SB
#undef PG8_STAGE
#undef PG8_LDA
#undef PG8_LDB
#undef PG8_MMA
#undef PG8_WAIT_V
#undef PG8_WAIT_L
#undef PG8_BAR
#undef PG8_SCHED
}
}
#define XB_TMO      128
#define XB_XCNT(j)  (256  + 64 * (j))
#define XB_XSUB(j)  (1280 + 64 * (j))
#define XB_XGEN(j)  (2304 + 64 * (j))
#define XB_TOP      3328
#define XB_TOPGEN   3392
#define XCD_BAR_WORDS 3456
#define XB_SPIN_CAP (1u << 18)
#define LAS __attribute__((address_space(3)))

__device__ __forceinline__ unsigned xb_ld(unsigned* p)              { return __hip_atomic_load(p, __ATOMIC_RELAXED, __HIP_MEMORY_SCOPE_AGENT); }
__device__ __forceinline__ unsigned xb_add(unsigned* p, unsigned v) { return __hip_atomic_fetch_add(p, v, __ATOMIC_RELAXED, __HIP_MEMORY_SCOPE_AGENT); }
__device__ __forceinline__ unsigned xb_xcc_id() { return (unsigned)__builtin_amdgcn_s_getreg((3 << 11) | 20) & 0xFu; }
#define XB_SPIN(cond, bar) do { unsigned _sp = 0; while (cond) { __builtin_amdgcn_s_sleep(1); \
    if ((++_sp & 255u) == 0u) { if (xb_ld(&(bar)[XB_TMO])) break; if (_sp > XB_SPIN_CAP) { atomicAdd(&(bar)[XB_TMO], 1u); break; } } } } while (0)

struct XcdBarrier {
    unsigned* bar; unsigned x;
    volatile LAS unsigned* st;
};

__device__ __forceinline__ XcdBarrier xcd_barrier_post(unsigned* bar, volatile LAS unsigned* st) {
    XcdBarrier b; b.bar = bar; b.x = xb_xcc_id(); b.st = st;
    if (threadIdx.x == 0) (void)xb_add(&bar[XB_XCNT(b.x)], 1u);
    return b;
}
__device__ __forceinline__ void xcd_barrier_complete(unsigned* bar, unsigned x, unsigned& nloc, unsigned& nx) {
    const unsigned G = gridDim.x * gridDim.y * gridDim.z;
    unsigned sum, cnt, mine, sp = 0u;
    for (;;) {
        sum = 0u; cnt = 0u; mine = 0u;
#pragma unroll
        for (unsigned j = 0; j < 16; ++j) { const unsigned c = xb_ld(&bar[XB_XCNT(j)]); sum += c; cnt += (c > 0u) ? 1u : 0u; mine = (j == x) ? c : mine; }
        if (sum == G) break;
        __builtin_amdgcn_s_sleep(1);
        if ((++sp & 255u) == 0u) { if (xb_ld(&bar[XB_TMO])) break; if (sp > XB_SPIN_CAP) { atomicAdd(&bar[XB_TMO], 1u); break; } }
    }
    nloc = mine > 0u ? mine : 1u; nx = cnt > 0u ? cnt : 1u;
}

__device__ __forceinline__ void xcd_barrier(const XcdBarrier& b) {
    asm volatile("s_waitcnt vmcnt(0)" ::: "memory");
    __syncthreads();
    if (threadIdx.x == 0) {
        unsigned* bar = b.bar; unsigned bx_ = b.x;
        asm volatile("" : "+s"(bar), "+s"(bx_));
        __builtin_amdgcn_s_waitcnt(0);
        unsigned nloc = b.st[0], nx = b.st[1];
        const unsigned old = xb_add(&bar[XB_XSUB(bx_)], 1u);
        const unsigned gen = old / nloc;
        if (old + 1u == (gen + 1u) * nloc) {
            __builtin_amdgcn_fence(__ATOMIC_RELEASE, "agent");
            asm volatile("s_waitcnt vmcnt(0)" ::: "memory");
            const unsigned og = xb_add(&bar[XB_TOP], 1u);
            const unsigned tg = og / nx;
            if (og + 1u == (tg + 1u) * nx) xb_add(&bar[XB_TOPGEN], 1u);
            else XB_SPIN(xb_ld(&bar[XB_TOPGEN]) == tg, bar);
            __builtin_amdgcn_fence(__ATOMIC_ACQUIRE, "agent");
            xb_add(&bar[XB_XGEN(bx_)], 1u);
            asm volatile("s_waitcnt vmcnt(0)" ::: "memory");
        } else {
            XB_SPIN(xb_ld(&bar[XB_XGEN(bx_)]) == gen, bar);
            __builtin_amdgcn_fence(__ATOMIC_ACQUIRE, "agent");
            asm volatile("s_waitcnt vmcnt(0)" ::: "memory");
        }
    }
    __syncthreads();
}

enum { X = 0, N1G, WIN, HCW, HCB, FW1, FB1, FW2, FB2, FW3, FB3, FW4, FREQ, HBIAS, LCW, LCB, LWA, LBA, LWX, LBX, LLAM, DLAM, DSUB, SCW, SCB, SDTB, SALOG, SD, SNG, WBR, BG, WOUT,
       N2G, WR, W1, W3, W2, RELB, FING };
struct MP {
    const float* in[39]; float* out; unsigned* bar;
    float* xres; bf16_t* hb; bf16_t* proj; bf16_t* gates; float* dtraw; bf16_t* br; bf16_t* mrg;
    float* fr; float* nrm; unsigned* hpp; bf16_t* vvt; float* hyt; bf16_t* vt;
    float* sumP; float* sumE; bf16_t* sxa; bf16_t* sxT; float* states; float* sdec; bf16_t* sprev;
    float* aff; int* tidx; float* tgat; int* tinv; bf16_t* hid; bf16_t* ybuf;
    bf16_t* wtin; bf16_t* wtbr; bf16_t* wtout; bf16_t* lruwt; float* m32;
    bf16_t* panel; unsigned* grp;
    int ngrid, pad1;
};
typedef const MP __attribute__((address_space(4)))* MPc;
__device__ __forceinline__ MPc params() { MPc q = (MPc)__builtin_amdgcn_kernarg_segment_ptr(); asm volatile("" : "+s"(q)); return q; }
__device__ __forceinline__ int bid_opaque() { int b = (int)__builtin_amdgcn_workgroup_id_x(); asm volatile("" : "+s"(b)); return b; }
__device__ __forceinline__ int grid_n() { return params()->ngrid; }

#define GRP_WORDS 16
#define GRP_COUNT (2 * 384)
template <bool DUAL>
__device__ __forceinline__ void moe_convert(const float* w, const float* w3, int col0, int q, bf16_t* panel) {
    const int tid = tid_opaque(), wid = __builtin_amdgcn_readfirstlane(tid >> 6), lane = tid & 63, kq = lane & 3, ngl = lane >> 2, ksub = wid & 1, grp = wid >> 1;
    const float* src = (DUAL ? ((grp >> 1) ? w3 : w) + col0 + (grp & 1) * 64 : w + col0 + grp * 64) + 4 * ngl + (size_t)(q * 512 + ksub * 32 + kq * 8) * DM_;
    bf16_t* dst = panel + (size_t)(grp * 64 + 4 * ngl) * DM_ + q * 512 + ksub * 32 + kq * 8;
#pragma unroll 1
    for (int ks = 0; ks < 8; ks += 2) {
        f32x4 v[2][8];
#pragma unroll
        for (int u = 0; u < 2; ++u)
#pragma unroll
            for (int r = 0; r < 8; ++r) v[u][r] = *(const f32x4*)(src + (size_t)((ks + u) * 64 + r) * DM_);
#pragma unroll
        for (int u = 0; u < 2; ++u)
#pragma unroll
            for (int i = 0; i < 4; ++i) { uint4 o; o.x = cvt_pk_bf16(v[u][0][i], v[u][1][i]); o.y = cvt_pk_bf16(v[u][2][i], v[u][3][i]); o.z = cvt_pk_bf16(v[u][4][i], v[u][5][i]); o.w = cvt_pk_bf16(v[u][6][i], v[u][7][i]);
                *(uint4*)(dst + (size_t)i * DM_ + (ks + u) * 64) = o; }
    }
}
__device__ __forceinline__ void group_sync(unsigned* cnt, unsigned* bar) {
    asm volatile("s_waitcnt vmcnt(0)" ::: "memory");
    __syncthreads();
    if (threadIdx.x == 0) {
        asm volatile("" : "+s"(cnt), "+s"(bar));
        __builtin_amdgcn_fence(__ATOMIC_RELEASE, "agent");
        asm volatile("s_waitcnt vmcnt(0)" ::: "memory");
        (void)xb_add(cnt, 1u);
        XB_SPIN(xb_ld(cnt) < 4u, bar);
        __builtin_amdgcn_fence(__ATOMIC_ACQUIRE, "agent");
        asm volatile("s_waitcnt vmcnt(0)" ::: "memory");
    }
    __syncthreads();
}
__device__ __forceinline__ void phase_moe_down2(char* shm, MPc p, int l) {
    const int bid = bid_opaque(), x = bid & 7, q = bid >> 3, b = q & 3, gi = q >> 2, ngx = grid_n() >> 5;
    if (q < ngx * 4) {
        if (gi < 16) { const int pair = x * 16 + gi, e = pair >> 3, nt = pair & 7;
            moe_convert<false>(p->in[W2] + ((size_t)l * 16 + e) * DM_ * DM_, nullptr, nt * 256, b, p->panel + (size_t)pair * 256 * DM_); }
        for (int j = gi; j < 16; j += ngx) {
            const int pair = x * 16 + j, e = pair >> 3, nt = pair & 7, z = b * 16 + e;
            bf16_t* panel = p->panel + (size_t)pair * 256 * DM_;
            group_sync(p->grp + (size_t)(l * 384 + 256 + pair) * GRP_WORDS, p->bar);
            const pg8::Gemm gg{p->hid + (size_t)z * 256 * DM_, panel, 256, 256, DM_, DM_, DM_}; const pg8::OneUnit so{}; const pg8::EpiMoeDown ep{p->ybuf + (size_t)z * 256 * DM_ + nt * 256, p->tgat + z * 256};
            if (j + ngx < 16) {
                const int pair2 = pair + ngx, e2 = pair2 >> 3, nt2 = pair2 & 7;
                const pg8::PanelConv cv = pg8::make_panel_conv<false>(p->in[W2] + ((size_t)l * 16 + e2) * DM_ * DM_, nullptr, nt2 * 256, b, p->panel + (size_t)pair2 * 256 * DM_);
                pg8::gemm_phase<pg8::EpiMoeDown, pg8::OneUnit, false, pg8::PanelConv>((PG8_LAS unsigned char*)shm, gg, so, ep, nullptr, cv);
            } else pg8::gemm_phase<pg8::EpiMoeDown, pg8::OneUnit, false>((PG8_LAS unsigned char*)shm, gg, so, ep, nullptr);
        }
    }
}
__device__ __forceinline__ void phase_moe_up2(char* shm, MPc p, int l) {
    const int bid = bid_opaque(), x = bid & 7, q = bid >> 3, b = q & 3, gi = q >> 2, ngx = grid_n() >> 5;
    if (q < ngx * 4)
    for (int j = gi; j < 32; j += ngx) {
        const int pair = x * 32 + j, e = pair >> 4, nt = pair & 15, z = b * 16 + e;
        bf16_t* panel = p->panel + (size_t)pair * 256 * DM_;
        moe_convert<true>(p->in[W1] + ((size_t)l * 16 + e) * DM_ * DM_, p->in[W3] + ((size_t)l * 16 + e) * DM_ * DM_, nt * 128, b, panel);
        group_sync(p->grp + (size_t)(l * 384 + pair) * GRP_WORDS, p->bar);
        const pg8::Gemm gg{p->hb, panel, 256, 256, DM_, DM_, DM_}; const pg8::OneUnitGather so{p->tidx + z * 256, b * SEQ_}; const pg8::EpiMoeUp ep{p->hid + (size_t)z * 256 * DM_ + nt * 128};
        pg8::gemm_phase<pg8::EpiMoeUp, pg8::OneUnitGather, false>((PG8_LAS unsigned char*)shm, gg, so, ep, nullptr);
    }
}
#ifndef MOE_DOWN2
#define MOE_DOWN2 0
#endif
#define MEGA_LDS (139264 + 1024)
#define NPH 12

template <int MODE>
__device__ __forceinline__ void phase_norm(char* shm, MPc p, int l) {
    float* hrow = (float*)shm;
    float* red = (float*)(shm + 65536);
    for (int it = bid_opaque(); it < TT_ / 8; it += grid_n()) {
        const int tid = tid_opaque(), wid = tid >> 6, lane = tid & 63;
        const int tok = it * 8 + wid, b = tok >> 11;
        const float* xin = (MODE == 0 && l == 0) ? p->in[X] : p->xres;
        f32x4 v[8];
#pragma unroll
        for (int i = 0; i < 8; ++i) v[i] = *(const f32x4*)(xin + (size_t)tok * DM_ + (i * 64 + lane) * 4);
        const float* g = MODE == 0 ? p->in[N1G] + l * DM_ : (MODE == 1 ? p->in[N2G] + l * DM_ : p->in[FING]);
        f32x4 gv[8];
#pragma unroll
        for (int i = 0; i < 8; ++i) gv[i] = *(const f32x4*)(g + (i * 64 + lane) * 4);
        if (MODE == 2 || (MODE == 0 && l > 0)) {
            const int myslot = lane < 16 ? p->tinv[tok * 16 + lane] : -1;
            unsigned long long em = __ballot(myslot >= 0);
            while (em) {
                const int e = __builtin_ctzll(em); em &= em - 1;
                const int slot = __shfl(myslot, e, 64);
                const bf16_t* yr = p->ybuf + ((size_t)(b * 16 + e) * 256 + slot) * DM_;
                uint2 y[8];
#pragma unroll
                for (int i = 0; i < 8; ++i) y[i] = *(const uint2*)(yr + (i * 64 + lane) * 4);
#pragma unroll
                for (int i = 0; i < 8; ++i) { v[i][0] += __uint_as_float(y[i].x << 16); v[i][1] += __uint_as_float(y[i].x & 0xffff0000u); v[i][2] += __uint_as_float(y[i].y << 16); v[i][3] += __uint_as_float(y[i].y & 0xffff0000u); }
            }
        }
        float ss = 0.f;
#pragma unroll
        for (int i = 0; i < 8; ++i) ss += v[i][0] * v[i][0] + v[i][1] * v[i][1] + v[i][2] * v[i][2] + v[i][3] * v[i][3];
#pragma unroll
        for (int o = 32; o > 0; o >>= 1) ss += __shfl_xor(ss, o, 64);
        const float rs = rsqrtf(ss * (1.0f / DM_) + 1e-6f);
        if (MODE != 2) __syncthreads();
#pragma unroll
        for (int i = 0; i < 8; ++i) {
            const int c = (i * 64 + lane) * 4;
            const f32x4 y = (f32x4){v[i][0] * rs * gv[i][0], v[i][1] * rs * gv[i][1], v[i][2] * rs * gv[i][2], v[i][3] * rs * gv[i][3]};
            if (MODE == 0 && l > 0) *(f32x4*)(p->xres + (size_t)tok * DM_ + c) = v[i];
            if (MODE == 2) *(f32x4*)(p->out + (size_t)tok * DM_ + c) = y;
            else {
                uint2 o; o.x = cvt_pk_bf16(y[0], y[1]); o.y = cvt_pk_bf16(y[2], y[3]);
                *(uint2*)(p->hb + (size_t)tok * DM_ + c) = o;
                *(f32x4*)(hrow + wid * DM_ + c) = y;
            }
        }
        if (MODE != 2) {
            __syncthreads();
            const float* W = MODE == 0 ? p->in[WIN] + (size_t)l * DM_ * INC_ + PROJW : p->in[WR] + (size_t)l * DM_ * 16;
            const int ldw = MODE == 0 ? INC_ : 16;
            const int e = tid & 15, part = tid >> 4;
            float acc[8] = {0.f, 0.f, 0.f, 0.f, 0.f, 0.f, 0.f, 0.f};
#pragma unroll 4
            for (int k = part * 64; k < part * 64 + 64; ++k) {
                const float w = W[(size_t)k * ldw + e];
#pragma unroll
                for (int t = 0; t < 8; ++t) acc[t] += hrow[t * DM_ + k] * w;
            }
#pragma unroll
            for (int t = 0; t < 8; ++t) red[(t * 32 + part) * 16 + e] = acc[t];
            __syncthreads();
            if (tid < 128) {
                const int tl = tid >> 4, e2 = tid & 15; float s = 0.f;
                for (int q = 0; q < 32; ++q) s += red[(tl * 32 + q) * 16 + e2];
                const int tk = it * 8 + tl;
                if (MODE == 0) p->dtraw[(size_t)tk * 16 + e2] = s;
                else {
                    float m = s;
#pragma unroll
                    for (int o = 8; o > 0; o >>= 1) m = fmaxf(m, __shfl_xor(m, o, 64));
                    const float ex = expf(s - m); float z = ex;
#pragma unroll
                    for (int o = 8; o > 0; o >>= 1) z += __shfl_xor(z, o, 64);
                    p->aff[(size_t)tk * 16 + e2] = ex / z;
                }
            }
        }
    }
}
__device__ __forceinline__ int block_sum_512(int v, volatile int* red  , int par, int tid) {
#pragma unroll
    for (int o = 32; o > 0; o >>= 1) v += __shfl_xor(v, o, 64);
    if ((tid & 63) == 0) red[par * 8 + (tid >> 6)] = v;
    __syncthreads();
    int s = 0;
#pragma unroll
    for (int w = 0; w < 8; ++w) s += red[par * 8 + w];
    return s;
}
__device__ __forceinline__ int block_exscan_512(int v, volatile int* wsum  , int tid) {
    int inc = v;
#pragma unroll
    for (int o = 1; o < 64; o <<= 1) { const int n = __shfl_up(inc, o, 64); if ((tid & 63) >= o) inc += n; }
    if ((tid & 63) == 63) wsum[tid >> 6] = inc;
    __syncthreads();
    int base = 0;
#pragma unroll
    for (int w = 0; w < 8; ++w) base += (w < (tid >> 6)) ? wsum[w] : 0;
    __syncthreads();
    return base + inc - v;
}
__device__ __forceinline__ void phase_topk(char* shm, MPc p) {
    volatile int* red = (volatile int*)shm;
    volatile int* wsum = red + 16;
    for (int z = bid_opaque(); z < 64; z += grid_n()) {
        const int b = z >> 4, e = z & 15, tid = tid_opaque();
        __syncthreads();
        float v[4]; unsigned u[4];
#pragma unroll
        for (int i = 0; i < 4; ++i) { v[i] = p->aff[(size_t)(b * SEQ_ + tid * 4 + i) * 16 + e]; u[i] = __float_as_uint(v[i]); }
        unsigned T = 0u;
        for (int bit = 30; bit >= 0; --bit) {
            const unsigned cand = T | (1u << bit);
            const int c = block_sum_512((u[0] >= cand) + (u[1] >= cand) + (u[2] >= cand) + (u[3] >= cand), red, bit & 1, tid);
            if (c >= 256) T = cand;
        }
        __syncthreads();
        const int ngt = block_sum_512((u[0] > T) + (u[1] > T) + (u[2] > T) + (u[3] > T), red, 0, tid);
        const int need = 256 - ngt;
        __syncthreads();
        const int eq_l = (u[0] == T) + (u[1] == T) + (u[2] == T) + (u[3] == T);
        int eqr = block_exscan_512(eq_l, wsum, tid);
        int sel[4], nsel = 0;
#pragma unroll
        for (int i = 0; i < 4; ++i) { const bool isq = u[i] == T; sel[i] = (u[i] > T) || (isq && eqr < need); eqr += isq ? 1 : 0; nsel += sel[i]; }
        int slot = block_exscan_512(nsel, wsum, tid);
#pragma unroll
        for (int i = 0; i < 4; ++i) {
            const int t = tid * 4 + i;
            if (sel[i]) { p->tidx[z * 256 + slot] = t; p->tgat[z * 256 + slot] = v[i]; }
            p->tinv[(b * SEQ_ + t) * 16 + e] = sel[i] ? slot : -1;
            slot += sel[i];
        }
    }
}
__device__ __forceinline__ void phase_hy_filter(char* shm, MPc p) {
    float* zz = (float*)shm; float* ha = zz + 8 * 64; float* hbq = ha + 8 * 64;
    for (int u = bid_opaque(); u < 512; u += grid_n()) {
        const int lf = u >> 8, tid = tid_opaque(), wid = tid >> 6, o = tid & 63, i = (u & 255) * 8 + wid;
        const float* fw1 = p->in[FW1] + lf * 33 * 64; const float* fw2 = p->in[FW2] + lf * 4096; const float* fw3 = p->in[FW3] + lf * 4096; const float* fw4 = p->in[FW4] + lf * 64 * 512;
        const float t = (float)i / (float)(SEQ_ - 1);
        const float w = (2.0f * 3.14159265358979323846f / (float)SEQ_) * (float)i;
        __syncthreads();
        if (o == 0) zz[wid * 64] = t;
        if (o < 16) { const float band = 1e-4f + (float)o * ((15.0f - 1e-4f) / 15.0f); zz[wid * 64 + 1 + o] = __cosf(band * w); zz[wid * 64 + 17 + o] = -__sinf(band * w); }
        __syncthreads();
        const float fq = p->in[FREQ][lf * 64 + o];
        float s = p->in[FB1][lf * 64 + o];
        for (int k = 0; k < 33; ++k) s += zz[wid * 64 + k] * fw1[k * 64 + o];
        ha[wid * 64 + o] = __sinf(fq * s);
        __syncthreads();
        s = p->in[FB2][lf * 64 + o];
        for (int k = 0; k < 64; ++k) s += ha[wid * 64 + k] * fw2[k * 64 + o];
        hbq[wid * 64 + o] = __sinf(fq * s);
        __syncthreads();
        s = p->in[FB3][lf * 64 + o];
        for (int k = 0; k < 64; ++k) s += hbq[wid * 64 + k] * fw3[k * 64 + o];
        __syncthreads();
        ha[wid * 64 + o] = __sinf(fq * s);
        __syncthreads();
        { const float d0 = logf(1e-2f) / 1.5f, d1 = logf(1e-2f) / 0.3f;
          const int c = tid;
          float a8[8] = {0.f, 0.f, 0.f, 0.f, 0.f, 0.f, 0.f, 0.f};
          for (int k = 0; k < 64; ++k) { const float wv = fw4[k * 512 + c];
#pragma unroll
              for (int q = 0; q < 8; ++q) a8[q] += ha[q * 64 + k] * wv; }
          const float delta = fabsf(d0 + (float)c * ((d1 - d0) / 511.0f));
#pragma unroll
          for (int q = 0; q < 8; ++q) { const int iq = (u & 255) * 8 + q; const float tq = (float)iq / (float)(SEQ_ - 1);
              p->fr[((size_t)lf * SEQ_ + iq) * 512 + c] = a8[q] * __expf(-2.0f * fabsf(tq - 0.5f) * delta); } }
    }
}
__device__ __forceinline__ void phase_hy_norm(MPc p) {
    for (int u = bid_opaque(); u < 128; u += grid_n()) {
        const int tid = tid_opaque(), pr = u * 8 + (tid >> 6), lane = tid & 63, lf = pr >> 9, c = pr & 511;
        float s = 0.f;
        for (int q = 0; q < 32; ++q) s += fabsf(p->fr[((size_t)lf * SEQ_ + lane + 64 * q) * 512 + c]);
#pragma unroll
        for (int o = 32; o > 0; o >>= 1) s += __shfl_xor(s, o, 64);
        if (lane == 0) p->nrm[pr] = s;
    }
}

__device__ __forceinline__ GP mk_gp(MPc p, int l, int which) {
    GP g{};
    if (which == 0) { g.A = p->hb; g.Bt = p->wtin + (size_t)l * 13824 * DM_; g.bias = p->in[BG] + (size_t)l * 4 * DM_; g.Cb = p->proj; g.Cb2 = p->gates; g.Vt = p->vt; }
    if (which == 1) { g.A = p->br; g.Bt = p->wtbr + (size_t)l * 4 * DM_ * 512; g.G = p->gates; g.Cb = p->mrg; }
    if (which == 2) { g.A = p->mrg; g.Bt = p->wtout + (size_t)l * DM_ * DM_; g.R = l == 0 ? p->in[X] : p->xres; g.Cf = p->xres; }
    if (which == 3) { g.A = p->hb; g.B = p->in[W1] + (size_t)l * 16 * DM_ * DM_; g.B2 = p->in[W3] + (size_t)l * 16 * DM_ * DM_; g.idx = p->tidx; g.Cb = p->hid; }
    if (which == 4) { g.A = p->hid; g.B = p->in[W2] + (size_t)l * 16 * DM_ * DM_; g.gate = p->tgat; g.Cb = p->ybuf; }
    return g;
}
__device__ __forceinline__ HP mk_hp(MPc p, int l) {
    HP h{}; h.proj = p->proj; h.fr = p->fr + (size_t)l * SEQ_ * 512; h.nrm = p->nrm + l * 512; h.pp = p->hpp + (size_t)l * 512 * HY_PPW; h.vvt = p->vvt; h.yt = p->hyt;
    h.cw = p->in[HCW] + l * 3 * 1536; h.cb = p->in[HCB] + l * 1536; h.hbias = p->in[HBIAS] + l * 512; h.br = p->br; return h;
}
__device__ __forceinline__ LP mk_lp(MPc p, int l) {
    LP q{}; q.proj = p->proj; q.cw = p->in[LCW] + l * 4 * 512; q.cb = p->in[LCB] + l * 512; q.wt = p->lruwt + (size_t)l * 8 * 256 * 64; q.ba = p->in[LBA] + l * 1024;
    q.bx = p->in[LBX] + l * 1024; q.lam = p->in[LLAM] + l * 1024; q.sumP = p->sumP; q.sumE = p->sumE; q.br = p->br; return q;
}
__device__ __forceinline__ SP_ mk_sp(MPc p, int l) {
    SP_ s{}; s.proj = p->proj; s.dtraw = p->dtraw; s.cw = p->in[SCW] + l * 4 * 1024; s.cb = p->in[SCB] + l * 1024; s.dtb = p->in[SDTB] + l * 16; s.a_log = p->in[SALOG] + l * 16; s.dsk = p->in[SD] + l * 8; s.ng = p->in[SNG] + l * 512;
    s.xa = p->sxa; s.xT = p->sxT; s.states = p->states; s.decay = p->sdec; s.prev = p->sprev; s.br = p->br; return s;
}
__device__ __forceinline__ AP mk_ap(MPc p, int l) {
    AP a{}; a.proj = p->proj; a.vt = p->vt; a.rel_bias = p->in[RELB]; a.dlam = p->in[DLAM] + l * 256; a.subg = p->in[DSUB] + l * 128; a.br = p->br; a.lam_init = l == 0 ? 0.2f : 0.35550906759096926f; return a;
}
__device__ __forceinline__ void wconv_tile(float* tile, const float* src, size_t ld_src, bf16_t* dst, size_t ld_dst, int tid) {
    __syncthreads();
    { const int kr = tid >> 4, n4 = (tid & 15) * 4;
#pragma unroll
      for (int h = 0; h < 2; ++h) { const f32x4 v = *(const f32x4*)(src + (size_t)(kr + 32 * h) * ld_src + n4); float* t = tile + (kr + 32 * h) * 65 + n4; t[0] = v[0]; t[1] = v[1]; t[2] = v[2]; t[3] = v[3]; } }
    __syncthreads();
    { const int n = tid >> 3, k8 = (tid & 7) * 8; const float* t = tile + k8 * 65 + n;
      uint4 o; o.x = cvt_pk_bf16(t[0], t[65]); o.y = cvt_pk_bf16(t[130], t[195]); o.z = cvt_pk_bf16(t[260], t[325]); o.w = cvt_pk_bf16(t[390], t[455]);
      *(uint4*)(dst + (size_t)n * ld_dst + k8) = o; }
}
__device__ __forceinline__ void phase_wconv(char* shm, MPc p, int l, int bw0, int bwn) {
    const int bq = bid_opaque() - bw0; if (bq < 0 || bq >= bwn) return;
    for (int e0 = bq * 512 + tid_opaque(); e0 < 8 * 256 * 64; e0 += bwn * 512) {
        const int e = l * 8 * 256 * 64 + e0; const int i = e & 63, n = (e >> 6) & 255, h = (e >> 14) & 7, j = n & 63, g = (n >> 6) & 1, dir = n >> 7;
        const float* w = (g ? p->in[LWX] : p->in[LWA]) + ((size_t)((l * 2 + dir) * 8 + h) * 64 + i) * 64 + j;
        p->lruwt[e] = f2bf(*w);
    }
    float* tile = (float*)shm;
    const int NJ_IN = 32 * 216, NJ_BR = 4 * 8 * 32, NJ_OUT = 32 * 32, NJ = NJ_IN + NJ_BR + NJ_OUT;
    for (int u = bq; u < NJ; u += bwn) {
        int j = u; const int tid = tid_opaque();
        if (j < NJ_IN) { const int nt = j % 216, kt = j / 216, n0 = nt * 64, ns = n0 < PROJW ? n0 : n0 + 16;
            wconv_tile(tile, p->in[WIN] + (size_t)l * DM_ * INC_ + (size_t)kt * 64 * INC_ + ns, INC_, p->wtin + ((size_t)l * 13824 + n0) * DM_ + kt * 64, DM_, tid); }
        else if (j < NJ_IN + NJ_BR) { j -= NJ_IN; const int nt = j & 31, kt = (j >> 5) & 7, k = j >> 8;
            wconv_tile(tile, p->in[WBR] + ((size_t)(l * 4 + k) * 512 + kt * 64) * DM_ + nt * 64, DM_, p->wtbr + (((size_t)(l * 4 + k) * DM_) + nt * 64) * 512 + kt * 64, 512, tid); }
        else { j -= NJ_IN + NJ_BR; const int nt = j & 31, kt = j >> 5;
            wconv_tile(tile, p->in[WOUT] + ((size_t)l * DM_ + kt * 64) * DM_ + nt * 64, DM_, p->wtout + ((size_t)l * DM_ + nt * 64) * DM_ + kt * 64, DM_, tid); }
    }
}
#define PH_ON(id) (ONLY < 0 || ONLY == (id))
#define PH_SYNC(id) do { if (ONLY < 0) xcd_barrier(bar); } while (0)
template <int ONLY>
__global__ void __launch_bounds__(512, 2) k_mega(MP p_unused) {
    extern __shared__ __attribute__((aligned(1024))) char shm[];
    XcdBarrier bar{};
    if (ONLY < 0) {
        volatile LAS unsigned* xbw = (volatile LAS unsigned*)(shm + MEGA_LDS - 16);
        if (threadIdx.x == 0) { xbw[0] = 0u; xbw[1] = 0u; }
        __syncthreads();
        bar = xcd_barrier_post(params()->bar, xbw);
        if (threadIdx.x == 0) { unsigned nloc, nx; xcd_barrier_complete(bar.bar, bar.x, nloc, nx); xbw[0] = nloc; xbw[1] = nx; }
        __syncthreads();
    }
    constexpr int L0 = ONLY < 0 ? 0 : (ONLY >= 2 * NPH ? 2 : ONLY / NPH), L1 = ONLY < 0 ? 2 : (ONLY >= 2 * NPH ? 2 : ONLY / NPH + 1);
#pragma unroll 1
    for (int l = L0; l < L1; ++l) {
        const int id0 = l * NPH;
        if (PH_ON(id0 + 0)) { phase_norm<0>(shm, params(), l); if (l == 0) { phase_hy_filter(shm, params()); phase_wconv(shm, params(), 0, 0, grid_n()); } }
        PH_SYNC(id0 + 0);
        if (PH_ON(id0 + 1)) { if (l == 0) phase_hy_norm(params()); const GP g = mk_gp(params(), l, 0);
            const pg8::Gemm gg{g.A, g.Bt, TT_, 13824, DM_, DM_, DM_}; const pg8::MegaOrder so{32, 54, grid_n(), bid_opaque()}; const pg8::EpiInproj ep{g.Cb, g.Cb2, g.Vt, g.bias};
            pg8::gemm_phase<pg8::EpiInproj, pg8::MegaOrder, false>((PG8_LAS unsigned char*)shm, gg, so, ep, nullptr); }
        PH_SYNC(id0 + 1);
        if (PH_ON(id0 + 2)) {
            { const AP a = mk_ap(params(), l); phase_attn(shm, a); }
            if (l == 0) { const HP h0 = mk_hp(params(), 0); phase_hy_pp(h0); const HP h1 = mk_hp(params(), 1); phase_hy_pp(h1); }
            { const HP h = mk_hp(params(), l); phase_hy_prep(shm, h); }
            { const SP_ s = mk_sp(params(), l); phase_ssd_prep(shm, s); }
            { const LP q = mk_lp(params(), l); phase_lru<0>(shm, q); }
        }
        PH_SYNC(id0 + 2);
        if (PH_ON(id0 + 3)) {
            { const HP h = mk_hp(params(), l); phase_hy_conv(shm, h); }
            { const SP_ s = mk_sp(params(), l); phase_ssd_states(shm, s); }
            { const LP q = mk_lp(params(), l); phase_lru<1>(shm, q); }
        }
        PH_SYNC(id0 + 3);
        if (PH_ON(id0 + 4)) { const SP_ s = mk_sp(params(), l); phase_ssd_scan(s); }
        PH_SYNC(id0 + 4);
        if (PH_ON(id0 + 5)) { { const SP_ s = mk_sp(params(), l); phase_ssd_out(shm, s); }
            { const HP h = mk_hp(params(), l); phase_hy_fin(shm, h, 0, grid_n()); }
            if (l == 0) phase_wconv(shm, params(), 1, 0, grid_n()); }
        PH_SYNC(id0 + 5);
        if (PH_ON(id0 + 6)) { const GP g = mk_gp(params(), l, 1); phase_merge(shm, g); }
        PH_SYNC(id0 + 6);
        if (PH_ON(id0 + 7)) { const GP g = mk_gp(params(), l, 2);
            const pg8::Gemm gg{g.A, g.Bt, TT_, DM_, DM_, DM_, DM_}; const pg8::MegaOrder so{32, 8, grid_n(), bid_opaque()}; const pg8::EpiOutproj ep{g.R, g.Cf};
            pg8::gemm_phase<pg8::EpiOutproj, pg8::MegaOrder, false>((PG8_LAS unsigned char*)shm, gg, so, ep, nullptr); }
        PH_SYNC(id0 + 7);
        if (PH_ON(id0 + 8)) phase_norm<1>(shm, params(), l);
        PH_SYNC(id0 + 8);
        if (PH_ON(id0 + 9)) phase_topk(shm, params());
        PH_SYNC(id0 + 9);
        if (PH_ON(id0 + 10)) { const GP g = mk_gp(params(), l, 3); phase_moe_up(shm, g); }
        PH_SYNC(id0 + 10);
        #if MOE_DOWN2
        if (PH_ON(id0 + 11)) phase_moe_down2(shm, params(), l);
#else
        if (PH_ON(id0 + 11)) { const GP g = mk_gp(params(), l, 4); phase_moe_down(shm, g); }
#endif
        PH_SYNC(id0 + 11);
    }
    if (PH_ON(2 * NPH)) phase_norm<2>(shm, params(), 0);
}
template <int I> struct PhaseLauncher { static void go(int grid, hipStream_t st, const MP& p) { (void)hipFuncSetAttribute((const void*)k_mega<I>, hipFuncAttributeMaxDynamicSharedMemorySize, MEGA_LDS); hipLaunchKernelGGL(k_mega<I>, dim3(grid), dim3(512), MEGA_LDS, st, p); PhaseLauncher<I + 1>::go(grid, st, p); } };
template <> struct PhaseLauncher<2 * NPH + 1> { static void go(int, hipStream_t, const MP&) {} };

#ifndef MK_N_LAUNCHES
#define MK_N_LAUNCHES 1
#endif
extern "C" void kernel_launch(void* const* d_in, const int* in_sizes, int n_in, void* d_out, int out_size, void* d_ws, size_t ws_size, hipStream_t stream) {
    static int grid = 0;
    if (grid == 0) {
        int dev = 0, cus = 0;
        if (hipGetDevice(&dev) != hipSuccess || hipDeviceGetAttribute(&cus, hipDeviceAttributeMultiprocessorCount, dev) != hipSuccess) { fprintf(stderr, "kernel_launch: device query failed\n"); grid = -1; return; }
        if (hipFuncSetAttribute((const void*)k_mega<-1>, hipFuncAttributeMaxDynamicSharedMemorySize, MEGA_LDS) != hipSuccess) { fprintf(stderr, "kernel_launch: hipFuncSetAttribute failed\n"); grid = -1; return; }
        (void)hipGetLastError();
        grid = cus;
    }
    if (grid < 0) return;
    char* w = (char*)d_ws; size_t off = 0;
    auto alloc = [&](size_t bytes) { void* q = w + off; off += (bytes + 255) & ~(size_t)255; return q; };
    MP p{};
    for (int i = 0; i < 39; ++i) p.in[i] = (const float*)d_in[i];
    p.out = (float*)d_out; p.ngrid = grid;
    p.bar = (unsigned*)alloc(XCD_BAR_WORDS * 4 + GRP_COUNT * GRP_WORDS * 4); p.grp = p.bar + XCD_BAR_WORDS;
    p.panel = (bf16_t*)alloc((size_t)256 * 256 * DM_ * 2);
    p.xres = (float*)alloc((size_t)TT_ * DM_ * 4);
    p.hb = (bf16_t*)alloc((size_t)TT_ * DM_ * 2);
    p.proj = (bf16_t*)alloc((size_t)TT_ * PROJW * 2);
    p.gates = (bf16_t*)alloc((size_t)TT_ * 8192 * 2);
    p.dtraw = (float*)alloc((size_t)TT_ * 16 * 4);
    p.br = (bf16_t*)alloc((size_t)TT_ * DM_ * 2);
    p.mrg = (bf16_t*)alloc((size_t)TT_ * DM_ * 2);
    p.fr = (float*)alloc((size_t)2 * SEQ_ * 512 * 4);
    p.nrm = (float*)alloc(2 * 512 * 4);
    p.hpp = (unsigned*)alloc((size_t)2 * 512 * HY_PPW * 4);
    p.vvt = (bf16_t*)alloc((size_t)512 * NB_ * SEQ_ * 2);
    p.hyt = (float*)alloc((size_t)512 * NB_ * SEQ_ * 4);
    p.vt = (bf16_t*)alloc((size_t)NB_ * 512 * SEQ_ * 2);
    p.sumP = (float*)alloc((size_t)2 * NB_ * 32 * 512 * 4);
    p.sumE = (float*)alloc((size_t)2 * NB_ * 32 * 512 * 4);
    p.sxa = (bf16_t*)alloc((size_t)TT_ * 1024 * 2);
    p.sxT = (bf16_t*)alloc((size_t)TT_ * 1024 * 2);
    p.states = (float*)alloc((size_t)NB_ * SSD_NC * 16 * 64 * 128 * 4);
    p.sdec = (float*)alloc(NB_ * SSD_NC * 16 * 4);
    p.sprev = (bf16_t*)alloc((size_t)NB_ * SSD_NC * 16 * 64 * 128 * 2);
    p.aff = (float*)alloc((size_t)TT_ * 16 * 4);
    p.tidx = (int*)alloc(64 * 256 * 4);
    p.tgat = (float*)alloc(64 * 256 * 4);
    p.tinv = (int*)alloc((size_t)TT_ * 16 * 4);
    p.hid = (bf16_t*)alloc((size_t)64 * 256 * DM_ * 2);
    p.ybuf = (bf16_t*)alloc((size_t)64 * 256 * DM_ * 2);
    p.wtin = (bf16_t*)alloc((size_t)2 * 13824 * DM_ * 2);
    p.wtbr = (bf16_t*)alloc((size_t)2 * 4 * DM_ * 512 * 2);
    p.wtout = (bf16_t*)alloc((size_t)2 * DM_ * DM_ * 2);
    p.lruwt = (bf16_t*)alloc((size_t)2 * 8 * 256 * 64 * 2);
    p.m32 = (float*)alloc((size_t)TT_ * DM_ * 4);
    if (off > ws_size) { fprintf(stderr, "kernel_launch: workspace too small (%zu > %zu)\n", off, ws_size); return; }
    (void)hipMemsetAsync(p.bar, 0, XCD_BAR_WORDS * 4 + GRP_COUNT * GRP_WORDS * 4, stream);
#if MK_N_LAUNCHES == 1
    hipLaunchKernelGGL(k_mega<-1>, dim3(grid), dim3(512), MEGA_LDS, stream, p);
#else
    PhaseLauncher<0>::go(grid, stream, p);
#endif
}
```

```cpp
#include <hip/hip_runtime.h>
#include <math.h>
#include <stdint.h>
#include <stdio.h>

#define NB_ 4
#define SEQ_ 2048
#define DM_ 2048
#define TT_ 8192
#define INC_ 13840
#define O_HY 0
#define O_LRU 1536
#define O_DA 2560
#define O_SSD 4096
#define O_GATE 5648
typedef short bf16x8 __attribute__((ext_vector_type(8)));
typedef float f32x4 __attribute__((ext_vector_type(4)));
typedef float f32x2 __attribute__((ext_vector_type(2)));
typedef int i32x4 __attribute__((ext_vector_type(4)));
typedef unsigned short bf16_t;
__device__ __forceinline__ int bid_opaque();
__device__ __forceinline__ int grid_n();

typedef __bf16 bf16x2_t __attribute__((ext_vector_type(2)));
__device__ __forceinline__ unsigned cvt_pk_bf16(float lo, float hi) { const f32x2 v = {lo, hi}; return __builtin_bit_cast(unsigned, __builtin_convertvector(v, bf16x2_t)); }
__device__ __forceinline__ int tid_opaque() { int t = (int)__builtin_amdgcn_workitem_id_x(); asm volatile("" : "+v"(t)); return t; }
__device__ __forceinline__ float bf2f(bf16_t v) { return __uint_as_float((unsigned)v << 16); }
__device__ __forceinline__ bf16_t f2bf(float f) { return (bf16_t)(cvt_pk_bf16(f, 0.f) & 0xffffu); }

__device__ __forceinline__ int lds_rc(int r, int chunk) { return r * 128 + ((chunk ^ ((r >> 1) & 7)) << 4); }
#define GEMM_LDS_BYTES(BM) (2 * ((BM) * 128 + 256 * 128))
#ifndef GEMM_L2PF
#define GEMM_L2PF 0
#endif
#ifndef GEMM_BT_AH
#define GEMM_BT_AH 8
#endif

#define GEMM_KTILE(buf, HOOK) do { const char* sS = shm + (buf) * STAGE; bf16x8 Bc[4], Bn[4], Ar[4]; \
        _Pragma("unroll") for (int n = 0; n < 4; ++n) Bc[n] = *(const bf16x8*)(sS + broff0 + n * 2048); \
        _Pragma("unroll") for (int q = 0; q < 3; ++q) Ar[q] = *(const bf16x8*)(sS + aroff0 + q * 2048); \
        __builtin_amdgcn_sched_barrier(0); \
        _Pragma("unroll") for (int g = 0; g < 2 * FM; ++g) { \
            if (g + 3 < 2 * FM) Ar[(g + 3) & 3] = *(const bf16x8*)(sS + ((g + 3) / FM ? aroff1 : aroff0) + ((g + 3) % FM) * 2048); \
            if (g == FM - 4) { _Pragma("unroll") for (int n = 0; n < 4; ++n) Bn[n] = *(const bf16x8*)(sS + broff1 + n * 2048); } \
            __builtin_amdgcn_sched_barrier(0); \
            _Pragma("unroll") for (int n = 0; n < 4; ++n) acc[g % FM][n] = __builtin_amdgcn_mfma_f32_16x16x32_bf16(Ar[g & 3], (g < FM ? Bc[n] : Bn[n]), acc[g % FM][n], 0, 0, 0); \
            HOOK(g); \
            __builtin_amdgcn_sched_barrier(0); } } while (0)
template <int BM, bool DUAL>
struct GemmCore {
    static constexpr int FM = BM / 32;
    static constexpr int GLA = BM * 128 / 8192;
    static constexpr int TILE_A = BM * 128, TILE_B = 256 * 128, STAGE = TILE_A + TILE_B;

    template <class AccT>
    static __device__ __forceinline__ void run(char* shm, const char* abase, const unsigned (&aoff)[GLA], const char* bl, unsigned ldb, int nt, AccT& acc) {
        const int tid = tid_opaque(), wid = tid >> 6, lane = tid & 63, wr = wid >> 2, wc = wid & 3, fr = lane & 15, fq = lane >> 4;
        const int kq = lane & 3, ngl = lane >> 2, ksub = wid & 1, grp = wid >> 1;
        i32x4 sa[GLA];
        f32x4 sb[8];
        const int awoff = lds_rc(tid >> 3, tid & 7);
        const int bwoff = TILE_A + lds_rc(grp * 64 + ngl, ksub * 4 + kq);
        const int aroff0 = lds_rc(wr * (BM / 2) + fr, fq), aroff1 = lds_rc(wr * (BM / 2) + fr, 4 + fq);
        const int broff0 = TILE_A + lds_rc(wc * 64 + fr, fq), broff1 = TILE_A + lds_rc(wc * 64 + fr, 4 + fq);
#define G_ISSUE(kt) do { const char* ab_ = abase + (size_t)(kt) * 128; _Pragma("unroll") for (int i = 0; i < GLA; ++i) sa[i] = *(const i32x4*)(ab_ + aoff[i]); \
        _Pragma("unroll") for (int r = 0; r < 8; ++r) sb[r] = *(const f32x4*)(bl + (size_t)((kt) * 64 + r) * ldb); \
        __builtin_amdgcn_sched_barrier(0); } while (0)
#define G_WRITE(buf) do { char* sbase = shm + (buf) * STAGE; _Pragma("unroll") for (int i = 0; i < GLA; ++i) *(i32x4*)(sbase + awoff + i * 8192) = sa[i]; \
        _Pragma("unroll") for (int i = 0; i < 4; ++i) { i32x4 w; w[0] = (int)cvt_pk_bf16(sb[0][i], sb[1][i]); w[1] = (int)cvt_pk_bf16(sb[2][i], sb[3][i]); \
              w[2] = (int)cvt_pk_bf16(sb[4][i], sb[5][i]); w[3] = (int)cvt_pk_bf16(sb[6][i], sb[7][i]); *(i32x4*)(sbase + bwoff + i * 2048) = w; } } while (0)
        G_ISSUE(0); G_WRITE(0); if (nt > 1) G_ISSUE(1); __syncthreads();
        for (int t = 0; t < nt; ++t) {
            const int cur = t & 1; const bool w_ok = t + 1 < nt, i_ok = t + 2 < nt;
            char* wb_ = shm + (cur ^ 1) * STAGE; const char* ab2_ = abase + (size_t)(t + 2) * 128; const char* bl2_ = bl + (size_t)(t + 2) * 64 * ldb;
#define G_HOOK(g) do { if ((g) < GLA) { if (w_ok) *(i32x4*)(wb_ + awoff + (g) * 8192) = sa[(g)]; if (i_ok) sa[(g)] = *(const i32x4*)(ab2_ + aoff[(g)]); } \
            else if ((g) >= 8 && (g) < 12) { if (w_ok) { const int i = (g) - 8; i32x4 w; w[0] = (int)cvt_pk_bf16(sb[0][i], sb[1][i]); w[1] = (int)cvt_pk_bf16(sb[2][i], sb[3][i]); \
                  w[2] = (int)cvt_pk_bf16(sb[4][i], sb[5][i]); w[3] = (int)cvt_pk_bf16(sb[6][i], sb[7][i]); *(i32x4*)(wb_ + bwoff + i * 2048) = w; } } \
            else if ((g) >= 12) { if (i_ok) { const int r = ((g) - 12) * 2; sb[r] = *(const f32x4*)(bl2_ + (size_t)r * ldb); sb[r + 1] = *(const f32x4*)(bl2_ + (size_t)(r + 1) * ldb); } } } while (0)
            GEMM_KTILE(cur, G_HOOK);
#undef G_HOOK
            __syncthreads();
        }
#undef G_ISSUE
#undef G_WRITE
    }
    struct NoEpi { __device__ __forceinline__ void operator()(int) const {} __device__ __forceinline__ void pre(int) const {} };
    template <class AccT>
    static __device__ __forceinline__ void run_bt(char* shm, const char* abase, const unsigned (&aoff)[GLA], const char* bbase, const unsigned (&boff)[4], unsigned ldbt, const char* pf_in, int nt, AccT& acc) {
        run_bt_seg<1 << 20>(shm, abase, aoff, bbase, boff, ldbt, 0, pf_in, nt, acc, NoEpi());
    }
    template <int SEG, class AccT, class Epi>
    static __device__ __forceinline__ void run_bt_seg(char* shm, const char* abase, const unsigned (&aoff)[GLA], const char* bbase, const unsigned (&boff)[4], unsigned ldbt, size_t segstride, const char* pf_in, int nt, AccT& acc, Epi seg_epi) {
        const int tid = tid_opaque(), wid = tid >> 6, lane = tid & 63, wr = wid >> 2, wc = wid & 3, fr = lane & 15, fq = lane >> 4;
        i32x4 sa[GLA], sbt[4];
        const unsigned astr = 64u * DM_ * 2u, bstr = 64u * ldbt;
        const int awoff = lds_rc(tid >> 3, tid & 7);
        const int aroff0 = lds_rc(wr * (BM / 2) + fr, fq), aroff1 = lds_rc(wr * (BM / 2) + fr, 4 + fq);
        const int broff0 = TILE_A + lds_rc(wc * 64 + fr, fq), broff1 = TILE_A + lds_rc(wc * 64 + fr, 4 + fq);
#define T_ISSUE(kt) do { const char* ab_ = abase + (size_t)(kt) * 128 + aoff[0]; const char* bb_ = bbase + (size_t)((kt) / SEG) * segstride + (size_t)((kt) % SEG) * 128 + boff[0]; \
        _Pragma("unroll") for (int i = 0; i < GLA; ++i) sa[i] = *(const i32x4*)(ab_ + (size_t)i * astr); \
        _Pragma("unroll") for (int i = 0; i < 4; ++i) sbt[i] = *(const i32x4*)(bb_ + (size_t)i * bstr); \
        __builtin_amdgcn_sched_barrier(0); } while (0)
#define T_WRITE(buf) do { char* sbase = shm + (buf) * STAGE; _Pragma("unroll") for (int i = 0; i < GLA; ++i) *(i32x4*)(sbase + awoff + i * 8192) = sa[i]; \
        _Pragma("unroll") for (int i = 0; i < 4; ++i) *(i32x4*)(sbase + TILE_A + awoff + i * 8192) = sbt[i]; } while (0)
        const unsigned long long pf0 = (unsigned long long)pf_in;
        const unsigned long long pfu = ((unsigned long long)(unsigned)__builtin_amdgcn_readfirstlane((int)(pf0 >> 32)) << 32) | (unsigned)__builtin_amdgcn_readfirstlane((int)(unsigned)pf0);
        const char* pf = (const char*)pfu; const unsigned pfo = (unsigned)(pf0 - pfu);
        unsigned pfa = 0u, pfb = 0u;
        T_ISSUE(0); T_WRITE(0); if (nt > 1) T_ISSUE(1);
#if GEMM_L2PF
        if (nt > 2) pfa = *(const unsigned*)(pf + 2 * 128 + pfo);
#endif
        __syncthreads();
        for (int t = 0; t < nt; ++t) {
            const int cur = t & 1;
            const bool w_ok = t + 1 < nt, i_ok = t + 2 < nt;
            char* wb_ = shm + (cur ^ 1) * STAGE; const char* ab2_ = abase + (size_t)(t + 2) * 128 + aoff[0];
            const char* bb2_ = bbase + (size_t)((t + 2) / SEG) * segstride + (size_t)((t + 2) % SEG) * 128 + boff[0];
#define T_HOOK(g) do { if ((g) < GLA) { if (w_ok) *(i32x4*)(wb_ + awoff + (g) * 8192) = sa[(g)]; if (i_ok) sa[(g)] = *(const i32x4*)(ab2_ + (size_t)(g) * astr); } \
            else if ((g) < GLA + 4) { const int i = (g) - GLA; if (w_ok) *(i32x4*)(wb_ + TILE_A + awoff + i * 8192) = sbt[i]; if (i_ok) sbt[i] = *(const i32x4*)(bb2_ + (size_t)i * bstr); } } while (0)
#if GEMM_L2PF
            if (t + 3 < nt) pfb = *(const unsigned*)(pf + (size_t)(t + 3) * 128 + pfo);
            asm volatile("" :: "v"(pfa));
            pfa = pfb;
#endif
            if ((t % SEG) == SEG - 1) seg_epi.pre(t / SEG);
            GEMM_KTILE(cur, T_HOOK);
#undef T_HOOK
            __syncthreads();
            if ((t % SEG) == SEG - 1) seg_epi(t / SEG);
        }
#undef T_ISSUE
#undef T_WRITE
    }
    static __device__ __forceinline__ void bt_coord(int tid, int i, int& col, int& C) { const int R = (tid >> 3) + 64 * i; C = (tid & 7) * 8;
        col = (R & ~63) + 4 * (R & 15) + ((R >> 4) & 3); }
    static __device__ __forceinline__ void a_coord(int tid, int i, int& R, int& C) { R = (tid >> 3) + 64 * i; C = (tid & 7) * 8; }
    static __device__ __forceinline__ void b_coord(int tid, int& k, int& col, int& which) { const int wid = tid >> 6, lane = tid & 63; const int kq = lane & 3, ngl = lane >> 2, ksub = wid & 1, grp = wid >> 1;
        k = ksub * 32 + kq * 8; if (DUAL) { which = ngl >> 3; col = grp * 32 + 4 * (ngl & 7); } else { which = 0; col = grp * 64 + 4 * ngl; } }
};
#define PROJW 5632
__device__ __forceinline__ float sigmoidf_(float x) { return 1.0f / (1.0f + expf(-x)); }
__device__ __forceinline__ float siluf_(float x) { return x / (1.0f + expf(-x)); }
__device__ __forceinline__ float softplusf_(float x) { return x > 20.f ? x : log1pf(expf(x)); }
__device__ __forceinline__ float sigmoid_fast_(float x) { return __builtin_amdgcn_rcpf(1.0f + __expf(-x)); }
__device__ __forceinline__ float silu_fast_(float x) { return x * __builtin_amdgcn_rcpf(1.0f + __expf(-x)); }
__device__ __forceinline__ float softplus_fast_(float x) { const float e = __expf(x); const float sm = e * (1.0f - e * (0.5f - e * (1.0f / 3.0f))); return x > 15.f ? x : (e < 0.01f ? sm : __logf(1.0f + e)); }
__device__ __forceinline__ float gelu_tanh_(float x) { const float u2 = 1.5957691216057308f * (x + 0.044715f * x * x * x); return x * __builtin_amdgcn_rcpf(1.0f + __expf(-u2)); }

__device__ __forceinline__ float block_sum_256(float v, float* red) {
    for (int o = 32; o > 0; o >>= 1) v += __shfl_down(v, o, 64);
    __syncthreads();
    if ((tid_opaque() & 63) == 0) red[tid_opaque() >> 6] = v;
    __syncthreads();
    float r = red[0] + red[1] + red[2] + red[3];
    __syncthreads();
    return r;
}
__device__ __forceinline__ float block_max_256(float v, float* red) {
    for (int o = 32; o > 0; o >>= 1) v = fmaxf(v, __shfl_down(v, o, 64));
    __syncthreads();
    if ((tid_opaque() & 63) == 0) red[tid_opaque() >> 6] = v;
    __syncthreads();
    float r = fmaxf(fmaxf(red[0], red[1]), fmaxf(red[2], red[3]));
    __syncthreads();
    return r;
}

__device__ __forceinline__ int t5_bucket(int rel) {
    const int ret = rel > 0 ? 16 : 0; const int n = rel < 0 ? -rel : rel;
    if (n < 8) return ret + n;
    const float v = logf((float)n / 8.0f) / 2.772588722239781f * 8.0f;
    int large = 8 + (int)v; if (large > 15) large = 15;
    return ret + large;
}
struct AP { const bf16_t* proj; const bf16_t* vt; const float* rel_bias; const float* dlam; const float* subg; bf16_t* br; float lam_init; };
#define ATT_LDS (2 * 32768 + 2048)
__device__ __forceinline__ void phase_attn(char* shm, const AP& p) {
    float* btab = (float*)(shm + 65536);
    const float LOG2E = 1.4426950408889634f;
    for (int unit = bid_opaque(); unit < NB_ * 4 * 16; unit += grid_n()) {
        const int xq = unit & 7, sq = unit >> 3, bh = (xq * 2 + (sq >> 4)) & 15, qt = sq & 15, h = bh & 3, b = bh >> 2;
        const int tid = tid_opaque(), wid = tid >> 6, lane = tid & 63, fr = lane & 15, fq = lane >> 4;
        __syncthreads();
        if (tid < 257) btab[tid] = p.rel_bias[t5_bucket(tid - 128) * 4 + h] * LOG2E;
        float l0 = 0.f, l1 = 0.f;
        for (int d = 0; d < 64; ++d) { l0 += p.dlam[d] * p.dlam[64 + d]; l1 += p.dlam[128 + d] * p.dlam[192 + d]; }
        const float lam = expf(l0) - expf(l1) + p.lam_init;
        const int q0 = qt * 128, qrow = q0 + wid * 16 + fr;
        bf16x8 qf[2][2];
        { const bf16_t* qp = p.proj + (size_t)(b * SEQ_ + qrow) * PROJW + O_DA + h * 128 + fq * 8;
#pragma unroll
          for (int i = 0; i < 2; ++i)
#pragma unroll
            for (int s = 0; s < 2; ++s) qf[i][s] = *(const bf16x8*)(qp + i * 64 + s * 32); }
        const bf16_t* kg[2]; const bf16_t* vg[2]; int kl[2], vl[2]; bool vswap[2];
#pragma unroll
        for (int u = 0; u < 2; ++u) {
            const int c = tid + u * 512;
            const int krow = c >> 4, kch = c & 15;
            kg[u] = p.proj + (size_t)(b * SEQ_ + krow) * PROJW + O_DA + 512 + h * 128 + kch * 8;
            kl[u] = krow * 256 + ((kch ^ (krow & 15)) * 16);
            const int dv = c >> 3, ch16 = c & 7;
            vg[u] = p.vt + (size_t)(b * 512 + h * 128 + dv) * SEQ_ + ch16 * 8;
            vl[u] = 16384 + dv * 128 + ((ch16 ^ ((dv & 15) >> 1)) * 16); vswap[u] = dv & 1;
        }
        i32x4 sk[2], sv[2];
#define A_ISSUE(kt) do { _Pragma("unroll") for (int u = 0; u < 2; ++u) { sk[u] = *(const i32x4*)(kg[u] + (size_t)(kt) * 64 * PROJW); sv[u] = *(const i32x4*)(vg[u] + (kt) * 64); } } while (0)
#define A_WRITE(buf) do { char* sb_ = shm + (buf) * 32768; _Pragma("unroll") for (int u = 0; u < 2; ++u) { *(i32x4*)(sb_ + kl[u]) = sk[u]; \
            i32x4 w_ = sv[u]; if (vswap[u]) w_ = (i32x4){sv[u][2], sv[u][3], sv[u][0], sv[u][1]}; *(i32x4*)(sb_ + vl[u]) = w_; } } while (0)
        f32x4 O[2][8];
#pragma unroll
        for (int i = 0; i < 2; ++i)
#pragma unroll
            for (int f = 0; f < 8; ++f) O[i][f] = (f32x4){0.f, 0.f, 0.f, 0.f};
        float mrun[2] = {-1e30f, -1e30f}, lrun[2] = {0.f, 0.f};
        A_ISSUE(0); A_WRITE(0); A_ISSUE(1); __syncthreads();
        const int NT = SEQ_ / 64;
        for (int kt = 0; kt < NT; ++kt) {
            const int cur = kt & 1;
            if (kt + 1 < NT) A_WRITE(cur ^ 1);
            if (kt + 2 < NT) A_ISSUE(kt + 2);
            const char* sK = shm + cur * 32768; const char* sV = sK + 16384;
            f32x4 S[2][4];
#pragma unroll
            for (int i = 0; i < 2; ++i)
#pragma unroll
                for (int kf = 0; kf < 4; ++kf) {
                    f32x4 a = (f32x4){0.f, 0.f, 0.f, 0.f};
#pragma unroll
                    for (int s = 0; s < 2; ++s) {
                        const int row = kf * 16 + fr, ch = i * 8 + s * 4 + fq;
                        const bf16x8 kfA = *(const bf16x8*)(sK + row * 256 + ((ch ^ (row & 15)) * 16));
                        a = __builtin_amdgcn_mfma_f32_16x16x32_bf16(kfA, qf[i][s], a, 0, 0, 0);
                    }
                    S[i][kf] = a;
                }
            const int k0 = kt * 64;
            const bool far_hi = (k0 >= q0 + 127 + 128), far_lo = (k0 + 63 <= q0 - 128);
            const float c1 = 0.125f * LOG2E;
            if (far_hi || far_lo) {
                const float bc_ = far_hi ? btab[256] : btab[0];
#pragma unroll
                for (int i = 0; i < 2; ++i)
#pragma unroll
                    for (int kf = 0; kf < 4; ++kf)
#pragma unroll
                        for (int j = 0; j < 4; ++j) S[i][kf][j] = S[i][kf][j] * c1 + bc_;
            } else {
#pragma unroll
                for (int kf = 0; kf < 4; ++kf)
#pragma unroll
                    for (int j = 0; j < 4; ++j) {
                        int rel = (k0 + kf * 16 + fq * 4 + j) - qrow; rel = rel < -128 ? -128 : (rel > 128 ? 128 : rel);
                        const float bv_ = btab[rel + 128];
                        S[0][kf][j] = S[0][kf][j] * c1 + bv_; S[1][kf][j] = S[1][kf][j] * c1 + bv_;
                    }
            }
            bf16x8 Pf[2][2];
#pragma unroll
            for (int i = 0; i < 2; ++i) {
                float mx = S[i][0][0];
#pragma unroll
                for (int kf = 0; kf < 4; ++kf)
#pragma unroll
                    for (int j = 0; j < 4; ++j) mx = fmaxf(mx, S[i][kf][j]);
                mx = fmaxf(mx, __shfl_xor(mx, 16, 64)); mx = fmaxf(mx, __shfl_xor(mx, 32, 64));
                const float mnew = fmaxf(mrun[i], mx);
                const float alpha = __builtin_amdgcn_exp2f(mrun[i] - mnew);
                mrun[i] = mnew;
                float ps = 0.f;
#pragma unroll
                for (int kf = 0; kf < 4; ++kf)
#pragma unroll
                    for (int j = 0; j < 4; ++j) { const float e = __builtin_amdgcn_exp2f(S[i][kf][j] - mnew); S[i][kf][j] = e; ps += e; }
                ps += __shfl_xor(ps, 16, 64); ps += __shfl_xor(ps, 32, 64);
                lrun[i] = lrun[i] * alpha + ps;
                if (__any(alpha != 1.0f)) {
#pragma unroll
                    for (int f = 0; f < 8; ++f) { O[i][f][0] *= alpha; O[i][f][1] *= alpha; O[i][f][2] *= alpha; O[i][f][3] *= alpha; }
                }
#pragma unroll
                for (int g = 0; g < 2; ++g) {
                    i32x4 w;
                    w[0] = (int)cvt_pk_bf16(S[i][2 * g][0], S[i][2 * g][1]); w[1] = (int)cvt_pk_bf16(S[i][2 * g][2], S[i][2 * g][3]);
                    w[2] = (int)cvt_pk_bf16(S[i][2 * g + 1][0], S[i][2 * g + 1][1]); w[3] = (int)cvt_pk_bf16(S[i][2 * g + 1][2], S[i][2 * g + 1][3]);
                    Pf[i][g] = __builtin_bit_cast(bf16x8, w);
                }
            }
#pragma unroll
            for (int f = 0; f < 8; ++f)
#pragma unroll
                for (int g = 0; g < 2; ++g) {
                    const int dv = f * 16 + fr, x = dv & 15;
                    const uint2 v0 = *(const uint2*)(sV + dv * 128 + (((8 * g + fq) ^ x) * 8));
                    const uint2 v1 = *(const uint2*)(sV + dv * 128 + (((8 * g + 4 + fq) ^ x) * 8));
                    const i32x4 w = (i32x4){(int)v0.x, (int)v0.y, (int)v1.x, (int)v1.y};
                    const bf16x8 vA = __builtin_bit_cast(bf16x8, w);
                    O[0][f] = __builtin_amdgcn_mfma_f32_16x16x32_bf16(vA, Pf[0][g], O[0][f], 0, 0, 0);
                    O[1][f] = __builtin_amdgcn_mfma_f32_16x16x32_bf16(vA, Pf[1][g], O[1][f], 0, 0, 0);
                }
            __syncthreads();
        }
#undef A_ISSUE
#undef A_WRITE
        const float r0 = 1.0f / lrun[0], r1 = lam / lrun[1];
        float ss = 0.f;
#pragma unroll
        for (int f = 0; f < 8; ++f)
#pragma unroll
            for (int j = 0; j < 4; ++j) { const float o = O[0][f][j] * r0 - O[1][f][j] * r1; O[0][f][j] = o; ss += o * o; }
        ss += __shfl_xor(ss, 16, 64); ss += __shfl_xor(ss, 32, 64);
        const float rs = rsqrtf(ss * (1.0f / 128.0f) + 1e-5f) * (1.0f - p.lam_init);
        bf16_t* op = p.br + (size_t)(b * SEQ_ + qrow) * DM_ + 1024 + h * 128 + fq * 4;
        f32x4 gv[8];
#pragma unroll
        for (int f = 0; f < 8; ++f) gv[f] = *(const f32x4*)(p.subg + f * 16 + fq * 4);
#pragma unroll
        for (int f = 0; f < 8; ++f) {
            uint2 o; o.x = cvt_pk_bf16(O[0][f][0] * rs * gv[f][0], O[0][f][1] * rs * gv[f][1]); o.y = cvt_pk_bf16(O[0][f][2] * rs * gv[f][2], O[0][f][3] * rs * gv[f][3]);
            *(uint2*)(op + f * 16) = o;
        }
    }
}

#define HY_PPW 2112
#define HY_PADL 1040
#define HY_VLEN 4112
#define HY_LDS (HY_PPW * 4 + 4 * HY_VLEN * 2)
struct HP { const bf16_t* proj; const float* fr; const float* nrm; unsigned* pp; bf16_t* vvt; float* yt; const float* cw; const float* cb; const float* hbias; bf16_t* br; };

__device__ __forceinline__ void phase_hy_pp(const HP& p) {
    for (int idx = bid_opaque() * 512 + tid_opaque(); idx < 512 * HY_PPW; idx += grid_n() * 512) {
        const int c = idx / HY_PPW, u = idx - c * HY_PPW;
        const float inv = 1.0f / p.nrm[c];
        const int s0 = 2080 - u, s1 = 2080 - (u + 1);
        const float f0 = (s0 >= 0 && s0 < SEQ_) ? p.fr[(size_t)s0 * 512 + c] * inv : 0.f;
        const float f1 = (s1 >= 0 && s1 < SEQ_) ? p.fr[(size_t)s1 * 512 + c] * inv : 0.f;
        p.pp[idx] = cvt_pk_bf16(f0, f1);
    }
}
__device__ __forceinline__ void unpack8(const uint4 v, float (&f)[8]) {
    f[0] = __uint_as_float(v.x << 16); f[1] = __uint_as_float(v.x & 0xffff0000u); f[2] = __uint_as_float(v.y << 16); f[3] = __uint_as_float(v.y & 0xffff0000u);
    f[4] = __uint_as_float(v.z << 16); f[5] = __uint_as_float(v.z & 0xffff0000u); f[6] = __uint_as_float(v.w << 16); f[7] = __uint_as_float(v.w & 0xffff0000u);
}
__device__ __forceinline__ void phase_hy_prep(char* shm, const HP& p) {
    bf16_t* tile = (bf16_t*)shm;
    for (int unit = bid_opaque(); unit < NB_ * 32 * 8; unit += grid_n()) {
        const int ct = unit & 7, tt = (unit >> 3) & 31, b = unit >> 8;
        const int tid = tid_opaque(), tl = tid >> 3, c8 = (tid & 7) * 8, c = ct * 64 + c8, t = tt * 64 + tl;
        float s1[8], s2[8];
#pragma unroll
        for (int e = 0; e < 8; ++e) { s1[e] = p.cb[512 + c + e]; s2[e] = p.cb[1024 + c + e]; }
        uint4 r1[3], r2[3];
#pragma unroll
        for (int k = 0; k < 3; ++k) { const int t2 = t + k - 1, t2c = t2 < 0 ? 0 : (t2 >= SEQ_ ? SEQ_ - 1 : t2);
            const bf16_t* pr = p.proj + (size_t)(b * SEQ_ + t2c) * PROJW + O_HY + c; r1[k] = *(const uint4*)(pr + 512); r2[k] = *(const uint4*)(pr + 1024);
            const unsigned mk = t2 == t2c ? 0xffffffffu : 0u; r1[k].x &= mk; r1[k].y &= mk; r1[k].z &= mk; r1[k].w &= mk; r2[k].x &= mk; r2[k].y &= mk; r2[k].z &= mk; r2[k].w &= mk; }
        f32x4 wq[3][4];
#pragma unroll
        for (int k = 0; k < 3; ++k) { wq[k][0] = *(const f32x4*)(p.cw + k * 1536 + 512 + c); wq[k][1] = *(const f32x4*)(p.cw + k * 1536 + 512 + c + 4);
            wq[k][2] = *(const f32x4*)(p.cw + k * 1536 + 1024 + c); wq[k][3] = *(const f32x4*)(p.cw + k * 1536 + 1024 + c + 4); }
        __builtin_amdgcn_sched_barrier(0);
#pragma unroll
        for (int k = 0; k < 3; ++k) {
            float x1[8], xv[8]; unpack8(r1[k], x1); unpack8(r2[k], xv);
            const f32x4 wa = wq[k][0], wb = wq[k][1], va = wq[k][2], vb = wq[k][3];
#pragma unroll
            for (int e = 0; e < 4; ++e) { s1[e] += wa[e] * x1[e]; s1[e + 4] += wb[e] * x1[e + 4]; s2[e] += va[e] * xv[e]; s2[e + 4] += vb[e] * xv[e + 4]; }
        }
        __syncthreads();
#pragma unroll
        for (int e = 0; e < 8; ++e) tile[(c8 + e) * 72 + tl] = f2bf(s1[e] * s2[e]);
        __syncthreads();
        { const int cl = tid >> 3, t8 = (tid & 7) * 8;
          *(uint4*)(p.vvt + ((size_t)(ct * 64 + cl) * NB_ + b) * SEQ_ + tt * 64 + t8) = *(const uint4*)(tile + cl * 72 + t8); }
    }
}
__device__ __forceinline__ void phase_hy_conv(char* shm, const HP& p) {
    unsigned* pps = (unsigned*)shm;
    bf16_t* vs = (bf16_t*)(shm + HY_PPW * 4);
    for (int c = bid_opaque(); c < 512; c += grid_n()) {
        const int tid = tid_opaque(), wid = tid >> 6, lane = tid & 63, fr = lane & 15, h = lane >> 4;
        __syncthreads();
        for (int i = tid; i < HY_PPW; i += 512) pps[i] = p.pp[(size_t)c * HY_PPW + i];
        for (int i = tid; i < 4 * (HY_VLEN / 8); i += 512) {
            const int b = i / (HY_VLEN / 8), ch = i - b * (HY_VLEN / 8), e0 = ch * 8 - HY_PADL;
            const int e0c = e0 < 0 ? 0 : (e0 >= SEQ_ ? SEQ_ - 8 : e0);
            uint4 v = *(const uint4*)(p.vvt + ((size_t)c * NB_ + b) * SEQ_ + e0c);
            if (e0 != e0c) v = make_uint4(0u, 0u, 0u, 0u);
            *(uint4*)(vs + b * HY_VLEN + ch * 8) = v;
        }
        __syncthreads();
        const int b = wid >> 1, ib = (wid & 1) * 64;
        f32x4 acc[4];
#pragma unroll
        for (int f = 0; f < 4; ++f) acc[f] = (f32x4){0.f, 0.f, 0.f, 0.f};
        const int ua = 1056 - 16 * (h >> 1) - fr + 8 * (h & 1);
        const bf16_t* vb = vs + b * HY_VLEN + HY_PADL + 16 * (ib + fr - (h >> 1)) + 8 * (h & 1);
#define HY_LOAD(d0_, af_, bf_) do { const unsigned* ap_ = pps + (ua - 16 * (d0_)); const i32x4 aw_ = (i32x4){(int)ap_[0], (int)ap_[2], (int)ap_[4], (int)ap_[6]}; af_ = __builtin_bit_cast(bf16x8, aw_); \
        _Pragma("unroll") for (int f = 0; f < 4; ++f) bf_[f] = *(const bf16x8*)(vb + 16 * (16 * f - (d0_))); } while (0)
        bf16x8 afA, afB, bfA[4], bfB[4];
        HY_LOAD(-64, afA, bfA);
        for (int d0 = -64; d0 < 64; d0 += 4) {
            HY_LOAD(d0 + 2, afB, bfB);
            __builtin_amdgcn_sched_barrier(0);
#pragma unroll
            for (int f = 0; f < 4; ++f) acc[f] = __builtin_amdgcn_mfma_f32_16x16x32_bf16(afA, bfA[f], acc[f], 0, 0, 0);
            __builtin_amdgcn_sched_barrier(0);
            HY_LOAD(d0 + 4, afA, bfA);
            __builtin_amdgcn_sched_barrier(0);
#pragma unroll
            for (int f = 0; f < 4; ++f) acc[f] = __builtin_amdgcn_mfma_f32_16x16x32_bf16(afB, bfB[f], acc[f], 0, 0, 0);
            __builtin_amdgcn_sched_barrier(0);
        }
#pragma unroll
        for (int f = 0; f < 4; ++f) acc[f] = __builtin_amdgcn_mfma_f32_16x16x32_bf16(afA, bfA[f], acc[f], 0, 0, 0);
#undef HY_LOAD
        const float hb = p.hbias[c];
#pragma unroll
        for (int f = 0; f < 4; ++f) {
            const int t = 16 * (ib + 16 * f + fr) + 4 * h;
            const bf16_t* vv = vs + b * HY_VLEN + HY_PADL + t;
            f32x4 o; o[0] = acc[f][0] + bf2f(vv[0]) * hb; o[1] = acc[f][1] + bf2f(vv[1]) * hb; o[2] = acc[f][2] + bf2f(vv[2]) * hb; o[3] = acc[f][3] + bf2f(vv[3]) * hb;
            *(f32x4*)(p.yt + ((size_t)c * NB_ + b) * SEQ_ + t) = o;
        }
    }
}
__device__ __forceinline__ void phase_hy_fin(char* shm, const HP& p, int bw0, int bwn) {
    float* tile = (float*)shm;
    const int bq = bid_opaque() - bw0; if (bq < 0 || bq >= bwn) return;
    for (int unit = bq; unit < NB_ * 32 * 8; unit += bwn) {
        const int ct = unit & 7, tt = (unit >> 3) & 31, b = unit >> 8, tid = tid_opaque();
        __syncthreads();
        { const int cl = tid >> 3, t8 = (tid & 7) * 8; const float* src = p.yt + ((size_t)(ct * 64 + cl) * NB_ + b) * SEQ_ + tt * 64 + t8;
          const f32x4 a = *(const f32x4*)src, bq = *(const f32x4*)(src + 4);
#pragma unroll
          for (int q = 0; q < 4; ++q) { tile[cl * 65 + t8 + q] = a[q]; tile[cl * 65 + t8 + 4 + q] = bq[q]; } }
        __syncthreads();
        const int cl = tid & 63, c = ct * 64 + cl, tq = tid >> 6;
        float w0[3];
#pragma unroll
        for (int k = 0; k < 3; ++k) w0[k] = p.cw[k * 1536 + c];
        const float b0 = p.cb[c];
        float xr[10];
#pragma unroll
        for (int r = 0; r < 10; ++r) { const int t2 = tt * 64 + tq * 8 + r - 1, t2c = t2 < 0 ? 0 : (t2 >= SEQ_ ? SEQ_ - 1 : t2);
            xr[r] = __uint_as_float((unsigned)p.proj[(size_t)(b * SEQ_ + t2c) * PROJW + O_HY + c]); }
        __builtin_amdgcn_sched_barrier(0);
#pragma unroll
        for (int r = 0; r < 10; ++r) { const int t2 = tt * 64 + tq * 8 + r - 1; xr[r] = (t2 >= 0 && t2 < SEQ_) ? __uint_as_float(__float_as_uint(xr[r]) << 16) : 0.f; }
#pragma unroll
        for (int q = 0; q < 8; ++q) {
            const int tl = tq * 8 + q, t = tt * 64 + tl;
            float s = b0;
#pragma unroll
            for (int k = 0; k < 3; ++k) s += w0[k] * xr[q + k];
            p.br[(size_t)(b * SEQ_ + t) * DM_ + c] = f2bf(tile[cl * 65 + tl] * s);
        }
    }
}
struct LP { const bf16_t* proj; const float* cw; const float* cb; const bf16_t* wt; const float* ba; const float* bx; const float* lam; float* sumP; float* sumE; bf16_t* br; };
#define LRU_LDS (32768 + 8192 + 64 * 65 * 4 + 2 * 64 * 65 * 4 + 2 * 2 * 16 * 64 * 4)
template <int PASS>
__device__ __forceinline__ void phase_lru(char* shm, const LP& p) {
    char* sW = shm;
    char* sXb = shm + 32768;
    float* X = (float*)(shm + 40960);
    float* H = X + 64 * 65;
    float* SP = H + 2 * 64 * 65;
    float* SE = SP + 2 * 16 * 64;
    for (int unit = bid_opaque(); unit < NB_ * 8 * 32; unit += grid_n()) {
        const int k = unit & 31, b = (unit >> 5) & 3, h = unit >> 7;
        const int tid = tid_opaque();
        const int wid = tid >> 6, lane = tid & 63, fr = lane & 15, fq = lane >> 4, dir = wid & 1, jf = wid >> 1, j = jf * 16 + fr, ch = h * 64 + j;
        const size_t sbase = ((size_t)(dir * NB_ + b) * 32) * 512 + ch;
        const float bav = p.ba[dir * 512 + ch], bxv = p.bx[dir * 512 + ch], lamv = p.lam[dir * 512 + ch];
        float cP8[8], cE8[8];
        if (PASS == 1) {
#pragma unroll
            for (int i = 0; i < 8; ++i) { cP8[i] = p.sumP[sbase + (size_t)(fq * 8 + i) * 512]; cE8[i] = p.sumE[sbase + (size_t)(fq * 8 + i) * 512]; }
        }
        __syncthreads();
        for (int i = tid; i < 256 * 8; i += 512) { const int row = i >> 3, ch = i & 7;
            *(uint4*)(sW + lds_rc(row, ch)) = *(const uint4*)(p.wt + ((size_t)h * 256 + row) * 64 + ch * 8); }
        { const int j = tid & 63, tq = tid >> 6, ch = h * 64 + j;
          float w4[4];
#pragma unroll
          for (int q = 0; q < 4; ++q) w4[q] = p.cw[q * 512 + ch];
          const float cbv = p.cb[ch];
          float xr[11];
#pragma unroll
          for (int r = 0; r < 11; ++r) { const int t2 = k * 64 + tq * 8 + r - 2, t2c = t2 < 0 ? 0 : (t2 >= SEQ_ ? SEQ_ - 1 : t2);
              xr[r] = __uint_as_float((unsigned)p.proj[(size_t)(b * SEQ_ + t2c) * PROJW + O_LRU + ch]); }
          __builtin_amdgcn_sched_barrier(0);
#pragma unroll
          for (int r = 0; r < 11; ++r) { const int t2 = k * 64 + tq * 8 + r - 2; xr[r] = (t2 >= 0 && t2 < SEQ_) ? __uint_as_float(__float_as_uint(xr[r]) << 16) : 0.f; }
#pragma unroll
          for (int q = 0; q < 8; ++q) {
              const int tl = tq * 8 + q; float s = cbv;
#pragma unroll
              for (int kk = 0; kk < 4; ++kk) s += w4[kk] * xr[q + kk];
              X[tl * 65 + j] = s;
              *(bf16_t*)(sXb + lds_rc(tl, j >> 3) + (j & 7) * 2) = f2bf(s);
          } }
        __syncthreads();
        f32x4 G[4][2];
        {
#pragma unroll
          for (int tf = 0; tf < 4; ++tf) { G[tf][0] = (f32x4){bav, bav, bav, bav}; G[tf][1] = (f32x4){bxv, bxv, bxv, bxv}; } }
#pragma unroll
        for (int ks = 0; ks < 2; ++ks) {
            const bf16x8 wA = *(const bf16x8*)(sW + lds_rc((dir * 2 + 0) * 64 + j, ks * 4 + fq));
            const bf16x8 wX = *(const bf16x8*)(sW + lds_rc((dir * 2 + 1) * 64 + j, ks * 4 + fq));
#pragma unroll
            for (int tf = 0; tf < 4; ++tf) {
                const bf16x8 xa = *(const bf16x8*)(sXb + lds_rc(tf * 16 + fr, ks * 4 + fq));
                G[tf][0] = __builtin_amdgcn_mfma_f32_16x16x32_bf16(xa, wA, G[tf][0], 0, 0, 0);
                G[tf][1] = __builtin_amdgcn_mfma_f32_16x16x32_bf16(xa, wX, G[tf][1], 0, 0, 0);
            }
        }
        const float spl = softplus_fast_(-lamv);
        const int tfirst = dir ? (SEQ_ - 1) : 0;
#pragma unroll
        for (int tf = 0; tf < 4; ++tf) {
            float P = 1.f, E = 0.f;
#pragma unroll
            for (int qq = 0; qq < 4; ++qq) {
                const int q = dir ? 3 - qq : qq, tl = tf * 16 + fq * 4 + q, t = k * 64 + tl;
                const float r = sigmoid_fast_(G[tf][0][q]), ig = sigmoid_fast_(G[tf][1][q]);
                const float log_a = -8.0f * r * spl;
                const float x2 = 2.0f * log_a;
                const float om = x2 > -0.02f ? -x2 * (1.0f + x2 * (0.5f + x2 * (1.0f / 6.0f))) : 1.0f - __expf(x2);
                float mult = __builtin_amdgcn_sqrtf(om); if (t == tfirst) mult = 1.0f;
                const float av = __expf(log_a), bv = mult * ig * X[tl * 65 + j];
                G[tf][0][q] = av; G[tf][1][q] = bv;
                E = av * E + bv; P *= av;
            }
            SP[(dir * 16 + tf * 4 + fq) * 64 + j] = P; SE[(dir * 16 + tf * 4 + fq) * 64 + j] = E;
        }
        __syncthreads();
        if (PASS == 0) {
            if (fq == 0) {
                float cP = 1.f, cE = 0.f;
                if (dir == 0) { for (int s = 0; s < 16; ++s) { cE = SP[s * 64 + j] * cE + SE[s * 64 + j]; cP *= SP[s * 64 + j]; } }
                else { for (int s = 15; s >= 0; --s) { cE = SP[(16 + s) * 64 + j] * cE + SE[(16 + s) * 64 + j]; cP *= SP[(16 + s) * 64 + j]; } }
                p.sumP[sbase + (size_t)k * 512] = cP; p.sumE[sbase + (size_t)k * 512] = cE;
            }
        } else {
            float Pl = 1.f, El = 0.f;
            if (dir == 0) {
#pragma unroll
                for (int i = 0; i < 8; ++i) { const bool ok = fq * 8 + i < k; const float Pq = ok ? cP8[i] : 1.f, Eq = ok ? cE8[i] : 0.f; El = Pq * El + Eq; Pl *= Pq; }
            } else {
#pragma unroll
                for (int i = 7; i >= 0; --i) { const bool ok = fq * 8 + i > k; const float Pq = ok ? cP8[i] : 1.f, Eq = ok ? cE8[i] : 0.f; El = Pq * El + Eq; Pl *= Pq; }
            }
            float c = 0.f;
            if (dir == 0) {
#pragma unroll
                for (int f = 0; f < 4; ++f) { const float Pf = __shfl(Pl, f * 16 + fr, 64), Ef = __shfl(El, f * 16 + fr, 64); c = Pf * c + Ef; }
            } else {
#pragma unroll
                for (int f = 3; f >= 0; --f) { const float Pf = __shfl(Pl, f * 16 + fr, 64), Ef = __shfl(El, f * 16 + fr, 64); c = Pf * c + Ef; }
            }
            float cin[4];
            if (dir == 0) {
#pragma unroll
                for (int s = 0; s < 16; ++s) { if ((s & 3) == fq) cin[s >> 2] = c; c = SP[s * 64 + j] * c + SE[s * 64 + j]; }
            } else {
#pragma unroll
                for (int s = 15; s >= 0; --s) { if ((s & 3) == fq) cin[s >> 2] = c; c = SP[(16 + s) * 64 + j] * c + SE[(16 + s) * 64 + j]; }
            }
            float* Hd = H + dir * 64 * 65;
#pragma unroll
            for (int tf = 0; tf < 4; ++tf) {
                float cc = cin[tf];
#pragma unroll
                for (int qq = 0; qq < 4; ++qq) { const int q = dir ? 3 - qq : qq; cc = G[tf][0][q] * cc + G[tf][1][q]; Hd[(tf * 16 + fq * 4 + q) * 65 + j] = cc; }
            }
            __syncthreads();
            const int j2 = tid & 63, tq = tid >> 6, ch2 = h * 64 + j2;
            bf16_t gq[8];
#pragma unroll
            for (int q = 0; q < 8; ++q) gq[q] = p.proj[(size_t)(b * SEQ_ + k * 64 + tq * 8 + q) * PROJW + O_LRU + 512 + ch2];
            __builtin_amdgcn_sched_barrier(0);
#pragma unroll
            for (int q = 0; q < 8; ++q) {
                const int tl = tq * 8 + q; const size_t tok = (size_t)(b * SEQ_ + k * 64 + tl);
                const float g = bf2f(gq[q]);
                p.br[tok * DM_ + 512 + ch2] = f2bf((H[tl * 65 + j2] + H[64 * 65 + tl * 65 + j2]) * gelu_tanh_(g));
            }
        }
    }
}
struct SP_ { const bf16_t* proj; const float* dtraw; const float* cw; const float* cb; const float* dtb; const float* a_log; const float* dsk; const float* ng;
             bf16_t* xa; bf16_t* xT; float* states; float* decay; bf16_t* prev; bf16_t* br; };
#define SSD_Q 128
#define SSD_NC 16

__device__ __forceinline__ void phase_ssd_prep(char* shm, const SP_& p) {
    bf16_t* tile = (bf16_t*)shm;
    for (int unit = bid_opaque(); unit < NB_ * 32 * 16; unit += grid_n()) {
        const int ct = unit & 15, tt = (unit >> 4) & 31, b = unit >> 9;
        const int tid = tid_opaque(), tl = tid >> 3, c8 = (tid & 7) * 8, c = ct * 64 + c8, t = tt * 64 + tl;
        float s[8];
#pragma unroll
        for (int e = 0; e < 8; ++e) s[e] = p.cb[c + e];
        uint4 rr[4];
#pragma unroll
        for (int k = 0; k < 4; ++k) { const int t2 = t + k - 2, t2c = t2 < 0 ? 0 : (t2 >= SEQ_ ? SEQ_ - 1 : t2);
            rr[k] = *(const uint4*)(p.proj + (size_t)(b * SEQ_ + t2c) * PROJW + O_SSD + 512 + c); const unsigned mk = t2 == t2c ? 0xffffffffu : 0u; rr[k].x &= mk; rr[k].y &= mk; rr[k].z &= mk; rr[k].w &= mk; }
        f32x4 wq[4][2];
#pragma unroll
        for (int k = 0; k < 4; ++k) { wq[k][0] = *(const f32x4*)(p.cw + k * 1024 + c); wq[k][1] = *(const f32x4*)(p.cw + k * 1024 + c + 4); }
        __builtin_amdgcn_sched_barrier(0);
#pragma unroll
        for (int k = 0; k < 4; ++k) {
            float x[8]; unpack8(rr[k], x);
            const f32x4 wa = wq[k][0], wb = wq[k][1];
#pragma unroll
            for (int e = 0; e < 4; ++e) { s[e] += wa[e] * x[e]; s[e + 4] += wb[e] * x[e + 4]; }
        }
        uint4 o; o.x = cvt_pk_bf16(silu_fast_(s[0]), silu_fast_(s[1])); o.y = cvt_pk_bf16(silu_fast_(s[2]), silu_fast_(s[3]));
        o.z = cvt_pk_bf16(silu_fast_(s[4]), silu_fast_(s[5])); o.w = cvt_pk_bf16(silu_fast_(s[6]), silu_fast_(s[7]));
        *(uint4*)(p.xa + (size_t)(b * SEQ_ + t) * 1024 + c) = o;
        __syncthreads();
        tile[(c8 + 0) * 72 + tl] = (bf16_t)(o.x & 0xffffu); tile[(c8 + 1) * 72 + tl] = (bf16_t)(o.x >> 16); tile[(c8 + 2) * 72 + tl] = (bf16_t)(o.y & 0xffffu); tile[(c8 + 3) * 72 + tl] = (bf16_t)(o.y >> 16);
        tile[(c8 + 4) * 72 + tl] = (bf16_t)(o.z & 0xffffu); tile[(c8 + 5) * 72 + tl] = (bf16_t)(o.z >> 16); tile[(c8 + 6) * 72 + tl] = (bf16_t)(o.w & 0xffffu); tile[(c8 + 7) * 72 + tl] = (bf16_t)(o.w >> 16);
        __syncthreads();
        { const int c2 = tid >> 3, t8 = (tid & 7) * 8;
          *(uint4*)(p.xT + ((size_t)b * 1024 + ct * 64 + c2) * SEQ_ + tt * 64 + t8) = *(const uint4*)(tile + c2 * 72 + t8); }
    }
}
__device__ __forceinline__ void ssd_tables(float* dtv, float* cum, const SP_& p, int b, int c, int g) {
    const int tid = tid_opaque();
    for (int i = tid; i < 8 * SSD_Q; i += 512) {
        const int l = i & 127, hd = i >> 7, dir = hd >> 2, j = hd & 3, h = g * 4 + j;
        dtv[i] = softplus_fast_(p.dtraw[(size_t)(b * SEQ_ + c * SSD_Q + l) * 16 + dir * 8 + h] + p.dtb[dir * 8 + h]);
    }
    __syncthreads();
    const int t8 = tid_opaque();
    if (t8 < 8) {
        const int dir = t8 >> 2, j = t8 & 3, h = g * 4 + j; const float a = -__expf(p.a_log[dir * 8 + h]);
        float s = 0.f;
        if (dir == 0) for (int l = 0; l < SSD_Q; ++l) { s += dtv[t8 * 128 + l] * a; cum[t8 * 128 + l] = s; }
        else for (int l = SSD_Q - 1; l >= 0; --l) { s += dtv[t8 * 128 + l] * a; cum[t8 * 128 + l] = s; }
    }
    __syncthreads();
}
#define SSD1_LDS (65536 + 32768 + 8192)
__device__ __forceinline__ void phase_ssd_states(char* shm, const SP_& p) {
    char* sX = shm;
    char* sB = shm + 65536;
    float* dtv = (float*)(shm + 98304); float* cum = dtv + 1024;
    for (int unit = bid_opaque(); unit < NB_ * SSD_NC * 2 * 2; unit += grid_n()) {
        const int hp = unit & 1, g = (unit >> 1) & 1, c = (unit >> 2) & 15, b = unit >> 6;
        const int tid = tid_opaque(), wid = tid >> 6, lane = tid & 63, fr = lane & 15, fq = lane >> 4;
        __syncthreads();
        for (int i = tid; i < 128 * 16; i += 512) { const int row = i >> 4, ch = i & 15;
            *(uint4*)(sX + row * 256 + ((ch ^ (row & 15)) * 16)) = *(const uint4*)(p.xT + ((size_t)b * 1024 + g * 256 + hp * 128 + row) * SEQ_ + c * SSD_Q + ch * 8); }
        for (int i = tid; i < 128 * 16; i += 512) { const int row = i >> 4, ch = i & 15;
            *(uint4*)(sB + row * 256 + ((ch ^ (row & 15)) * 16)) = *(const uint4*)(p.xT + ((size_t)b * 1024 + 512 + g * 128 + row) * SEQ_ + c * SSD_Q + ch * 8); }
        ssd_tables(dtv, cum, p, b, c, g);
        const int jj = wid >> 2, dir = (wid >> 1) & 1, nh = wid & 1, j = hp * 2 + jj, hd = dir * 4 + j, h = g * 4 + j;
        const float* dth = dtv + hd * 128; const float* cm = cum + hd * 128;
        const float cend = dir ? cm[0] : cm[SSD_Q - 1];
        f32x4 acc[4][4];
#pragma unroll
        for (int pf = 0; pf < 4; ++pf)
#pragma unroll
            for (int nf = 0; nf < 4; ++nf) acc[pf][nf] = (f32x4){0.f, 0.f, 0.f, 0.f};
#pragma unroll 1
        for (int ks = 0; ks < 4; ++ks) {
            float sc[8];
#pragma unroll
            for (int e = 0; e < 8; ++e) { const int l = ks * 32 + fq * 8 + e; sc[e] = dth[l] * __expf(cend - cm[l]); }
            bf16x8 af[4];
#pragma unroll
            for (int pf = 0; pf < 4; ++pf) {
                const int row = jj * 64 + pf * 16 + fr, ch = ks * 4 + fq;
                const i32x4 raw = *(const i32x4*)(sX + row * 256 + ((ch ^ (row & 15)) * 16));
                i32x4 o;
#pragma unroll
                for (int q = 0; q < 4; ++q) { const unsigned u = (unsigned)raw[q]; o[q] = (int)cvt_pk_bf16(__uint_as_float(u << 16) * sc[2 * q], __uint_as_float(u & 0xffff0000u) * sc[2 * q + 1]); }
                af[pf] = __builtin_bit_cast(bf16x8, o);
            }
#pragma unroll
            for (int nf = 0; nf < 4; ++nf) {
                const int row = nh * 64 + nf * 16 + fr, ch = ks * 4 + fq;
                const bf16x8 bfr = *(const bf16x8*)(sB + row * 256 + ((ch ^ (row & 15)) * 16));
#pragma unroll
                for (int pf = 0; pf < 4; ++pf) acc[pf][nf] = __builtin_amdgcn_mfma_f32_16x16x32_bf16(bfr, af[pf], acc[pf][nf], 0, 0, 0);
            }
        }
        float* st = p.states + ((((size_t)(b * SSD_NC + c) * 8 + h) * 2 + dir) * 64) * 128;
        float* rp = st + (size_t)fr * 128 + nh * 64 + fq * 4;
#pragma unroll
        for (int pf = 0; pf < 4; ++pf)
#pragma unroll
            for (int nf = 0; nf < 4; ++nf) *(f32x4*)(rp + pf * 16 * 128 + nf * 16) = acc[pf][nf];
        if (lane == 0 && nh == 0) p.decay[((b * SSD_NC + c) * 8 + h) * 2 + dir] = __expf(cend);
    }
}
__device__ __forceinline__ void phase_ssd_scan(const SP_& p) {
    for (int idx = bid_opaque() * 512 + tid_opaque(); idx < NB_ * 8 * 2 * 64 * 32; idx += grid_n() * 512) {
        const int n4 = idx & 31, pp = (idx >> 5) & 63, dir = (idx >> 11) & 1, h = (idx >> 12) & 7, b = idx >> 15;
        f32x4 s = (f32x4){0.f, 0.f, 0.f, 0.f};
#pragma unroll 1
        for (int half = 0; half < 2; ++half) {
            f32x4 st[8]; float dc[8];
#pragma unroll
            for (int q = 0; q < 8; ++q) {
                const int cc = half * 8 + q, c = dir ? (SSD_NC - 1 - cc) : cc;
                st[q] = *(const f32x4*)(p.states + ((((size_t)(b * SSD_NC + c) * 8 + h) * 2 + dir) * 64 + pp) * 128 + n4 * 4);
                dc[q] = p.decay[((b * SSD_NC + c) * 8 + h) * 2 + dir];
            }
#pragma unroll
            for (int q = 0; q < 8; ++q) {
                const int cc = half * 8 + q, c = dir ? (SSD_NC - 1 - cc) : cc;
                const size_t o = ((((size_t)(b * SSD_NC + c) * 8 + h) * 2 + dir) * 64 + pp) * 128 + n4 * 4;
                uint2 w; w.x = cvt_pk_bf16(s[0], s[1]); w.y = cvt_pk_bf16(s[2], s[3]);
                *(uint2*)(p.prev + o) = w;
                s = s * dc[q] + st[q];
            }
        }
    }
}
#define SSD3_LDS (32768 + 65536 + 32768 + 8192 + 512)
__device__ __forceinline__ void phase_ssd_out(char* shm, const SP_& p) {
    char* sB = shm;
    char* sX = shm + 32768;
    char* sC = shm + 98304;
    float* dtv = (float*)(shm + 131072); float* cum = dtv + 1024; float* ssx = cum + 1024;
    for (int unit = bid_opaque(); unit < NB_ * SSD_NC * 2 * 2; unit += grid_n()) {
        const int half_ = unit & 1, g = (unit >> 1) & 1, c = (unit >> 2) & 15, b = unit >> 6;
        const int tid = tid_opaque(), wid = tid >> 6, lane = tid & 63, fr = lane & 15, fq = lane >> 4;
        __syncthreads();
        for (int i = tid; i < 128 * 16; i += 512) { const int row = i >> 4, ch = i & 15; const bf16_t* src_ = p.xa + (size_t)(b * SEQ_ + c * SSD_Q + row) * 1024 + 512 + g * 128 + ch * 8;
            *(uint4*)(sB + row * 256 + ((ch ^ (row & 15)) * 16)) = *(const uint4*)src_;
            *(uint4*)(sC + row * 256 + ((ch ^ (row & 15)) * 16)) = *(const uint4*)(src_ + 256); }
        for (int i = tid; i < 256 * 16; i += 512) { const int row = i >> 4, ch = i & 15, x = row & 15;
            uint4 v = *(const uint4*)(p.xT + ((size_t)b * 1024 + g * 256 + row) * SEQ_ + c * SSD_Q + ch * 8);
            if (x & 1) v = make_uint4(v.z, v.w, v.x, v.y);
            *(uint4*)(sX + row * 256 + ((ch ^ (x >> 1)) * 16)) = v; }
        ssd_tables(dtv, cum, p, b, c, g);
        const int hp = wid >> 2, lrow = half_ * 64 + (wid & 3) * 16 + fr;
        const size_t tok = (size_t)(b * SEQ_ + c * SSD_Q + lrow);
#define SSD_CF(ks_) (*(const bf16x8*)(sC + lrow * 256 + ((((ks_) * 4 + fq) ^ (lrow & 15)) * 16)))
        f32x4 G[8];
#pragma unroll
        for (int sf = 0; sf < 8; ++sf) {
            f32x4 a = (f32x4){0.f, 0.f, 0.f, 0.f};
#pragma unroll
            for (int ks = 0; ks < 4; ++ks) {
                const int row = sf * 16 + fr, ch = ks * 4 + fq;
                const bf16x8 bfr = *(const bf16x8*)(sB + row * 256 + ((ch ^ (row & 15)) * 16));
                a = __builtin_amdgcn_mfma_f32_16x16x32_bf16(bfr, SSD_CF(ks), a, 0, 0, 0);
            }
            G[sf] = a;
        }
        f32x4 Y[2][4];
#pragma unroll
        for (int jj = 0; jj < 2; ++jj)
#pragma unroll
            for (int pf = 0; pf < 4; ++pf) Y[jj][pf] = (f32x4){0.f, 0.f, 0.f, 0.f};
#pragma unroll
        for (int jj = 0; jj < 2; ++jj) {
            const int j = hp * 2 + jj;
#pragma unroll 1
            for (int dir = 0; dir < 2; ++dir) {
                const int hd = dir * 4 + j, h = g * 4 + j;
                const float* dth = dtv + hd * 128; const float* cm = cum + hd * 128;
                const float cl = cm[lrow];
                const bf16_t* pv = p.prev + ((((size_t)(b * SSD_NC + c) * 8 + h) * 2 + dir) * 64) * 128;
                bf16x8 pa[4][4];
#pragma unroll
                for (int pf = 0; pf < 4; ++pf)
#pragma unroll
                    for (int ks = 0; ks < 4; ++ks) pa[pf][ks] = *(const bf16x8*)(pv + (size_t)(pf * 16 + fr) * 128 + ks * 32 + fq * 8);
#pragma unroll
                for (int g2 = 0; g2 < 4; ++g2) {
                    float e[8];
#pragma unroll
                    for (int half = 0; half < 2; ++half)
#pragma unroll
                        for (int q = 0; q < 4; ++q) {
                            const int sf = 2 * g2 + half, s = sf * 16 + fq * 4 + q;
                            const bool keep = dir ? (s >= lrow) : (s <= lrow);
                            const float v = G[sf][q] * __expf(keep ? (cl - cm[s]) : 0.f) * dth[s];
                            e[half * 4 + q] = keep ? v : 0.f;
                        }
                    i32x4 w; w[0] = (int)cvt_pk_bf16(e[0], e[1]); w[1] = (int)cvt_pk_bf16(e[2], e[3]); w[2] = (int)cvt_pk_bf16(e[4], e[5]); w[3] = (int)cvt_pk_bf16(e[6], e[7]);
                    const bf16x8 Pf = __builtin_bit_cast(bf16x8, w);
#pragma unroll
                    for (int pf = 0; pf < 4; ++pf) {
                        const int row = j * 64 + pf * 16 + fr, x = row & 15;
                        const uint2 v0 = *(const uint2*)(sX + row * 256 + (((8 * g2 + fq) ^ x) * 8));
                        const uint2 v1 = *(const uint2*)(sX + row * 256 + (((8 * g2 + 4 + fq) ^ x) * 8));
                        const i32x4 wv = (i32x4){(int)v0.x, (int)v0.y, (int)v1.x, (int)v1.y};
                        Y[jj][pf] = __builtin_amdgcn_mfma_f32_16x16x32_bf16(__builtin_bit_cast(bf16x8, wv), Pf, Y[jj][pf], 0, 0, 0);
                    }
                    __builtin_amdgcn_sched_barrier(0);
                }
                const float el = __expf(cl);
#pragma unroll
                for (int pf = 0; pf < 4; ++pf) {
                    f32x4 t = (f32x4){0.f, 0.f, 0.f, 0.f};
#pragma unroll
                    for (int ks = 0; ks < 4; ++ks) {
                        t = __builtin_amdgcn_mfma_f32_16x16x32_bf16(pa[pf][ks], SSD_CF(ks), t, 0, 0, 0);
                    }
                    Y[jj][pf] += t * el;
                    __builtin_amdgcn_sched_barrier(0);
                }
            }
        }
        const int te = tid_opaque(); const int fqe = (te & 63) >> 4, wde = te >> 6, hpe = wde >> 2; const size_t toke = (size_t)(b * SEQ_ + c * SSD_Q + half_ * 64 + (wde & 3) * 16 + (te & 15));
        float ss = 0.f;
        uint2 xva[2][4], zva[2][4]; f32x4 gva[2][4];
#pragma unroll
        for (int jj = 0; jj < 2; ++jj)
#pragma unroll
            for (int pf = 0; pf < 4; ++pf) { const int cch = g * 256 + (hpe * 2 + jj) * 64 + pf * 16 + fqe * 4;
                xva[jj][pf] = *(const uint2*)(p.xa + toke * 1024 + cch); zva[jj][pf] = *(const uint2*)(p.proj + toke * PROJW + O_SSD + cch); gva[jj][pf] = *(const f32x4*)(p.ng + cch); }
#pragma unroll
        for (int jj = 0; jj < 2; ++jj) {
            const float dk = p.dsk[g * 4 + hpe * 2 + jj];
#pragma unroll
            for (int pf = 0; pf < 4; ++pf) {
                const uint2 xv = xva[jj][pf];
                const uint2 zv = zva[jj][pf];
                const float xs[4] = {__uint_as_float(xv.x << 16), __uint_as_float(xv.x & 0xffff0000u), __uint_as_float(xv.y << 16), __uint_as_float(xv.y & 0xffff0000u)};
                const float zs[4] = {__uint_as_float(zv.x << 16), __uint_as_float(zv.x & 0xffff0000u), __uint_as_float(zv.y << 16), __uint_as_float(zv.y & 0xffff0000u)};
#pragma unroll
                for (int q = 0; q < 4; ++q) { const float y = (Y[jj][pf][q] + dk * xs[q]) * silu_fast_(zs[q]); Y[jj][pf][q] = y; ss += y * y; }
                __builtin_amdgcn_sched_barrier(0);
            }
        }
        ss += __shfl_xor(ss, 16, 64); ss += __shfl_xor(ss, 32, 64);
        if (fqe == 0) ssx[wde * 16 + (te & 15)] = ss;
        __syncthreads();
        ss += ssx[(wde ^ 4) * 16 + (te & 15)];
        const float rs = rsqrtf(ss * (1.0f / 256.0f) + 1e-6f);
#pragma unroll
        for (int jj = 0; jj < 2; ++jj)
#pragma unroll
            for (int pf = 0; pf < 4; ++pf) {
                const int cch = g * 256 + (hpe * 2 + jj) * 64 + pf * 16 + fqe * 4;
                const f32x4 gv = gva[jj][pf];
                uint2 o; o.x = cvt_pk_bf16(Y[jj][pf][0] * rs * gv[0], Y[jj][pf][1] * rs * gv[1]); o.y = cvt_pk_bf16(Y[jj][pf][2] * rs * gv[2], Y[jj][pf][3] * rs * gv[3]);
                *(uint2*)(p.br + toke * DM_ + 1536 + cch) = o;
                __builtin_amdgcn_sched_barrier(0);
            }
    }
}
struct GP {
    const bf16_t* A; const bf16_t* Bt; const float* B; const float* B2; const float* bias; const float* R; float* Cf; bf16_t* Cb; bf16_t* Cb2; bf16_t* Vt; const bf16_t* G;
    const int* idx; const float* gate;
};
#ifndef GS_ROWS
#define GS_ROWS 8
#endif
__device__ __forceinline__ void static_order(int L, int nM, int nN, int& pm, int& pn) {
    const int nwg = nM * nN; int wgid = L;
    { const int q = nwg / 8, r = nwg % 8, xcd = wgid % 8, off = wgid / 8; wgid = (xcd < r ? xcd * (q + 1) : r * (q + 1) + (xcd - r) * q) + off; }
    const int nig = GS_ROWS * nN, gid = wgid / nig, fm = gid * GS_ROWS, gsz = (nM - fm) < GS_ROWS ? (nM - fm) : GS_ROWS;
    pm = fm + ((wgid % nig) % gsz); pn = (wgid % nig) / gsz;
}
#define LANE_IDS(t_) const int wid = (t_) >> 6, lane = (t_) & 63, wr = wid >> 2, wc = wid & 3, fr = lane & 15, fq = lane >> 4; (void)wr; (void)wc; (void)fr; (void)fq;
#define ZERO_ACC(acc, FM_) _Pragma("unroll") for (int m = 0; m < FM_; ++m) _Pragma("unroll") for (int n = 0; n < 4; ++n) acc[m][n] = (f32x4){0.f, 0.f, 0.f, 0.f}

__device__ __forceinline__ void phase_inproj(char* shm, const GP& p) {
    typedef GemmCore<256, false> G;
    for (int L = bid_opaque(); L < 32 * 54; L += grid_n()) {
        int pm, pn; static_order(L, 32, 54, pm, pn);
        const int col0 = pn < 22 ? pn * 256 : O_GATE + (pn - 22) * 256;
        f32x4 acc[8][4]; ZERO_ACC(acc, 8);
        {
            const int t0 = tid_opaque();
            unsigned aoff[G::GLA], boff[4];
#pragma unroll
            for (int i = 0; i < G::GLA; ++i) { int R, C; G::a_coord(t0, i, R, C); aoff[i] = (unsigned)((R * DM_ + C) * 2); }
#pragma unroll
            for (int i = 0; i < 4; ++i) { int cc, C; G::bt_coord(t0, i, cc, C); boff[i] = (unsigned)((cc * DM_ + C) * 2); }
            const char* pf = t0 < 256 ? (const char*)(p.A + (size_t)(pm * 256 + t0) * DM_) : (const char*)(p.Bt + (size_t)(pn * 256 + t0 - 256) * DM_);
            G::run_bt(shm, (const char*)(p.A + (size_t)pm * 256 * DM_), aoff, (const char*)(p.Bt + (size_t)pn * 256 * DM_), boff, DM_ * 2, pf, DM_ / 64, acc);
        }
        const int t1 = tid_opaque(); LANE_IDS(t1)
        const int cl = wc * 64 + 4 * fr;
        if (pn == 14 || pn == 15) {
            const int t0_ = pm * 256 + wr * 128 + fq * 4, bb = t0_ >> 11, tl = t0_ & (SEQ_ - 1);
            bf16_t* vp = p.Vt + (size_t)(bb * 512 + (pn - 14) * 256 + cl) * SEQ_ + tl;
#pragma unroll
            for (int m = 0; m < 8; ++m)
#pragma unroll
                for (int n = 0; n < 4; ++n) {
                    uint2 o; o.x = cvt_pk_bf16(acc[m][n][0], acc[m][n][1]); o.y = cvt_pk_bf16(acc[m][n][2], acc[m][n][3]);
                    *(uint2*)(vp + (size_t)n * SEQ_ + m * 16) = o;
                }
        } else if (pn < 22) {
#pragma unroll
            for (int m = 0; m < 8; ++m)
#pragma unroll
                for (int j = 0; j < 4; ++j) {
                    const int row = pm * 256 + wr * 128 + m * 16 + fq * 4 + j;
                    uint2 o; o.x = cvt_pk_bf16(acc[m][0][j], acc[m][1][j]); o.y = cvt_pk_bf16(acc[m][2][j], acc[m][3][j]);
                    *(uint2*)(p.Cb + (size_t)row * PROJW + pn * 256 + cl) = o;
                }
        } else {
            const int gc = (pn - 22) * 256 + cl;
            const f32x4 bg = *(const f32x4*)(p.bias + gc);
#pragma unroll
            for (int m = 0; m < 8; ++m)
#pragma unroll
                for (int j = 0; j < 4; ++j) {
                    const int row = pm * 256 + wr * 128 + m * 16 + fq * 4 + j;
                    uint2 o; o.x = cvt_pk_bf16(sigmoid_fast_(acc[m][0][j] + bg[0]), sigmoid_fast_(acc[m][1][j] + bg[1])); o.y = cvt_pk_bf16(sigmoid_fast_(acc[m][2][j] + bg[2]), sigmoid_fast_(acc[m][3][j] + bg[3]));
                    *(uint2*)(p.Cb2 + (size_t)row * 8192 + gc) = o;
                }
        }
    }
}
__device__ __forceinline__ void phase_merge(char* shm, const GP& p) {
    typedef GemmCore<128, false> G;
    for (int L = bid_opaque(); L < 64 * 8; L += grid_n()) {
        int pm, pn; static_order(L, 64, 8, pm, pn);
        f32x4 mg[4][4]; ZERO_ACC(mg, 4);
        f32x4 acc[4][4]; ZERO_ACC(acc, 4);
        {
            const int t0 = tid_opaque();
            unsigned aoff[G::GLA], boff[4];
#pragma unroll
            for (int i = 0; i < G::GLA; ++i) { int R, C; G::a_coord(t0, i, R, C); aoff[i] = (unsigned)((R * DM_ + C) * 2); }
#pragma unroll
            for (int i = 0; i < 4; ++i) { int cc, C; G::bt_coord(t0, i, cc, C); boff[i] = (unsigned)((cc * 512 + C) * 2); }
            const bf16_t* gates = p.G;
            struct SegEpi {
                f32x4 (&acc)[4][4]; f32x4 (&mg)[4][4]; uint2 (&gq)[4][4]; const bf16_t* gates; int pm, pn;
                __device__ __forceinline__ void pre(int k) const {
                    const int t1 = tid_opaque(); LANE_IDS(t1)
                    const bf16_t* gp = gates + (size_t)(pm * 128 + wr * 64 + fq * 4) * 8192 + k * DM_ + pn * 256 + wc * 64 + 4 * fr;
#pragma unroll
                    for (int m = 0; m < 4; ++m)
#pragma unroll
                        for (int j = 0; j < 4; ++j) gq[m][j] = *(const uint2*)(gp + (size_t)(m * 16 + j) * 8192);
                    __builtin_amdgcn_sched_barrier(0);
                }
                __device__ __forceinline__ void operator()(int) const {
#pragma unroll
                    for (int m = 0; m < 4; ++m) {
#pragma unroll
                        for (int j = 0; j < 4; ++j) {
                            const uint2 gv = gq[m][j];
                            mg[m][0][j] += __uint_as_float(gv.x << 16) * acc[m][0][j]; mg[m][1][j] += __uint_as_float(gv.x & 0xffff0000u) * acc[m][1][j];
                            mg[m][2][j] += __uint_as_float(gv.y << 16) * acc[m][2][j]; mg[m][3][j] += __uint_as_float(gv.y & 0xffff0000u) * acc[m][3][j];
                        }
#pragma unroll
                        for (int n = 0; n < 4; ++n) acc[m][n] = (f32x4){0.f, 0.f, 0.f, 0.f};
                    }
                    __builtin_amdgcn_sched_barrier(0);
                }
            };
            uint2 gq[4][4];
            const SegEpi seg_epi{acc, mg, gq, gates, pm, pn};
            G::template run_bt_seg<8>(shm, (const char*)(p.A + (size_t)pm * 128 * DM_), aoff, (const char*)(p.Bt + (size_t)pn * 256 * 512), boff, 512 * 2, (size_t)DM_ * 512 * 2,
                                      (const char*)(p.A + (size_t)pm * 128 * DM_), 32, acc, seg_epi);
        }
        const int t2 = tid_opaque(); LANE_IDS(t2)
        bf16_t* op = p.Cb + (size_t)(pm * 128 + wr * 64 + fq * 4) * DM_ + pn * 256 + wc * 64 + 4 * fr;
#pragma unroll
        for (int m = 0; m < 4; ++m)
#pragma unroll
            for (int j = 0; j < 4; ++j) {
                uint2 o; o.x = cvt_pk_bf16(mg[m][0][j], mg[m][1][j]); o.y = cvt_pk_bf16(mg[m][2][j], mg[m][3][j]);
                *(uint2*)(op + (size_t)(m * 16 + j) * DM_) = o;
            }
    }
}
__device__ __forceinline__ void phase_outproj(char* shm, const GP& p) {
    typedef GemmCore<256, false> G;
    for (int L = bid_opaque(); L < 32 * 8; L += grid_n()) {
        int pm, pn; static_order(L, 32, 8, pm, pn);
        f32x4 acc[8][4]; ZERO_ACC(acc, 8);
        {
            const int t0 = tid_opaque();
            unsigned aoff[G::GLA], boff[4];
#pragma unroll
            for (int i = 0; i < G::GLA; ++i) { int R, C; G::a_coord(t0, i, R, C); aoff[i] = (unsigned)((R * DM_ + C) * 2); }
#pragma unroll
            for (int i = 0; i < 4; ++i) { int cc, C; G::bt_coord(t0, i, cc, C); boff[i] = (unsigned)((cc * DM_ + C) * 2); }
            const char* pf = t0 < 256 ? (const char*)(p.A + (size_t)(pm * 256 + t0) * DM_) : (const char*)(p.Bt + (size_t)(pn * 256 + t0 - 256) * DM_);
            G::run_bt(shm, (const char*)(p.A + (size_t)pm * 256 * DM_), aoff, (const char*)(p.Bt + (size_t)pn * 256 * DM_), boff, DM_ * 2, pf, DM_ / 64, acc);
        }
        const int t1 = tid_opaque(); LANE_IDS(t1)
        const size_t o0 = (size_t)(pm * 256 + wr * 128 + fq * 4) * DM_ + pn * 256 + wc * 64 + 4 * fr;
#pragma unroll
        for (int m = 0; m < 8; ++m)
#pragma unroll
            for (int j = 0; j < 4; ++j) {
                const size_t o = o0 + (size_t)(m * 16 + j) * DM_;
                const f32x4 r = *(const f32x4*)(p.R + o);
                *(f32x4*)(p.Cf + o) = (f32x4){r[0] + acc[m][0][j], r[1] + acc[m][1][j], r[2] + acc[m][2][j], r[3] + acc[m][3][j]};
            }
    }
}
__device__ __forceinline__ void phase_moe_up(char* shm, const GP& p) {
    typedef GemmCore<256, true> G;
    for (int L = bid_opaque(); L < 64 * 16; L += grid_n()) {
        const int xcd = L & 7, wg = xcd * 128 + (L >> 3), b = wg & 3, pair = wg >> 2, e = pair >> 4, nt = pair & 15, z = b * 16 + e;
        f32x4 acc[8][4]; ZERO_ACC(acc, 8);
        {
            const int t0 = tid_opaque(); int bk, bc, bw; G::b_coord(t0, bk, bc, bw);
            unsigned aoff[G::GLA];
#pragma unroll
            for (int i = 0; i < G::GLA; ++i) { int R, C; G::a_coord(t0, i, R, C); aoff[i] = (unsigned)(((b * SEQ_ + p.idx[z * 256 + R]) * DM_ + C) * 2); }
            const float* wsel = bw ? p.B2 : p.B;
            G::run(shm, (const char*)p.A, aoff, (const char*)(wsel + (size_t)e * DM_ * DM_ + (size_t)bk * DM_ + nt * 128 + bc), DM_ * 4, DM_ / 64, acc);
        }
        const int t1 = tid_opaque(); LANE_IDS(t1)
        const int hi = (fr >> 3) & 1;
        bf16_t* op = p.Cb + (size_t)(z * 256 + wr * 128 + fq * 4) * DM_ + nt * 128 + wc * 32 + 4 * (fr & 7);
#pragma unroll
        for (int mm = 0; mm < 4; ++mm)
#pragma unroll
            for (int j = 0; j < 4; ++j) {
                float a[4], g[4];
#pragma unroll
                for (int n = 0; n < 4; ++n) {
                    const float lo = acc[mm][n][j], hv = acc[mm + 4][n][j];
                    const float send = hi ? lo : hv;
                    const float recv = __shfl_xor(send, 8, 64);
                    a[n] = hi ? recv : lo;
                    g[n] = hi ? hv : recv;
                }
                uint2 o; o.x = cvt_pk_bf16(silu_fast_(a[0]) * g[0], silu_fast_(a[1]) * g[1]); o.y = cvt_pk_bf16(silu_fast_(a[2]) * g[2], silu_fast_(a[3]) * g[3]);
                *(uint2*)(op + (size_t)((mm + 4 * hi) * 16 + j) * DM_) = o;
            }
    }
}
__device__ __forceinline__ void phase_moe_down(char* shm, const GP& p) {
    typedef GemmCore<256, false> G;
    for (int L = bid_opaque(); L < 64 * 8; L += grid_n()) {
        const int xcd = L & 7, wg = xcd * 64 + (L >> 3), b = wg & 3, pair = wg >> 2, e = pair >> 3, nt = pair & 7, z = b * 16 + e;
        f32x4 acc[8][4]; ZERO_ACC(acc, 8);
        {
            const int t0 = tid_opaque(); int bk, bc, bw; G::b_coord(t0, bk, bc, bw);
            unsigned aoff[G::GLA];
#pragma unroll
            for (int i = 0; i < G::GLA; ++i) { int R, C; G::a_coord(t0, i, R, C); aoff[i] = (unsigned)((R * DM_ + C) * 2); }
            G::run(shm, (const char*)(p.A + (size_t)z * 256 * DM_), aoff, (const char*)(p.B + (size_t)e * DM_ * DM_ + (size_t)bk * DM_ + nt * 256 + bc), DM_ * 4, DM_ / 64, acc);
        }
        const int t1 = tid_opaque(); LANE_IDS(t1)
        const int row0 = z * 256 + wr * 128 + fq * 4;
        bf16_t* op = p.Cb + (size_t)row0 * DM_ + nt * 256 + wc * 64 + 4 * fr;
        f32x4 gtv[8];
#pragma unroll
        for (int m = 0; m < 8; ++m) gtv[m] = *(const f32x4*)(p.gate + row0 + m * 16);
#pragma unroll
        for (int m = 0; m < 8; ++m)
#pragma unroll
            for (int j = 0; j < 4; ++j) {
                const float gt = gtv[m][j];
                uint2 o; o.x = cvt_pk_bf16(gt * acc[m][0][j], gt * acc[m][1][j]); o.y = cvt_pk_bf16(gt * acc[m][2][j], gt * acc[m][3][j]);
                *(uint2*)(op + (size_t)(m * 16 + j) * DM_) = o;
            }
    }
}

namespace pg8 {
#define PG8_LAS __attribute__((address_space(3)))
constexpr int BM = 256, BK = 64, HALF = 128, HTB = HALF * BK * 2  , STAGE_BYTES = 8 * HTB;
__device__ __forceinline__ int lds_byte(int r, int c) { const int st = (r >> 4) * 2 + (c >> 5), rr = r & 15, cc = c & 31, ob = rr * 64 + cc * 2; return st * 1024 + (ob ^ (((ob >> 9) & 1) << 5)); }
__device__ __forceinline__ void stage_rc(int b, int& R, int& C) { const int st = b / 1024, sb = b % 1024, swz = sb ^ (((sb >> 9) & 1) << 5); R = (st >> 1) * 16 + swz / 64; C = (st & 1) * 32 + (swz % 64) / 2; }
__device__ __forceinline__ int perm32(int rho) { const int n = rho >> 4, i = rho & 15; return 8 * (i >> 2) + 4 * n + (i & 3); }
struct Unit { int pm, pn, kz; };
struct Gemm { const bf16_t* A; const bf16_t* Bt; int M, N, K, lda, ldb; };
struct MegaOrder {
    static constexpr bool GATHER = false;
    int nM, nN, G, c;
    __device__ __forceinline__ unsigned a_off(const Gemm& g, int R, int C) const { return (unsigned)(R * g.lda + C) * 2u; }
    __device__ __forceinline__ bool next(int i, Unit& u) const { const int L = i * G + c; if (L >= nM * nN) return false; int pm, pn; static_order(L, nM, nN, pm, pn); u.pm = pm; u.pn = pn; u.kz = 0; return true; }
    __device__ __forceinline__ void base(const Gemm& g, const Unit& u, const char*& a, const char*& b) const { a = (const char*)g.A + (size_t)u.pm * BM * g.lda * 2; b = (const char*)g.Bt + (size_t)u.pn * BM * g.ldb * 2; }
    __device__ __forceinline__ void a_ready(const Unit&) const {}
    __device__ __forceinline__ void done(const Unit&) const {}
};
__device__ __forceinline__ uint4 pack8_bf16(const f32x4& a, const f32x4& b) { return make_uint4(cvt_pk_bf16(a[0], a[1]), cvt_pk_bf16(a[2], a[3]), cvt_pk_bf16(b[0], b[1]), cvt_pk_bf16(b[2], b[3])); }
struct EpiInproj {
    static constexpr bool PERM = true, AFTER_DRAIN = false;
    bf16_t* proj; bf16_t* gates; bf16_t* vt; const float* bgate;
    __device__ __forceinline__ void operator()(const f32x4 (&acc)[2][2][4][2], const Unit& u, int wr, int wc, int fr, int fq) const {
        const int row0 = u.pm * BM + wr * 64 + fr, cb = wc * 32 + 8 * fq;
        if (u.pn == 14 || u.pn == 15) {
            const int bb = row0 >> 11;
#pragma unroll
            for (int ai = 0; ai < 2; ++ai)
#pragma unroll
                for (int m = 0; m < 4; ++m) { const int t = (row0 + ai * HALF + m * 16) & (SEQ_ - 1);
#pragma unroll
                    for (int bj = 0; bj < 2; ++bj)
#pragma unroll
                        for (int n = 0; n < 2; ++n)
#pragma unroll
                            for (int e = 0; e < 4; ++e) vt[(size_t)(bb * 512 + (u.pn - 14) * 256 + bj * HALF + cb + 4 * n + e) * SEQ_ + t] = f2bf(acc[ai][bj][m][n][e]); }
        } else if (u.pn < 22) {
#pragma unroll
            for (int ai = 0; ai < 2; ++ai)
#pragma unroll
                for (int m = 0; m < 4; ++m) { bf16_t* rowp = proj + (size_t)(row0 + ai * HALF + m * 16) * PROJW + u.pn * BM + cb;
#pragma unroll
                    for (int bj = 0; bj < 2; ++bj) *(uint4*)(rowp + bj * HALF) = pack8_bf16(acc[ai][bj][m][0], acc[ai][bj][m][1]); }
        } else {
            const int gc = (u.pn - 22) * BM + cb;
            f32x4 bv[2][2];
#pragma unroll
            for (int bj = 0; bj < 2; ++bj) { bv[bj][0] = *(const f32x4*)(bgate + gc + bj * HALF); bv[bj][1] = *(const f32x4*)(bgate + gc + bj * HALF + 4); }
#pragma unroll
            for (int ai = 0; ai < 2; ++ai)
#pragma unroll
                for (int m = 0; m < 4; ++m) { bf16_t* rowp = gates + (size_t)(row0 + ai * HALF + m * 16) * 8192 + gc;
#pragma unroll
                    for (int bj = 0; bj < 2; ++bj) { f32x4 v0 = acc[ai][bj][m][0] + bv[bj][0], v1 = acc[ai][bj][m][1] + bv[bj][1];
#pragma unroll
                        for (int e = 0; e < 4; ++e) { v0[e] = sigmoid_fast_(v0[e]); v1[e] = sigmoid_fast_(v1[e]); }
                        *(uint4*)(rowp + bj * HALF) = pack8_bf16(v0, v1); } }
        }
    }
};
struct EpiOutproj {
    static constexpr bool PERM = false, AFTER_DRAIN = false;
    const float* R; float* C;
    __device__ __forceinline__ void operator()(const f32x4 (&acc)[2][2][4][2], const Unit& u, int wr, int wc, int fr, int fq) const {
        const int row0 = u.pm * BM + wr * 64 + fr, col0 = u.pn * BM + wc * 32 + 4 * fq;
#pragma unroll
        for (int ai = 0; ai < 2; ++ai) {
            f32x4 rv[4][2][2];
#pragma unroll
            for (int m = 0; m < 4; ++m) { const size_t ro = (size_t)(row0 + ai * HALF + m * 16) * DM_ + col0;
#pragma unroll
                for (int bj = 0; bj < 2; ++bj)
#pragma unroll
                    for (int n = 0; n < 2; ++n) rv[m][bj][n] = *(const f32x4*)(R + ro + bj * HALF + n * 16); }
            __builtin_amdgcn_sched_barrier(0);
#pragma unroll
            for (int m = 0; m < 4; ++m) { const size_t ro = (size_t)(row0 + ai * HALF + m * 16) * DM_ + col0;
#pragma unroll
                for (int bj = 0; bj < 2; ++bj)
#pragma unroll
                    for (int n = 0; n < 2; ++n) *(f32x4*)(C + ro + bj * HALF + n * 16) = rv[m][bj][n] + acc[ai][bj][m][n]; }
            __builtin_amdgcn_sched_barrier(0);
        }
    }
};
struct OneUnit {
    static constexpr bool GATHER = false;
    __device__ __forceinline__ bool next(int i, Unit& u) const { if (i) return false; u.pm = 0; u.pn = 0; u.kz = 0; return true; }
    __device__ __forceinline__ void base(const Gemm& g, const Unit&, const char*& a, const char*& b) const { a = (const char*)g.A; b = (const char*)g.Bt; }
    __device__ __forceinline__ unsigned a_off(const Gemm& g, int R, int C) const { return (unsigned)(R * g.lda + C) * 2u; }
    __device__ __forceinline__ void a_ready(const Unit&) const {}
    __device__ __forceinline__ void done(const Unit&) const {}
};
struct OneUnitGather {
    static constexpr bool GATHER = true;
    const int* idx; int tok0;
    __device__ __forceinline__ bool next(int i, Unit& u) const { if (i) return false; u.pm = 0; u.pn = 0; u.kz = 0; return true; }
    __device__ __forceinline__ void base(const Gemm& g, const Unit&, const char*& a, const char*& b) const { a = (const char*)g.A; b = (const char*)g.Bt; }
    __device__ __forceinline__ unsigned a_off(const Gemm& g, int R, int C) const { return (unsigned)((tok0 + idx[R]) * g.lda + C) * 2u; }
    __device__ __forceinline__ void a_ready(const Unit&) const {}
    __device__ __forceinline__ void done(const Unit&) const {}
};
struct EpiMoeDown {
    static constexpr bool PERM = true, AFTER_DRAIN = false;
    bf16_t* out; const float* gate;
    __device__ __forceinline__ void operator()(const f32x4 (&acc)[2][2][4][2], const Unit&, int wr, int wc, int fr, int fq) const {
        const int row0 = wr * 64 + fr, cb = wc * 32 + 8 * fq;
        float gt[2][4];
#pragma unroll
        for (int ai = 0; ai < 2; ++ai)
#pragma unroll
            for (int m = 0; m < 4; ++m) gt[ai][m] = gate[row0 + ai * HALF + m * 16];
#pragma unroll
        for (int ai = 0; ai < 2; ++ai)
#pragma unroll
            for (int m = 0; m < 4; ++m) { const int r = row0 + ai * HALF + m * 16; bf16_t* rowp = out + (size_t)r * DM_ + cb;
#pragma unroll
                for (int bj = 0; bj < 2; ++bj) *(uint4*)(rowp + bj * HALF) = pack8_bf16(acc[ai][bj][m][0] * gt[ai][m], acc[ai][bj][m][1] * gt[ai][m]); }
    }
};
struct EpiMoeUp {
    static constexpr bool PERM = true, AFTER_DRAIN = false;
    bf16_t* out;
    __device__ __forceinline__ void operator()(const f32x4 (&acc)[2][2][4][2], const Unit&, int wr, int wc, int fr, int fq) const {
        const int row0 = wr * 64 + fr, cb = wc * 32 + 8 * fq;
#pragma unroll
        for (int ai = 0; ai < 2; ++ai)
#pragma unroll
            for (int m = 0; m < 4; ++m) { const int r = row0 + ai * HALF + m * 16;
                f32x4 v0, v1;
#pragma unroll
                for (int e = 0; e < 4; ++e) { v0[e] = silu_fast_(acc[ai][0][m][0][e]) * acc[ai][1][m][0][e]; v1[e] = silu_fast_(acc[ai][0][m][1][e]) * acc[ai][1][m][1][e]; }
                *(uint4*)(out + (size_t)r * DM_ + cb) = pack8_bf16(v0, v1); }
    }
};
struct MergeOrder {
    static constexpr bool GATHER = false;
    int G, c;
    __device__ __forceinline__ unsigned a_off(const Gemm& g, int R, int C) const { return (unsigned)(R * g.lda + C) * 2u; }
    __device__ __forceinline__ bool next(int i, Unit& u) const { const int L = (i >> 2) * G + c; if (L >= 32 * 8) return false; int pm, pn; static_order(L, 32, 8, pm, pn); u.pm = pm; u.pn = pn; u.kz = i & 3; return true; }
    __device__ __forceinline__ void base(const Gemm& g, const Unit& u, const char*& a, const char*& b) const {
        a = (const char*)g.A + ((size_t)u.pm * BM * DM_ + u.kz * 512) * 2; b = (const char*)g.Bt + ((size_t)u.kz * DM_ + u.pn * BM) * 512 * 2; }
    __device__ __forceinline__ void a_ready(const Unit&) const {}
    __device__ __forceinline__ void done(const Unit&) const {}
};
struct EpiMerge {
    static constexpr bool PERM = true, AFTER_DRAIN = false;
    const bf16_t* gates; float* m32; bf16_t* out;
    __device__ __forceinline__ void operator()(const f32x4 (&acc)[2][2][4][2], const Unit& u, int wr, int wc, int fr, int fq) const {
        const int row0 = u.pm * BM + wr * 64 + fr, col0 = u.pn * BM + wc * 32 + 8 * fq;
#pragma unroll
        for (int ai = 0; ai < 2; ++ai)
#pragma unroll
            for (int mp = 0; mp < 2; ++mp) {
                uint4 gv[2][2]; f32x4 pv[2][2][2];
#pragma unroll
                for (int mm = 0; mm < 2; ++mm) { const size_t row = (size_t)(row0 + ai * HALF + (mp * 2 + mm) * 16);
#pragma unroll
                    for (int bj = 0; bj < 2; ++bj) { const int col = col0 + bj * HALF;
                        gv[mm][bj] = *(const uint4*)(gates + row * 8192 + u.kz * DM_ + col);
                        if (u.kz > 0) { const float* mp_ = m32 + row * DM_ + col; pv[mm][bj][0] = *(const f32x4*)mp_; pv[mm][bj][1] = *(const f32x4*)(mp_ + 4); }
                        else { pv[mm][bj][0] = (f32x4){0.f, 0.f, 0.f, 0.f}; pv[mm][bj][1] = (f32x4){0.f, 0.f, 0.f, 0.f}; } } }
                __builtin_amdgcn_sched_barrier(0);
#pragma unroll
                for (int mm = 0; mm < 2; ++mm) { const int m = mp * 2 + mm; const size_t row = (size_t)(row0 + ai * HALF + m * 16);
#pragma unroll
                    for (int bj = 0; bj < 2; ++bj) { const int col = col0 + bj * HALF; const uint4 g4 = gv[mm][bj];
                        f32x4 v0 = acc[ai][bj][m][0], v1 = acc[ai][bj][m][1];
                        v0[0] = v0[0] * __uint_as_float(g4.x << 16) + pv[mm][bj][0][0]; v0[1] = v0[1] * __uint_as_float(g4.x & 0xffff0000u) + pv[mm][bj][0][1];
                        v0[2] = v0[2] * __uint_as_float(g4.y << 16) + pv[mm][bj][0][2]; v0[3] = v0[3] * __uint_as_float(g4.y & 0xffff0000u) + pv[mm][bj][0][3];
                        v1[0] = v1[0] * __uint_as_float(g4.z << 16) + pv[mm][bj][1][0]; v1[1] = v1[1] * __uint_as_float(g4.z & 0xffff0000u) + pv[mm][bj][1][1];
                        v1[2] = v1[2] * __uint_as_float(g4.w << 16) + pv[mm][bj][1][2]; v1[3] = v1[3] * __uint_as_float(g4.w & 0xffff0000u) + pv[mm][bj][1][3];
                        if (u.kz < 3) { float* mp_ = m32 + row * DM_ + col; *(f32x4*)mp_ = v0; *(f32x4*)(mp_ + 4) = v1; }
                        else *(uint4*)(out + row * DM_ + col) = pack8_bf16(v0, v1); } }
                __builtin_amdgcn_sched_barrier(0);
            }
    }
};
struct NoConv { static constexpr bool ON = false;
    __device__ __forceinline__ void load(int, f32x4 (&)[4]) const {}
    __device__ __forceinline__ void store(int, const f32x4 (&)[4]) const {} };
struct PanelConv { static constexpr bool ON = true;
    const float* src; bf16_t* dst;
    __device__ __forceinline__ void load(int it, f32x4 (&v)[4]) const {
#pragma unroll
        for (int r = 0; r < 4; ++r) v[r] = *(const f32x4*)(src + (size_t)(it * 32 + r) * DM_); }
    __device__ __forceinline__ void store(int it, const f32x4 (&v)[4]) const {
#pragma unroll
        for (int i = 0; i < 4; ++i) { uint2 o; o.x = cvt_pk_bf16(v[0][i], v[1][i]); o.y = cvt_pk_bf16(v[2][i], v[3][i]); *(uint2*)(dst + (size_t)i * DM_ + it * 32) = o; } }
};
template <bool DUAL>
__device__ __forceinline__ PanelConv make_panel_conv(const float* w, const float* w3, int col0, int q, bf16_t* panel) {
    const int tid = tid_opaque(), wid = __builtin_amdgcn_readfirstlane(tid >> 6), lane = tid & 63, kq = lane & 7, nl = lane >> 3;
    PanelConv c;
    c.src = (DUAL ? ((wid >> 2) ? w3 : w) + col0 + (wid & 3) * 32 : w + col0 + wid * 32) + nl * 4 + (size_t)(q * 512 + kq * 4) * DM_;
    c.dst = panel + (size_t)(wid * 32 + nl * 4) * DM_ + q * 512 + kq * 4;
    return c;
}
template <class Epi, class Sched, bool STAMP = false, class Conv = NoConv>
__device__ __forceinline__ void gemm_phase(PG8_LAS unsigned char* lds, const Gemm g, const Sched& S, const Epi& E, unsigned long long* stamps, const Conv cv = Conv{}) {
    const int tid = tid_opaque(), wid = __builtin_amdgcn_readfirstlane(tid >> 6), lane = tid & 63, wr = wid >> 2, wc = wid & 3, fr = lane & 15, fq = lane >> 4;
    const int K = g.K, nt = K / BK;
    int ts_lo = 0, ts_hi = 0, nts = 0; const unsigned long long rt_entry = STAMP ? (unsigned long long)wall_clock64() : 0ull;
#define PG8_STAMP() do { if (STAMP && wid == 0 && nts < 64) { const unsigned long long _c = (unsigned long long)clock64(); \
        ts_lo = (lane == nts) ? (int)(unsigned)_c : ts_lo; ts_hi = (lane == nts) ? (int)(unsigned)(_c >> 32) : ts_hi; ++nts; } } while (0)
    PG8_STAMP();
    unsigned voffA[2], voffA1[2], voffB[2];
#pragma unroll
    for (int i = 0; i < 2; ++i) { int R, C; stage_rc(tid * 16 + i * 8192, R, C); const int Rb = Epi::PERM ? ((R & ~31) + perm32(R & 31)) : R;
        voffA[i] = S.a_off(g, R, C); voffA1[i] = Sched::GATHER ? S.a_off(g, R + HALF, C) : voffA[i]; voffB[i] = (unsigned)(Rb * g.ldb + C) * 2u; }
    const size_t kstep = (size_t)(BK * 2);
    const size_t hstepA = Sched::GATHER ? (size_t)0 : (size_t)HALF * g.lda * 2, hstepB = (size_t)HALF * g.ldb * 2;
    const unsigned ldsw = (unsigned)wid * 1024u;
    const int aoff = lds_byte(wr * 64 + fr, fq * 8), boff = lds_byte(wc * 32 + fr, fq * 8);
#define PG8_SA(b, h) (((b) * 2 + (h)) * HTB)
#define PG8_SB(b, h) ((4 + (b) * 2 + (h)) * HTB)
#define PG8_STAGE(bufoff, gbase, voff) do { _Pragma("unroll") for (int _i = 0; _i < 2; ++_i) \
        __builtin_amdgcn_global_load_lds((const unsigned*)((const char*)(gbase) + (voff)[_i]), (PG8_LAS unsigned*)(lds + (bufoff) + ldsw + _i * 8192), 16, 0, 0); } while (0)
#define PG8_LDA(dst, b, h) do { _Pragma("unroll") for (int m = 0; m < 4; ++m) _Pragma("unroll") for (int k = 0; k < 2; ++k) dst[m][k] = *(const PG8_LAS bf16x8*)(lds + PG8_SA(b, h) + aoff + m * 2048 + k * 1024); } while (0)
#define PG8_LDB(dst, b, h) do { _Pragma("unroll") for (int n = 0; n < 2; ++n) _Pragma("unroll") for (int k = 0; k < 2; ++k) dst[n][k] = *(const PG8_LAS bf16x8*)(lds + PG8_SB(b, h) + boff + n * 2048 + k * 1024); } while (0)
#define PG8_MMA(ai, bj, At, Bt) do { __builtin_amdgcn_s_setprio(1); _Pragma("unroll") for (int m = 0; m < 4; ++m) _Pragma("unroll") for (int n = 0; n < 2; ++n) _Pragma("unroll") for (int k = 0; k < 2; ++k) \
        acc[ai][bj][m][n] = __builtin_amdgcn_mfma_f32_16x16x32_bf16(Bt[n][k], At[m][k], acc[ai][bj][m][n], 0, 0, 0); __builtin_amdgcn_s_setprio(0); } while (0)
#define PG8_WAIT_V(n) asm volatile("s_waitcnt vmcnt(" #n ")" ::: "memory")
#define PG8_WAIT_L(n) asm volatile("s_waitcnt lgkmcnt(" #n ")" ::: "memory")
#define PG8_BAR __builtin_amdgcn_s_barrier()
#define PG8_SCHED __builtin_amdgcn_sched_barrier(0)
    Unit cur, nxt; int ui = 0;
    if (!S.next(0, cur)) return;
    f32x4 acc[2][2][4][2];
#pragma unroll
    for (int a = 0; a < 2; ++a)
#pragma unroll
        for (int b = 0; b < 2; ++b)
#pragma unroll
            for (int m = 0; m < 4; ++m)
#pragma unroll
                for (int n = 0; n < 2; ++n) acc[a][b][m][n] = (f32x4){0.f, 0.f, 0.f, 0.f};
    bf16x8 At[4][2], B0[2][2], B1[2][2];
    const char* cA; const char* cB; S.base(g, cur, cA, cB);
    S.a_ready(cur);
    PG8_STAGE(PG8_SB(0, 0), cB, voffB); PG8_STAGE(PG8_SA(0, 0), cA, voffA); PG8_STAGE(PG8_SB(0, 1), cB + hstepB, voffB); PG8_STAGE(PG8_SA(0, 1), cA + hstepA, voffA1);
    if (wr == 1) PG8_BAR;
    PG8_WAIT_V(4); PG8_BAR;
    PG8_STAGE(PG8_SB(1, 0), cB + kstep, voffB); PG8_STAGE(PG8_SA(1, 0), cA + kstep, voffA); PG8_STAGE(PG8_SB(1, 1), cB + hstepB + kstep, voffB);
    PG8_WAIT_V(6); PG8_BAR;
    PG8_STAMP();
    for (;;) {
        const bool has_next = S.next(ui + 1, nxt);
        const char* nA = cA; const char* nB = cB; if (has_next) S.base(g, nxt, nA, nB);
        for (int t = 0; t < nt; t += 2) {
            const bool last = (t == nt - 2);
            const char* a1 = cA + (size_t)(t + 1) * kstep;
            const char* a2 = last ? nA : cA + (size_t)(t + 2) * kstep; const char* b2 = last ? nB : cB + (size_t)(t + 2) * kstep;
            const char* a3 = a2 + kstep; const char* b3 = b2 + kstep;
            if (last && has_next) S.a_ready(nxt);
            f32x4 cvv[4]; if constexpr (Conv::ON) { cv.load(t >> 1, cvv); PG8_SCHED; }
            PG8_LDB(B0, 0, 0); PG8_SCHED; PG8_LDA(At, 0, 0); PG8_STAGE(PG8_SA(1, 1), a1 + hstepA, voffA1);
            PG8_WAIT_L(8); PG8_BAR; PG8_WAIT_L(0); PG8_MMA(0, 0, At, B0); PG8_BAR; PG8_SCHED;
            PG8_LDB(B1, 0, 1); PG8_STAGE(PG8_SB(0, 0), b2, voffB);
            PG8_BAR; PG8_WAIT_L(0); PG8_MMA(0, 1, At, B1); PG8_BAR;
            PG8_LDA(At, 0, 1); PG8_STAGE(PG8_SA(0, 0), a2, voffA);
            PG8_BAR; PG8_WAIT_L(0); PG8_MMA(1, 0, At, B0); PG8_BAR; PG8_SCHED;
            PG8_STAGE(PG8_SB(0, 1), b2 + hstepB, voffB);
            PG8_WAIT_V(6); PG8_BAR; PG8_MMA(1, 1, At, B1); PG8_BAR;
            if constexpr (Conv::ON) { cv.store(t >> 1, cvv); PG8_SCHED; }
            PG8_LDB(B0, 1, 0); PG8_SCHED; PG8_LDA(At, 1, 0); PG8_STAGE(PG8_SA(0, 1), a2 + hstepA, voffA1);
            PG8_WAIT_L(8); PG8_BAR; PG8_WAIT_L(0); PG8_MMA(0, 0, At, B0); PG8_BAR; PG8_SCHED;
            PG8_LDB(B1, 1, 1); PG8_STAGE(PG8_SB(1, 0), b3, voffB);
            PG8_BAR; PG8_WAIT_L(0); PG8_MMA(0, 1, At, B1); PG8_BAR;
            PG8_LDA(At, 1, 1); PG8_STAGE(PG8_SA(1, 0), a3, voffA);
            PG8_BAR; PG8_WAIT_L(0); PG8_MMA(1, 0, At, B0); PG8_BAR; PG8_SCHED;
            PG8_STAGE(PG8_SB(1, 1), b3 + hstepB, voffB);
            PG8_WAIT_V(6); PG8_BAR; PG8_MMA(1, 1, At, B1); PG8_BAR;
        }
        PG8_STAMP();
        if constexpr (!Epi::AFTER_DRAIN) { E(acc, cur, wr, wc, fr, fq); S.done(cur); }
        PG8_STAMP();
        if (!has_next) break;
#pragma unroll
        for (int a = 0; a < 2; ++a)
#pragma unroll
            for (int b = 0; b < 2; ++b)
#pragma unroll
                for (int m = 0; m < 4; ++m)
#pragma unroll
                    for (int n = 0; n < 2; ++n) acc[a][b][m][n] = (f32x4){0.f, 0.f, 0.f, 0.f};
        cur = nxt; cA = nA; cB = nB; ++ui;
    }
    PG8_WAIT_V(0);
    if (wr == 0) PG8_BAR;
    PG8_BAR;
    if constexpr (Epi::AFTER_DRAIN) { E.fused(acc, cur, wr, wc, fr, fq, lds, wid, lane); S.done(cur); }
    PG8_STAMP();
    if (STAMP && wid == 0) { stamps[lane] = lane < nts ? (((unsigned long long)(unsigned)ts_hi << 32) | (unsigned)ts_lo) : 0ull;
        if (lane == 62) stamps[62] = rt_entry; if (lane == 63) stamps[63] = (unsigned long long)wall_clock64(); }
#undef PG8_STAMP
#undef PG8_SA
#undef PG8_SB
#undef PG8_STAGE
#undef PG8_LDA
#undef PG8_LDB
#undef PG8_MMA
#undef PG8_WAIT_V
#undef PG8_WAIT_L
#undef PG8_BAR
#undef PG8_SCHED
}
}
#define XB_TMO      128
#define XB_XCNT(j)  (256  + 64 * (j))
#define XB_XSUB(j)  (1280 + 64 * (j))
#define XB_XGEN(j)  (2304 + 64 * (j))
#define XB_TOP      3328
#define XB_TOPGEN   3392
#define XCD_BAR_WORDS 3456
#define XB_SPIN_CAP (1u << 18)
#define LAS __attribute__((address_space(3)))

__device__ __forceinline__ unsigned xb_ld(unsigned* p)              { return __hip_atomic_load(p, __ATOMIC_RELAXED, __HIP_MEMORY_SCOPE_AGENT); }
__device__ __forceinline__ unsigned xb_add(unsigned* p, unsigned v) { return __hip_atomic_fetch_add(p, v, __ATOMIC_RELAXED, __HIP_MEMORY_SCOPE_AGENT); }
__device__ __forceinline__ unsigned xb_xcc_id() { return (unsigned)__builtin_amdgcn_s_getreg((3 << 11) | 20) & 0xFu; }
#define XB_SPIN(cond, bar) do { unsigned _sp = 0; while (cond) { __builtin_amdgcn_s_sleep(1); \
    if ((++_sp & 255u) == 0u) { if (xb_ld(&(bar)[XB_TMO])) break; if (_sp > XB_SPIN_CAP) { atomicAdd(&(bar)[XB_TMO], 1u); break; } } } } while (0)

struct XcdBarrier {
    unsigned* bar; unsigned x;
    volatile LAS unsigned* st;
};

__device__ __forceinline__ XcdBarrier xcd_barrier_post(unsigned* bar, volatile LAS unsigned* st) {
    XcdBarrier b; b.bar = bar; b.x = xb_xcc_id(); b.st = st;
    if (threadIdx.x == 0) (void)xb_add(&bar[XB_XCNT(b.x)], 1u);
    return b;
}
__device__ __forceinline__ void xcd_barrier_complete(unsigned* bar, unsigned x, unsigned& nloc, unsigned& nx) {
    const unsigned G = gridDim.x * gridDim.y * gridDim.z;
    unsigned sum, cnt, mine, sp = 0u;
    for (;;) {
        sum = 0u; cnt = 0u; mine = 0u;
#pragma unroll
        for (unsigned j = 0; j < 16; ++j) { const unsigned c = xb_ld(&bar[XB_XCNT(j)]); sum += c; cnt += (c > 0u) ? 1u : 0u; mine = (j == x) ? c : mine; }
        if (sum == G) break;
        __builtin_amdgcn_s_sleep(1);
        if ((++sp & 255u) == 0u) { if (xb_ld(&bar[XB_TMO])) break; if (sp > XB_SPIN_CAP) { atomicAdd(&bar[XB_TMO], 1u); break; } }
    }
    nloc = mine > 0u ? mine : 1u; nx = cnt > 0u ? cnt : 1u;
}

__device__ __forceinline__ void xcd_barrier(const XcdBarrier& b) {
    asm volatile("s_waitcnt vmcnt(0)" ::: "memory");
    __syncthreads();
    if (threadIdx.x == 0) {
        unsigned* bar = b.bar; unsigned bx_ = b.x;
        asm volatile("" : "+s"(bar), "+s"(bx_));
        __builtin_amdgcn_s_waitcnt(0);
        unsigned nloc = b.st[0], nx = b.st[1];
        const unsigned old = xb_add(&bar[XB_XSUB(bx_)], 1u);
        const unsigned gen = old / nloc;
        if (old + 1u == (gen + 1u) * nloc) {
            __builtin_amdgcn_fence(__ATOMIC_RELEASE, "agent");
            asm volatile("s_waitcnt vmcnt(0)" ::: "memory");
            const unsigned og = xb_add(&bar[XB_TOP], 1u);
            const unsigned tg = og / nx;
            if (og + 1u == (tg + 1u) * nx) xb_add(&bar[XB_TOPGEN], 1u);
            else XB_SPIN(xb_ld(&bar[XB_TOPGEN]) == tg, bar);
            __builtin_amdgcn_fence(__ATOMIC_ACQUIRE, "agent");
            xb_add(&bar[XB_XGEN(bx_)], 1u);
            asm volatile("s_waitcnt vmcnt(0)" ::: "memory");
        } else {
            XB_SPIN(xb_ld(&bar[XB_XGEN(bx_)]) == gen, bar);
            __builtin_amdgcn_fence(__ATOMIC_ACQUIRE, "agent");
            asm volatile("s_waitcnt vmcnt(0)" ::: "memory");
        }
    }
    __syncthreads();
}

enum { X = 0, N1G, WIN, HCW, HCB, FW1, FB1, FW2, FB2, FW3, FB3, FW4, FREQ, HBIAS, LCW, LCB, LWA, LBA, LWX, LBX, LLAM, DLAM, DSUB, SCW, SCB, SDTB, SALOG, SD, SNG, WBR, BG, WOUT,
       N2G, WR, W1, W3, W2, RELB, FING };
struct MP {
    const float* in[39]; float* out; unsigned* bar;
    float* xres; bf16_t* hb; bf16_t* proj; bf16_t* gates; float* dtraw; bf16_t* br; bf16_t* mrg;
    float* fr; float* nrm; unsigned* hpp; bf16_t* vvt; float* hyt; bf16_t* vt;
    float* sumP; float* sumE; bf16_t* sxa; bf16_t* sxT; float* states; float* sdec; bf16_t* sprev;
    float* aff; int* tidx; float* tgat; int* tinv; bf16_t* hid; bf16_t* ybuf;
    bf16_t* wtin; bf16_t* wtbr; bf16_t* wtout; bf16_t* lruwt; float* m32;
    bf16_t* panel; unsigned* grp;
    int ngrid, pad1;
};
typedef const MP __attribute__((address_space(4)))* MPc;
__device__ __forceinline__ MPc params() { MPc q = (MPc)__builtin_amdgcn_kernarg_segment_ptr(); asm volatile("" : "+s"(q)); return q; }
__device__ __forceinline__ int bid_opaque() { int b = (int)__builtin_amdgcn_workgroup_id_x(); asm volatile("" : "+s"(b)); return b; }
__device__ __forceinline__ int grid_n() { return params()->ngrid; }

#define GRP_WORDS 16
#define GRP_COUNT (2 * 384)
template <bool DUAL>
__device__ __forceinline__ void moe_convert(const float* w, const float* w3, int col0, int q, bf16_t* panel) {
    const int tid = tid_opaque(), wid = __builtin_amdgcn_readfirstlane(tid >> 6), lane = tid & 63, kq = lane & 3, ngl = lane >> 2, ksub = wid & 1, grp = wid >> 1;
    const float* src = (DUAL ? ((grp >> 1) ? w3 : w) + col0 + (grp & 1) * 64 : w + col0 + grp * 64) + 4 * ngl + (size_t)(q * 512 + ksub * 32 + kq * 8) * DM_;
    bf16_t* dst = panel + (size_t)(grp * 64 + 4 * ngl) * DM_ + q * 512 + ksub * 32 + kq * 8;
#pragma unroll 1
    for (int ks = 0; ks < 8; ks += 2) {
        f32x4 v[2][8];
#pragma unroll
        for (int u = 0; u < 2; ++u)
#pragma unroll
            for (int r = 0; r < 8; ++r) v[u][r] = *(const f32x4*)(src + (size_t)((ks + u) * 64 + r) * DM_);
#pragma unroll
        for (int u = 0; u < 2; ++u)
#pragma unroll
            for (int i = 0; i < 4; ++i) { uint4 o; o.x = cvt_pk_bf16(v[u][0][i], v[u][1][i]); o.y = cvt_pk_bf16(v[u][2][i], v[u][3][i]); o.z = cvt_pk_bf16(v[u][4][i], v[u][5][i]); o.w = cvt_pk_bf16(v[u][6][i], v[u][7][i]);
                *(uint4*)(dst + (size_t)i * DM_ + (ks + u) * 64) = o; }
    }
}
__device__ __forceinline__ void group_sync(unsigned* cnt, unsigned* bar) {
    asm volatile("s_waitcnt vmcnt(0)" ::: "memory");
    __syncthreads();
    if (threadIdx.x == 0) {
        asm volatile("" : "+s"(cnt), "+s"(bar));
        __builtin_amdgcn_fence(__ATOMIC_RELEASE, "agent");
        asm volatile("s_waitcnt vmcnt(0)" ::: "memory");
        (void)xb_add(cnt, 1u);
        XB_SPIN(xb_ld(cnt) < 4u, bar);
        __builtin_amdgcn_fence(__ATOMIC_ACQUIRE, "agent");
        asm volatile("s_waitcnt vmcnt(0)" ::: "memory");
    }
    __syncthreads();
}
__device__ __forceinline__ void phase_moe_down2(char* shm, MPc p, int l) {
    const int bid = bid_opaque(), x = bid & 7, q = bid >> 3, b = q & 3, gi = q >> 2, ngx = grid_n() >> 5;
    if (q < ngx * 4) {
        if (gi < 16) { const int pair = x * 16 + gi, e = pair >> 3, nt = pair & 7;
            moe_convert<false>(p->in[W2] + ((size_t)l * 16 + e) * DM_ * DM_, nullptr, nt * 256, b, p->panel + (size_t)pair * 256 * DM_); }
        for (int j = gi; j < 16; j += ngx) {
            const int pair = x * 16 + j, e = pair >> 3, nt = pair & 7, z = b * 16 + e;
            bf16_t* panel = p->panel + (size_t)pair * 256 * DM_;
            group_sync(p->grp + (size_t)(l * 384 + 256 + pair) * GRP_WORDS, p->bar);
            const pg8::Gemm gg{p->hid + (size_t)z * 256 * DM_, panel, 256, 256, DM_, DM_, DM_}; const pg8::OneUnit so{}; const pg8::EpiMoeDown ep{p->ybuf + (size_t)z * 256 * DM_ + nt * 256, p->tgat + z * 256};
            if (j + ngx < 16) {
                const int pair2 = pair + ngx, e2 = pair2 >> 3, nt2 = pair2 & 7;
                const pg8::PanelConv cv = pg8::make_panel_conv<false>(p->in[W2] + ((size_t)l * 16 + e2) * DM_ * DM_, nullptr, nt2 * 256, b, p->panel + (size_t)pair2 * 256 * DM_);
                pg8::gemm_phase<pg8::EpiMoeDown, pg8::OneUnit, false, pg8::PanelConv>((PG8_LAS unsigned char*)shm, gg, so, ep, nullptr, cv);
            } else pg8::gemm_phase<pg8::EpiMoeDown, pg8::OneUnit, false>((PG8_LAS unsigned char*)shm, gg, so, ep, nullptr);
        }
    }
}
__device__ __forceinline__ void phase_moe_up2(char* shm, MPc p, int l) {
    const int bid = bid_opaque(), x = bid & 7, q = bid >> 3, b = q & 3, gi = q >> 2, ngx = grid_n() >> 5;
    if (q < ngx * 4)
    for (int j = gi; j < 32; j += ngx) {
        const int pair = x * 32 + j, e = pair >> 4, nt = pair & 15, z = b * 16 + e;
        bf16_t* panel = p->panel + (size_t)pair * 256 * DM_;
        moe_convert<true>(p->in[W1] + ((size_t)l * 16 + e) * DM_ * DM_, p->in[W3] + ((size_t)l * 16 + e) * DM_ * DM_, nt * 128, b, panel);
        group_sync(p->grp + (size_t)(l * 384 + pair) * GRP_WORDS, p->bar);
        const pg8::Gemm gg{p->hb, panel, 256, 256, DM_, DM_, DM_}; const pg8::OneUnitGather so{p->tidx + z * 256, b * SEQ_}; const pg8::EpiMoeUp ep{p->hid + (size_t)z * 256 * DM_ + nt * 128};
        pg8::gemm_phase<pg8::EpiMoeUp, pg8::OneUnitGather, false>((PG8_LAS unsigned char*)shm, gg, so, ep, nullptr);
    }
}
#ifndef MERGE_PG8
#define MERGE_PG8 0
#endif
#ifndef MOE_DOWN2
#define MOE_DOWN2 0
#endif
#define MEGA_LDS (139264 + 1024)
#define NPH 12

template <int MODE>
__device__ __forceinline__ void phase_norm(char* shm, MPc p, int l) {
    float* hrow = (float*)shm;
    float* red = (float*)(shm + 65536);
    float wreg[64];
    if (MODE != 2) {
        const float* W = MODE == 0 ? p->in[WIN] + (size_t)l * DM_ * INC_ + PROJW : p->in[WR] + (size_t)l * DM_ * 16;
        const int ldw = MODE == 0 ? INC_ : 16; const int t0_ = tid_opaque(), e = t0_ & 15, part = t0_ >> 4;
#pragma unroll
        for (int kk = 0; kk < 64; ++kk) wreg[kk] = W[(size_t)(part * 64 + kk) * ldw + e];
    }
    for (int it = bid_opaque(); it < TT_ / 8; it += grid_n()) {
        const int tid = tid_opaque(), wid = tid >> 6, lane = tid & 63;
        const int tok = it * 8 + wid, b = tok >> 11;
        const float* xin = (MODE == 0 && l == 0) ? p->in[X] : p->xres;
        f32x4 v[8];
#pragma unroll
        for (int i = 0; i < 8; ++i) v[i] = *(const f32x4*)(xin + (size_t)tok * DM_ + (i * 64 + lane) * 4);
        const float* g = MODE == 0 ? p->in[N1G] + l * DM_ : (MODE == 1 ? p->in[N2G] + l * DM_ : p->in[FING]);
        f32x4 gv[8];
#pragma unroll
        for (int i = 0; i < 8; ++i) gv[i] = *(const f32x4*)(g + (i * 64 + lane) * 4);
        if (MODE == 2 || (MODE == 0 && l > 0)) {
            const int myslot = lane < 16 ? p->tinv[tok * 16 + lane] : -1;
            unsigned long long em = __ballot(myslot >= 0);
            while (em) {
                const int e = __builtin_ctzll(em); em &= em - 1;
                const int slot = __shfl(myslot, e, 64);
                const bf16_t* yr = p->ybuf + ((size_t)(b * 16 + e) * 256 + slot) * DM_;
                uint2 y[8];
#pragma unroll
                for (int i = 0; i < 8; ++i) y[i] = *(const uint2*)(yr + (i * 64 + lane) * 4);
#pragma unroll
                for (int i = 0; i < 8; ++i) { v[i][0] += __uint_as_float(y[i].x << 16); v[i][1] += __uint_as_float(y[i].x & 0xffff0000u); v[i][2] += __uint_as_float(y[i].y << 16); v[i][3] += __uint_as_float(y[i].y & 0xffff0000u); }
            }
        }
        float ss = 0.f;
#pragma unroll
        for (int i = 0; i < 8; ++i) ss += v[i][0] * v[i][0] + v[i][1] * v[i][1] + v[i][2] * v[i][2] + v[i][3] * v[i][3];
#pragma unroll
        for (int o = 32; o > 0; o >>= 1) ss += __shfl_xor(ss, o, 64);
        const float rs = rsqrtf(ss * (1.0f / DM_) + 1e-6f);
        if (MODE != 2) __syncthreads();
#pragma unroll
        for (int i = 0; i < 8; ++i) {
            const int c = (i * 64 + lane) * 4;
            const f32x4 y = (f32x4){v[i][0] * rs * gv[i][0], v[i][1] * rs * gv[i][1], v[i][2] * rs * gv[i][2], v[i][3] * rs * gv[i][3]};
            if (MODE == 0 && l > 0) *(f32x4*)(p->xres + (size_t)tok * DM_ + c) = v[i];
            if (MODE == 2) *(f32x4*)(p->out + (size_t)tok * DM_ + c) = y;
            else {
                uint2 o; o.x = cvt_pk_bf16(y[0], y[1]); o.y = cvt_pk_bf16(y[2], y[3]);
                *(uint2*)(p->hb + (size_t)tok * DM_ + c) = o;
                *(f32x4*)(hrow + wid * DM_ + c) = y;
            }
        }
        if (MODE != 2) {
            __syncthreads();
            const int e = tid & 15, part = tid >> 4;
            float acc[8] = {0.f, 0.f, 0.f, 0.f, 0.f, 0.f, 0.f, 0.f};
#pragma unroll
            for (int kk = 0; kk < 64; kk += 4) {
#pragma unroll
                for (int t = 0; t < 8; ++t) { const f32x4 hv = *(const f32x4*)(hrow + t * DM_ + part * 64 + kk);
                    acc[t] += hv[0] * wreg[kk]; acc[t] += hv[1] * wreg[kk + 1]; acc[t] += hv[2] * wreg[kk + 2]; acc[t] += hv[3] * wreg[kk + 3]; }
            }
#pragma unroll
            for (int t = 0; t < 8; ++t) red[(t * 32 + part) * 16 + e] = acc[t];
            __syncthreads();
            if (tid < 128) {
                const int tl = tid >> 4, e2 = tid & 15; float s = 0.f;
                for (int q = 0; q < 32; ++q) s += red[(tl * 32 + q) * 16 + e2];
                const int tk = it * 8 + tl;
                if (MODE == 0) p->dtraw[(size_t)tk * 16 + e2] = s;
                else {
                    float m = s;
#pragma unroll
                    for (int o = 8; o > 0; o >>= 1) m = fmaxf(m, __shfl_xor(m, o, 64));
                    const float ex = expf(s - m); float z = ex;
#pragma unroll
                    for (int o = 8; o > 0; o >>= 1) z += __shfl_xor(z, o, 64);
                    p->aff[(size_t)tk * 16 + e2] = ex / z;
                }
            }
        }
    }
}
__device__ __forceinline__ int block_sum_512(int v, volatile int* red  , int par, int tid) {
#pragma unroll
    for (int o = 32; o > 0; o >>= 1) v += __shfl_xor(v, o, 64);
    if ((tid & 63) == 0) red[par * 8 + (tid >> 6)] = v;
    __syncthreads();
    int s = 0;
#pragma unroll
    for (int w = 0; w < 8; ++w) s += red[par * 8 + w];
    return s;
}
__device__ __forceinline__ int block_exscan_512(int v, volatile int* wsum  , int tid) {
    int inc = v;
#pragma unroll
    for (int o = 1; o < 64; o <<= 1) { const int n = __shfl_up(inc, o, 64); if ((tid & 63) >= o) inc += n; }
    if ((tid & 63) == 63) wsum[tid >> 6] = inc;
    __syncthreads();
    int base = 0;
#pragma unroll
    for (int w = 0; w < 8; ++w) base += (w < (tid >> 6)) ? wsum[w] : 0;
    __syncthreads();
    return base + inc - v;
}
__device__ __forceinline__ void phase_topk(char* shm, MPc p) {
    volatile int* red = (volatile int*)shm;
    volatile int* wsum = red + 16;
    for (int z = bid_opaque(); z < 64; z += grid_n()) {
        const int b = z >> 4, e = z & 15, tid = tid_opaque();
        __syncthreads();
        float v[4]; unsigned u[4];
#pragma unroll
        for (int i = 0; i < 4; ++i) { v[i] = p->aff[(size_t)(b * SEQ_ + tid * 4 + i) * 16 + e]; u[i] = __float_as_uint(v[i]); }
        unsigned T = 0u;
        for (int bit = 30; bit >= 0; --bit) {
            const unsigned cand = T | (1u << bit);
            const int c = block_sum_512((u[0] >= cand) + (u[1] >= cand) + (u[2] >= cand) + (u[3] >= cand), red, bit & 1, tid);
            if (c >= 256) T = cand;
        }
        __syncthreads();
        const int ngt = block_sum_512((u[0] > T) + (u[1] > T) + (u[2] > T) + (u[3] > T), red, 0, tid);
        const int need = 256 - ngt;
        __syncthreads();
        const int eq_l = (u[0] == T) + (u[1] == T) + (u[2] == T) + (u[3] == T);
        int eqr = block_exscan_512(eq_l, wsum, tid);
        int sel[4], nsel = 0;
#pragma unroll
        for (int i = 0; i < 4; ++i) { const bool isq = u[i] == T; sel[i] = (u[i] > T) || (isq && eqr < need); eqr += isq ? 1 : 0; nsel += sel[i]; }
        int slot = block_exscan_512(nsel, wsum, tid);
#pragma unroll
        for (int i = 0; i < 4; ++i) {
            const int t = tid * 4 + i;
            if (sel[i]) { p->tidx[z * 256 + slot] = t; p->tgat[z * 256 + slot] = v[i]; }
            p->tinv[(b * SEQ_ + t) * 16 + e] = sel[i] ? slot : -1;
            slot += sel[i];
        }
    }
}
__device__ __forceinline__ void phase_hy_filter(char* shm, MPc p) {
    float* zz = (float*)shm; float* ha = zz + 8 * 64; float* hbq = ha + 8 * 64;
    for (int u = bid_opaque(); u < 512; u += grid_n()) {
        const int lf = u >> 8, tid = tid_opaque(), wid = tid >> 6, o = tid & 63, i = (u & 255) * 8 + wid;
        const float* fw1 = p->in[FW1] + lf * 33 * 64; const float* fw2 = p->in[FW2] + lf * 4096; const float* fw3 = p->in[FW3] + lf * 4096; const float* fw4 = p->in[FW4] + lf * 64 * 512;
        const float t = (float)i / (float)(SEQ_ - 1);
        const float w = (2.0f * 3.14159265358979323846f / (float)SEQ_) * (float)i;
        __syncthreads();
        if (o == 0) zz[wid * 64] = t;
        if (o < 16) { const float band = 1e-4f + (float)o * ((15.0f - 1e-4f) / 15.0f); zz[wid * 64 + 1 + o] = __cosf(band * w); zz[wid * 64 + 17 + o] = -__sinf(band * w); }
        __syncthreads();
        const float fq = p->in[FREQ][lf * 64 + o];
        float s = p->in[FB1][lf * 64 + o];
        for (int k = 0; k < 33; ++k) s += zz[wid * 64 + k] * fw1[k * 64 + o];
        ha[wid * 64 + o] = __sinf(fq * s);
        __syncthreads();
        s = p->in[FB2][lf * 64 + o];
        for (int k = 0; k < 64; ++k) s += ha[wid * 64 + k] * fw2[k * 64 + o];
        hbq[wid * 64 + o] = __sinf(fq * s);
        __syncthreads();
        s = p->in[FB3][lf * 64 + o];
        for (int k = 0; k < 64; ++k) s += hbq[wid * 64 + k] * fw3[k * 64 + o];
        __syncthreads();
        ha[wid * 64 + o] = __sinf(fq * s);
        __syncthreads();
        { const float d0 = logf(1e-2f) / 1.5f, d1 = logf(1e-2f) / 0.3f;
          const int c = tid;
          float a8[8] = {0.f, 0.f, 0.f, 0.f, 0.f, 0.f, 0.f, 0.f};
          for (int k = 0; k < 64; ++k) { const float wv = fw4[k * 512 + c];
#pragma unroll
              for (int q = 0; q < 8; ++q) a8[q] += ha[q * 64 + k] * wv; }
          const float delta = fabsf(d0 + (float)c * ((d1 - d0) / 511.0f));
#pragma unroll
          for (int q = 0; q < 8; ++q) { const int iq = (u & 255) * 8 + q; const float tq = (float)iq / (float)(SEQ_ - 1);
              p->fr[((size_t)lf * SEQ_ + iq) * 512 + c] = a8[q] * __expf(-2.0f * fabsf(tq - 0.5f) * delta); } }
    }
}
__device__ __forceinline__ void phase_hy_norm(MPc p) {
    for (int u = bid_opaque(); u < 128; u += grid_n()) {
        const int tid = tid_opaque(), pr = u * 8 + (tid >> 6), lane = tid & 63, lf = pr >> 9, c = pr & 511;
        float s = 0.f;
        for (int q = 0; q < 32; ++q) s += fabsf(p->fr[((size_t)lf * SEQ_ + lane + 64 * q) * 512 + c]);
#pragma unroll
        for (int o = 32; o > 0; o >>= 1) s += __shfl_xor(s, o, 64);
        if (lane == 0) p->nrm[pr] = s;
    }
}

__device__ __forceinline__ GP mk_gp(MPc p, int l, int which) {
    GP g{};
    if (which == 0) { g.A = p->hb; g.Bt = p->wtin + (size_t)l * 13824 * DM_; g.bias = p->in[BG] + (size_t)l * 4 * DM_; g.Cb = p->proj; g.Cb2 = p->gates; g.Vt = p->vt; }
    if (which == 1) { g.A = p->br; g.Bt = p->wtbr + (size_t)l * 4 * DM_ * 512; g.G = p->gates; g.Cb = p->mrg; }
    if (which == 2) { g.A = p->mrg; g.Bt = p->wtout + (size_t)l * DM_ * DM_; g.R = l == 0 ? p->in[X] : p->xres; g.Cf = p->xres; }
    if (which == 3) { g.A = p->hb; g.B = p->in[W1] + (size_t)l * 16 * DM_ * DM_; g.B2 = p->in[W3] + (size_t)l * 16 * DM_ * DM_; g.idx = p->tidx; g.Cb = p->hid; }
    if (which == 4) { g.A = p->hid; g.B = p->in[W2] + (size_t)l * 16 * DM_ * DM_; g.gate = p->tgat; g.Cb = p->ybuf; }
    return g;
}
__device__ __forceinline__ HP mk_hp(MPc p, int l) {
    HP h{}; h.proj = p->proj; h.fr = p->fr + (size_t)l * SEQ_ * 512; h.nrm = p->nrm + l * 512; h.pp = p->hpp + (size_t)l * 512 * HY_PPW; h.vvt = p->vvt; h.yt = p->hyt;
    h.cw = p->in[HCW] + l * 3 * 1536; h.cb = p->in[HCB] + l * 1536; h.hbias = p->in[HBIAS] + l * 512; h.br = p->br; return h;
}
__device__ __forceinline__ LP mk_lp(MPc p, int l) {
    LP q{}; q.proj = p->proj; q.cw = p->in[LCW] + l * 4 * 512; q.cb = p->in[LCB] + l * 512; q.wt = p->lruwt + (size_t)l * 8 * 256 * 64; q.ba = p->in[LBA] + l * 1024;
    q.bx = p->in[LBX] + l * 1024; q.lam = p->in[LLAM] + l * 1024; q.sumP = p->sumP; q.sumE = p->sumE; q.br = p->br; return q;
}
__device__ __forceinline__ SP_ mk_sp(MPc p, int l) {
    SP_ s{}; s.proj = p->proj; s.dtraw = p->dtraw; s.cw = p->in[SCW] + l * 4 * 1024; s.cb = p->in[SCB] + l * 1024; s.dtb = p->in[SDTB] + l * 16; s.a_log = p->in[SALOG] + l * 16; s.dsk = p->in[SD] + l * 8; s.ng = p->in[SNG] + l * 512;
    s.xa = p->sxa; s.xT = p->sxT; s.states = p->states; s.decay = p->sdec; s.prev = p->sprev; s.br = p->br; return s;
}
__device__ __forceinline__ AP mk_ap(MPc p, int l) {
    AP a{}; a.proj = p->proj; a.vt = p->vt; a.rel_bias = p->in[RELB]; a.dlam = p->in[DLAM] + l * 256; a.subg = p->in[DSUB] + l * 128; a.br = p->br; a.lam_init = l == 0 ? 0.2f : 0.35550906759096926f; return a;
}
__device__ __forceinline__ void wconv_tile(float* tile, const float* src, size_t ld_src, bf16_t* dst, size_t ld_dst, int tid) {
    __syncthreads();
    { const int kr = tid >> 4, n4 = (tid & 15) * 4;
#pragma unroll
      for (int h = 0; h < 2; ++h) { const f32x4 v = *(const f32x4*)(src + (size_t)(kr + 32 * h) * ld_src + n4); float* t = tile + (kr + 32 * h) * 65 + n4; t[0] = v[0]; t[1] = v[1]; t[2] = v[2]; t[3] = v[3]; } }
    __syncthreads();
    { const int n = tid >> 3, k8 = (tid & 7) * 8; const float* t = tile + k8 * 65 + n;
      uint4 o; o.x = cvt_pk_bf16(t[0], t[65]); o.y = cvt_pk_bf16(t[130], t[195]); o.z = cvt_pk_bf16(t[260], t[325]); o.w = cvt_pk_bf16(t[390], t[455]);
      *(uint4*)(dst + (size_t)n * ld_dst + k8) = o; }
}
__device__ __forceinline__ void phase_wconv(char* shm, MPc p, int l, int bw0, int bwn) {
    const int bq = bid_opaque() - bw0; if (bq < 0 || bq >= bwn) return;
    for (int e0 = bq * 512 + tid_opaque(); e0 < 8 * 256 * 64; e0 += bwn * 512) {
        const int e = l * 8 * 256 * 64 + e0; const int i = e & 63, n = (e >> 6) & 255, h = (e >> 14) & 7, j = n & 63, g = (n >> 6) & 1, dir = n >> 7;
        const float* w = (g ? p->in[LWX] : p->in[LWA]) + ((size_t)((l * 2 + dir) * 8 + h) * 64 + i) * 64 + j;
        p->lruwt[e] = f2bf(*w);
    }
    float* tile = (float*)shm;
    const int NJ_IN = 32 * 216, NJ_BR = 4 * 8 * 32, NJ_OUT = 32 * 32, NJ = NJ_IN + NJ_BR + NJ_OUT;
    for (int u = bq; u < NJ; u += bwn) {
        int j = u; const int tid = tid_opaque();
        if (j < NJ_IN) { const int nt = j % 216, kt = j / 216, n0 = nt * 64, ns = n0 < PROJW ? n0 : n0 + 16;
            wconv_tile(tile, p->in[WIN] + (size_t)l * DM_ * INC_ + (size_t)kt * 64 * INC_ + ns, INC_, p->wtin + ((size_t)l * 13824 + n0) * DM_ + kt * 64, DM_, tid); }
        else if (j < NJ_IN + NJ_BR) { j -= NJ_IN; const int nt = j & 31, kt = (j >> 5) & 7, k = j >> 8;
            wconv_tile(tile, p->in[WBR] + ((size_t)(l * 4 + k) * 512 + kt * 64) * DM_ + nt * 64, DM_, p->wtbr + (((size_t)(l * 4 + k) * DM_) + nt * 64) * 512 + kt * 64, 512, tid); }
        else { j -= NJ_IN + NJ_BR; const int nt = j & 31, kt = j >> 5;
            wconv_tile(tile, p->in[WOUT] + ((size_t)l * DM_ + kt * 64) * DM_ + nt * 64, DM_, p->wtout + ((size_t)l * DM_ + nt * 64) * DM_ + kt * 64, DM_, tid); }
    }
}
#define PH_ON(id) (ONLY < 0 || ONLY == (id))
#define PH_SYNC(id) do { if (ONLY < 0) xcd_barrier(bar); } while (0)
template <int ONLY>
__global__ void __launch_bounds__(512, 2) k_mega(MP p_unused) {
    extern __shared__ __attribute__((aligned(1024))) char shm[];
    XcdBarrier bar{};
    if (ONLY < 0) {
        volatile LAS unsigned* xbw = (volatile LAS unsigned*)(shm + MEGA_LDS - 16);
        if (threadIdx.x == 0) { xbw[0] = 0u; xbw[1] = 0u; }
        __syncthreads();
        bar = xcd_barrier_post(params()->bar, xbw);
        if (threadIdx.x == 0) { unsigned nloc, nx; xcd_barrier_complete(bar.bar, bar.x, nloc, nx); xbw[0] = nloc; xbw[1] = nx; }
        __syncthreads();
    }
    constexpr int L0 = ONLY < 0 ? 0 : (ONLY >= 2 * NPH ? 2 : ONLY / NPH), L1 = ONLY < 0 ? 2 : (ONLY >= 2 * NPH ? 2 : ONLY / NPH + 1);
#pragma unroll 1
    for (int l = L0; l < L1; ++l) {
        const int id0 = l * NPH;
        if (PH_ON(id0 + 0)) { phase_norm<0>(shm, params(), l); if (l == 0) { phase_hy_filter(shm, params()); phase_wconv(shm, params(), 0, 0, grid_n()); } }
        PH_SYNC(id0 + 0);
        if (PH_ON(id0 + 1)) { if (l == 0) phase_hy_norm(params()); const GP g = mk_gp(params(), l, 0);
            const pg8::Gemm gg{g.A, g.Bt, TT_, 13824, DM_, DM_, DM_}; const pg8::MegaOrder so{32, 54, grid_n(), bid_opaque()}; const pg8::EpiInproj ep{g.Cb, g.Cb2, g.Vt, g.bias};
            pg8::gemm_phase<pg8::EpiInproj, pg8::MegaOrder, false>((PG8_LAS unsigned char*)shm, gg, so, ep, nullptr); }
        PH_SYNC(id0 + 1);
        if (PH_ON(id0 + 2)) {
            { const AP a = mk_ap(params(), l); phase_attn(shm, a); }
            if (l == 0) { const HP h0 = mk_hp(params(), 0); phase_hy_pp(h0); const HP h1 = mk_hp(params(), 1); phase_hy_pp(h1); }
            { const HP h = mk_hp(params(), l); phase_hy_prep(shm, h); }
            { const SP_ s = mk_sp(params(), l); phase_ssd_prep(shm, s); }
            { const LP q = mk_lp(params(), l); phase_lru<0>(shm, q); }
        }
        PH_SYNC(id0 + 2);
        if (PH_ON(id0 + 3)) {
            { const HP h = mk_hp(params(), l); phase_hy_conv(shm, h); }
            { const SP_ s = mk_sp(params(), l); phase_ssd_states(shm, s); }
            { const LP q = mk_lp(params(), l); phase_lru<1>(shm, q); }
        }
        PH_SYNC(id0 + 3);
        if (PH_ON(id0 + 4)) { const SP_ s = mk_sp(params(), l); phase_ssd_scan(s); }
        PH_SYNC(id0 + 4);
        if (PH_ON(id0 + 5)) { { const SP_ s = mk_sp(params(), l); phase_ssd_out(shm, s); }
            { const HP h = mk_hp(params(), l); phase_hy_fin(shm, h, 0, grid_n()); }
            if (l == 0) phase_wconv(shm, params(), 1, 0, grid_n()); }
        PH_SYNC(id0 + 5);
#if MERGE_PG8
        if (PH_ON(id0 + 6)) { const GP g = mk_gp(params(), l, 1);
            const pg8::Gemm gg{g.A, g.Bt, TT_, DM_, 512, DM_, 512}; const pg8::MergeOrder so{grid_n(), bid_opaque()}; const pg8::EpiMerge ep{g.G, params()->m32, g.Cb};
            pg8::gemm_phase<pg8::EpiMerge, pg8::MergeOrder, false>((PG8_LAS unsigned char*)shm, gg, so, ep, nullptr); }
#else
        if (PH_ON(id0 + 6)) { const GP g = mk_gp(params(), l, 1); phase_merge(shm, g); }
#endif
        PH_SYNC(id0 + 6);
        if (PH_ON(id0 + 7)) { const GP g = mk_gp(params(), l, 2);
            const pg8::Gemm gg{g.A, g.Bt, TT_, DM_, DM_, DM_, DM_}; const pg8::MegaOrder so{32, 8, grid_n(), bid_opaque()}; const pg8::EpiOutproj ep{g.R, g.Cf};
            pg8::gemm_phase<pg8::EpiOutproj, pg8::MegaOrder, false>((PG8_LAS unsigned char*)shm, gg, so, ep, nullptr); }
        PH_SYNC(id0 + 7);
        if (PH_ON(id0 + 8)) phase_norm<1>(shm, params(), l);
        PH_SYNC(id0 + 8);
        if (PH_ON(id0 + 9)) phase_topk(shm, params());
        PH_SYNC(id0 + 9);
        if (PH_ON(id0 + 10)) { const GP g = mk_gp(params(), l, 3); phase_moe_up(shm, g); }
        PH_SYNC(id0 + 10);
        #if MOE_DOWN2
        if (PH_ON(id0 + 11)) phase_moe_down2(shm, params(), l);
#else
        if (PH_ON(id0 + 11)) { const GP g = mk_gp(params(), l, 4); phase_moe_down(shm, g); }
#endif
        PH_SYNC(id0 + 11);
    }
    if (PH_ON(2 * NPH)) phase_norm<2>(shm, params(), 0);
}
template <int I> struct PhaseLauncher { static void go(int grid, hipStream_t st, const MP& p) { (void)hipFuncSetAttribute((const void*)k_mega<I>, hipFuncAttributeMaxDynamicSharedMemorySize, MEGA_LDS); hipLaunchKernelGGL(k_mega<I>, dim3(grid), dim3(512), MEGA_LDS, st, p); PhaseLauncher<I + 1>::go(grid, st, p); } };
template <> struct PhaseLauncher<2 * NPH + 1> { static void go(int, hipStream_t, const MP&) {} };

#ifndef MK_N_LAUNCHES
#define MK_N_LAUNCHES 1
#endif
extern "C" void kernel_launch(void* const* d_in, const int* in_sizes, int n_in, void* d_out, int out_size, void* d_ws, size_t ws_size, hipStream_t stream) {
    static int grid = 0;
    if (grid == 0) {
        int dev = 0, cus = 0;
        if (hipGetDevice(&dev) != hipSuccess || hipDeviceGetAttribute(&cus, hipDeviceAttributeMultiprocessorCount, dev) != hipSuccess) { fprintf(stderr, "kernel_launch: device query failed\n"); grid = -1; return; }
        if (hipFuncSetAttribute((const void*)k_mega<-1>, hipFuncAttributeMaxDynamicSharedMemorySize, MEGA_LDS) != hipSuccess) { fprintf(stderr, "kernel_launch: hipFuncSetAttribute failed\n"); grid = -1; return; }
        (void)hipGetLastError();
        grid = cus;
    }
    if (grid < 0) return;
    char* w = (char*)d_ws; size_t off = 0;
    auto alloc = [&](size_t bytes) { void* q = w + off; off += (bytes + 255) & ~(size_t)255; return q; };
    MP p{};
    for (int i = 0; i < 39; ++i) p.in[i] = (const float*)d_in[i];
    p.out = (float*)d_out; p.ngrid = grid;
    p.bar = (unsigned*)alloc(XCD_BAR_WORDS * 4 + GRP_COUNT * GRP_WORDS * 4); p.grp = p.bar + XCD_BAR_WORDS;
    p.panel = (bf16_t*)alloc((size_t)256 * 256 * DM_ * 2);
    p.xres = (float*)alloc((size_t)TT_ * DM_ * 4);
    p.hb = (bf16_t*)alloc((size_t)TT_ * DM_ * 2);
    p.proj = (bf16_t*)alloc((size_t)TT_ * PROJW * 2);
    p.gates = (bf16_t*)alloc((size_t)TT_ * 8192 * 2);
    p.dtraw = (float*)alloc((size_t)TT_ * 16 * 4);
    p.br = (bf16_t*)alloc((size_t)TT_ * DM_ * 2);
    p.mrg = (bf16_t*)alloc((size_t)TT_ * DM_ * 2);
    p.fr = (float*)alloc((size_t)2 * SEQ_ * 512 * 4);
    p.nrm = (float*)alloc(2 * 512 * 4);
    p.hpp = (unsigned*)alloc((size_t)2 * 512 * HY_PPW * 4);
    p.vvt = (bf16_t*)alloc((size_t)512 * NB_ * SEQ_ * 2);
    p.hyt = (float*)alloc((size_t)512 * NB_ * SEQ_ * 4);
    p.vt = (bf16_t*)alloc((size_t)NB_ * 512 * SEQ_ * 2);
    p.sumP = (float*)alloc((size_t)2 * NB_ * 32 * 512 * 4);
    p.sumE = (float*)alloc((size_t)2 * NB_ * 32 * 512 * 4);
    p.sxa = (bf16_t*)alloc((size_t)TT_ * 1024 * 2);
    p.sxT = (bf16_t*)alloc((size_t)TT_ * 1024 * 2);
    p.states = (float*)alloc((size_t)NB_ * SSD_NC * 16 * 64 * 128 * 4);
    p.sdec = (float*)alloc(NB_ * SSD_NC * 16 * 4);
    p.sprev = (bf16_t*)alloc((size_t)NB_ * SSD_NC * 16 * 64 * 128 * 2);
    p.aff = (float*)alloc((size_t)TT_ * 16 * 4);
    p.tidx = (int*)alloc(64 * 256 * 4);
    p.tgat = (float*)alloc(64 * 256 * 4);
    p.tinv = (int*)alloc((size_t)TT_ * 16 * 4);
    p.hid = (bf16_t*)alloc((size_t)64 * 256 * DM_ * 2);
    p.ybuf = (bf16_t*)alloc((size_t)64 * 256 * DM_ * 2);
    p.wtin = (bf16_t*)alloc((size_t)2 * 13824 * DM_ * 2);
    p.wtbr = (bf16_t*)alloc((size_t)2 * 4 * DM_ * 512 * 2);
    p.wtout = (bf16_t*)alloc((size_t)2 * DM_ * DM_ * 2);
    p.lruwt = (bf16_t*)alloc((size_t)2 * 8 * 256 * 64 * 2);
    p.m32 = (float*)alloc((size_t)TT_ * DM_ * 4);
    if (off > ws_size) { fprintf(stderr, "kernel_launch: workspace too small (%zu > %zu)\n", off, ws_size); return; }
    (void)hipMemsetAsync(p.bar, 0, XCD_BAR_WORDS * 4 + GRP_COUNT * GRP_WORDS * 4, stream);
#if MK_N_LAUNCHES == 1
    hipLaunchKernelGGL(k_mega<-1>, dim3(grid), dim3(512), MEGA_LDS, stream, p);
#else
    PhaseLauncher<0>::go(grid, stream, p);
#endif
}
```

```cpp
#include <hip/hip_runtime.h>
#include <math.h>
#include <stdint.h>
#include <stdio.h>

#define NB_ 4
#define SEQ_ 2048
#define DM_ 2048
#define TT_ 8192
#define INC_ 13840
#define O_HY 0
#define O_LRU 1536
#define O_DA 2560
#define O_SSD 4096
#define O_GATE 5648
typedef short bf16x8 __attribute__((ext_vector_type(8)));
typedef float f32x4 __attribute__((ext_vector_type(4)));
typedef float f32x2 __attribute__((ext_vector_type(2)));
typedef int i32x4 __attribute__((ext_vector_type(4)));
typedef unsigned short bf16_t;
__device__ __forceinline__ int bid_opaque();
__device__ __forceinline__ int grid_n();

typedef __bf16 bf16x2_t __attribute__((ext_vector_type(2)));
__device__ __forceinline__ unsigned cvt_pk_bf16(float lo, float hi) { const f32x2 v = {lo, hi}; return __builtin_bit_cast(unsigned, __builtin_convertvector(v, bf16x2_t)); }
__device__ __forceinline__ int tid_opaque() { int t = (int)__builtin_amdgcn_workitem_id_x(); asm volatile("" : "+v"(t)); return t; }
__device__ __forceinline__ float bf2f(bf16_t v) { return __uint_as_float((unsigned)v << 16); }
__device__ __forceinline__ bf16_t f2bf(float f) { return (bf16_t)(cvt_pk_bf16(f, 0.f) & 0xffffu); }

__device__ __forceinline__ int lds_rc(int r, int chunk) { return r * 128 + ((chunk ^ ((r >> 1) & 7)) << 4); }
#define GEMM_LDS_BYTES(BM) (2 * ((BM) * 128 + 256 * 128))
#ifndef GEMM_L2PF
#define GEMM_L2PF 0
#endif
#ifndef GEMM_BT_AH
#define GEMM_BT_AH 8
#endif

#define GEMM_KTILE(buf, HOOK) do { const char* sS = shm + (buf) * STAGE; bf16x8 Bc[4], Bn[4], Ar[4]; \
        _Pragma("unroll") for (int n = 0; n < 4; ++n) Bc[n] = *(const bf16x8*)(sS + broff0 + n * 2048); \
        _Pragma("unroll") for (int q = 0; q < 3; ++q) Ar[q] = *(const bf16x8*)(sS + aroff0 + q * 2048); \
        __builtin_amdgcn_sched_barrier(0); \
        _Pragma("unroll") for (int g = 0; g < 2 * FM; ++g) { \
            if (g + 3 < 2 * FM) Ar[(g + 3) & 3] = *(const bf16x8*)(sS + ((g + 3) / FM ? aroff1 : aroff0) + ((g + 3) % FM) * 2048); \
            if (g == FM - 4) { _Pragma("unroll") for (int n = 0; n < 4; ++n) Bn[n] = *(const bf16x8*)(sS + broff1 + n * 2048); } \
            __builtin_amdgcn_sched_barrier(0); \
            _Pragma("unroll") for (int n = 0; n < 4; ++n) acc[g % FM][n] = __builtin_amdgcn_mfma_f32_16x16x32_bf16(Ar[g & 3], (g < FM ? Bc[n] : Bn[n]), acc[g % FM][n], 0, 0, 0); \
            HOOK(g); \
            __builtin_amdgcn_sched_barrier(0); } } while (0)
template <int BM, bool DUAL>
struct GemmCore {
    static constexpr int FM = BM / 32;
    static constexpr int GLA = BM * 128 / 8192;
    static constexpr int TILE_A = BM * 128, TILE_B = 256 * 128, STAGE = TILE_A + TILE_B;

    template <class AccT>
    static __device__ __forceinline__ void run(char* shm, const char* abase, const unsigned (&aoff)[GLA], const char* bl, unsigned ldb, int nt, AccT& acc) {
        const int tid = tid_opaque(), wid = tid >> 6, lane = tid & 63, wr = wid >> 2, wc = wid & 3, fr = lane & 15, fq = lane >> 4;
        const int kq = lane & 3, ngl = lane >> 2, ksub = wid & 1, grp = wid >> 1;
        i32x4 sa[GLA];
        f32x4 sb[8];
        const int awoff = lds_rc(tid >> 3, tid & 7);
        const int bwoff = TILE_A + lds_rc(grp * 64 + ngl, ksub * 4 + kq);
        const int aroff0 = lds_rc(wr * (BM / 2) + fr, fq), aroff1 = lds_rc(wr * (BM / 2) + fr, 4 + fq);
        const int broff0 = TILE_A + lds_rc(wc * 64 + fr, fq), broff1 = TILE_A + lds_rc(wc * 64 + fr, 4 + fq);
#define G_ISSUE(kt) do { const char* ab_ = abase + (size_t)(kt) * 128; _Pragma("unroll") for (int i = 0; i < GLA; ++i) sa[i] = *(const i32x4*)(ab_ + aoff[i]); \
        _Pragma("unroll") for (int r = 0; r < 8; ++r) sb[r] = *(const f32x4*)(bl + (size_t)((kt) * 64 + r) * ldb); \
        __builtin_amdgcn_sched_barrier(0); } while (0)
#define G_WRITE(buf) do { char* sbase = shm + (buf) * STAGE; _Pragma("unroll") for (int i = 0; i < GLA; ++i) *(i32x4*)(sbase + awoff + i * 8192) = sa[i]; \
        _Pragma("unroll") for (int i = 0; i < 4; ++i) { i32x4 w; w[0] = (int)cvt_pk_bf16(sb[0][i], sb[1][i]); w[1] = (int)cvt_pk_bf16(sb[2][i], sb[3][i]); \
              w[2] = (int)cvt_pk_bf16(sb[4][i], sb[5][i]); w[3] = (int)cvt_pk_bf16(sb[6][i], sb[7][i]); *(i32x4*)(sbase + bwoff + i * 2048) = w; } } while (0)
        G_ISSUE(0); G_WRITE(0); if (nt > 1) G_ISSUE(1); __syncthreads();
        for (int t = 0; t < nt; ++t) {
            const int cur = t & 1; const bool w_ok = t + 1 < nt, i_ok = t + 2 < nt;
            char* wb_ = shm + (cur ^ 1) * STAGE; const char* ab2_ = abase + (size_t)(t + 2) * 128; const char* bl2_ = bl + (size_t)(t + 2) * 64 * ldb;
#define G_HOOK(g) do { if ((g) < GLA) { if (w_ok) *(i32x4*)(wb_ + awoff + (g) * 8192) = sa[(g)]; if (i_ok) sa[(g)] = *(const i32x4*)(ab2_ + aoff[(g)]); } \
            else if ((g) >= 8 && (g) < 12) { if (w_ok) { const int i = (g) - 8; i32x4 w; w[0] = (int)cvt_pk_bf16(sb[0][i], sb[1][i]); w[1] = (int)cvt_pk_bf16(sb[2][i], sb[3][i]); \
                  w[2] = (int)cvt_pk_bf16(sb[4][i], sb[5][i]); w[3] = (int)cvt_pk_bf16(sb[6][i], sb[7][i]); *(i32x4*)(wb_ + bwoff + i * 2048) = w; } } \
            else if ((g) >= 12) { if (i_ok) { const int r = ((g) - 12) * 2; sb[r] = *(const f32x4*)(bl2_ + (size_t)r * ldb); sb[r + 1] = *(const f32x4*)(bl2_ + (size_t)(r + 1) * ldb); } } } while (0)
            GEMM_KTILE(cur, G_HOOK);
#undef G_HOOK
            __syncthreads();
        }
#undef G_ISSUE
#undef G_WRITE
    }
    struct NoEpi { __device__ __forceinline__ void operator()(int) const {} __device__ __forceinline__ void pre(int) const {} };
    template <class AccT>
    static __device__ __forceinline__ void run_bt(char* shm, const char* abase, const unsigned (&aoff)[GLA], const char* bbase, const unsigned (&boff)[4], unsigned ldbt, const char* pf_in, int nt, AccT& acc) {
        run_bt_seg<1 << 20>(shm, abase, aoff, bbase, boff, ldbt, 0, pf_in, nt, acc, NoEpi());
    }
    template <int SEG, class AccT, class Epi>
    static __device__ __forceinline__ void run_bt_seg(char* shm, const char* abase, const unsigned (&aoff)[GLA], const char* bbase, const unsigned (&boff)[4], unsigned ldbt, size_t segstride, const char* pf_in, int nt, AccT& acc, Epi seg_epi) {
        const int tid = tid_opaque(), wid = tid >> 6, lane = tid & 63, wr = wid >> 2, wc = wid & 3, fr = lane & 15, fq = lane >> 4;
        i32x4 sa[GLA], sbt[4];
        const unsigned astr = 64u * DM_ * 2u, bstr = 64u * ldbt;
        const int awoff = lds_rc(tid >> 3, tid & 7);
        const int aroff0 = lds_rc(wr * (BM / 2) + fr, fq), aroff1 = lds_rc(wr * (BM / 2) + fr, 4 + fq);
        const int broff0 = TILE_A + lds_rc(wc * 64 + fr, fq), broff1 = TILE_A + lds_rc(wc * 64 + fr, 4 + fq);
#define T_ISSUE(kt) do { const char* ab_ = abase + (size_t)(kt) * 128 + aoff[0]; const char* bb_ = bbase + (size_t)((kt) / SEG) * segstride + (size_t)((kt) % SEG) * 128 + boff[0]; \
        _Pragma("unroll") for (int i = 0; i < GLA; ++i) sa[i] = *(const i32x4*)(ab_ + (size_t)i * astr); \
        _Pragma("unroll") for (int i = 0; i < 4; ++i) sbt[i] = *(const i32x4*)(bb_ + (size_t)i * bstr); \
        __builtin_amdgcn_sched_barrier(0); } while (0)
#define T_WRITE(buf) do { char* sbase = shm + (buf) * STAGE; _Pragma("unroll") for (int i = 0; i < GLA; ++i) *(i32x4*)(sbase + awoff + i * 8192) = sa[i]; \
        _Pragma("unroll") for (int i = 0; i < 4; ++i) *(i32x4*)(sbase + TILE_A + awoff + i * 8192) = sbt[i]; } while (0)
        const unsigned long long pf0 = (unsigned long long)pf_in;
        const unsigned long long pfu = ((unsigned long long)(unsigned)__builtin_amdgcn_readfirstlane((int)(pf0 >> 32)) << 32) | (unsigned)__builtin_amdgcn_readfirstlane((int)(unsigned)pf0);
        const char* pf = (const char*)pfu; const unsigned pfo = (unsigned)(pf0 - pfu);
        unsigned pfa = 0u, pfb = 0u;
        T_ISSUE(0); T_WRITE(0); if (nt > 1) T_ISSUE(1);
#if GEMM_L2PF
        if (nt > 2) pfa = *(const unsigned*)(pf + 2 * 128 + pfo);
#endif
        __syncthreads();
        for (int t = 0; t < nt; ++t) {
            const int cur = t & 1;
            const bool w_ok = t + 1 < nt, i_ok = t + 2 < nt;
            char* wb_ = shm + (cur ^ 1) * STAGE; const char* ab2_ = abase + (size_t)(t + 2) * 128 + aoff[0];
            const char* bb2_ = bbase + (size_t)((t + 2) / SEG) * segstride + (size_t)((t + 2) % SEG) * 128 + boff[0];
#define T_HOOK(g) do { if ((g) < GLA) { if (w_ok) *(i32x4*)(wb_ + awoff + (g) * 8192) = sa[(g)]; if (i_ok) sa[(g)] = *(const i32x4*)(ab2_ + (size_t)(g) * astr); } \
            else if ((g) < GLA + 4) { const int i = (g) - GLA; if (w_ok) *(i32x4*)(wb_ + TILE_A + awoff + i * 8192) = sbt[i]; if (i_ok) sbt[i] = *(const i32x4*)(bb2_ + (size_t)i * bstr); } } while (0)
#if GEMM_L2PF
            if (t + 3 < nt) pfb = *(const unsigned*)(pf + (size_t)(t + 3) * 128 + pfo);
            asm volatile("" :: "v"(pfa));
            pfa = pfb;
#endif
            if ((t % SEG) == SEG - 1) seg_epi.pre(t / SEG);
            GEMM_KTILE(cur, T_HOOK);
#undef T_HOOK
            __syncthreads();
            if ((t % SEG) == SEG - 1) seg_epi(t / SEG);
        }
#undef T_ISSUE
#undef T_WRITE
    }
    static __device__ __forceinline__ void bt_coord(int tid, int i, int& col, int& C) { const int R = (tid >> 3) + 64 * i; C = (tid & 7) * 8;
        col = (R & ~63) + 4 * (R & 15) + ((R >> 4) & 3); }
    static __device__ __forceinline__ void a_coord(int tid, int i, int& R, int& C) { R = (tid >> 3) + 64 * i; C = (tid & 7) * 8; }
    static __device__ __forceinline__ void b_coord(int tid, int& k, int& col, int& which) { const int wid = tid >> 6, lane = tid & 63; const int kq = lane & 3, ngl = lane >> 2, ksub = wid & 1, grp = wid >> 1;
        k = ksub * 32 + kq * 8; if (DUAL) { which = ngl >> 3; col = grp * 32 + 4 * (ngl & 7); } else { which = 0; col = grp * 64 + 4 * ngl; } }
};
#define PROJW 5632
__device__ __forceinline__ float sigmoidf_(float x) { return 1.0f / (1.0f + expf(-x)); }
__device__ __forceinline__ float siluf_(float x) { return x / (1.0f + expf(-x)); }
__device__ __forceinline__ float softplusf_(float x) { return x > 20.f ? x : log1pf(expf(x)); }
__device__ __forceinline__ float sigmoid_fast_(float x) { return __builtin_amdgcn_rcpf(1.0f + __expf(-x)); }
__device__ __forceinline__ float silu_fast_(float x) { return x * __builtin_amdgcn_rcpf(1.0f + __expf(-x)); }
__device__ __forceinline__ float softplus_fast_(float x) { const float e = __expf(x); const float sm = e * (1.0f - e * (0.5f - e * (1.0f / 3.0f))); return x > 15.f ? x : (e < 0.01f ? sm : __logf(1.0f + e)); }
__device__ __forceinline__ float gelu_tanh_(float x) { const float u2 = 1.5957691216057308f * (x + 0.044715f * x * x * x); return x * __builtin_amdgcn_rcpf(1.0f + __expf(-u2)); }

__device__ __forceinline__ float block_sum_256(float v, float* red) {
    for (int o = 32; o > 0; o >>= 1) v += __shfl_down(v, o, 64);
    __syncthreads();
    if ((tid_opaque() & 63) == 0) red[tid_opaque() >> 6] = v;
    __syncthreads();
    float r = red[0] + red[1] + red[2] + red[3];
    __syncthreads();
    return r;
}
__device__ __forceinline__ float block_max_256(float v, float* red) {
    for (int o = 32; o > 0; o >>= 1) v = fmaxf(v, __shfl_down(v, o, 64));
    __syncthreads();
    if ((tid_opaque() & 63) == 0) red[tid_opaque() >> 6] = v;
    __syncthreads();
    float r = fmaxf(fmaxf(red[0], red[1]), fmaxf(red[2], red[3]));
    __syncthreads();
    return r;
}

__device__ __forceinline__ int t5_bucket(int rel) {
    const int ret = rel > 0 ? 16 : 0; const int n = rel < 0 ? -rel : rel;
    if (n < 8) return ret + n;
    const float v = logf((float)n / 8.0f) / 2.772588722239781f * 8.0f;
    int large = 8 + (int)v; if (large > 15) large = 15;
    return ret + large;
}
struct AP { const bf16_t* proj; const bf16_t* vt; const float* rel_bias; const float* dlam; const float* subg; bf16_t* br; float lam_init; };
#define ATT_LDS (2 * 32768 + 2048)
__device__ __forceinline__ void phase_attn(char* shm, const AP& p) {
    float* btab = (float*)(shm + 65536);
    const float LOG2E = 1.4426950408889634f;
    for (int unit = bid_opaque(); unit < NB_ * 4 * 16; unit += grid_n()) {
        const int xq = unit & 7, sq = unit >> 3, bh = (xq * 2 + (sq >> 4)) & 15, qt = sq & 15, h = bh & 3, b = bh >> 2;
        const int tid = tid_opaque(), wid = tid >> 6, lane = tid & 63, fr = lane & 15, fq = lane >> 4;
        __syncthreads();
        if (tid < 257) btab[tid] = p.rel_bias[t5_bucket(tid - 128) * 4 + h] * LOG2E;
        float l0 = p.dlam[lane] * p.dlam[64 + lane], l1 = p.dlam[128 + lane] * p.dlam[192 + lane];
#pragma unroll
        for (int o = 32; o > 0; o >>= 1) { l0 += __shfl_xor(l0, o, 64); l1 += __shfl_xor(l1, o, 64); }
        const float lam = expf(l0) - expf(l1) + p.lam_init;
        const int q0 = qt * 128, qrow = q0 + wid * 16 + fr;
        bf16x8 qf[2][2];
        { const bf16_t* qp = p.proj + (size_t)(b * SEQ_ + qrow) * PROJW + O_DA + h * 128 + fq * 8;
#pragma unroll
          for (int i = 0; i < 2; ++i)
#pragma unroll
            for (int s = 0; s < 2; ++s) qf[i][s] = *(const bf16x8*)(qp + i * 64 + s * 32); }
        const bf16_t* kg[2]; const bf16_t* vg[2]; int kl[2], vl[2]; bool vswap[2];
#pragma unroll
        for (int u = 0; u < 2; ++u) {
            const int c = tid + u * 512;
            const int krow = c >> 4, kch = c & 15;
            kg[u] = p.proj + (size_t)(b * SEQ_ + krow) * PROJW + O_DA + 512 + h * 128 + kch * 8;
            kl[u] = krow * 256 + ((kch ^ (krow & 15)) * 16);
            const int dv = c >> 3, ch16 = c & 7;
            vg[u] = p.vt + (size_t)(b * 512 + h * 128 + dv) * SEQ_ + ch16 * 8;
            vl[u] = 16384 + dv * 128 + ((ch16 ^ ((dv & 15) >> 1)) * 16); vswap[u] = dv & 1;
        }
        i32x4 sk[2], sv[2];
#define A_ISSUE(kt) do { _Pragma("unroll") for (int u = 0; u < 2; ++u) { sk[u] = *(const i32x4*)(kg[u] + (size_t)(kt) * 64 * PROJW); sv[u] = *(const i32x4*)(vg[u] + (kt) * 64); } } while (0)
#define A_WRITE(buf) do { char* sb_ = shm + (buf) * 32768; _Pragma("unroll") for (int u = 0; u < 2; ++u) { *(i32x4*)(sb_ + kl[u]) = sk[u]; \
            i32x4 w_ = sv[u]; if (vswap[u]) w_ = (i32x4){sv[u][2], sv[u][3], sv[u][0], sv[u][1]}; *(i32x4*)(sb_ + vl[u]) = w_; } } while (0)
        f32x4 O[2][8];
#pragma unroll
        for (int i = 0; i < 2; ++i)
#pragma unroll
            for (int f = 0; f < 8; ++f) O[i][f] = (f32x4){0.f, 0.f, 0.f, 0.f};
        float mrun[2] = {-1e30f, -1e30f}, lrun[2] = {0.f, 0.f};
        A_ISSUE(0); A_WRITE(0); A_ISSUE(1); __syncthreads();
        const int NT = SEQ_ / 64;
        for (int kt = 0; kt < NT; ++kt) {
            const int cur = kt & 1;
            if (kt + 1 < NT) A_WRITE(cur ^ 1);
            if (kt + 2 < NT) A_ISSUE(kt + 2);
            const char* sK = shm + cur * 32768; const char* sV = sK + 16384;
            f32x4 S[2][4];
#pragma unroll
            for (int i = 0; i < 2; ++i)
#pragma unroll
                for (int kf = 0; kf < 4; ++kf) {
                    f32x4 a = (f32x4){0.f, 0.f, 0.f, 0.f};
#pragma unroll
                    for (int s = 0; s < 2; ++s) {
                        const int row = kf * 16 + fr, ch = i * 8 + s * 4 + fq;
                        const bf16x8 kfA = *(const bf16x8*)(sK + row * 256 + ((ch ^ (row & 15)) * 16));
                        a = __builtin_amdgcn_mfma_f32_16x16x32_bf16(kfA, qf[i][s], a, 0, 0, 0);
                    }
                    S[i][kf] = a;
                }
            const int k0 = kt * 64;
            const bool far_hi = (k0 >= q0 + 127 + 128), far_lo = (k0 + 63 <= q0 - 128);
            const float c1 = 0.125f * LOG2E;
            if (far_hi || far_lo) {
                const float bc_ = far_hi ? btab[256] : btab[0];
#pragma unroll
                for (int i = 0; i < 2; ++i)
#pragma unroll
                    for (int kf = 0; kf < 4; ++kf)
#pragma unroll
                        for (int j = 0; j < 4; ++j) S[i][kf][j] = S[i][kf][j] * c1 + bc_;
            } else {
#pragma unroll
                for (int kf = 0; kf < 4; ++kf)
#pragma unroll
                    for (int j = 0; j < 4; ++j) {
                        int rel = (k0 + kf * 16 + fq * 4 + j) - qrow; rel = rel < -128 ? -128 : (rel > 128 ? 128 : rel);
                        const float bv_ = btab[rel + 128];
                        S[0][kf][j] = S[0][kf][j] * c1 + bv_; S[1][kf][j] = S[1][kf][j] * c1 + bv_;
                    }
            }
            bf16x8 Pf[2][2];
#pragma unroll
            for (int i = 0; i < 2; ++i) {
                float mx = S[i][0][0];
#pragma unroll
                for (int kf = 0; kf < 4; ++kf)
#pragma unroll
                    for (int j = 0; j < 4; ++j) mx = fmaxf(mx, S[i][kf][j]);
                mx = fmaxf(mx, __shfl_xor(mx, 16, 64)); mx = fmaxf(mx, __shfl_xor(mx, 32, 64));
                const float mnew = fmaxf(mrun[i], mx);
                const float alpha = __builtin_amdgcn_exp2f(mrun[i] - mnew);
                mrun[i] = mnew;
                float ps = 0.f;
#pragma unroll
                for (int kf = 0; kf < 4; ++kf)
#pragma unroll
                    for (int j = 0; j < 4; ++j) { const float e = __builtin_amdgcn_exp2f(S[i][kf][j] - mnew); S[i][kf][j] = e; ps += e; }
                ps += __shfl_xor(ps, 16, 64); ps += __shfl_xor(ps, 32, 64);
                lrun[i] = lrun[i] * alpha + ps;
                if (__any(alpha != 1.0f)) {
#pragma unroll
                    for (int f = 0; f < 8; ++f) { O[i][f][0] *= alpha; O[i][f][1] *= alpha; O[i][f][2] *= alpha; O[i][f][3] *= alpha; }
                }
#pragma unroll
                for (int g = 0; g < 2; ++g) {
                    i32x4 w;
                    w[0] = (int)cvt_pk_bf16(S[i][2 * g][0], S[i][2 * g][1]); w[1] = (int)cvt_pk_bf16(S[i][2 * g][2], S[i][2 * g][3]);
                    w[2] = (int)cvt_pk_bf16(S[i][2 * g + 1][0], S[i][2 * g + 1][1]); w[3] = (int)cvt_pk_bf16(S[i][2 * g + 1][2], S[i][2 * g + 1][3]);
                    Pf[i][g] = __builtin_bit_cast(bf16x8, w);
                }
            }
#pragma unroll
            for (int f = 0; f < 8; ++f)
#pragma unroll
                for (int g = 0; g < 2; ++g) {
                    const int dv = f * 16 + fr, x = dv & 15;
                    const uint2 v0 = *(const uint2*)(sV + dv * 128 + (((8 * g + fq) ^ x) * 8));
                    const uint2 v1 = *(const uint2*)(sV + dv * 128 + (((8 * g + 4 + fq) ^ x) * 8));
                    const i32x4 w = (i32x4){(int)v0.x, (int)v0.y, (int)v1.x, (int)v1.y};
                    const bf16x8 vA = __builtin_bit_cast(bf16x8, w);
                    O[0][f] = __builtin_amdgcn_mfma_f32_16x16x32_bf16(vA, Pf[0][g], O[0][f], 0, 0, 0);
                    O[1][f] = __builtin_amdgcn_mfma_f32_16x16x32_bf16(vA, Pf[1][g], O[1][f], 0, 0, 0);
                }
            __syncthreads();
        }
#undef A_ISSUE
#undef A_WRITE
        const float r0 = 1.0f / lrun[0], r1 = lam / lrun[1];
        float ss = 0.f;
#pragma unroll
        for (int f = 0; f < 8; ++f)
#pragma unroll
            for (int j = 0; j < 4; ++j) { const float o = O[0][f][j] * r0 - O[1][f][j] * r1; O[0][f][j] = o; ss += o * o; }
        ss += __shfl_xor(ss, 16, 64); ss += __shfl_xor(ss, 32, 64);
        const float rs = rsqrtf(ss * (1.0f / 128.0f) + 1e-5f) * (1.0f - p.lam_init);
        bf16_t* op = p.br + (size_t)(b * SEQ_ + qrow) * DM_ + 1024 + h * 128 + fq * 4;
        f32x4 gv[8];
#pragma unroll
        for (int f = 0; f < 8; ++f) gv[f] = *(const f32x4*)(p.subg + f * 16 + fq * 4);
#pragma unroll
        for (int f = 0; f < 8; ++f) {
            uint2 o; o.x = cvt_pk_bf16(O[0][f][0] * rs * gv[f][0], O[0][f][1] * rs * gv[f][1]); o.y = cvt_pk_bf16(O[0][f][2] * rs * gv[f][2], O[0][f][3] * rs * gv[f][3]);
            *(uint2*)(op + f * 16) = o;
        }
    }
}

#define HY_PPW 2112
#define HY_PADL 1040
#define HY_VLEN 4112
#define HY_LDS (HY_PPW * 4 + 4 * HY_VLEN * 2)
struct HP { const bf16_t* proj; const float* fr; const float* nrm; unsigned* pp; bf16_t* vvt; float* yt; const float* cw; const float* cb; const float* hbias; bf16_t* br; };

__device__ __forceinline__ void phase_hy_pp(const HP& p) {
    for (int idx = bid_opaque() * 512 + tid_opaque(); idx < 512 * HY_PPW; idx += grid_n() * 512) {
        const int c = idx / HY_PPW, u = idx - c * HY_PPW;
        const float inv = 1.0f / p.nrm[c];
        const int s0 = 2080 - u, s1 = 2080 - (u + 1);
        const float f0 = (s0 >= 0 && s0 < SEQ_) ? p.fr[(size_t)s0 * 512 + c] * inv : 0.f;
        const float f1 = (s1 >= 0 && s1 < SEQ_) ? p.fr[(size_t)s1 * 512 + c] * inv : 0.f;
        p.pp[idx] = cvt_pk_bf16(f0, f1);
    }
}
__device__ __forceinline__ void unpack8(const uint4 v, float (&f)[8]) {
    f[0] = __uint_as_float(v.x << 16); f[1] = __uint_as_float(v.x & 0xffff0000u); f[2] = __uint_as_float(v.y << 16); f[3] = __uint_as_float(v.y & 0xffff0000u);
    f[4] = __uint_as_float(v.z << 16); f[5] = __uint_as_float(v.z & 0xffff0000u); f[6] = __uint_as_float(v.w << 16); f[7] = __uint_as_float(v.w & 0xffff0000u);
}
__device__ __forceinline__ void phase_hy_prep(char* shm, const HP& p) {
    bf16_t* tile = (bf16_t*)shm;
    for (int unit = bid_opaque(); unit < NB_ * 32 * 8; unit += grid_n()) {
        const int ct = unit & 7, tt = (unit >> 3) & 31, b = unit >> 8;
        const int tid = tid_opaque(), tl = tid >> 3, c8 = (tid & 7) * 8, c = ct * 64 + c8, t = tt * 64 + tl;
        float s1[8], s2[8];
#pragma unroll
        for (int e = 0; e < 8; ++e) { s1[e] = p.cb[512 + c + e]; s2[e] = p.cb[1024 + c + e]; }
        uint4 r1[3], r2[3];
#pragma unroll
        for (int k = 0; k < 3; ++k) { const int t2 = t + k - 1, t2c = t2 < 0 ? 0 : (t2 >= SEQ_ ? SEQ_ - 1 : t2);
            const bf16_t* pr = p.proj + (size_t)(b * SEQ_ + t2c) * PROJW + O_HY + c; r1[k] = *(const uint4*)(pr + 512); r2[k] = *(const uint4*)(pr + 1024);
            const unsigned mk = t2 == t2c ? 0xffffffffu : 0u; r1[k].x &= mk; r1[k].y &= mk; r1[k].z &= mk; r1[k].w &= mk; r2[k].x &= mk; r2[k].y &= mk; r2[k].z &= mk; r2[k].w &= mk; }
        f32x4 wq[3][4];
#pragma unroll
        for (int k = 0; k < 3; ++k) { wq[k][0] = *(const f32x4*)(p.cw + k * 1536 + 512 + c); wq[k][1] = *(const f32x4*)(p.cw + k * 1536 + 512 + c + 4);
            wq[k][2] = *(const f32x4*)(p.cw + k * 1536 + 1024 + c); wq[k][3] = *(const f32x4*)(p.cw + k * 1536 + 1024 + c + 4); }
        __builtin_amdgcn_sched_barrier(0);
#pragma unroll
        for (int k = 0; k < 3; ++k) {
            float x1[8], xv[8]; unpack8(r1[k], x1); unpack8(r2[k], xv);
            const f32x4 wa = wq[k][0], wb = wq[k][1], va = wq[k][2], vb = wq[k][3];
#pragma unroll
            for (int e = 0; e < 4; ++e) { s1[e] += wa[e] * x1[e]; s1[e + 4] += wb[e] * x1[e + 4]; s2[e] += va[e] * xv[e]; s2[e + 4] += vb[e] * xv[e + 4]; }
        }
        __syncthreads();
#pragma unroll
        for (int e = 0; e < 8; ++e) tile[(c8 + e) * 72 + tl] = f2bf(s1[e] * s2[e]);
        __syncthreads();
        { const int cl = tid >> 3, t8 = (tid & 7) * 8;
          *(uint4*)(p.vvt + ((size_t)(ct * 64 + cl) * NB_ + b) * SEQ_ + tt * 64 + t8) = *(const uint4*)(tile + cl * 72 + t8); }
    }
}
__device__ __forceinline__ void phase_hy_conv(char* shm, const HP& p) {
    unsigned* pps = (unsigned*)shm;
    bf16_t* vs = (bf16_t*)(shm + HY_PPW * 4);
    for (int c = bid_opaque(); c < 512; c += grid_n()) {
        const int tid = tid_opaque(), wid = tid >> 6, lane = tid & 63, fr = lane & 15, h = lane >> 4;
        __syncthreads();
        for (int i = tid; i < HY_PPW; i += 512) pps[i] = p.pp[(size_t)c * HY_PPW + i];
        for (int i = tid; i < 4 * (HY_VLEN / 8); i += 512) {
            const int b = i / (HY_VLEN / 8), ch = i - b * (HY_VLEN / 8), e0 = ch * 8 - HY_PADL;
            const int e0c = e0 < 0 ? 0 : (e0 >= SEQ_ ? SEQ_ - 8 : e0);
            uint4 v = *(const uint4*)(p.vvt + ((size_t)c * NB_ + b) * SEQ_ + e0c);
            if (e0 != e0c) v = make_uint4(0u, 0u, 0u, 0u);
            *(uint4*)(vs + b * HY_VLEN + ch * 8) = v;
        }
        __syncthreads();
        const int b = wid >> 1, ib = (wid & 1) * 64;
        f32x4 acc[4];
#pragma unroll
        for (int f = 0; f < 4; ++f) acc[f] = (f32x4){0.f, 0.f, 0.f, 0.f};
        const int ua = 1056 - 16 * (h >> 1) - fr + 8 * (h & 1);
        const bf16_t* vb = vs + b * HY_VLEN + HY_PADL + 16 * (ib + fr - (h >> 1)) + 8 * (h & 1);
#define HY_LOAD(d0_, af_, bf_) do { const unsigned* ap_ = pps + (ua - 16 * (d0_)); const i32x4 aw_ = (i32x4){(int)ap_[0], (int)ap_[2], (int)ap_[4], (int)ap_[6]}; af_ = __builtin_bit_cast(bf16x8, aw_); \
        _Pragma("unroll") for (int f = 0; f < 4; ++f) bf_[f] = *(const bf16x8*)(vb + 16 * (16 * f - (d0_))); } while (0)
        bf16x8 afA, afB, bfA[4], bfB[4];
        HY_LOAD(-64, afA, bfA);
        for (int d0 = -64; d0 < 64; d0 += 4) {
            HY_LOAD(d0 + 2, afB, bfB);
            __builtin_amdgcn_sched_barrier(0);
#pragma unroll
            for (int f = 0; f < 4; ++f) acc[f] = __builtin_amdgcn_mfma_f32_16x16x32_bf16(afA, bfA[f], acc[f], 0, 0, 0);
            __builtin_amdgcn_sched_barrier(0);
            HY_LOAD(d0 + 4, afA, bfA);
            __builtin_amdgcn_sched_barrier(0);
#pragma unroll
            for (int f = 0; f < 4; ++f) acc[f] = __builtin_amdgcn_mfma_f32_16x16x32_bf16(afB, bfB[f], acc[f], 0, 0, 0);
            __builtin_amdgcn_sched_barrier(0);
        }
#pragma unroll
        for (int f = 0; f < 4; ++f) acc[f] = __builtin_amdgcn_mfma_f32_16x16x32_bf16(afA, bfA[f], acc[f], 0, 0, 0);
#undef HY_LOAD
        const float hb = p.hbias[c];
#pragma unroll
        for (int f = 0; f < 4; ++f) {
            const int t = 16 * (ib + 16 * f + fr) + 4 * h;
            const bf16_t* vv = vs + b * HY_VLEN + HY_PADL + t;
            f32x4 o; o[0] = acc[f][0] + bf2f(vv[0]) * hb; o[1] = acc[f][1] + bf2f(vv[1]) * hb; o[2] = acc[f][2] + bf2f(vv[2]) * hb; o[3] = acc[f][3] + bf2f(vv[3]) * hb;
            *(f32x4*)(p.yt + ((size_t)c * NB_ + b) * SEQ_ + t) = o;
        }
    }
}
__device__ __forceinline__ void phase_hy_fin(char* shm, const HP& p, int bw0, int bwn) {
    float* tile = (float*)shm;
    const int bq = bid_opaque() - bw0; if (bq < 0 || bq >= bwn) return;
    for (int unit = bq; unit < NB_ * 32 * 8; unit += bwn) {
        const int ct = unit & 7, tt = (unit >> 3) & 31, b = unit >> 8, tid = tid_opaque();
        __syncthreads();
        { const int cl = tid >> 3, t8 = (tid & 7) * 8; const float* src = p.yt + ((size_t)(ct * 64 + cl) * NB_ + b) * SEQ_ + tt * 64 + t8;
          const f32x4 a = *(const f32x4*)src, bq = *(const f32x4*)(src + 4);
#pragma unroll
          for (int q = 0; q < 4; ++q) { tile[cl * 65 + t8 + q] = a[q]; tile[cl * 65 + t8 + 4 + q] = bq[q]; } }
        __syncthreads();
        const int cl = tid & 63, c = ct * 64 + cl, tq = tid >> 6;
        float w0[3];
#pragma unroll
        for (int k = 0; k < 3; ++k) w0[k] = p.cw[k * 1536 + c];
        const float b0 = p.cb[c];
        float xr[10];
#pragma unroll
        for (int r = 0; r < 10; ++r) { const int t2 = tt * 64 + tq * 8 + r - 1, t2c = t2 < 0 ? 0 : (t2 >= SEQ_ ? SEQ_ - 1 : t2);
            xr[r] = __uint_as_float((unsigned)p.proj[(size_t)(b * SEQ_ + t2c) * PROJW + O_HY + c]); }
        __builtin_amdgcn_sched_barrier(0);
#pragma unroll
        for (int r = 0; r < 10; ++r) { const int t2 = tt * 64 + tq * 8 + r - 1; xr[r] = (t2 >= 0 && t2 < SEQ_) ? __uint_as_float(__float_as_uint(xr[r]) << 16) : 0.f; }
#pragma unroll
        for (int q = 0; q < 8; ++q) {
            const int tl = tq * 8 + q, t = tt * 64 + tl;
            float s = b0;
#pragma unroll
            for (int k = 0; k < 3; ++k) s += w0[k] * xr[q + k];
            p.br[(size_t)(b * SEQ_ + t) * DM_ + c] = f2bf(tile[cl * 65 + tl] * s);
        }
    }
}
struct LP { const bf16_t* proj; const float* cw; const float* cb; const bf16_t* wt; const float* ba; const float* bx; const float* lam; float* sumP; float* sumE; bf16_t* br; };
#define LRU_LDS (32768 + 8192 + 64 * 65 * 4 + 2 * 64 * 65 * 4 + 2 * 2 * 16 * 64 * 4)
template <int PASS>
__device__ __forceinline__ void phase_lru(char* shm, const LP& p) {
    char* sW = shm;
    char* sXb = shm + 32768;
    float* X = (float*)(shm + 40960);
    float* H = X + 64 * 65;
    float* SP = H + 2 * 64 * 65;
    float* SE = SP + 2 * 16 * 64;
    for (int unit = bid_opaque(); unit < NB_ * 8 * 32; unit += grid_n()) {
        const int k = unit & 31, b = (unit >> 5) & 3, h = unit >> 7;
        const int tid = tid_opaque();
        const int wid = tid >> 6, lane = tid & 63, fr = lane & 15, fq = lane >> 4, dir = wid & 1, jf = wid >> 1, j = jf * 16 + fr, ch = h * 64 + j;
        const size_t sbase = ((size_t)(dir * NB_ + b) * 32) * 512 + ch;
        const float bav = p.ba[dir * 512 + ch], bxv = p.bx[dir * 512 + ch], lamv = p.lam[dir * 512 + ch];
        float cP8[8], cE8[8];
        if (PASS == 1) {
#pragma unroll
            for (int i = 0; i < 8; ++i) { cP8[i] = p.sumP[sbase + (size_t)(fq * 8 + i) * 512]; cE8[i] = p.sumE[sbase + (size_t)(fq * 8 + i) * 512]; }
        }
        __syncthreads();
        for (int i = tid; i < 256 * 8; i += 512) { const int row = i >> 3, ch = i & 7;
            *(uint4*)(sW + lds_rc(row, ch)) = *(const uint4*)(p.wt + ((size_t)h * 256 + row) * 64 + ch * 8); }
        { const int j = tid & 63, tq = tid >> 6, ch = h * 64 + j;
          float w4[4];
#pragma unroll
          for (int q = 0; q < 4; ++q) w4[q] = p.cw[q * 512 + ch];
          const float cbv = p.cb[ch];
          float xr[11];
#pragma unroll
          for (int r = 0; r < 11; ++r) { const int t2 = k * 64 + tq * 8 + r - 2, t2c = t2 < 0 ? 0 : (t2 >= SEQ_ ? SEQ_ - 1 : t2);
              xr[r] = __uint_as_float((unsigned)p.proj[(size_t)(b * SEQ_ + t2c) * PROJW + O_LRU + ch]); }
          __builtin_amdgcn_sched_barrier(0);
#pragma unroll
          for (int r = 0; r < 11; ++r) { const int t2 = k * 64 + tq * 8 + r - 2; xr[r] = (t2 >= 0 && t2 < SEQ_) ? __uint_as_float(__float_as_uint(xr[r]) << 16) : 0.f; }
#pragma unroll
          for (int q = 0; q < 8; ++q) {
              const int tl = tq * 8 + q; float s = cbv;
#pragma unroll
              for (int kk = 0; kk < 4; ++kk) s += w4[kk] * xr[q + kk];
              X[tl * 65 + j] = s;
              *(bf16_t*)(sXb + lds_rc(tl, j >> 3) + (j & 7) * 2) = f2bf(s);
          } }
        __syncthreads();
        f32x4 G[4][2];
        {
#pragma unroll
          for (int tf = 0; tf < 4; ++tf) { G[tf][0] = (f32x4){bav, bav, bav, bav}; G[tf][1] = (f32x4){bxv, bxv, bxv, bxv}; } }
#pragma unroll
        for (int ks = 0; ks < 2; ++ks) {
            const bf16x8 wA = *(const bf16x8*)(sW + lds_rc((dir * 2 + 0) * 64 + j, ks * 4 + fq));
            const bf16x8 wX = *(const bf16x8*)(sW + lds_rc((dir * 2 + 1) * 64 + j, ks * 4 + fq));
#pragma unroll
            for (int tf = 0; tf < 4; ++tf) {
                const bf16x8 xa = *(const bf16x8*)(sXb + lds_rc(tf * 16 + fr, ks * 4 + fq));
                G[tf][0] = __builtin_amdgcn_mfma_f32_16x16x32_bf16(xa, wA, G[tf][0], 0, 0, 0);
                G[tf][1] = __builtin_amdgcn_mfma_f32_16x16x32_bf16(xa, wX, G[tf][1], 0, 0, 0);
            }
        }
        const float spl = softplus_fast_(-lamv);
        const int tfirst = dir ? (SEQ_ - 1) : 0;
#pragma unroll
        for (int tf = 0; tf < 4; ++tf) {
            float P = 1.f, E = 0.f;
#pragma unroll
            for (int qq = 0; qq < 4; ++qq) {
                const int q = dir ? 3 - qq : qq, tl = tf * 16 + fq * 4 + q, t = k * 64 + tl;
                const float r = sigmoid_fast_(G[tf][0][q]), ig = sigmoid_fast_(G[tf][1][q]);
                const float log_a = -8.0f * r * spl;
                const float x2 = 2.0f * log_a;
                const float om = x2 > -0.02f ? -x2 * (1.0f + x2 * (0.5f + x2 * (1.0f / 6.0f))) : 1.0f - __expf(x2);
                float mult = __builtin_amdgcn_sqrtf(om); if (t == tfirst) mult = 1.0f;
                const float av = __expf(log_a), bv = mult * ig * X[tl * 65 + j];
                G[tf][0][q] = av; G[tf][1][q] = bv;
                E = av * E + bv; P *= av;
            }
            SP[(dir * 16 + tf * 4 + fq) * 64 + j] = P; SE[(dir * 16 + tf * 4 + fq) * 64 + j] = E;
        }
        __syncthreads();
        if (PASS == 0) {
            if (fq == 0) {
                float cP = 1.f, cE = 0.f;
                if (dir == 0) { for (int s = 0; s < 16; ++s) { cE = SP[s * 64 + j] * cE + SE[s * 64 + j]; cP *= SP[s * 64 + j]; } }
                else { for (int s = 15; s >= 0; --s) { cE = SP[(16 + s) * 64 + j] * cE + SE[(16 + s) * 64 + j]; cP *= SP[(16 + s) * 64 + j]; } }
                p.sumP[sbase + (size_t)k * 512] = cP; p.sumE[sbase + (size_t)k * 512] = cE;
            }
        } else {
            float Pl = 1.f, El = 0.f;
            if (dir == 0) {
#pragma unroll
                for (int i = 0; i < 8; ++i) { const bool ok = fq * 8 + i < k; const float Pq = ok ? cP8[i] : 1.f, Eq = ok ? cE8[i] : 0.f; El = Pq * El + Eq; Pl *= Pq; }
            } else {
#pragma unroll
                for (int i = 7; i >= 0; --i) { const bool ok = fq * 8 + i > k; const float Pq = ok ? cP8[i] : 1.f, Eq = ok ? cE8[i] : 0.f; El = Pq * El + Eq; Pl *= Pq; }
            }
            float c = 0.f;
            if (dir == 0) {
#pragma unroll
                for (int f = 0; f < 4; ++f) { const float Pf = __shfl(Pl, f * 16 + fr, 64), Ef = __shfl(El, f * 16 + fr, 64); c = Pf * c + Ef; }
            } else {
#pragma unroll
                for (int f = 3; f >= 0; --f) { const float Pf = __shfl(Pl, f * 16 + fr, 64), Ef = __shfl(El, f * 16 + fr, 64); c = Pf * c + Ef; }
            }
            float cin[4];
            if (dir == 0) {
#pragma unroll
                for (int s = 0; s < 16; ++s) { if ((s & 3) == fq) cin[s >> 2] = c; c = SP[s * 64 + j] * c + SE[s * 64 + j]; }
            } else {
#pragma unroll
                for (int s = 15; s >= 0; --s) { if ((s & 3) == fq) cin[s >> 2] = c; c = SP[(16 + s) * 64 + j] * c + SE[(16 + s) * 64 + j]; }
            }
            float* Hd = H + dir * 64 * 65;
#pragma unroll
            for (int tf = 0; tf < 4; ++tf) {
                float cc = cin[tf];
#pragma unroll
                for (int qq = 0; qq < 4; ++qq) { const int q = dir ? 3 - qq : qq; cc = G[tf][0][q] * cc + G[tf][1][q]; Hd[(tf * 16 + fq * 4 + q) * 65 + j] = cc; }
            }
            __syncthreads();
            const int j2 = tid & 63, tq = tid >> 6, ch2 = h * 64 + j2;
            bf16_t gq[8];
#pragma unroll
            for (int q = 0; q < 8; ++q) gq[q] = p.proj[(size_t)(b * SEQ_ + k * 64 + tq * 8 + q) * PROJW + O_LRU + 512 + ch2];
            __builtin_amdgcn_sched_barrier(0);
#pragma unroll
            for (int q = 0; q < 8; ++q) {
                const int tl = tq * 8 + q; const size_t tok = (size_t)(b * SEQ_ + k * 64 + tl);
                const float g = bf2f(gq[q]);
                p.br[tok * DM_ + 512 + ch2] = f2bf((H[tl * 65 + j2] + H[64 * 65 + tl * 65 + j2]) * gelu_tanh_(g));
            }
        }
    }
}
struct SP_ { const bf16_t* proj; const float* dtraw; const float* cw; const float* cb; const float* dtb; const float* a_log; const float* dsk; const float* ng;
             bf16_t* xa; bf16_t* xT; float* states; float* decay; bf16_t* prev; bf16_t* br; };
#define SSD_Q 128
#define SSD_NC 16

__device__ __forceinline__ void phase_ssd_prep(char* shm, const SP_& p) {
    bf16_t* tile = (bf16_t*)shm;
    for (int unit = bid_opaque(); unit < NB_ * 32 * 16; unit += grid_n()) {
        const int ct = unit & 15, tt = (unit >> 4) & 31, b = unit >> 9;
        const int tid = tid_opaque(), tl = tid >> 3, c8 = (tid & 7) * 8, c = ct * 64 + c8, t = tt * 64 + tl;
        float s[8];
#pragma unroll
        for (int e = 0; e < 8; ++e) s[e] = p.cb[c + e];
        uint4 rr[4];
#pragma unroll
        for (int k = 0; k < 4; ++k) { const int t2 = t + k - 2, t2c = t2 < 0 ? 0 : (t2 >= SEQ_ ? SEQ_ - 1 : t2);
            rr[k] = *(const uint4*)(p.proj + (size_t)(b * SEQ_ + t2c) * PROJW + O_SSD + 512 + c); const unsigned mk = t2 == t2c ? 0xffffffffu : 0u; rr[k].x &= mk; rr[k].y &= mk; rr[k].z &= mk; rr[k].w &= mk; }
        f32x4 wq[4][2];
#pragma unroll
        for (int k = 0; k < 4; ++k) { wq[k][0] = *(const f32x4*)(p.cw + k * 1024 + c); wq[k][1] = *(const f32x4*)(p.cw + k * 1024 + c + 4); }
        __builtin_amdgcn_sched_barrier(0);
#pragma unroll
        for (int k = 0; k < 4; ++k) {
            float x[8]; unpack8(rr[k], x);
            const f32x4 wa = wq[k][0], wb = wq[k][1];
#pragma unroll
            for (int e = 0; e < 4; ++e) { s[e] += wa[e] * x[e]; s[e + 4] += wb[e] * x[e + 4]; }
        }
        uint4 o; o.x = cvt_pk_bf16(silu_fast_(s[0]), silu_fast_(s[1])); o.y = cvt_pk_bf16(silu_fast_(s[2]), silu_fast_(s[3]));
        o.z = cvt_pk_bf16(silu_fast_(s[4]), silu_fast_(s[5])); o.w = cvt_pk_bf16(silu_fast_(s[6]), silu_fast_(s[7]));
        *(uint4*)(p.xa + (size_t)(b * SEQ_ + t) * 1024 + c) = o;
        __syncthreads();
        tile[(c8 + 0) * 72 + tl] = (bf16_t)(o.x & 0xffffu); tile[(c8 + 1) * 72 + tl] = (bf16_t)(o.x >> 16); tile[(c8 + 2) * 72 + tl] = (bf16_t)(o.y & 0xffffu); tile[(c8 + 3) * 72 + tl] = (bf16_t)(o.y >> 16);
        tile[(c8 + 4) * 72 + tl] = (bf16_t)(o.z & 0xffffu); tile[(c8 + 5) * 72 + tl] = (bf16_t)(o.z >> 16); tile[(c8 + 6) * 72 + tl] = (bf16_t)(o.w & 0xffffu); tile[(c8 + 7) * 72 + tl] = (bf16_t)(o.w >> 16);
        __syncthreads();
        { const int c2 = tid >> 3, t8 = (tid & 7) * 8;
          *(uint4*)(p.xT + ((size_t)b * 1024 + ct * 64 + c2) * SEQ_ + tt * 64 + t8) = *(const uint4*)(tile + c2 * 72 + t8); }
    }
}
__device__ __forceinline__ void ssd_tables(float* dtv, float* cum, const SP_& p, int b, int c, int g) {
    const int tid = tid_opaque();
    for (int i = tid; i < 8 * SSD_Q; i += 512) {
        const int l = i & 127, hd = i >> 7, dir = hd >> 2, j = hd & 3, h = g * 4 + j;
        dtv[i] = softplus_fast_(p.dtraw[(size_t)(b * SEQ_ + c * SSD_Q + l) * 16 + dir * 8 + h] + p.dtb[dir * 8 + h]);
    }
    __syncthreads();
    { const int t8 = tid_opaque(), hd = t8 >> 6, lane = t8 & 63, dir = hd >> 2, j = hd & 3, h = g * 4 + j; const float a = -__expf(p.a_log[dir * 8 + h]);
      const int la = dir ? 127 - 2 * lane : 2 * lane, lb = dir ? 126 - 2 * lane : 2 * lane + 1;
      const float v0 = dtv[hd * 128 + la] * a, v1 = dtv[hd * 128 + lb] * a;
      float inc = v0 + v1;
#pragma unroll
      for (int o = 1; o < 64; o <<= 1) { const float t = __shfl_up(inc, o, 64); if (lane >= o) inc += t; }
      cum[hd * 128 + la] = inc - v1; cum[hd * 128 + lb] = inc; }
    __syncthreads();
}
#define SSD1_LDS (65536 + 32768 + 8192)
__device__ __forceinline__ void phase_ssd_states(char* shm, const SP_& p) {
    char* sX = shm;
    char* sB = shm + 65536;
    float* dtv = (float*)(shm + 98304); float* cum = dtv + 1024;
    for (int unit = bid_opaque(); unit < NB_ * SSD_NC * 2 * 2; unit += grid_n()) {
        const int hp = unit & 1, g = (unit >> 1) & 1, c = (unit >> 2) & 15, b = unit >> 6;
        const int tid = tid_opaque(), wid = tid >> 6, lane = tid & 63, fr = lane & 15, fq = lane >> 4;
        __syncthreads();
        for (int i = tid; i < 128 * 16; i += 512) { const int row = i >> 4, ch = i & 15;
            *(uint4*)(sX + row * 256 + ((ch ^ (row & 15)) * 16)) = *(const uint4*)(p.xT + ((size_t)b * 1024 + g * 256 + hp * 128 + row) * SEQ_ + c * SSD_Q + ch * 8); }
        for (int i = tid; i < 128 * 16; i += 512) { const int row = i >> 4, ch = i & 15;
            *(uint4*)(sB + row * 256 + ((ch ^ (row & 15)) * 16)) = *(const uint4*)(p.xT + ((size_t)b * 1024 + 512 + g * 128 + row) * SEQ_ + c * SSD_Q + ch * 8); }
        ssd_tables(dtv, cum, p, b, c, g);
        const int jj = wid >> 2, dir = (wid >> 1) & 1, nh = wid & 1, j = hp * 2 + jj, hd = dir * 4 + j, h = g * 4 + j;
        const float* dth = dtv + hd * 128; const float* cm = cum + hd * 128;
        const float cend = dir ? cm[0] : cm[SSD_Q - 1];
        f32x4 acc[4][4];
#pragma unroll
        for (int pf = 0; pf < 4; ++pf)
#pragma unroll
            for (int nf = 0; nf < 4; ++nf) acc[pf][nf] = (f32x4){0.f, 0.f, 0.f, 0.f};
#pragma unroll 1
        for (int ks = 0; ks < 4; ++ks) {
            float sc[8];
#pragma unroll
            for (int e = 0; e < 8; ++e) { const int l = ks * 32 + fq * 8 + e; sc[e] = dth[l] * __expf(cend - cm[l]); }
            bf16x8 af[4];
#pragma unroll
            for (int pf = 0; pf < 4; ++pf) {
                const int row = jj * 64 + pf * 16 + fr, ch = ks * 4 + fq;
                const i32x4 raw = *(const i32x4*)(sX + row * 256 + ((ch ^ (row & 15)) * 16));
                i32x4 o;
#pragma unroll
                for (int q = 0; q < 4; ++q) { const unsigned u = (unsigned)raw[q]; o[q] = (int)cvt_pk_bf16(__uint_as_float(u << 16) * sc[2 * q], __uint_as_float(u & 0xffff0000u) * sc[2 * q + 1]); }
                af[pf] = __builtin_bit_cast(bf16x8, o);
            }
#pragma unroll
            for (int nf = 0; nf < 4; ++nf) {
                const int row = nh * 64 + nf * 16 + fr, ch = ks * 4 + fq;
                const bf16x8 bfr = *(const bf16x8*)(sB + row * 256 + ((ch ^ (row & 15)) * 16));
#pragma unroll
                for (int pf = 0; pf < 4; ++pf) acc[pf][nf] = __builtin_amdgcn_mfma_f32_16x16x32_bf16(bfr, af[pf], acc[pf][nf], 0, 0, 0);
            }
        }
        float* st = p.states + ((((size_t)(b * SSD_NC + c) * 8 + h) * 2 + dir) * 64) * 128;
        float* rp = st + (size_t)fr * 128 + nh * 64 + fq * 4;
#pragma unroll
        for (int pf = 0; pf < 4; ++pf)
#pragma unroll
            for (int nf = 0; nf < 4; ++nf) *(f32x4*)(rp + pf * 16 * 128 + nf * 16) = acc[pf][nf];
        if (lane == 0 && nh == 0) p.decay[((b * SSD_NC + c) * 8 + h) * 2 + dir] = __expf(cend);
    }
}
__device__ __forceinline__ void phase_ssd_scan(const SP_& p) {
    for (int idx = bid_opaque() * 512 + tid_opaque(); idx < NB_ * 8 * 2 * 64 * 32; idx += grid_n() * 512) {
        const int n4 = idx & 31, pp = (idx >> 5) & 63, dir = (idx >> 11) & 1, h = (idx >> 12) & 7, b = idx >> 15;
        f32x4 s = (f32x4){0.f, 0.f, 0.f, 0.f};
#pragma unroll 1
        for (int half = 0; half < 2; ++half) {
            f32x4 st[8]; float dc[8];
#pragma unroll
            for (int q = 0; q < 8; ++q) {
                const int cc = half * 8 + q, c = dir ? (SSD_NC - 1 - cc) : cc;
                st[q] = *(const f32x4*)(p.states + ((((size_t)(b * SSD_NC + c) * 8 + h) * 2 + dir) * 64 + pp) * 128 + n4 * 4);
                dc[q] = p.decay[((b * SSD_NC + c) * 8 + h) * 2 + dir];
            }
#pragma unroll
            for (int q = 0; q < 8; ++q) {
                const int cc = half * 8 + q, c = dir ? (SSD_NC - 1 - cc) : cc;
                const size_t o = ((((size_t)(b * SSD_NC + c) * 8 + h) * 2 + dir) * 64 + pp) * 128 + n4 * 4;
                uint2 w; w.x = cvt_pk_bf16(s[0], s[1]); w.y = cvt_pk_bf16(s[2], s[3]);
                *(uint2*)(p.prev + o) = w;
                s = s * dc[q] + st[q];
            }
        }
    }
}
#define SSD3_LDS (32768 + 65536 + 32768 + 8192 + 512)
__device__ __forceinline__ void phase_ssd_out(char* shm, const SP_& p) {
    char* sB = shm;
    char* sX = shm + 32768;
    char* sC = shm + 98304;
    float* dtv = (float*)(shm + 131072); float* cum = dtv + 1024; float* ssx = cum + 1024;
    for (int unit = bid_opaque(); unit < NB_ * SSD_NC * 2 * 2; unit += grid_n()) {
        const int half_ = unit & 1, g = (unit >> 1) & 1, c = (unit >> 2) & 15, b = unit >> 6;
        const int tid = tid_opaque(), wid = tid >> 6, lane = tid & 63, fr = lane & 15, fq = lane >> 4;
        __syncthreads();
        for (int i = tid; i < 128 * 16; i += 512) { const int row = i >> 4, ch = i & 15; const bf16_t* src_ = p.xa + (size_t)(b * SEQ_ + c * SSD_Q + row) * 1024 + 512 + g * 128 + ch * 8;
            *(uint4*)(sB + row * 256 + ((ch ^ (row & 15)) * 16)) = *(const uint4*)src_;
            *(uint4*)(sC + row * 256 + ((ch ^ (row & 15)) * 16)) = *(const uint4*)(src_ + 256); }
        for (int i = tid; i < 256 * 16; i += 512) { const int row = i >> 4, ch = i & 15, x = row & 15;
            uint4 v = *(const uint4*)(p.xT + ((size_t)b * 1024 + g * 256 + row) * SEQ_ + c * SSD_Q + ch * 8);
            if (x & 1) v = make_uint4(v.z, v.w, v.x, v.y);
            *(uint4*)(sX + row * 256 + ((ch ^ (x >> 1)) * 16)) = v; }
        ssd_tables(dtv, cum, p, b, c, g);
        const int hp = wid >> 2, lrow = half_ * 64 + (wid & 3) * 16 + fr;
        const size_t tok = (size_t)(b * SEQ_ + c * SSD_Q + lrow);
#define SSD_CF(ks_) (*(const bf16x8*)(sC + lrow * 256 + ((((ks_) * 4 + fq) ^ (lrow & 15)) * 16)))
        f32x4 G[8];
#pragma unroll
        for (int sf = 0; sf < 8; ++sf) {
            f32x4 a = (f32x4){0.f, 0.f, 0.f, 0.f};
#pragma unroll
            for (int ks = 0; ks < 4; ++ks) {
                const int row = sf * 16 + fr, ch = ks * 4 + fq;
                const bf16x8 bfr = *(const bf16x8*)(sB + row * 256 + ((ch ^ (row & 15)) * 16));
                a = __builtin_amdgcn_mfma_f32_16x16x32_bf16(bfr, SSD_CF(ks), a, 0, 0, 0);
            }
            G[sf] = a;
        }
        f32x4 Y[2][4];
#pragma unroll
        for (int jj = 0; jj < 2; ++jj)
#pragma unroll
            for (int pf = 0; pf < 4; ++pf) Y[jj][pf] = (f32x4){0.f, 0.f, 0.f, 0.f};
#pragma unroll
        for (int jj = 0; jj < 2; ++jj) {
            const int j = hp * 2 + jj;
#pragma unroll 1
            for (int dir = 0; dir < 2; ++dir) {
                const int hd = dir * 4 + j, h = g * 4 + j;
                const float* dth = dtv + hd * 128; const float* cm = cum + hd * 128;
                const float cl = cm[lrow];
                const bf16_t* pv = p.prev + ((((size_t)(b * SSD_NC + c) * 8 + h) * 2 + dir) * 64) * 128;
                bf16x8 pa[4][4];
#pragma unroll
                for (int pf = 0; pf < 4; ++pf)
#pragma unroll
                    for (int ks = 0; ks < 4; ++ks) pa[pf][ks] = *(const bf16x8*)(pv + (size_t)(pf * 16 + fr) * 128 + ks * 32 + fq * 8);
#pragma unroll
                for (int g2 = 0; g2 < 4; ++g2) {
                    float e[8];
#pragma unroll
                    for (int half = 0; half < 2; ++half)
#pragma unroll
                        for (int q = 0; q < 4; ++q) {
                            const int sf = 2 * g2 + half, s = sf * 16 + fq * 4 + q;
                            const bool keep = dir ? (s >= lrow) : (s <= lrow);
                            const float v = G[sf][q] * __expf(keep ? (cl - cm[s]) : 0.f) * dth[s];
                            e[half * 4 + q] = keep ? v : 0.f;
                        }
                    i32x4 w; w[0] = (int)cvt_pk_bf16(e[0], e[1]); w[1] = (int)cvt_pk_bf16(e[2], e[3]); w[2] = (int)cvt_pk_bf16(e[4], e[5]); w[3] = (int)cvt_pk_bf16(e[6], e[7]);
                    const bf16x8 Pf = __builtin_bit_cast(bf16x8, w);
#pragma unroll
                    for (int pf = 0; pf < 4; ++pf) {
                        const int row = j * 64 + pf * 16 + fr, x = row & 15;
                        const uint2 v0 = *(const uint2*)(sX + row * 256 + (((8 * g2 + fq) ^ x) * 8));
                        const uint2 v1 = *(const uint2*)(sX + row * 256 + (((8 * g2 + 4 + fq) ^ x) * 8));
                        const i32x4 wv = (i32x4){(int)v0.x, (int)v0.y, (int)v1.x, (int)v1.y};
                        Y[jj][pf] = __builtin_amdgcn_mfma_f32_16x16x32_bf16(__builtin_bit_cast(bf16x8, wv), Pf, Y[jj][pf], 0, 0, 0);
                    }
                    __builtin_amdgcn_sched_barrier(0);
                }
                const float el = __expf(cl);
#pragma unroll
                for (int pf = 0; pf < 4; ++pf) {
                    f32x4 t = (f32x4){0.f, 0.f, 0.f, 0.f};
#pragma unroll
                    for (int ks = 0; ks < 4; ++ks) {
                        t = __builtin_amdgcn_mfma_f32_16x16x32_bf16(pa[pf][ks], SSD_CF(ks), t, 0, 0, 0);
                    }
                    Y[jj][pf] += t * el;
                    __builtin_amdgcn_sched_barrier(0);
                }
            }
        }
        const int te = tid_opaque(); const int fqe = (te & 63) >> 4, wde = te >> 6, hpe = wde >> 2; const size_t toke = (size_t)(b * SEQ_ + c * SSD_Q + half_ * 64 + (wde & 3) * 16 + (te & 15));
        float ss = 0.f;
        uint2 xva[2][4], zva[2][4]; f32x4 gva[2][4];
#pragma unroll
        for (int jj = 0; jj < 2; ++jj)
#pragma unroll
            for (int pf = 0; pf < 4; ++pf) { const int cch = g * 256 + (hpe * 2 + jj) * 64 + pf * 16 + fqe * 4;
                xva[jj][pf] = *(const uint2*)(p.xa + toke * 1024 + cch); zva[jj][pf] = *(const uint2*)(p.proj + toke * PROJW + O_SSD + cch); gva[jj][pf] = *(const f32x4*)(p.ng + cch); }
#pragma unroll
        for (int jj = 0; jj < 2; ++jj) {
            const float dk = p.dsk[g * 4 + hpe * 2 + jj];
#pragma unroll
            for (int pf = 0; pf < 4; ++pf) {
                const uint2 xv = xva[jj][pf];
                const uint2 zv = zva[jj][pf];
                const float xs[4] = {__uint_as_float(xv.x << 16), __uint_as_float(xv.x & 0xffff0000u), __uint_as_float(xv.y << 16), __uint_as_float(xv.y & 0xffff0000u)};
                const float zs[4] = {__uint_as_float(zv.x << 16), __uint_as_float(zv.x & 0xffff0000u), __uint_as_float(zv.y << 16), __uint_as_float(zv.y & 0xffff0000u)};
#pragma unroll
                for (int q = 0; q < 4; ++q) { const float y = (Y[jj][pf][q] + dk * xs[q]) * silu_fast_(zs[q]); Y[jj][pf][q] = y; ss += y * y; }
                __builtin_amdgcn_sched_barrier(0);
            }
        }
        ss += __shfl_xor(ss, 16, 64); ss += __shfl_xor(ss, 32, 64);
        if (fqe == 0) ssx[wde * 16 + (te & 15)] = ss;
        __syncthreads();
        ss += ssx[(wde ^ 4) * 16 + (te & 15)];
        const float rs = rsqrtf(ss * (1.0f / 256.0f) + 1e-6f);
#pragma unroll
        for (int jj = 0; jj < 2; ++jj)
#pragma unroll
            for (int pf = 0; pf < 4; ++pf) {
                const int cch = g * 256 + (hpe * 2 + jj) * 64 + pf * 16 + fqe * 4;
                const f32x4 gv = gva[jj][pf];
                uint2 o; o.x = cvt_pk_bf16(Y[jj][pf][0] * rs * gv[0], Y[jj][pf][1] * rs * gv[1]); o.y = cvt_pk_bf16(Y[jj][pf][2] * rs * gv[2], Y[jj][pf][3] * rs * gv[3]);
                *(uint2*)(p.br + toke * DM_ + 1536 + cch) = o;
                __builtin_amdgcn_sched_barrier(0);
            }
    }
}
struct GP {
    const bf16_t* A; const bf16_t* Bt; const float* B; const float* B2; const float* bias; const float* R; float* Cf; bf16_t* Cb; bf16_t* Cb2; bf16_t* Vt; const bf16_t* G;
    const int* idx; const float* gate;
};
#ifndef GS_ROWS
#define GS_ROWS 8
#endif
__device__ __forceinline__ void static_order(int L, int nM, int nN, int& pm, int& pn) {
    const int nwg = nM * nN; int wgid = L;
    { const int q = nwg / 8, r = nwg % 8, xcd = wgid % 8, off = wgid / 8; wgid = (xcd < r ? xcd * (q + 1) : r * (q + 1) + (xcd - r) * q) + off; }
    const int nig = GS_ROWS * nN, gid = wgid / nig, fm = gid * GS_ROWS, gsz = (nM - fm) < GS_ROWS ? (nM - fm) : GS_ROWS;
    pm = fm + ((wgid % nig) % gsz); pn = (wgid % nig) / gsz;
}
#define LANE_IDS(t_) const int wid = (t_) >> 6, lane = (t_) & 63, wr = wid >> 2, wc = wid & 3, fr = lane & 15, fq = lane >> 4; (void)wr; (void)wc; (void)fr; (void)fq;
#define ZERO_ACC(acc, FM_) _Pragma("unroll") for (int m = 0; m < FM_; ++m) _Pragma("unroll") for (int n = 0; n < 4; ++n) acc[m][n] = (f32x4){0.f, 0.f, 0.f, 0.f}

__device__ __forceinline__ void phase_inproj(char* shm, const GP& p) {
    typedef GemmCore<256, false> G;
    for (int L = bid_opaque(); L < 32 * 54; L += grid_n()) {
        int pm, pn; static_order(L, 32, 54, pm, pn);
        const int col0 = pn < 22 ? pn * 256 : O_GATE + (pn - 22) * 256;
        f32x4 acc[8][4]; ZERO_ACC(acc, 8);
        {
            const int t0 = tid_opaque();
            unsigned aoff[G::GLA], boff[4];
#pragma unroll
            for (int i = 0; i < G::GLA; ++i) { int R, C; G::a_coord(t0, i, R, C); aoff[i] = (unsigned)((R * DM_ + C) * 2); }
#pragma unroll
            for (int i = 0; i < 4; ++i) { int cc, C; G::bt_coord(t0, i, cc, C); boff[i] = (unsigned)((cc * DM_ + C) * 2); }
            const char* pf = t0 < 256 ? (const char*)(p.A + (size_t)(pm * 256 + t0) * DM_) : (const char*)(p.Bt + (size_t)(pn * 256 + t0 - 256) * DM_);
            G::run_bt(shm, (const char*)(p.A + (size_t)pm * 256 * DM_), aoff, (const char*)(p.Bt + (size_t)pn * 256 * DM_), boff, DM_ * 2, pf, DM_ / 64, acc);
        }
        const int t1 = tid_opaque(); LANE_IDS(t1)
        const int cl = wc * 64 + 4 * fr;
        if (pn == 14 || pn == 15) {
            const int t0_ = pm * 256 + wr * 128 + fq * 4, bb = t0_ >> 11, tl = t0_ & (SEQ_ - 1);
            bf16_t* vp = p.Vt + (size_t)(bb * 512 + (pn - 14) * 256 + cl) * SEQ_ + tl;
#pragma unroll
            for (int m = 0; m < 8; ++m)
#pragma unroll
                for (int n = 0; n < 4; ++n) {
                    uint2 o; o.x = cvt_pk_bf16(acc[m][n][0], acc[m][n][1]); o.y = cvt_pk_bf16(acc[m][n][2], acc[m][n][3]);
                    *(uint2*)(vp + (size_t)n * SEQ_ + m * 16) = o;
                }
        } else if (pn < 22) {
#pragma unroll
            for (int m = 0; m < 8; ++m)
#pragma unroll
                for (int j = 0; j < 4; ++j) {
                    const int row = pm * 256 + wr * 128 + m * 16 + fq * 4 + j;
                    uint2 o; o.x = cvt_pk_bf16(acc[m][0][j], acc[m][1][j]); o.y = cvt_pk_bf16(acc[m][2][j], acc[m][3][j]);
                    *(uint2*)(p.Cb + (size_t)row * PROJW + pn * 256 + cl) = o;
                }
        } else {
            const int gc = (pn - 22) * 256 + cl;
            const f32x4 bg = *(const f32x4*)(p.bias + gc);
#pragma unroll
            for (int m = 0; m < 8; ++m)
#pragma unroll
                for (int j = 0; j < 4; ++j) {
                    const int row = pm * 256 + wr * 128 + m * 16 + fq * 4 + j;
                    uint2 o; o.x = cvt_pk_bf16(sigmoid_fast_(acc[m][0][j] + bg[0]), sigmoid_fast_(acc[m][1][j] + bg[1])); o.y = cvt_pk_bf16(sigmoid_fast_(acc[m][2][j] + bg[2]), sigmoid_fast_(acc[m][3][j] + bg[3]));
                    *(uint2*)(p.Cb2 + (size_t)row * 8192 + gc) = o;
                }
        }
    }
}
__device__ __forceinline__ void phase_merge(char* shm, const GP& p) {
    typedef GemmCore<128, false> G;
    for (int L = bid_opaque(); L < 64 * 8; L += grid_n()) {
        int pm, pn; static_order(L, 64, 8, pm, pn);
        f32x4 mg[4][4]; ZERO_ACC(mg, 4);
        f32x4 acc[4][4]; ZERO_ACC(acc, 4);
        {
            const int t0 = tid_opaque();
            unsigned aoff[G::GLA], boff[4];
#pragma unroll
            for (int i = 0; i < G::GLA; ++i) { int R, C; G::a_coord(t0, i, R, C); aoff[i] = (unsigned)((R * DM_ + C) * 2); }
#pragma unroll
            for (int i = 0; i < 4; ++i) { int cc, C; G::bt_coord(t0, i, cc, C); boff[i] = (unsigned)((cc * 512 + C) * 2); }
            const bf16_t* gates = p.G;
            struct SegEpi {
                f32x4 (&acc)[4][4]; f32x4 (&mg)[4][4]; uint2 (&gq)[4][4]; const bf16_t* gates; int pm, pn;
                __device__ __forceinline__ void pre(int k) const {
                    const int t1 = tid_opaque(); LANE_IDS(t1)
                    const bf16_t* gp = gates + (size_t)(pm * 128 + wr * 64 + fq * 4) * 8192 + k * DM_ + pn * 256 + wc * 64 + 4 * fr;
#pragma unroll
                    for (int m = 0; m < 4; ++m)
#pragma unroll
                        for (int j = 0; j < 4; ++j) gq[m][j] = *(const uint2*)(gp + (size_t)(m * 16 + j) * 8192);
                    __builtin_amdgcn_sched_barrier(0);
                }
                __device__ __forceinline__ void operator()(int) const {
#pragma unroll
                    for (int m = 0; m < 4; ++m) {
#pragma unroll
                        for (int j = 0; j < 4; ++j) {
                            const uint2 gv = gq[m][j];
                            mg[m][0][j] += __uint_as_float(gv.x << 16) * acc[m][0][j]; mg[m][1][j] += __uint_as_float(gv.x & 0xffff0000u) * acc[m][1][j];
                            mg[m][2][j] += __uint_as_float(gv.y << 16) * acc[m][2][j]; mg[m][3][j] += __uint_as_float(gv.y & 0xffff0000u) * acc[m][3][j];
                        }
#pragma unroll
                        for (int n = 0; n < 4; ++n) acc[m][n] = (f32x4){0.f, 0.f, 0.f, 0.f};
                    }
                    __builtin_amdgcn_sched_barrier(0);
                }
            };
            uint2 gq[4][4];
            const SegEpi seg_epi{acc, mg, gq, gates, pm, pn};
            G::template run_bt_seg<8>(shm, (const char*)(p.A + (size_t)pm * 128 * DM_), aoff, (const char*)(p.Bt + (size_t)pn * 256 * 512), boff, 512 * 2, (size_t)DM_ * 512 * 2,
                                      (const char*)(p.A + (size_t)pm * 128 * DM_), 32, acc, seg_epi);
        }
        const int t2 = tid_opaque(); LANE_IDS(t2)
        bf16_t* op = p.Cb + (size_t)(pm * 128 + wr * 64 + fq * 4) * DM_ + pn * 256 + wc * 64 + 4 * fr;
#pragma unroll
        for (int m = 0; m < 4; ++m)
#pragma unroll
            for (int j = 0; j < 4; ++j) {
                uint2 o; o.x = cvt_pk_bf16(mg[m][0][j], mg[m][1][j]); o.y = cvt_pk_bf16(mg[m][2][j], mg[m][3][j]);
                *(uint2*)(op + (size_t)(m * 16 + j) * DM_) = o;
            }
    }
}
__device__ __forceinline__ void phase_outproj(char* shm, const GP& p) {
    typedef GemmCore<256, false> G;
    for (int L = bid_opaque(); L < 32 * 8; L += grid_n()) {
        int pm, pn; static_order(L, 32, 8, pm, pn);
        f32x4 acc[8][4]; ZERO_ACC(acc, 8);
        {
            const int t0 = tid_opaque();
            unsigned aoff[G::GLA], boff[4];
#pragma unroll
            for (int i = 0; i < G::GLA; ++i) { int R, C; G::a_coord(t0, i, R, C); aoff[i] = (unsigned)((R * DM_ + C) * 2); }
#pragma unroll
            for (int i = 0; i < 4; ++i) { int cc, C; G::bt_coord(t0, i, cc, C); boff[i] = (unsigned)((cc * DM_ + C) * 2); }
            const char* pf = t0 < 256 ? (const char*)(p.A + (size_t)(pm * 256 + t0) * DM_) : (const char*)(p.Bt + (size_t)(pn * 256 + t0 - 256) * DM_);
            G::run_bt(shm, (const char*)(p.A + (size_t)pm * 256 * DM_), aoff, (const char*)(p.Bt + (size_t)pn * 256 * DM_), boff, DM_ * 2, pf, DM_ / 64, acc);
        }
        const int t1 = tid_opaque(); LANE_IDS(t1)
        const size_t o0 = (size_t)(pm * 256 + wr * 128 + fq * 4) * DM_ + pn * 256 + wc * 64 + 4 * fr;
#pragma unroll
        for (int m = 0; m < 8; ++m)
#pragma unroll
            for (int j = 0; j < 4; ++j) {
                const size_t o = o0 + (size_t)(m * 16 + j) * DM_;
                const f32x4 r = *(const f32x4*)(p.R + o);
                *(f32x4*)(p.Cf + o) = (f32x4){r[0] + acc[m][0][j], r[1] + acc[m][1][j], r[2] + acc[m][2][j], r[3] + acc[m][3][j]};
            }
    }
}
__device__ __forceinline__ void phase_moe_up(char* shm, const GP& p) {
    typedef GemmCore<256, true> G;
    for (int L = bid_opaque(); L < 64 * 16; L += grid_n()) {
        const int xcd = L & 7, wg = xcd * 128 + (L >> 3), b = wg & 3, pair = wg >> 2, e = pair >> 4, nt = pair & 15, z = b * 16 + e;
        f32x4 acc[8][4]; ZERO_ACC(acc, 8);
        {
            const int t0 = tid_opaque(); int bk, bc, bw; G::b_coord(t0, bk, bc, bw);
            unsigned aoff[G::GLA];
#pragma unroll
            for (int i = 0; i < G::GLA; ++i) { int R, C; G::a_coord(t0, i, R, C); aoff[i] = (unsigned)(((b * SEQ_ + p.idx[z * 256 + R]) * DM_ + C) * 2); }
            const float* wsel = bw ? p.B2 : p.B;
            G::run(shm, (const char*)p.A, aoff, (const char*)(wsel + (size_t)e * DM_ * DM_ + (size_t)bk * DM_ + nt * 128 + bc), DM_ * 4, DM_ / 64, acc);
        }
        const int t1 = tid_opaque(); LANE_IDS(t1)
        const int hi = (fr >> 3) & 1;
        bf16_t* op = p.Cb + (size_t)(z * 256 + wr * 128 + fq * 4) * DM_ + nt * 128 + wc * 32 + 4 * (fr & 7);
#pragma unroll
        for (int mm = 0; mm < 4; ++mm)
#pragma unroll
            for (int j = 0; j < 4; ++j) {
                float a[4], g[4];
#pragma unroll
                for (int n = 0; n < 4; ++n) {
                    const float lo = acc[mm][n][j], hv = acc[mm + 4][n][j];
                    const float send = hi ? lo : hv;
                    const float recv = __shfl_xor(send, 8, 64);
                    a[n] = hi ? recv : lo;
                    g[n] = hi ? hv : recv;
                }
                uint2 o; o.x = cvt_pk_bf16(silu_fast_(a[0]) * g[0], silu_fast_(a[1]) * g[1]); o.y = cvt_pk_bf16(silu_fast_(a[2]) * g[2], silu_fast_(a[3]) * g[3]);
                *(uint2*)(op + (size_t)((mm + 4 * hi) * 16 + j) * DM_) = o;
            }
    }
}
__device__ __forceinline__ void phase_moe_down(char* shm, const GP& p) {
    typedef GemmCore<256, false> G;
    for (int L = bid_opaque(); L < 64 * 8; L += grid_n()) {
        const int xcd = L & 7, wg = xcd * 64 + (L >> 3), b = wg & 3, pair = wg >> 2, e = pair >> 3, nt = pair & 7, z = b * 16 + e;
        f32x4 acc[8][4]; ZERO_ACC(acc, 8);
        {
            const int t0 = tid_opaque(); int bk, bc, bw; G::b_coord(t0, bk, bc, bw);
            unsigned aoff[G::GLA];
#pragma unroll
            for (int i = 0; i < G::GLA; ++i) { int R, C; G::a_coord(t0, i, R, C); aoff[i] = (unsigned)((R * DM_ + C) * 2); }
            G::run(shm, (const char*)(p.A + (size_t)z * 256 * DM_), aoff, (const char*)(p.B + (size_t)e * DM_ * DM_ + (size_t)bk * DM_ + nt * 256 + bc), DM_ * 4, DM_ / 64, acc);
        }
        const int t1 = tid_opaque(); LANE_IDS(t1)
        const int row0 = z * 256 + wr * 128 + fq * 4;
        bf16_t* op = p.Cb + (size_t)row0 * DM_ + nt * 256 + wc * 64 + 4 * fr;
        f32x4 gtv[8];
#pragma unroll
        for (int m = 0; m < 8; ++m) gtv[m] = *(const f32x4*)(p.gate + row0 + m * 16);
#pragma unroll
        for (int m = 0; m < 8; ++m)
#pragma unroll
            for (int j = 0; j < 4; ++j) {
                const float gt = gtv[m][j];
                uint2 o; o.x = cvt_pk_bf16(gt * acc[m][0][j], gt * acc[m][1][j]); o.y = cvt_pk_bf16(gt * acc[m][2][j], gt * acc[m][3][j]);
                *(uint2*)(op + (size_t)(m * 16 + j) * DM_) = o;
            }
    }
}

namespace pg8 {
#define PG8_LAS __attribute__((address_space(3)))
constexpr int BM = 256, BK = 64, HALF = 128, HTB = HALF * BK * 2  , STAGE_BYTES = 8 * HTB;
__device__ __forceinline__ int lds_byte(int r, int c) { const int st = (r >> 4) * 2 + (c >> 5), rr = r & 15, cc = c & 31, ob = rr * 64 + cc * 2; return st * 1024 + (ob ^ (((ob >> 9) & 1) << 5)); }
__device__ __forceinline__ void stage_rc(int b, int& R, int& C) { const int st = b / 1024, sb = b % 1024, swz = sb ^ (((sb >> 9) & 1) << 5); R = (st >> 1) * 16 + swz / 64; C = (st & 1) * 32 + (swz % 64) / 2; }
__device__ __forceinline__ int perm32(int rho) { const int n = rho >> 4, i = rho & 15; return 8 * (i >> 2) + 4 * n + (i & 3); }
struct Unit { int pm, pn, kz; };
struct Gemm { const bf16_t* A; const bf16_t* Bt; int M, N, K, lda, ldb; };
struct MegaOrder {
    static constexpr bool GATHER = false;
    int nM, nN, G, c;
    __device__ __forceinline__ unsigned a_off(const Gemm& g, int R, int C) const { return (unsigned)(R * g.lda + C) * 2u; }
    __device__ __forceinline__ bool next(int i, Unit& u) const { const int L = i * G + c; if (L >= nM * nN) return false; int pm, pn; static_order(L, nM, nN, pm, pn); u.pm = pm; u.pn = pn; u.kz = 0; return true; }
    __device__ __forceinline__ void base(const Gemm& g, const Unit& u, const char*& a, const char*& b) const { a = (const char*)g.A + (size_t)u.pm * BM * g.lda * 2; b = (const char*)g.Bt + (size_t)u.pn * BM * g.ldb * 2; }
    __device__ __forceinline__ void a_ready(const Unit&) const {}
    __device__ __forceinline__ void done(const Unit&) const {}
};
__device__ __forceinline__ uint4 pack8_bf16(const f32x4& a, const f32x4& b) { return make_uint4(cvt_pk_bf16(a[0], a[1]), cvt_pk_bf16(a[2], a[3]), cvt_pk_bf16(b[0], b[1]), cvt_pk_bf16(b[2], b[3])); }
struct EpiInproj {
    static constexpr bool PERM = true, AFTER_DRAIN = false;
    bf16_t* proj; bf16_t* gates; bf16_t* vt; const float* bgate;
    __device__ __forceinline__ void operator()(const f32x4 (&acc)[2][2][4][2], const Unit& u, int wr, int wc, int fr, int fq) const {
        const int row0 = u.pm * BM + wr * 64 + fr, cb = wc * 32 + 8 * fq;
        if (u.pn == 14 || u.pn == 15) {
            const int bb = row0 >> 11;
#pragma unroll
            for (int ai = 0; ai < 2; ++ai)
#pragma unroll
                for (int m = 0; m < 4; ++m) { const int t = (row0 + ai * HALF + m * 16) & (SEQ_ - 1);
#pragma unroll
                    for (int bj = 0; bj < 2; ++bj)
#pragma unroll
                        for (int n = 0; n < 2; ++n)
#pragma unroll
                            for (int e = 0; e < 4; ++e) vt[(size_t)(bb * 512 + (u.pn - 14) * 256 + bj * HALF + cb + 4 * n + e) * SEQ_ + t] = f2bf(acc[ai][bj][m][n][e]); }
        } else if (u.pn < 22) {
#pragma unroll
            for (int ai = 0; ai < 2; ++ai)
#pragma unroll
                for (int m = 0; m < 4; ++m) { bf16_t* rowp = proj + (size_t)(row0 + ai * HALF + m * 16) * PROJW + u.pn * BM + cb;
#pragma unroll
                    for (int bj = 0; bj < 2; ++bj) *(uint4*)(rowp + bj * HALF) = pack8_bf16(acc[ai][bj][m][0], acc[ai][bj][m][1]); }
        } else {
            const int gc = (u.pn - 22) * BM + cb;
            f32x4 bv[2][2];
#pragma unroll
            for (int bj = 0; bj < 2; ++bj) { bv[bj][0] = *(const f32x4*)(bgate + gc + bj * HALF); bv[bj][1] = *(const f32x4*)(bgate + gc + bj * HALF + 4); }
#pragma unroll
            for (int ai = 0; ai < 2; ++ai)
#pragma unroll
                for (int m = 0; m < 4; ++m) { bf16_t* rowp = gates + (size_t)(row0 + ai * HALF + m * 16) * 8192 + gc;
#pragma unroll
                    for (int bj = 0; bj < 2; ++bj) { f32x4 v0 = acc[ai][bj][m][0] + bv[bj][0], v1 = acc[ai][bj][m][1] + bv[bj][1];
#pragma unroll
                        for (int e = 0; e < 4; ++e) { v0[e] = sigmoid_fast_(v0[e]); v1[e] = sigmoid_fast_(v1[e]); }
                        *(uint4*)(rowp + bj * HALF) = pack8_bf16(v0, v1); } }
        }
    }
};
struct EpiOutproj {
    static constexpr bool PERM = false, AFTER_DRAIN = false;
    const float* R; float* C;
    __device__ __forceinline__ void operator()(const f32x4 (&acc)[2][2][4][2], const Unit& u, int wr, int wc, int fr, int fq) const {
        const int row0 = u.pm * BM + wr * 64 + fr, col0 = u.pn * BM + wc * 32 + 4 * fq;
#pragma unroll
        for (int ai = 0; ai < 2; ++ai) {
            f32x4 rv[4][2][2];
#pragma unroll
            for (int m = 0; m < 4; ++m) { const size_t ro = (size_t)(row0 + ai * HALF + m * 16) * DM_ + col0;
#pragma unroll
                for (int bj = 0; bj < 2; ++bj)
#pragma unroll
                    for (int n = 0; n < 2; ++n) rv[m][bj][n] = *(const f32x4*)(R + ro + bj * HALF + n * 16); }
            __builtin_amdgcn_sched_barrier(0);
#pragma unroll
            for (int m = 0; m < 4; ++m) { const size_t ro = (size_t)(row0 + ai * HALF + m * 16) * DM_ + col0;
#pragma unroll
                for (int bj = 0; bj < 2; ++bj)
#pragma unroll
                    for (int n = 0; n < 2; ++n) *(f32x4*)(C + ro + bj * HALF + n * 16) = rv[m][bj][n] + acc[ai][bj][m][n]; }
            __builtin_amdgcn_sched_barrier(0);
        }
    }
};
struct OneUnit {
    static constexpr bool GATHER = false;
    __device__ __forceinline__ bool next(int i, Unit& u) const { if (i) return false; u.pm = 0; u.pn = 0; u.kz = 0; return true; }
    __device__ __forceinline__ void base(const Gemm& g, const Unit&, const char*& a, const char*& b) const { a = (const char*)g.A; b = (const char*)g.Bt; }
    __device__ __forceinline__ unsigned a_off(const Gemm& g, int R, int C) const { return (unsigned)(R * g.lda + C) * 2u; }
    __device__ __forceinline__ void a_ready(const Unit&) const {}
    __device__ __forceinline__ void done(const Unit&) const {}
};
struct OneUnitGather {
    static constexpr bool GATHER = true;
    const int* idx; int tok0;
    __device__ __forceinline__ bool next(int i, Unit& u) const { if (i) return false; u.pm = 0; u.pn = 0; u.kz = 0; return true; }
    __device__ __forceinline__ void base(const Gemm& g, const Unit&, const char*& a, const char*& b) const { a = (const char*)g.A; b = (const char*)g.Bt; }
    __device__ __forceinline__ unsigned a_off(const Gemm& g, int R, int C) const { return (unsigned)((tok0 + idx[R]) * g.lda + C) * 2u; }
    __device__ __forceinline__ void a_ready(const Unit&) const {}
    __device__ __forceinline__ void done(const Unit&) const {}
};
struct EpiMoeDown {
    static constexpr bool PERM = true, AFTER_DRAIN = false;
    bf16_t* out; const float* gate;
    __device__ __forceinline__ void operator()(const f32x4 (&acc)[2][2][4][2], const Unit&, int wr, int wc, int fr, int fq) const {
        const int row0 = wr * 64 + fr, cb = wc * 32 + 8 * fq;
        float gt[2][4];
#pragma unroll
        for (int ai = 0; ai < 2; ++ai)
#pragma unroll
            for (int m = 0; m < 4; ++m) gt[ai][m] = gate[row0 + ai * HALF + m * 16];
#pragma unroll
        for (int ai = 0; ai < 2; ++ai)
#pragma unroll
            for (int m = 0; m < 4; ++m) { const int r = row0 + ai * HALF + m * 16; bf16_t* rowp = out + (size_t)r * DM_ + cb;
#pragma unroll
                for (int bj = 0; bj < 2; ++bj) *(uint4*)(rowp + bj * HALF) = pack8_bf16(acc[ai][bj][m][0] * gt[ai][m], acc[ai][bj][m][1] * gt[ai][m]); }
    }
};
struct EpiMoeUp {
    static constexpr bool PERM = true, AFTER_DRAIN = false;
    bf16_t* out;
    __device__ __forceinline__ void operator()(const f32x4 (&acc)[2][2][4][2], const Unit&, int wr, int wc, int fr, int fq) const {
        const int row0 = wr * 64 + fr, cb = wc * 32 + 8 * fq;
#pragma unroll
        for (int ai = 0; ai < 2; ++ai)
#pragma unroll
            for (int m = 0; m < 4; ++m) { const int r = row0 + ai * HALF + m * 16;
                f32x4 v0, v1;
#pragma unroll
                for (int e = 0; e < 4; ++e) { v0[e] = silu_fast_(acc[ai][0][m][0][e]) * acc[ai][1][m][0][e]; v1[e] = silu_fast_(acc[ai][0][m][1][e]) * acc[ai][1][m][1][e]; }
                *(uint4*)(out + (size_t)r * DM_ + cb) = pack8_bf16(v0, v1); }
    }
};
struct MergeOrder {
    static constexpr bool GATHER = false;
    int G, c;
    __device__ __forceinline__ unsigned a_off(const Gemm& g, int R, int C) const { return (unsigned)(R * g.lda + C) * 2u; }
    __device__ __forceinline__ bool next(int i, Unit& u) const { const int L = (i >> 2) * G + c; if (L >= 32 * 8) return false; int pm, pn; static_order(L, 32, 8, pm, pn); u.pm = pm; u.pn = pn; u.kz = i & 3; return true; }
    __device__ __forceinline__ void base(const Gemm& g, const Unit& u, const char*& a, const char*& b) const {
        a = (const char*)g.A + ((size_t)u.pm * BM * DM_ + u.kz * 512) * 2; b = (const char*)g.Bt + ((size_t)u.kz * DM_ + u.pn * BM) * 512 * 2; }
    __device__ __forceinline__ void a_ready(const Unit&) const {}
    __device__ __forceinline__ void done(const Unit&) const {}
};
struct EpiMerge {
    static constexpr bool PERM = true, AFTER_DRAIN = false;
    const bf16_t* gates; float* m32; bf16_t* out;
    __device__ __forceinline__ void operator()(const f32x4 (&acc)[2][2][4][2], const Unit& u, int wr, int wc, int fr, int fq) const {
        const int row0 = u.pm * BM + wr * 64 + fr, col0 = u.pn * BM + wc * 32 + 8 * fq;
#pragma unroll
        for (int ai = 0; ai < 2; ++ai)
#pragma unroll
            for (int mp = 0; mp < 2; ++mp) {
                uint4 gv[2][2]; f32x4 pv[2][2][2];
#pragma unroll
                for (int mm = 0; mm < 2; ++mm) { const size_t row = (size_t)(row0 + ai * HALF + (mp * 2 + mm) * 16);
#pragma unroll
                    for (int bj = 0; bj < 2; ++bj) { const int col = col0 + bj * HALF;
                        gv[mm][bj] = *(const uint4*)(gates + row * 8192 + u.kz * DM_ + col);
                        if (u.kz > 0) { const float* mp_ = m32 + row * DM_ + col; pv[mm][bj][0] = *(const f32x4*)mp_; pv[mm][bj][1] = *(const f32x4*)(mp_ + 4); }
                        else { pv[mm][bj][0] = (f32x4){0.f, 0.f, 0.f, 0.f}; pv[mm][bj][1] = (f32x4){0.f, 0.f, 0.f, 0.f}; } } }
                __builtin_amdgcn_sched_barrier(0);
#pragma unroll
                for (int mm = 0; mm < 2; ++mm) { const int m = mp * 2 + mm; const size_t row = (size_t)(row0 + ai * HALF + m * 16);
#pragma unroll
                    for (int bj = 0; bj < 2; ++bj) { const int col = col0 + bj * HALF; const uint4 g4 = gv[mm][bj];
                        f32x4 v0 = acc[ai][bj][m][0], v1 = acc[ai][bj][m][1];
                        v0[0] = v0[0] * __uint_as_float(g4.x << 16) + pv[mm][bj][0][0]; v0[1] = v0[1] * __uint_as_float(g4.x & 0xffff0000u) + pv[mm][bj][0][1];
                        v0[2] = v0[2] * __uint_as_float(g4.y << 16) + pv[mm][bj][0][2]; v0[3] = v0[3] * __uint_as_float(g4.y & 0xffff0000u) + pv[mm][bj][0][3];
                        v1[0] = v1[0] * __uint_as_float(g4.z << 16) + pv[mm][bj][1][0]; v1[1] = v1[1] * __uint_as_float(g4.z & 0xffff0000u) + pv[mm][bj][1][1];
                        v1[2] = v1[2] * __uint_as_float(g4.w << 16) + pv[mm][bj][1][2]; v1[3] = v1[3] * __uint_as_float(g4.w & 0xffff0000u) + pv[mm][bj][1][3];
                        if (u.kz < 3) { float* mp_ = m32 + row * DM_ + col; *(f32x4*)mp_ = v0; *(f32x4*)(mp_ + 4) = v1; }
                        else *(uint4*)(out + row * DM_ + col) = pack8_bf16(v0, v1); } }
                __builtin_amdgcn_sched_barrier(0);
            }
    }
};
struct NoConv { static constexpr bool ON = false;
    __device__ __forceinline__ void load(int, f32x4 (&)[4]) const {}
    __device__ __forceinline__ void store(int, const f32x4 (&)[4]) const {} };
struct PanelConv { static constexpr bool ON = true;
    const float* src; bf16_t* dst;
    __device__ __forceinline__ void load(int it, f32x4 (&v)[4]) const {
#pragma unroll
        for (int r = 0; r < 4; ++r) v[r] = *(const f32x4*)(src + (size_t)(it * 32 + r) * DM_); }
    __device__ __forceinline__ void store(int it, const f32x4 (&v)[4]) const {
#pragma unroll
        for (int i = 0; i < 4; ++i) { uint2 o; o.x = cvt_pk_bf16(v[0][i], v[1][i]); o.y = cvt_pk_bf16(v[2][i], v[3][i]); *(uint2*)(dst + (size_t)i * DM_ + it * 32) = o; } }
};
template <bool DUAL>
__device__ __forceinline__ PanelConv make_panel_conv(const float* w, const float* w3, int col0, int q, bf16_t* panel) {
    const int tid = tid_opaque(), wid = __builtin_amdgcn_readfirstlane(tid >> 6), lane = tid & 63, kq = lane & 7, nl = lane >> 3;
    PanelConv c;
    c.src = (DUAL ? ((wid >> 2) ? w3 : w) + col0 + (wid & 3) * 32 : w + col0 + wid * 32) + nl * 4 + (size_t)(q * 512 + kq * 4) * DM_;
    c.dst = panel + (size_t)(wid * 32 + nl * 4) * DM_ + q * 512 + kq * 4;
    return c;
}
template <class Epi, class Sched, bool STAMP = false, class Conv = NoConv>
__device__ __forceinline__ void gemm_phase(PG8_LAS unsigned char* lds, const Gemm g, const Sched& S, const Epi& E, unsigned long long* stamps, const Conv cv = Conv{}) {
    const int tid = tid_opaque(), wid = __builtin_amdgcn_readfirstlane(tid >> 6), lane = tid & 63, wr = wid >> 2, wc = wid & 3, fr = lane & 15, fq = lane >> 4;
    const int K = g.K, nt = K / BK;
    int ts_lo = 0, ts_hi = 0, nts = 0; const unsigned long long rt_entry = STAMP ? (unsigned long long)wall_clock64() : 0ull;
#define PG8_STAMP() do { if (STAMP && wid == 0 && nts < 64) { const unsigned long long _c = (unsigned long long)clock64(); \
        ts_lo = (lane == nts) ? (int)(unsigned)_c : ts_lo; ts_hi = (lane == nts) ? (int)(unsigned)(_c >> 32) : ts_hi; ++nts; } } while (0)
    PG8_STAMP();
    unsigned voffA[2], voffA1[2], voffB[2];
#pragma unroll
    for (int i = 0; i < 2; ++i) { int R, C; stage_rc(tid * 16 + i * 8192, R, C); const int Rb = Epi::PERM ? ((R & ~31) + perm32(R & 31)) : R;
        voffA[i] = S.a_off(g, R, C); voffA1[i] = Sched::GATHER ? S.a_off(g, R + HALF, C) : voffA[i]; voffB[i] = (unsigned)(Rb * g.ldb + C) * 2u; }
    const size_t kstep = (size_t)(BK * 2);
    const size_t hstepA = Sched::GATHER ? (size_t)0 : (size_t)HALF * g.lda * 2, hstepB = (size_t)HALF * g.ldb * 2;
    const unsigned ldsw = (unsigned)wid * 1024u;
    const int aoff = lds_byte(wr * 64 + fr, fq * 8), boff = lds_byte(wc * 32 + fr, fq * 8);
#define PG8_SA(b, h) (((b) * 2 + (h)) * HTB)
#define PG8_SB(b, h) ((4 + (b) * 2 + (h)) * HTB)
#define PG8_STAGE(bufoff, gbase, voff) do { _Pragma("unroll") for (int _i = 0; _i < 2; ++_i) \
        __builtin_amdgcn_global_load_lds((const unsigned*)((const char*)(gbase) + (voff)[_i]), (PG8_LAS unsigned*)(lds + (bufoff) + ldsw + _i * 8192), 16, 0, 0); } while (0)
#define PG8_LDA(dst, b, h) do { _Pragma("unroll") for (int m = 0; m < 4; ++m) _Pragma("unroll") for (int k = 0; k < 2; ++k) dst[m][k] = *(const PG8_LAS bf16x8*)(lds + PG8_SA(b, h) + aoff + m * 2048 + k * 1024); } while (0)
#define PG8_LDB(dst, b, h) do { _Pragma("unroll") for (int n = 0; n < 2; ++n) _Pragma("unroll") for (int k = 0; k < 2; ++k) dst[n][k] = *(const PG8_LAS bf16x8*)(lds + PG8_SB(b, h) + boff + n * 2048 + k * 1024); } while (0)
#define PG8_MMA(ai, bj, At, Bt) do { __builtin_amdgcn_s_setprio(1); _Pragma("unroll") for (int m = 0; m < 4; ++m) _Pragma("unroll") for (int n = 0; n < 2; ++n) _Pragma("unroll") for (int k = 0; k < 2; ++k) \
        acc[ai][bj][m][n] = __builtin_amdgcn_mfma_f32_16x16x32_bf16(Bt[n][k], At[m][k], acc[ai][bj][m][n], 0, 0, 0); __builtin_amdgcn_s_setprio(0); } while (0)
#define PG8_WAIT_V(n) asm volatile("s_waitcnt vmcnt(" #n ")" ::: "memory")
#define PG8_WAIT_L(n) asm volatile("s_waitcnt lgkmcnt(" #n ")" ::: "memory")
#define PG8_BAR __builtin_amdgcn_s_barrier()
#define PG8_SCHED __builtin_amdgcn_sched_barrier(0)
    Unit cur, nxt; int ui = 0;
    if (!S.next(0, cur)) return;
    f32x4 acc[2][2][4][2];
#pragma unroll
    for (int a = 0; a < 2; ++a)
#pragma unroll
        for (int b = 0; b < 2; ++b)
#pragma unroll
            for (int m = 0; m < 4; ++m)
#pragma unroll
                for (int n = 0; n < 2; ++n) acc[a][b][m][n] = (f32x4){0.f, 0.f, 0.f, 0.f};
    bf16x8 At[4][2], B0[2][2], B1[2][2];
    const char* cA; const char* cB; S.base(g, cur, cA, cB);
    S.a_ready(cur);
    PG8_STAGE(PG8_SB(0, 0), cB, voffB); PG8_STAGE(PG8_SA(0, 0), cA, voffA); PG8_STAGE(PG8_SB(0, 1), cB + hstepB, voffB); PG8_STAGE(PG8_SA(0, 1), cA + hstepA, voffA1);
    if (wr == 1) PG8_BAR;
    PG8_WAIT_V(4); PG8_BAR;
    PG8_STAGE(PG8_SB(1, 0), cB + kstep, voffB); PG8_STAGE(PG8_SA(1, 0), cA + kstep, voffA); PG8_STAGE(PG8_SB(1, 1), cB + hstepB + kstep, voffB);
    PG8_WAIT_V(6); PG8_BAR;
    PG8_STAMP();
    for (;;) {
        const bool has_next = S.next(ui + 1, nxt);
        const char* nA = cA; const char* nB = cB; if (has_next) S.base(g, nxt, nA, nB);
        for (int t = 0; t < nt; t += 2) {
            const bool last = (t == nt - 2);
            const char* a1 = cA + (size_t)(t + 1) * kstep;
            const char* a2 = last ? nA : cA + (size_t)(t + 2) * kstep; const char* b2 = last ? nB : cB + (size_t)(t + 2) * kstep;
            const char* a3 = a2 + kstep; const char* b3 = b2 + kstep;
            if (last && has_next) S.a_ready(nxt);
            f32x4 cvv[4]; if constexpr (Conv::ON) { cv.load(t >> 1, cvv); PG8_SCHED; }
            PG8_LDB(B0, 0, 0); PG8_SCHED; PG8_LDA(At, 0, 0); PG8_STAGE(PG8_SA(1, 1), a1 + hstepA, voffA1);
            PG8_WAIT_L(8); PG8_BAR; PG8_WAIT_L(0); PG8_MMA(0, 0, At, B0); PG8_BAR; PG8_SCHED;
            PG8_LDB(B1, 0, 1); PG8_STAGE(PG8_SB(0, 0), b2, voffB);
            PG8_BAR; PG8_WAIT_L(0); PG8_MMA(0, 1, At, B1); PG8_BAR;
            PG8_LDA(At, 0, 1); PG8_STAGE(PG8_SA(0, 0), a2, voffA);
            PG8_BAR; PG8_WAIT_L(0); PG8_MMA(1, 0, At, B0); PG8_BAR; PG8_SCHED;
            PG8_STAGE(PG8_SB(0, 1), b2 + hstepB, voffB);
            PG8_WAIT_V(6); PG8_BAR; PG8_MMA(1, 1, At, B1); PG8_BAR;
            if constexpr (Conv::ON) { cv.store(t >> 1, cvv); PG8_SCHED; }
            PG8_LDB(B0, 1, 0); PG8_SCHED; PG8_LDA(At, 1, 0); PG8_STAGE(PG8_SA(0, 1), a2 + hstepA, voffA1);
            PG8_WAIT_L(8); PG8_BAR; PG8_WAIT_L(0); PG8_MMA(0, 0, At, B0); PG8_BAR; PG8_SCHED;
            PG8_LDB(B1, 1, 1); PG8_STAGE(PG8_SB(1, 0), b3, voffB);
            PG8_BAR; PG8_WAIT_L(0); PG8_MMA(0, 1, At, B1); PG8_BAR;
            PG8_LDA(At, 1, 1); PG8_STAGE(PG8_SA(1, 0), a3, voffA);
            PG8_BAR; PG8_WAIT_L(0); PG8_MMA(1, 0, At, B0); PG8_BAR; PG8_SCHED;
            PG8_STAGE(PG8_SB(1, 1), b3 + hstepB, voffB);
            PG8_WAIT_V(6); PG8_BAR; PG8_MMA(1, 1, At, B1); PG8_BAR;
        }
        PG8_STAMP();
        if constexpr (!Epi::AFTER_DRAIN) { E(acc, cur, wr, wc, fr, fq); S.done(cur); }
        PG8_STAMP();
        if (!has_next) break;
#pragma unroll
        for (int a = 0; a < 2; ++a)
#pragma unroll
            for (int b = 0; b < 2; ++b)
#pragma unroll
                for (int m = 0; m < 4; ++m)
#pragma unroll
                    for (int n = 0; n < 2; ++n) acc[a][b][m][n] = (f32x4){0.f, 0.f, 0.f, 0.f};
        cur = nxt; cA = nA; cB = nB; ++ui;
    }
    PG8_WAIT_V(0);
    if (wr == 0) PG8_BAR;
    PG8_BAR;
    if constexpr (Epi::AFTER_DRAIN) { E.fused(acc, cur, wr, wc, fr, fq, lds, wid, lane); S.done(cur); }
    PG8_STAMP();
    if (STAMP && wid == 0) { stamps[lane] = lane < nts ? (((unsigned long long)(unsigned)ts_hi << 32) | (unsigned)ts_lo) : 0ull;
        if (lane == 62) stamps[62] = rt_entry; if (lane == 63) stamps[63] = (unsigned long long)wall_clock64(); }
#undef PG8_STAMP
#undef PG8_SA
#undef PG8_SB
#undef PG8_STAGE
#undef PG8_LDA
#undef PG8_LDB
#undef PG8_MMA
#undef PG8_WAIT_V
#undef PG8_WAIT_L
#undef PG8_BAR
#undef PG8_SCHED
}
}
#define XB_TMO      128
#define XB_XCNT(j)  (256  + 64 * (j))
#define XB_XSUB(j)  (1280 + 64 * (j))
#define XB_XGEN(j)  (2304 + 64 * (j))
#define XB_TOP      3328
#define XB_TOPGEN   3392
#define XCD_BAR_WORDS 3456
#define XB_SPIN_CAP (1u << 18)
#define LAS __attribute__((address_space(3)))

__device__ __forceinline__ unsigned xb_ld(unsigned* p)              { return __hip_atomic_load(p, __ATOMIC_RELAXED, __HIP_MEMORY_SCOPE_AGENT); }
__device__ __forceinline__ unsigned xb_add(unsigned* p, unsigned v) { return __hip_atomic_fetch_add(p, v, __ATOMIC_RELAXED, __HIP_MEMORY_SCOPE_AGENT); }
__device__ __forceinline__ unsigned xb_xcc_id() { return (unsigned)__builtin_amdgcn_s_getreg((3 << 11) | 20) & 0xFu; }
#define XB_SPIN(cond, bar) do { unsigned _sp = 0; while (cond) { __builtin_amdgcn_s_sleep(1); \
    if ((++_sp & 255u) == 0u) { if (xb_ld(&(bar)[XB_TMO])) break; if (_sp > XB_SPIN_CAP) { atomicAdd(&(bar)[XB_TMO], 1u); break; } } } } while (0)

struct XcdBarrier {
    unsigned* bar; unsigned x;
    volatile LAS unsigned* st;
};

__device__ __forceinline__ XcdBarrier xcd_barrier_post(unsigned* bar, volatile LAS unsigned* st) {
    XcdBarrier b; b.bar = bar; b.x = xb_xcc_id(); b.st = st;
    if (threadIdx.x == 0) (void)xb_add(&bar[XB_XCNT(b.x)], 1u);
    return b;
}
__device__ __forceinline__ void xcd_barrier_complete(unsigned* bar, unsigned x, unsigned& nloc, unsigned& nx) {
    const unsigned G = gridDim.x * gridDim.y * gridDim.z;
    unsigned sum, cnt, mine, sp = 0u;
    for (;;) {
        sum = 0u; cnt = 0u; mine = 0u;
#pragma unroll
        for (unsigned j = 0; j < 16; ++j) { const unsigned c = xb_ld(&bar[XB_XCNT(j)]); sum += c; cnt += (c > 0u) ? 1u : 0u; mine = (j == x) ? c : mine; }
        if (sum == G) break;
        __builtin_amdgcn_s_sleep(1);
        if ((++sp & 255u) == 0u) { if (xb_ld(&bar[XB_TMO])) break; if (sp > XB_SPIN_CAP) { atomicAdd(&bar[XB_TMO], 1u); break; } }
    }
    nloc = mine > 0u ? mine : 1u; nx = cnt > 0u ? cnt : 1u;
}

__device__ __forceinline__ void xcd_barrier(const XcdBarrier& b) {
    asm volatile("s_waitcnt vmcnt(0)" ::: "memory");
    __syncthreads();
    if (threadIdx.x == 0) {
        unsigned* bar = b.bar; unsigned bx_ = b.x;
        asm volatile("" : "+s"(bar), "+s"(bx_));
        __builtin_amdgcn_s_waitcnt(0);
        unsigned nloc = b.st[0], nx = b.st[1];
        const unsigned old = xb_add(&bar[XB_XSUB(bx_)], 1u);
        const unsigned gen = old / nloc;
        if (old + 1u == (gen + 1u) * nloc) {
            __builtin_amdgcn_fence(__ATOMIC_RELEASE, "agent");
            asm volatile("s_waitcnt vmcnt(0)" ::: "memory");
            const unsigned og = xb_add(&bar[XB_TOP], 1u);
            const unsigned tg = og / nx;
            if (og + 1u == (tg + 1u) * nx) xb_add(&bar[XB_TOPGEN], 1u);
            else XB_SPIN(xb_ld(&bar[XB_TOPGEN]) == tg, bar);
            __builtin_amdgcn_fence(__ATOMIC_ACQUIRE, "agent");
            xb_add(&bar[XB_XGEN(bx_)], 1u);
            asm volatile("s_waitcnt vmcnt(0)" ::: "memory");
        } else {
            XB_SPIN(xb_ld(&bar[XB_XGEN(bx_)]) == gen, bar);
            __builtin_amdgcn_fence(__ATOMIC_ACQUIRE, "agent");
            asm volatile("s_waitcnt vmcnt(0)" ::: "memory");
        }
    }
    __syncthreads();
}

enum { X = 0, N1G, WIN, HCW, HCB, FW1, FB1, FW2, FB2, FW3, FB3, FW4, FREQ, HBIAS, LCW, LCB, LWA, LBA, LWX, LBX, LLAM, DLAM, DSUB, SCW, SCB, SDTB, SALOG, SD, SNG, WBR, BG, WOUT,
       N2G, WR, W1, W3, W2, RELB, FING };
struct MP {
    const float* in[39]; float* out; unsigned* bar;
    float* xres; bf16_t* hb; bf16_t* proj; bf16_t* gates; float* dtraw; bf16_t* br; bf16_t* mrg;
    float* fr; float* nrm; unsigned* hpp; bf16_t* vvt; float* hyt; bf16_t* vt;
    float* sumP; float* sumE; bf16_t* sxa; bf16_t* sxT; float* states; float* sdec; bf16_t* sprev;
    float* aff; int* tidx; float* tgat; int* tinv; bf16_t* hid; bf16_t* ybuf;
    bf16_t* wtin; bf16_t* wtbr; bf16_t* wtout; bf16_t* lruwt; float* m32;
    bf16_t* panel; unsigned* grp;
    int ngrid, pad1;
};
typedef const MP __attribute__((address_space(4)))* MPc;
__device__ __forceinline__ MPc params() { MPc q = (MPc)__builtin_amdgcn_kernarg_segment_ptr(); asm volatile("" : "+s"(q)); return q; }
__device__ __forceinline__ int bid_opaque() { int b = (int)__builtin_amdgcn_workgroup_id_x(); asm volatile("" : "+s"(b)); return b; }
__device__ __forceinline__ int grid_n() { return params()->ngrid; }

#define GRP_WORDS 16
#define GRP_COUNT (2 * 384)
template <bool DUAL>
__device__ __forceinline__ void moe_convert(const float* w, const float* w3, int col0, int q, bf16_t* panel) {
    const int tid = tid_opaque(), wid = __builtin_amdgcn_readfirstlane(tid >> 6), lane = tid & 63, kq = lane & 3, ngl = lane >> 2, ksub = wid & 1, grp = wid >> 1;
    const float* src = (DUAL ? ((grp >> 1) ? w3 : w) + col0 + (grp & 1) * 64 : w + col0 + grp * 64) + 4 * ngl + (size_t)(q * 512 + ksub * 32 + kq * 8) * DM_;
    bf16_t* dst = panel + (size_t)(grp * 64 + 4 * ngl) * DM_ + q * 512 + ksub * 32 + kq * 8;
#pragma unroll 1
    for (int ks = 0; ks < 8; ks += 2) {
        f32x4 v[2][8];
#pragma unroll
        for (int u = 0; u < 2; ++u)
#pragma unroll
            for (int r = 0; r < 8; ++r) v[u][r] = *(const f32x4*)(src + (size_t)((ks + u) * 64 + r) * DM_);
#pragma unroll
        for (int u = 0; u < 2; ++u)
#pragma unroll
            for (int i = 0; i < 4; ++i) { uint4 o; o.x = cvt_pk_bf16(v[u][0][i], v[u][1][i]); o.y = cvt_pk_bf16(v[u][2][i], v[u][3][i]); o.z = cvt_pk_bf16(v[u][4][i], v[u][5][i]); o.w = cvt_pk_bf16(v[u][6][i], v[u][7][i]);
                *(uint4*)(dst + (size_t)i * DM_ + (ks + u) * 64) = o; }
    }
}
__device__ __forceinline__ void group_sync(unsigned* cnt, unsigned* bar) {
    asm volatile("s_waitcnt vmcnt(0)" ::: "memory");
    __syncthreads();
    if (threadIdx.x == 0) {
        asm volatile("" : "+s"(cnt), "+s"(bar));
        __builtin_amdgcn_fence(__ATOMIC_RELEASE, "agent");
        asm volatile("s_waitcnt vmcnt(0)" ::: "memory");
        (void)xb_add(cnt, 1u);
        XB_SPIN(xb_ld(cnt) < 4u, bar);
        __builtin_amdgcn_fence(__ATOMIC_ACQUIRE, "agent");
        asm volatile("s_waitcnt vmcnt(0)" ::: "memory");
    }
    __syncthreads();
}
__device__ __forceinline__ void phase_moe_down2(char* shm, MPc p, int l) {
    const int bid = bid_opaque(), x = bid & 7, q = bid >> 3, b = q & 3, gi = q >> 2, ngx = grid_n() >> 5;
    if (q < ngx * 4) {
        if (gi < 16) { const int pair = x * 16 + gi, e = pair >> 3, nt = pair & 7;
            moe_convert<false>(p->in[W2] + ((size_t)l * 16 + e) * DM_ * DM_, nullptr, nt * 256, b, p->panel + (size_t)pair * 256 * DM_); }
        for (int j = gi; j < 16; j += ngx) {
            const int pair = x * 16 + j, e = pair >> 3, nt = pair & 7, z = b * 16 + e;
            bf16_t* panel = p->panel + (size_t)pair * 256 * DM_;
            group_sync(p->grp + (size_t)(l * 384 + 256 + pair) * GRP_WORDS, p->bar);
            const pg8::Gemm gg{p->hid + (size_t)z * 256 * DM_, panel, 256, 256, DM_, DM_, DM_}; const pg8::OneUnit so{}; const pg8::EpiMoeDown ep{p->ybuf + (size_t)z * 256 * DM_ + nt * 256, p->tgat + z * 256};
            if (j + ngx < 16) {
                const int pair2 = pair + ngx, e2 = pair2 >> 3, nt2 = pair2 & 7;
                const pg8::PanelConv cv = pg8::make_panel_conv<false>(p->in[W2] + ((size_t)l * 16 + e2) * DM_ * DM_, nullptr, nt2 * 256, b, p->panel + (size_t)pair2 * 256 * DM_);
                pg8::gemm_phase<pg8::EpiMoeDown, pg8::OneUnit, false, pg8::PanelConv>((PG8_LAS unsigned char*)shm, gg, so, ep, nullptr, cv);
            } else pg8::gemm_phase<pg8::EpiMoeDown, pg8::OneUnit, false>((PG8_LAS unsigned char*)shm, gg, so, ep, nullptr);
        }
    }
}
__device__ __forceinline__ void phase_moe_up2(char* shm, MPc p, int l) {
    const int bid = bid_opaque(), x = bid & 7, q = bid >> 3, b = q & 3, gi = q >> 2, ngx = grid_n() >> 5;
    if (q < ngx * 4)
    for (int j = gi; j < 32; j += ngx) {
        const int pair = x * 32 + j, e = pair >> 4, nt = pair & 15, z = b * 16 + e;
        bf16_t* panel = p->panel + (size_t)pair * 256 * DM_;
        moe_convert<true>(p->in[W1] + ((size_t)l * 16 + e) * DM_ * DM_, p->in[W3] + ((size_t)l * 16 + e) * DM_ * DM_, nt * 128, b, panel);
        group_sync(p->grp + (size_t)(l * 384 + pair) * GRP_WORDS, p->bar);
        const pg8::Gemm gg{p->hb, panel, 256, 256, DM_, DM_, DM_}; const pg8::OneUnitGather so{p->tidx + z * 256, b * SEQ_}; const pg8::EpiMoeUp ep{p->hid + (size_t)z * 256 * DM_ + nt * 128};
        pg8::gemm_phase<pg8::EpiMoeUp, pg8::OneUnitGather, false>((PG8_LAS unsigned char*)shm, gg, so, ep, nullptr);
    }
}
#ifndef MERGE_PG8
#define MERGE_PG8 0
#endif
#ifndef MOE_DOWN2
#define MOE_DOWN2 0
#endif
#define MEGA_LDS (139264 + 1024)
#define NPH 12

template <int MODE>
__device__ __forceinline__ void phase_norm(char* shm, MPc p, int l) {
    float* hrow = (float*)shm;
    float* red = (float*)(shm + 65536);
    float wreg[64];
    if (MODE != 2) {
        const float* W = MODE == 0 ? p->in[WIN] + (size_t)l * DM_ * INC_ + PROJW : p->in[WR] + (size_t)l * DM_ * 16;
        const int ldw = MODE == 0 ? INC_ : 16; const int t0_ = tid_opaque(), e = t0_ & 15, part = t0_ >> 4;
#pragma unroll
        for (int kk = 0; kk < 64; ++kk) wreg[kk] = W[(size_t)(part * 64 + kk) * ldw + e];
    }
    f32x4 vn[8]; int slotn = -1;
    { const int it0 = bid_opaque(), t0_ = tid_opaque(), tok0 = it0 * 8 + (t0_ >> 6), ln0 = t0_ & 63; const float* xin = (MODE == 0 && l == 0) ? p->in[X] : p->xres;
      if (it0 < TT_ / 8) {
#pragma unroll
          for (int i = 0; i < 8; ++i) vn[i] = *(const f32x4*)(xin + (size_t)tok0 * DM_ + (i * 64 + ln0) * 4);
          if (MODE == 2 || (MODE == 0 && l > 0)) slotn = ln0 < 16 ? p->tinv[tok0 * 16 + ln0] : -1; } }
    for (int it = bid_opaque(); it < TT_ / 8; it += grid_n()) {
        const int tid = tid_opaque(), wid = tid >> 6, lane = tid & 63;
        const int tok = it * 8 + wid, b = tok >> 11;
        const float* xin = (MODE == 0 && l == 0) ? p->in[X] : p->xres;
        f32x4 v[8];
#pragma unroll
        for (int i = 0; i < 8; ++i) v[i] = vn[i];
        const int myslot_cur = slotn;
        { const int itn = it + grid_n(), tokn = itn * 8 + wid;
          if (itn < TT_ / 8) {
#pragma unroll
              for (int i = 0; i < 8; ++i) vn[i] = *(const f32x4*)(xin + (size_t)tokn * DM_ + (i * 64 + lane) * 4);
              if (MODE == 2 || (MODE == 0 && l > 0)) slotn = lane < 16 ? p->tinv[tokn * 16 + lane] : -1; } }
        const float* g = MODE == 0 ? p->in[N1G] + l * DM_ : (MODE == 1 ? p->in[N2G] + l * DM_ : p->in[FING]);
        f32x4 gv[8];
#pragma unroll
        for (int i = 0; i < 8; ++i) gv[i] = *(const f32x4*)(g + (i * 64 + lane) * 4);
        if (MODE == 2 || (MODE == 0 && l > 0)) {
            const int myslot = myslot_cur;
            unsigned long long em = __ballot(myslot >= 0);
            while (em) {
                const int e = __builtin_ctzll(em); em &= em - 1;
                const int slot = __shfl(myslot, e, 64);
                const bf16_t* yr = p->ybuf + ((size_t)(b * 16 + e) * 256 + slot) * DM_;
                uint2 y[8];
#pragma unroll
                for (int i = 0; i < 8; ++i) y[i] = *(const uint2*)(yr + (i * 64 + lane) * 4);
#pragma unroll
                for (int i = 0; i < 8; ++i) { v[i][0] += __uint_as_float(y[i].x << 16); v[i][1] += __uint_as_float(y[i].x & 0xffff0000u); v[i][2] += __uint_as_float(y[i].y << 16); v[i][3] += __uint_as_float(y[i].y & 0xffff0000u); }
            }
        }
        float ss = 0.f;
#pragma unroll
        for (int i = 0; i < 8; ++i) ss += v[i][0] * v[i][0] + v[i][1] * v[i][1] + v[i][2] * v[i][2] + v[i][3] * v[i][3];
#pragma unroll
        for (int o = 32; o > 0; o >>= 1) ss += __shfl_xor(ss, o, 64);
        const float rs = rsqrtf(ss * (1.0f / DM_) + 1e-6f);
        if (MODE != 2) __syncthreads();
#pragma unroll
        for (int i = 0; i < 8; ++i) {
            const int c = (i * 64 + lane) * 4;
            const f32x4 y = (f32x4){v[i][0] * rs * gv[i][0], v[i][1] * rs * gv[i][1], v[i][2] * rs * gv[i][2], v[i][3] * rs * gv[i][3]};
            if (MODE == 0 && l > 0) *(f32x4*)(p->xres + (size_t)tok * DM_ + c) = v[i];
            if (MODE == 2) *(f32x4*)(p->out + (size_t)tok * DM_ + c) = y;
            else {
                uint2 o; o.x = cvt_pk_bf16(y[0], y[1]); o.y = cvt_pk_bf16(y[2], y[3]);
                *(uint2*)(p->hb + (size_t)tok * DM_ + c) = o;
                *(f32x4*)(hrow + wid * DM_ + c) = y;
            }
        }
        if (MODE != 2) {
            __syncthreads();
            const int e = tid & 15, part = tid >> 4;
            float acc[8] = {0.f, 0.f, 0.f, 0.f, 0.f, 0.f, 0.f, 0.f};
#pragma unroll
            for (int kk = 0; kk < 64; kk += 4) {
#pragma unroll
                for (int t = 0; t < 8; ++t) { const f32x4 hv = *(const f32x4*)(hrow + t * DM_ + part * 64 + kk);
                    acc[t] += hv[0] * wreg[kk]; acc[t] += hv[1] * wreg[kk + 1]; acc[t] += hv[2] * wreg[kk + 2]; acc[t] += hv[3] * wreg[kk + 3]; }
            }
#pragma unroll
            for (int t = 0; t < 8; ++t) red[(t * 32 + part) * 16 + e] = acc[t];
            __syncthreads();
            if (tid < 128) {
                const int tl = tid >> 4, e2 = tid & 15; float s = 0.f;
                for (int q = 0; q < 32; ++q) s += red[(tl * 32 + q) * 16 + e2];
                const int tk = it * 8 + tl;
                if (MODE == 0) p->dtraw[(size_t)tk * 16 + e2] = s;
                else {
                    float m = s;
#pragma unroll
                    for (int o = 8; o > 0; o >>= 1) m = fmaxf(m, __shfl_xor(m, o, 64));
                    const float ex = expf(s - m); float z = ex;
#pragma unroll
                    for (int o = 8; o > 0; o >>= 1) z += __shfl_xor(z, o, 64);
                    p->aff[(size_t)tk * 16 + e2] = ex / z;
                }
            }
        }
    }
}
__device__ __forceinline__ int block_sum_512(int v, volatile int* red  , int par, int tid) {
#pragma unroll
    for (int o = 32; o > 0; o >>= 1) v += __shfl_xor(v, o, 64);
    if ((tid & 63) == 0) red[par * 8 + (tid >> 6)] = v;
    __syncthreads();
    int s = 0;
#pragma unroll
    for (int w = 0; w < 8; ++w) s += red[par * 8 + w];
    return s;
}
__device__ __forceinline__ int block_exscan_512(int v, volatile int* wsum  , int tid) {
    int inc = v;
#pragma unroll
    for (int o = 1; o < 64; o <<= 1) { const int n = __shfl_up(inc, o, 64); if ((tid & 63) >= o) inc += n; }
    if ((tid & 63) == 63) wsum[tid >> 6] = inc;
    __syncthreads();
    int base = 0;
#pragma unroll
    for (int w = 0; w < 8; ++w) base += (w < (tid >> 6)) ? wsum[w] : 0;
    __syncthreads();
    return base + inc - v;
}
__device__ __forceinline__ void phase_topk(char* shm, MPc p) {
    volatile int* red = (volatile int*)shm;
    volatile int* wsum = red + 16;
    for (int z = bid_opaque(); z < 64; z += grid_n()) {
        const int b = z >> 4, e = z & 15, tid = tid_opaque();
        __syncthreads();
        float v[4]; unsigned u[4];
#pragma unroll
        for (int i = 0; i < 4; ++i) { v[i] = p->aff[(size_t)(b * SEQ_ + tid * 4 + i) * 16 + e]; u[i] = __float_as_uint(v[i]); }
        unsigned T = 0u;
        for (int bit = 30; bit >= 0; --bit) {
            const unsigned cand = T | (1u << bit);
            const int c = block_sum_512((u[0] >= cand) + (u[1] >= cand) + (u[2] >= cand) + (u[3] >= cand), red, bit & 1, tid);
            if (c >= 256) T = cand;
        }
        __syncthreads();
        const int ngt = block_sum_512((u[0] > T) + (u[1] > T) + (u[2] > T) + (u[3] > T), red, 0, tid);
        const int need = 256 - ngt;
        __syncthreads();
        const int eq_l = (u[0] == T) + (u[1] == T) + (u[2] == T) + (u[3] == T);
        int eqr = block_exscan_512(eq_l, wsum, tid);
        int sel[4], nsel = 0;
#pragma unroll
        for (int i = 0; i < 4; ++i) { const bool isq = u[i] == T; sel[i] = (u[i] > T) || (isq && eqr < need); eqr += isq ? 1 : 0; nsel += sel[i]; }
        int slot = block_exscan_512(nsel, wsum, tid);
#pragma unroll
        for (int i = 0; i < 4; ++i) {
            const int t = tid * 4 + i;
            if (sel[i]) { p->tidx[z * 256 + slot] = t; p->tgat[z * 256 + slot] = v[i]; }
            p->tinv[(b * SEQ_ + t) * 16 + e] = sel[i] ? slot : -1;
            slot += sel[i];
        }
    }
}
__device__ __forceinline__ void phase_hy_filter(char* shm, MPc p) {
    float* zz = (float*)shm; float* ha = zz + 8 * 64; float* hbq = ha + 8 * 64;
    for (int u = bid_opaque(); u < 512; u += grid_n()) {
        const int lf = u >> 8, tid = tid_opaque(), wid = tid >> 6, o = tid & 63, i = (u & 255) * 8 + wid;
        const float* fw1 = p->in[FW1] + lf * 33 * 64; const float* fw2 = p->in[FW2] + lf * 4096; const float* fw3 = p->in[FW3] + lf * 4096; const float* fw4 = p->in[FW4] + lf * 64 * 512;
        const float t = (float)i / (float)(SEQ_ - 1);
        const float w = (2.0f * 3.14159265358979323846f / (float)SEQ_) * (float)i;
        __syncthreads();
        if (o == 0) zz[wid * 64] = t;
        if (o < 16) { const float band = 1e-4f + (float)o * ((15.0f - 1e-4f) / 15.0f); zz[wid * 64 + 1 + o] = __cosf(band * w); zz[wid * 64 + 17 + o] = -__sinf(band * w); }
        __syncthreads();
        const float fq = p->in[FREQ][lf * 64 + o];
        float s = p->in[FB1][lf * 64 + o];
        for (int k = 0; k < 33; ++k) s += zz[wid * 64 + k] * fw1[k * 64 + o];
        ha[wid * 64 + o] = __sinf(fq * s);
        __syncthreads();
        s = p->in[FB2][lf * 64 + o];
        for (int k = 0; k < 64; ++k) s += ha[wid * 64 + k] * fw2[k * 64 + o];
        hbq[wid * 64 + o] = __sinf(fq * s);
        __syncthreads();
        s = p->in[FB3][lf * 64 + o];
        for (int k = 0; k < 64; ++k) s += hbq[wid * 64 + k] * fw3[k * 64 + o];
        __syncthreads();
        ha[wid * 64 + o] = __sinf(fq * s);
        __syncthreads();
        { const float d0 = logf(1e-2f) / 1.5f, d1 = logf(1e-2f) / 0.3f;
          const int c = tid;
          float a8[8] = {0.f, 0.f, 0.f, 0.f, 0.f, 0.f, 0.f, 0.f};
          for (int k = 0; k < 64; ++k) { const float wv = fw4[k * 512 + c];
#pragma unroll
              for (int q = 0; q < 8; ++q) a8[q] += ha[q * 64 + k] * wv; }
          const float delta = fabsf(d0 + (float)c * ((d1 - d0) / 511.0f));
#pragma unroll
          for (int q = 0; q < 8; ++q) { const int iq = (u & 255) * 8 + q; const float tq = (float)iq / (float)(SEQ_ - 1);
              p->fr[((size_t)lf * SEQ_ + iq) * 512 + c] = a8[q] * __expf(-2.0f * fabsf(tq - 0.5f) * delta); } }
    }
}
__device__ __forceinline__ void phase_hy_norm(MPc p) {
    for (int u = bid_opaque(); u < 128; u += grid_n()) {
        const int tid = tid_opaque(), pr = u * 8 + (tid >> 6), lane = tid & 63, lf = pr >> 9, c = pr & 511;
        float s = 0.f;
        for (int q = 0; q < 32; ++q) s += fabsf(p->fr[((size_t)lf * SEQ_ + lane + 64 * q) * 512 + c]);
#pragma unroll
        for (int o = 32; o > 0; o >>= 1) s += __shfl_xor(s, o, 64);
        if (lane == 0) p->nrm[pr] = s;
    }
}

__device__ __forceinline__ GP mk_gp(MPc p, int l, int which) {
    GP g{};
    if (which == 0) { g.A = p->hb; g.Bt = p->wtin + (size_t)l * 13824 * DM_; g.bias = p->in[BG] + (size_t)l * 4 * DM_; g.Cb = p->proj; g.Cb2 = p->gates; g.Vt = p->vt; }
    if (which == 1) { g.A = p->br; g.Bt = p->wtbr + (size_t)l * 4 * DM_ * 512; g.G = p->gates; g.Cb = p->mrg; }
    if (which == 2) { g.A = p->mrg; g.Bt = p->wtout + (size_t)l * DM_ * DM_; g.R = l == 0 ? p->in[X] : p->xres; g.Cf = p->xres; }
    if (which == 3) { g.A = p->hb; g.B = p->in[W1] + (size_t)l * 16 * DM_ * DM_; g.B2 = p->in[W3] + (size_t)l * 16 * DM_ * DM_; g.idx = p->tidx; g.Cb = p->hid; }
    if (which == 4) { g.A = p->hid; g.B = p->in[W2] + (size_t)l * 16 * DM_ * DM_; g.gate = p->tgat; g.Cb = p->ybuf; }
    return g;
}
__device__ __forceinline__ HP mk_hp(MPc p, int l) {
    HP h{}; h.proj = p->proj; h.fr = p->fr + (size_t)l * SEQ_ * 512; h.nrm = p->nrm + l * 512; h.pp = p->hpp + (size_t)l * 512 * HY_PPW; h.vvt = p->vvt; h.yt = p->hyt;
    h.cw = p->in[HCW] + l * 3 * 1536; h.cb = p->in[HCB] + l * 1536; h.hbias = p->in[HBIAS] + l * 512; h.br = p->br; return h;
}
__device__ __forceinline__ LP mk_lp(MPc p, int l) {
    LP q{}; q.proj = p->proj; q.cw = p->in[LCW] + l * 4 * 512; q.cb = p->in[LCB] + l * 512; q.wt = p->lruwt + (size_t)l * 8 * 256 * 64; q.ba = p->in[LBA] + l * 1024;
    q.bx = p->in[LBX] + l * 1024; q.lam = p->in[LLAM] + l * 1024; q.sumP = p->sumP; q.sumE = p->sumE; q.br = p->br; return q;
}
__device__ __forceinline__ SP_ mk_sp(MPc p, int l) {
    SP_ s{}; s.proj = p->proj; s.dtraw = p->dtraw; s.cw = p->in[SCW] + l * 4 * 1024; s.cb = p->in[SCB] + l * 1024; s.dtb = p->in[SDTB] + l * 16; s.a_log = p->in[SALOG] + l * 16; s.dsk = p->in[SD] + l * 8; s.ng = p->in[SNG] + l * 512;
    s.xa = p->sxa; s.xT = p->sxT; s.states = p->states; s.decay = p->sdec; s.prev = p->sprev; s.br = p->br; return s;
}
__device__ __forceinline__ AP mk_ap(MPc p, int l) {
    AP a{}; a.proj = p->proj; a.vt = p->vt; a.rel_bias = p->in[RELB]; a.dlam = p->in[DLAM] + l * 256; a.subg = p->in[DSUB] + l * 128; a.br = p->br; a.lam_init = l == 0 ? 0.2f : 0.35550906759096926f; return a;
}
__device__ __forceinline__ void wconv_tile(float* tile, const float* src, size_t ld_src, bf16_t* dst, size_t ld_dst, int tid) {
    __syncthreads();
    { const int kr = tid >> 4, n4 = (tid & 15) * 4;
#pragma unroll
      for (int h = 0; h < 2; ++h) { const f32x4 v = *(const f32x4*)(src + (size_t)(kr + 32 * h) * ld_src + n4); float* t = tile + (kr + 32 * h) * 65 + n4; t[0] = v[0]; t[1] = v[1]; t[2] = v[2]; t[3] = v[3]; } }
    __syncthreads();
    { const int n = tid >> 3, k8 = (tid & 7) * 8; const float* t = tile + k8 * 65 + n;
      uint4 o; o.x = cvt_pk_bf16(t[0], t[65]); o.y = cvt_pk_bf16(t[130], t[195]); o.z = cvt_pk_bf16(t[260], t[325]); o.w = cvt_pk_bf16(t[390], t[455]);
      *(uint4*)(dst + (size_t)n * ld_dst + k8) = o; }
}
__device__ __forceinline__ void phase_wconv(char* shm, MPc p, int l, int bw0, int bwn) {
    const int bq = bid_opaque() - bw0; if (bq < 0 || bq >= bwn) return;
    for (int e0 = bq * 512 + tid_opaque(); e0 < 8 * 256 * 64; e0 += bwn * 512) {
        const int e = l * 8 * 256 * 64 + e0; const int i = e & 63, n = (e >> 6) & 255, h = (e >> 14) & 7, j = n & 63, g = (n >> 6) & 1, dir = n >> 7;
        const float* w = (g ? p->in[LWX] : p->in[LWA]) + ((size_t)((l * 2 + dir) * 8 + h) * 64 + i) * 64 + j;
        p->lruwt[e] = f2bf(*w);
    }
    float* tile = (float*)shm;
    const int NJ_IN = 32 * 216, NJ_BR = 4 * 8 * 32, NJ_OUT = 32 * 32, NJ = NJ_IN + NJ_BR + NJ_OUT;
    for (int u = bq; u < NJ; u += bwn) {
        int j = u; const int tid = tid_opaque();
        if (j < NJ_IN) { const int nt = j % 216, kt = j / 216, n0 = nt * 64, ns = n0 < PROJW ? n0 : n0 + 16;
            wconv_tile(tile, p->in[WIN] + (size_t)l * DM_ * INC_ + (size_t)kt * 64 * INC_ + ns, INC_, p->wtin + ((size_t)l * 13824 + n0) * DM_ + kt * 64, DM_, tid); }
        else if (j < NJ_IN + NJ_BR) { j -= NJ_IN; const int nt = j & 31, kt = (j >> 5) & 7, k = j >> 8;
            wconv_tile(tile, p->in[WBR] + ((size_t)(l * 4 + k) * 512 + kt * 64) * DM_ + nt * 64, DM_, p->wtbr + (((size_t)(l * 4 + k) * DM_) + nt * 64) * 512 + kt * 64, 512, tid); }
        else { j -= NJ_IN + NJ_BR; const int nt = j & 31, kt = j >> 5;
            wconv_tile(tile, p->in[WOUT] + ((size_t)l * DM_ + kt * 64) * DM_ + nt * 64, DM_, p->wtout + ((size_t)l * DM_ + nt * 64) * DM_ + kt * 64, DM_, tid); }
    }
}
#define PH_ON(id) (ONLY < 0 || ONLY == (id))
#define PH_SYNC(id) do { if (ONLY < 0) xcd_barrier(bar); } while (0)
template <int ONLY>
__global__ void __launch_bounds__(512, 2) k_mega(MP p_unused) {
    extern __shared__ __attribute__((aligned(1024))) char shm[];
    XcdBarrier bar{};
    if (ONLY < 0) {
        volatile LAS unsigned* xbw = (volatile LAS unsigned*)(shm + MEGA_LDS - 16);
        if (threadIdx.x == 0) { xbw[0] = 0u; xbw[1] = 0u; }
        __syncthreads();
        bar = xcd_barrier_post(params()->bar, xbw);
        if (threadIdx.x == 0) { unsigned nloc, nx; xcd_barrier_complete(bar.bar, bar.x, nloc, nx); xbw[0] = nloc; xbw[1] = nx; }
        __syncthreads();
    }
    constexpr int L0 = ONLY < 0 ? 0 : (ONLY >= 2 * NPH ? 2 : ONLY / NPH), L1 = ONLY < 0 ? 2 : (ONLY >= 2 * NPH ? 2 : ONLY / NPH + 1);
#pragma unroll 1
    for (int l = L0; l < L1; ++l) {
        const int id0 = l * NPH;
        if (PH_ON(id0 + 0)) { phase_norm<0>(shm, params(), l); if (l == 0) { phase_hy_filter(shm, params()); phase_wconv(shm, params(), 0, 0, grid_n()); } }
        PH_SYNC(id0 + 0);
        if (PH_ON(id0 + 1)) { if (l == 0) phase_hy_norm(params()); const GP g = mk_gp(params(), l, 0);
            const pg8::Gemm gg{g.A, g.Bt, TT_, 13824, DM_, DM_, DM_}; const pg8::MegaOrder so{32, 54, grid_n(), bid_opaque()}; const pg8::EpiInproj ep{g.Cb, g.Cb2, g.Vt, g.bias};
            pg8::gemm_phase<pg8::EpiInproj, pg8::MegaOrder, false>((PG8_LAS unsigned char*)shm, gg, so, ep, nullptr); }
        PH_SYNC(id0 + 1);
        if (PH_ON(id0 + 2)) {
            { const AP a = mk_ap(params(), l); phase_attn(shm, a); }
            if (l == 0) { const HP h0 = mk_hp(params(), 0); phase_hy_pp(h0); const HP h1 = mk_hp(params(), 1); phase_hy_pp(h1); }
            { const HP h = mk_hp(params(), l); phase_hy_prep(shm, h); }
            { const SP_ s = mk_sp(params(), l); phase_ssd_prep(shm, s); }
            { const LP q = mk_lp(params(), l); phase_lru<0>(shm, q); }
        }
        PH_SYNC(id0 + 2);
        if (PH_ON(id0 + 3)) {
            { const HP h = mk_hp(params(), l); phase_hy_conv(shm, h); }
            { const SP_ s = mk_sp(params(), l); phase_ssd_states(shm, s); }
            { const LP q = mk_lp(params(), l); phase_lru<1>(shm, q); }
        }
        PH_SYNC(id0 + 3);
        if (PH_ON(id0 + 4)) { const SP_ s = mk_sp(params(), l); phase_ssd_scan(s); }
        PH_SYNC(id0 + 4);
        if (PH_ON(id0 + 5)) { { const SP_ s = mk_sp(params(), l); phase_ssd_out(shm, s); }
            { const HP h = mk_hp(params(), l); phase_hy_fin(shm, h, 0, grid_n()); }
            if (l == 0) phase_wconv(shm, params(), 1, 0, grid_n()); }
        PH_SYNC(id0 + 5);
#if MERGE_PG8
        if (PH_ON(id0 + 6)) { const GP g = mk_gp(params(), l, 1);
            const pg8::Gemm gg{g.A, g.Bt, TT_, DM_, 512, DM_, 512}; const pg8::MergeOrder so{grid_n(), bid_opaque()}; const pg8::EpiMerge ep{g.G, params()->m32, g.Cb};
            pg8::gemm_phase<pg8::EpiMerge, pg8::MergeOrder, false>((PG8_LAS unsigned char*)shm, gg, so, ep, nullptr); }
#else
        if (PH_ON(id0 + 6)) { const GP g = mk_gp(params(), l, 1); phase_merge(shm, g); }
#endif
        PH_SYNC(id0 + 6);
        if (PH_ON(id0 + 7)) { const GP g = mk_gp(params(), l, 2);
            const pg8::Gemm gg{g.A, g.Bt, TT_, DM_, DM_, DM_, DM_}; const pg8::MegaOrder so{32, 8, grid_n(), bid_opaque()}; const pg8::EpiOutproj ep{g.R, g.Cf};
            pg8::gemm_phase<pg8::EpiOutproj, pg8::MegaOrder, false>((PG8_LAS unsigned char*)shm, gg, so, ep, nullptr); }
        PH_SYNC(id0 + 7);
        if (PH_ON(id0 + 8)) phase_norm<1>(shm, params(), l);
        PH_SYNC(id0 + 8);
        if (PH_ON(id0 + 9)) phase_topk(shm, params());
        PH_SYNC(id0 + 9);
        if (PH_ON(id0 + 10)) { const GP g = mk_gp(params(), l, 3); phase_moe_up(shm, g); }
        PH_SYNC(id0 + 10);
        #if MOE_DOWN2
        if (PH_ON(id0 + 11)) phase_moe_down2(shm, params(), l);
#else
        if (PH_ON(id0 + 11)) { const GP g = mk_gp(params(), l, 4); phase_moe_down(shm, g); }
#endif
        PH_SYNC(id0 + 11);
    }
    if (PH_ON(2 * NPH)) phase_norm<2>(shm, params(), 0);
}
template <int I> struct PhaseLauncher { static void go(int grid, hipStream_t st, const MP& p) { (void)hipFuncSetAttribute((const void*)k_mega<I>, hipFuncAttributeMaxDynamicSharedMemorySize, MEGA_LDS); hipLaunchKernelGGL(k_mega<I>, dim3(grid), dim3(512), MEGA_LDS, st, p); PhaseLauncher<I + 1>::go(grid, st, p); } };
template <> struct PhaseLauncher<2 * NPH + 1> { static void go(int, hipStream_t, const MP&) {} };

#ifndef MK_N_LAUNCHES
#define MK_N_LAUNCHES 1
#endif
extern "C" void kernel_launch(void* const* d_in, const int* in_sizes, int n_in, void* d_out, int out_size, void* d_ws, size_t ws_size, hipStream_t stream) {
    static int grid = 0;
    if (grid == 0) {
        int dev = 0, cus = 0;
        if (hipGetDevice(&dev) != hipSuccess || hipDeviceGetAttribute(&cus, hipDeviceAttributeMultiprocessorCount, dev) != hipSuccess) { fprintf(stderr, "kernel_launch: device query failed\n"); grid = -1; return; }
        if (hipFuncSetAttribute((const void*)k_mega<-1>, hipFuncAttributeMaxDynamicSharedMemorySize, MEGA_LDS) != hipSuccess) { fprintf(stderr, "kernel_launch: hipFuncSetAttribute failed\n"); grid = -1; return; }
        (void)hipGetLastError();
        grid = cus;
    }
    if (grid < 0) return;
    char* w = (char*)d_ws; size_t off = 0;
    auto alloc = [&](size_t bytes) { void* q = w + off; off += (bytes + 255) & ~(size_t)255; return q; };
    MP p{};
    for (int i = 0; i < 39; ++i) p.in[i] = (const float*)d_in[i];
    p.out = (float*)d_out; p.ngrid = grid;
    p.bar = (unsigned*)alloc(XCD_BAR_WORDS * 4 + GRP_COUNT * GRP_WORDS * 4); p.grp = p.bar + XCD_BAR_WORDS;
    p.panel = (bf16_t*)alloc((size_t)256 * 256 * DM_ * 2);
    p.xres = (float*)alloc((size_t)TT_ * DM_ * 4);
    p.hb = (bf16_t*)alloc((size_t)TT_ * DM_ * 2);
    p.proj = (bf16_t*)alloc((size_t)TT_ * PROJW * 2);
    p.gates = (bf16_t*)alloc((size_t)TT_ * 8192 * 2);
    p.dtraw = (float*)alloc((size_t)TT_ * 16 * 4);
    p.br = (bf16_t*)alloc((size_t)TT_ * DM_ * 2);
    p.mrg = (bf16_t*)alloc((size_t)TT_ * DM_ * 2);
    p.fr = (float*)alloc((size_t)2 * SEQ_ * 512 * 4);
    p.nrm = (float*)alloc(2 * 512 * 4);
    p.hpp = (unsigned*)alloc((size_t)2 * 512 * HY_PPW * 4);
    p.vvt = (bf16_t*)alloc((size_t)512 * NB_ * SEQ_ * 2);
    p.hyt = (float*)alloc((size_t)512 * NB_ * SEQ_ * 4);
    p.vt = (bf16_t*)alloc((size_t)NB_ * 512 * SEQ_ * 2);
    p.sumP = (float*)alloc((size_t)2 * NB_ * 32 * 512 * 4);
    p.sumE = (float*)alloc((size_t)2 * NB_ * 32 * 512 * 4);
    p.sxa = (bf16_t*)alloc((size_t)TT_ * 1024 * 2);
    p.sxT = (bf16_t*)alloc((size_t)TT_ * 1024 * 2);
    p.states = (float*)alloc((size_t)NB_ * SSD_NC * 16 * 64 * 128 * 4);
    p.sdec = (float*)alloc(NB_ * SSD_NC * 16 * 4);
    p.sprev = (bf16_t*)alloc((size_t)NB_ * SSD_NC * 16 * 64 * 128 * 2);
    p.aff = (float*)alloc((size_t)TT_ * 16 * 4);
    p.tidx = (int*)alloc(64 * 256 * 4);
    p.tgat = (float*)alloc(64 * 256 * 4);
    p.tinv = (int*)alloc((size_t)TT_ * 16 * 4);
    p.hid = (bf16_t*)alloc((size_t)64 * 256 * DM_ * 2);
    p.ybuf = (bf16_t*)alloc((size_t)64 * 256 * DM_ * 2);
    p.wtin = (bf16_t*)alloc((size_t)2 * 13824 * DM_ * 2);
    p.wtbr = (bf16_t*)alloc((size_t)2 * 4 * DM_ * 512 * 2);
    p.wtout = (bf16_t*)alloc((size_t)2 * DM_ * DM_ * 2);
    p.lruwt = (bf16_t*)alloc((size_t)2 * 8 * 256 * 64 * 2);
    p.m32 = (float*)alloc((size_t)TT_ * DM_ * 4);
    if (off > ws_size) { fprintf(stderr, "kernel_launch: workspace too small (%zu > %zu)\n", off, ws_size); return; }
    (void)hipMemsetAsync(p.bar, 0, XCD_BAR_WORDS * 4 + GRP_COUNT * GRP_WORDS * 4, stream);
#if MK_N_LAUNCHES == 1
    hipLaunchKernelGGL(k_mega<-1>, dim3(grid), dim3(512), MEGA_LDS, stream, p);
#else
    PhaseLauncher<0>::go(grid, stream, p);
#endif
}
```
